# Optimizing an MI355X kernel written in HIP

```python
import math
import jax, jax.numpy as jnp
from jax import lax
import numpy as np

D_MODEL = 1024
BATCH = 4
SEQ = 4096
DEPTH = 2

N_META = 16
EPS = 1e-6
ATT_HEADS = 4
ATT_QK_DIM = 64
ATT_V_DIM = 2 * ATT_QK_DIM
ATT_QK_COLS = 2 * ATT_HEADS * ATT_QK_DIM
ATT_WIDTH = ATT_HEADS * ATT_V_DIM
Q_BLOCK = 128
REL_BUCKETS = 32
REL_MAX_DIST = 128
CONV_WIDTH = 512
CONV_K = 3
HGRN_HEADS = 4
HGRN_DK = 128
HGRN_DV = 128
HGRN_WIDTH = HGRN_HEADS * HGRN_DV
HGRN_CHUNK = 64
N_BRANCH = 3
BRANCH_WIDTH = 512
IN_SPLITS = (ATT_QK_COLS, ATT_QK_COLS, ATT_WIDTH,
             CONV_WIDTH, CONV_WIDTH, CONV_WIDTH,
             HGRN_HEADS * HGRN_DK, HGRN_HEADS * HGRN_DK, HGRN_WIDTH, HGRN_WIDTH,
             N_BRANCH * D_MODEL)
IN_COLS = sum(IN_SPLITS)
D_FF_DENSE = 2816
N_EXPERTS = 8
TOP_K = 2
D_FF_EXPERT = 3584
N_DENSE = (DEPTH + 1) // 2
N_MOE = DEPTH // 2

kernel_name = "hybrid_diffattn_shortconv_hgrn2_moe"


def rms_norm(x, gain):
    xf = x.astype(jnp.float32)
    y = xf * lax.rsqrt(jnp.mean(xf * xf, axis=-1, keepdims=True) + EPS)
    return (y * gain.astype(jnp.float32)).astype(x.dtype)


def rel_bucket(q_pos, k_pos):
    n = jnp.maximum(q_pos[:, None] - k_pos[None, :], 0)
    max_exact = REL_BUCKETS // 2
    nf = jnp.maximum(n, 1).astype(jnp.float32)
    large = max_exact + (jnp.log(nf / max_exact) / math.log(REL_MAX_DIST / max_exact)
                         * (REL_BUCKETS - max_exact)).astype(jnp.int32)
    large = jnp.minimum(large, REL_BUCKETS - 1)
    return jnp.where(n < max_exact, n, large)


def diff_attn_block(q, q_pos, k, v, k_pos, rel_bias, lam):
    bias = jnp.moveaxis(rel_bias[rel_bucket(q_pos, k_pos)], -1, 0).astype(jnp.float32)
    logits = jnp.einsum('bmhqd,bmhkd->bmhqk', q, k, preferred_element_type=jnp.float32)
    logits = logits * (ATT_QK_DIM ** -0.5) + bias
    causal = k_pos[None, :] <= q_pos[:, None]
    probs = jax.nn.softmax(jnp.where(causal, logits, -jnp.inf), axis=-1)
    attn = probs[:, 0] - lam * probs[:, 1]
    return jnp.einsum('bhqk,bhkd->bhqd', attn.astype(v.dtype), v)


def diff_attention(q, k, v, q_gain, k_gain, lam_params, sub_gain, rel_bias, layer):
    bsz, t_len, _ = q.shape
    n_real = t_len - N_META
    n_blk = n_real // Q_BLOCK
    q = rms_norm(q.reshape(bsz, t_len, 2, ATT_HEADS, ATT_QK_DIM), q_gain).transpose(0, 2, 3, 1, 4)
    k = rms_norm(k.reshape(bsz, t_len, 2, ATT_HEADS, ATT_QK_DIM), k_gain).transpose(0, 2, 3, 1, 4)
    v = v.reshape(bsz, t_len, ATT_HEADS, ATT_V_DIM).transpose(0, 2, 1, 3)
    lam_init = 0.8 - 0.6 * math.exp(-0.3 * layer)
    lp = lam_params.astype(jnp.float32)
    lam = jnp.exp(jnp.sum(lp[0] * lp[1])) - jnp.exp(jnp.sum(lp[2] * lp[3])) + lam_init
    pos = jnp.arange(t_len)
    o_meta = diff_attn_block(q[:, :, :, :N_META], pos[:N_META], k[:, :, :, :N_META],
                             v[:, :, :N_META], pos[:N_META], rel_bias, lam)
    q_blocks = jnp.moveaxis(q[:, :, :, N_META:].reshape(bsz, 2, ATT_HEADS, n_blk, Q_BLOCK, ATT_QK_DIM), 3, 0)
    qpos_blocks = pos[N_META:].reshape(n_blk, Q_BLOCK)
    o_real = lax.map(lambda a: diff_attn_block(a[0], a[1], k, v, pos, rel_bias, lam), (q_blocks, qpos_blocks))
    o_real = jnp.moveaxis(o_real, 0, 2).reshape(bsz, ATT_HEADS, n_real, ATT_V_DIM)
    o = jnp.concatenate([o_meta, o_real], axis=2)
    o = rms_norm(o, sub_gain) * (1.0 - lam_init)
    return o.transpose(0, 2, 1, 3).reshape(bsz, t_len, ATT_WIDTH)


def short_conv(b, c, h, conv_w):
    z = c * h
    y = lax.conv_general_dilated(z, conv_w[:, None, :].astype(z.dtype), window_strides=(1,),
                                 padding=[(CONV_K - 1, 0)], dimension_numbers=('NWC', 'WIO', 'NWC'),
                                 feature_group_count=CONV_WIDTH)
    return b * y


def gla_chunk(state, q, k, v, log_f):
    c_len = q.shape[2]
    g_cum = jnp.cumsum(log_f, axis=2)
    o_inter = jnp.einsum('bhcd,bhde->bhce', q * jnp.exp(g_cum), state)
    diff = g_cum[:, :, :, None, :] - g_cum[:, :, None, :, :]
    mask = jnp.tril(jnp.ones((c_len, c_len), dtype=bool))[:, :, None]
    decay = jnp.exp(jnp.where(mask, diff, -jnp.inf))
    scores = jnp.einsum('bhtd,bhsd,bhtsd->bhts', q, k, decay)
    o_intra = jnp.einsum('bhts,bhse->bhte', scores, v)
    g_last = g_cum[:, :, -1, :]
    new_state = jnp.exp(g_last)[..., None] * state + jnp.einsum(
        'bhsd,bhse->bhde', k * jnp.exp(g_last[:, :, None, :] - g_cum), v)
    return new_state, o_inter + o_intra


def hgrn2(q, f_pre, i, g, lb, out_gain):
    bsz, t_len, _ = q.shape
    out_dtype = q.dtype
    n_real = t_len - N_META
    n_chunk = n_real // HGRN_CHUNK
    f32 = jnp.float32
    qh = jax.nn.silu(q.astype(f32)).reshape(bsz, t_len, HGRN_HEADS, HGRN_DK)
    z = f_pre.astype(f32).reshape(bsz, t_len, HGRN_HEADS, HGRN_DK)
    lb = lb.astype(f32).reshape(HGRN_HEADS, HGRN_DK)
    log_f = jnp.logaddexp(jnp.log(lb), jnp.log1p(-lb) + jax.nn.log_sigmoid(z))
    kh = (1.0 - lb) * jax.nn.sigmoid(-z)
    vh = i.astype(f32).reshape(bsz, t_len, HGRN_HEADS, HGRN_DV)
    qh, kh, vh, log_f = (a.transpose(0, 2, 1, 3) for a in (qh, kh, vh, log_f))
    state0 = jnp.zeros((bsz, HGRN_HEADS, HGRN_DK, HGRN_DV), f32)
    state, o_meta = gla_chunk(state0, qh[:, :, :N_META], kh[:, :, :N_META],
                              vh[:, :, :N_META], log_f[:, :, :N_META])

    def to_chunks(a):
        return jnp.moveaxis(a[:, :, N_META:].reshape(bsz, HGRN_HEADS, n_chunk, HGRN_CHUNK, a.shape[-1]), 2, 0)

    _, o_real = lax.scan(lambda s, xs: gla_chunk(s, *xs), state,
                         (to_chunks(qh), to_chunks(kh), to_chunks(vh), to_chunks(log_f)))
    o_real = jnp.moveaxis(o_real, 0, 2).reshape(bsz, HGRN_HEADS, n_real, HGRN_DV)
    o = jnp.concatenate([o_meta, o_real], axis=2).transpose(0, 2, 1, 3)
    gate = g.astype(f32).reshape(bsz, t_len, HGRN_HEADS, HGRN_DV)
    o = rms_norm(o, out_gain) * jax.nn.silu(gate)
    return o.reshape(bsz, t_len, HGRN_WIDTH).astype(out_dtype)


def swiglu(h, w_gate, w_up, w_down):
    return (jax.nn.silu(h @ w_gate) * (h @ w_up)) @ w_down


def moe_swiglu(h, router_w, w_gate, w_up, w_down):
    logits = jnp.einsum('btd,de->bte', h, router_w).astype(jnp.float32)
    top_logits, top_idx = lax.top_k(logits, TOP_K)
    top_w = jax.nn.softmax(top_logits, axis=-1)
    combine = jnp.sum(jax.nn.one_hot(top_idx, N_EXPERTS, dtype=jnp.float32) * top_w[..., None], axis=-2)
    combine = combine.astype(h.dtype)
    out = jnp.zeros_like(h)
    for e in range(N_EXPERTS):
        out = out + combine[..., e:e + 1] * swiglu(h, w_gate[e], w_up[e], w_down[e])
    return out


def setup_inputs(seed: int = 0) -> dict:
    key = jax.random.key(seed)
    ks = iter(jax.random.split(key, 32))

    def nrm(shape, scale):
        return scale * jax.random.normal(next(ks), shape, jnp.float32)

    def gain(shape):
        return 1.0 + nrm(shape, 0.05)

    return {
        "x": nrm((BATCH, SEQ, D_MODEL), 1.0),
        "meta_tokens": nrm((N_META, D_MODEL), 1.0),
        "norm1_gain": gain((DEPTH, D_MODEL)),
        "norm2_gain": gain((DEPTH, D_MODEL)),
        "w_in": nrm((DEPTH, D_MODEL, IN_COLS), D_MODEL ** -0.5),
        "q_norm_gain": gain((DEPTH, ATT_QK_DIM)),
        "k_norm_gain": gain((DEPTH, ATT_QK_DIM)),
        "diff_lambda": nrm((DEPTH, 4, ATT_QK_DIM), 0.1),
        "attn_sub_gain": gain((DEPTH, ATT_V_DIM)),
        "rel_bias": nrm((REL_BUCKETS, ATT_HEADS), 0.5),
        "conv_w": nrm((DEPTH, CONV_K, CONV_WIDTH), CONV_K ** -0.5),
        "hgrn_lb_logits": nrm((DEPTH, HGRN_HEADS * HGRN_DK), 1.0),
        "hgrn_out_gain": gain((DEPTH, HGRN_DV)),
        "w_branch": nrm((DEPTH, N_BRANCH, BRANCH_WIDTH, D_MODEL), BRANCH_WIDTH ** -0.5),
        "w_out": nrm((DEPTH, D_MODEL, D_MODEL), D_MODEL ** -0.5),
        "ffn_w_gate": nrm((N_DENSE, D_MODEL, D_FF_DENSE), D_MODEL ** -0.5),
        "ffn_w_up": nrm((N_DENSE, D_MODEL, D_FF_DENSE), D_MODEL ** -0.5),
        "ffn_w_down": nrm((N_DENSE, D_FF_DENSE, D_MODEL), D_FF_DENSE ** -0.5),
        "router_w": nrm((N_MOE, D_MODEL, N_EXPERTS), D_MODEL ** -0.5),
        "moe_w_gate": nrm((N_MOE, N_EXPERTS, D_MODEL, D_FF_EXPERT), D_MODEL ** -0.5),
        "moe_w_up": nrm((N_MOE, N_EXPERTS, D_MODEL, D_FF_EXPERT), D_MODEL ** -0.5),
        "moe_w_down": nrm((N_MOE, N_EXPERTS, D_FF_EXPERT, D_MODEL), D_FF_EXPERT ** -0.5),
    }


def reference(x, meta_tokens, norm1_gain, norm2_gain, w_in, q_norm_gain, k_norm_gain,
              diff_lambda, attn_sub_gain, rel_bias, conv_w, hgrn_lb_logits, hgrn_out_gain,
              w_branch, w_out, ffn_w_gate, ffn_w_up, ffn_w_down, router_w,
              moe_w_gate, moe_w_up, moe_w_down):
    bsz = x.shape[0]
    meta = jnp.broadcast_to(meta_tokens.astype(x.dtype)[None], (bsz, N_META, D_MODEL))
    hs = jnp.concatenate([meta, x], axis=1)
    t_len = hs.shape[1]
    lb_all = jnp.cumsum(jax.nn.softmax(hgrn_lb_logits.astype(jnp.float32), axis=0), axis=0)
    lb_all = lb_all - lb_all[0]
    split_at = [int(s) for s in np.cumsum(IN_SPLITS)[:-1]]
    for layer in range(DEPTH):
        hn = rms_norm(hs, norm1_gain[layer])
        proj = jnp.einsum('btd,dn->btn', hn, w_in[layer])
        (a_q, a_k, a_v, c_b, c_c, c_h, r_q, r_f, r_i, r_g, gates) = jnp.split(proj, split_at, axis=-1)
        u_att = diff_attention(a_q, a_k, a_v, q_norm_gain[layer], k_norm_gain[layer],
                               diff_lambda[layer], attn_sub_gain[layer], rel_bias, layer)
        u_conv = short_conv(c_b, c_c, c_h, conv_w[layer])
        u_hgrn = hgrn2(r_q, r_f, r_i, r_g, lb_all[layer], hgrn_out_gain[layer])
        branches = jnp.stack([u_att, u_conv, u_hgrn], axis=2)
        up = jnp.einsum('btnw,nwd->btnd', branches, w_branch[layer])
        gate = jax.nn.sigmoid(gates.reshape(bsz, t_len, N_BRANCH, D_MODEL))
        mixed = jnp.sum(gate * up, axis=2)
        hs = hs + jnp.einsum('btd,de->bte', mixed, w_out[layer])
        hn2 = rms_norm(hs, norm2_gain[layer])
        if layer % 2 == 0:
            j = layer // 2
            ffn = swiglu(hn2, ffn_w_gate[j], ffn_w_up[j], ffn_w_down[j])
        else:
            j = layer // 2
            ffn = moe_swiglu(hn2, router_w[j], moe_w_gate[j], moe_w_up[j], moe_w_down[j])
        hs = hs + ffn
    return hs[:, N_META:]
```

```cpp
#include <hip/hip_runtime.h>
#include <cstdio>
#include <cstdint>
#include <cmath>
#include <hip/hip_bf16.h>
namespace pg8 {
#define PG8_LAS __attribute__((address_space(3)))
typedef unsigned short bf16_t;
typedef short bf16x8 __attribute__((ext_vector_type(8)));
typedef float f32x4 __attribute__((ext_vector_type(4)));
typedef unsigned u32x4 __attribute__((ext_vector_type(4)));
typedef unsigned u32x2 __attribute__((ext_vector_type(2)));
typedef int v4i_t __attribute__((ext_vector_type(4)));
typedef int v8i_t __attribute__((ext_vector_type(8)));
constexpr int BM = 256, BK = 64, HALF = 128, HTB = HALF * BK * 2, STAGE_BYTES = 8 * HTB;

__host__ __device__ __forceinline__ int lds_byte(int r, int c) { const int st = (r >> 4) * 2 + (c >> 5), rr = r & 15, cc = c & 31, ob = rr * 64 + cc * 2; return st * 1024 + (ob ^ (((ob >> 9) & 1) << 5)); }
__host__ __device__ __forceinline__ void stage_rc(int b, int& R, int& C) { const int st = b / 1024, sb = b % 1024, swz = sb ^ (((sb >> 9) & 1) << 5); R = (st >> 1) * 16 + swz / 64; C = (st & 1) * 32 + (swz % 64) / 2; }
__host__ __device__ __forceinline__ int perm32(int rho) { const int n = rho >> 4, i = rho & 15; return 8 * (i >> 2) + 4 * n + (i & 3); }

struct Unit { int pm, pn, z; unsigned a_off, b_off; const int* gidx; };
struct Gemm { const bf16_t* A; const bf16_t* Bt; int lda, ldb, K; };

__device__ __forceinline__ int lane_id() { unsigned m = ~0u; asm volatile("" : "+s"(m)); return (int)__builtin_amdgcn_mbcnt_hi(m, __builtin_amdgcn_mbcnt_lo(m, 0u)); }
__device__ __forceinline__ int make_tid(int wave) { int t = (wave << 6) | lane_id(); asm volatile("" : "+v"(t)); return t; }
typedef float f32x2_cv __attribute__((ext_vector_type(2))); typedef __bf16 bf16x2_cv __attribute__((ext_vector_type(2)));
__device__ __forceinline__ unsigned cvt_pk_bf16(float lo, float hi) { const f32x2_cv v = {lo, hi}; const bf16x2_cv b = __builtin_convertvector(v, bf16x2_cv); return __builtin_bit_cast(unsigned, b); }

template <class Epi, class Sched, bool GATHER = false, bool FP8 = false>
__device__ __forceinline__ void gemm_phase(PG8_LAS unsigned char* lds, const Gemm g, const Sched& S, const Epi& E, int wave0) {
    const int tid = make_tid(wave0),
              wid = __builtin_amdgcn_readfirstlane(tid >> 6), lane = tid & 63, wr = wid >> 2, wc = wid & 3, fr = lane & 15, fq = lane >> 4;
    const int K = g.K, nt = K / BK;
    unsigned voffA[2], voffB[2];
#pragma unroll
    for (int i = 0; i < 2; ++i) { int R, C; stage_rc(tid * 16 + i * 8192, R, C); const int Rb = Epi::PERM ? ((R & ~31) + perm32(R & 31)) : R;
        voffA[i] = (unsigned)(R * g.lda + C) * 2u; voffB[i] = (unsigned)(Rb * g.ldb + C) * 2u; }
    const size_t kstep = (size_t)(BK * 2);
    const size_t hstepA = GATHER ? 0 : (size_t)HALF * g.lda * 2, hstepB = (size_t)HALF * g.ldb * 2;
    const unsigned ldsw = (unsigned)wid * 1024u;
    const int aoff = lds_byte(wr * 64 + fr, fq * 8), boff = lds_byte(wc * 32 + fr, fq * 8);
    unsigned gvc[2][2], gvn[2][2];
#define PG8_SA(b, h) (((b) * 2 + (h)) * HTB)
#define PG8_SB(b, h) ((4 + (b) * 2 + (h)) * HTB)
#define PG8_STAGE(bufoff, gbase, voff) do { _Pragma("unroll") for (int _i = 0; _i < 2; ++_i) \
        __builtin_amdgcn_global_load_lds((const unsigned*)((const char*)(gbase) + (voff)[_i]), (PG8_LAS unsigned*)(lds + (bufoff) + ldsw + _i * 8192), 16, 0, 0); } while (0)
#define PG8_STAGE_A(bufoff, base, h, nx) do { if constexpr (GATHER) { if (nx) PG8_STAGE(bufoff, base, gvn[h]); else PG8_STAGE(bufoff, base, gvc[h]); } else { PG8_STAGE(bufoff, (base) + (h) * hstepA, voffA); } } while (0)
#define PG8_LD8(a_) __builtin_shufflevector(*(const PG8_LAS v4i_t*)(a_), *(const PG8_LAS v4i_t*)((a_) + 1024), 0, 1, 2, 3, 4, 5, 6, 7)
#define PG8_LDA(dst, b, h) do { if constexpr (FP8) { _Pragma("unroll") for (int m = 0; m < 4; ++m) dst##8[m] = PG8_LD8(lds + PG8_SA(b, h) + aoff + m * 2048); } else { \
        _Pragma("unroll") for (int m = 0; m < 4; ++m) _Pragma("unroll") for (int k = 0; k < 2; ++k) dst[m][k] = *(const PG8_LAS bf16x8*)(lds + PG8_SA(b, h) + aoff + m * 2048 + k * 1024); } } while (0)
#define PG8_LDB(dst, b, h) do { if constexpr (FP8) { _Pragma("unroll") for (int n = 0; n < 2; ++n) dst##8[n] = PG8_LD8(lds + PG8_SB(b, h) + boff + n * 2048); } else { \
        _Pragma("unroll") for (int n = 0; n < 2; ++n) _Pragma("unroll") for (int k = 0; k < 2; ++k) dst[n][k] = *(const PG8_LAS bf16x8*)(lds + PG8_SB(b, h) + boff + n * 2048 + k * 1024); } } while (0)
#define PG8_MMA(ai, bj, At, Bt) do { __builtin_amdgcn_s_setprio(1); if constexpr (FP8) { _Pragma("unroll") for (int m = 0; m < 4; ++m) _Pragma("unroll") for (int n = 0; n < 2; ++n) \
        asm volatile("v_mfma_scale_f32_16x16x128_f8f6f4 %0, %1, %2, %0, %3, %3 op_sel_hi:[0,0,0]" : "+v"(acc[ai][bj][m][n]) : "v"(Bt##8[n]), "v"(At##8[m]), "v"(one8)); } else { \
        _Pragma("unroll") for (int m = 0; m < 4; ++m) _Pragma("unroll") for (int n = 0; n < 2; ++n) _Pragma("unroll") for (int k = 0; k < 2; ++k) \
        acc[ai][bj][m][n] = __builtin_amdgcn_mfma_f32_16x16x32_bf16(Bt[n][k], At[m][k], acc[ai][bj][m][n], 0, 0, 0); } __builtin_amdgcn_s_setprio(0); } while (0)
#define PG8_WAIT_V(n) asm volatile("s_waitcnt vmcnt(" #n ")" ::: "memory")
#define PG8_WAIT_L(n) asm volatile("s_waitcnt lgkmcnt(" #n ")" ::: "memory")
#define PG8_BAR __builtin_amdgcn_s_barrier()
#define PG8_SCHED __builtin_amdgcn_sched_barrier(0)
#define PG8_GLOAD(dst, u) do { if constexpr (GATHER) { const int t2_ = make_tid(wave0); _Pragma("unroll") for (int _i = 0; _i < 2; ++_i) { int R_, C_; stage_rc(t2_ * 16 + _i * 8192, R_, C_); \
        _Pragma("unroll") for (int _h = 0; _h < 2; ++_h) dst[_h][_i] = (unsigned)((u).gidx[_h * HALF + R_] * g.lda + C_) * 2u; } } } while (0)
    Unit cur, nxt; int ui = 0;
    if (!S.next(0, cur)) return;
    f32x4 acc[2][2][4][2];
#pragma unroll
    for (int a = 0; a < 2; ++a)
#pragma unroll
        for (int b = 0; b < 2; ++b)
#pragma unroll
            for (int m = 0; m < 4; ++m)
#pragma unroll
                for (int n = 0; n < 2; ++n) acc[a][b][m][n] = (f32x4){0.f, 0.f, 0.f, 0.f};
    bf16x8 At[4][2], B0[2][2], B1[2][2]; v8i_t At8[4], B08[2], B18[2];
    int one8 = 0x7f7f7f7f; asm volatile("" : "+v"(one8));
    const char* cA = (const char*)g.A + cur.a_off; const char* cB = (const char*)g.Bt + cur.b_off;
    PG8_GLOAD(gvc, cur);
#pragma unroll
    for (int _h = 0; _h < 2; ++_h)
#pragma unroll
        for (int _i = 0; _i < 2; ++_i) gvn[_h][_i] = 0u;
    PG8_STAGE(PG8_SB(0, 0), cB, voffB); PG8_STAGE(PG8_SB(0, 1), cB + hstepB, voffB); PG8_STAGE_A(PG8_SA(0, 0), cA, 0, false); PG8_STAGE_A(PG8_SA(0, 1), cA, 1, false);
    if (wr == 1) PG8_BAR;
    PG8_WAIT_V(2); PG8_BAR;
    PG8_STAGE(PG8_SB(1, 0), cB + kstep, voffB); PG8_STAGE_A(PG8_SA(1, 0), cA + kstep, 0, false); PG8_STAGE(PG8_SB(1, 1), cB + hstepB + kstep, voffB);
    PG8_WAIT_V(6); PG8_BAR;
    for (;;) {
        const bool has_next = S.next(ui + 1, nxt);
        const char* nA = has_next ? (const char*)g.A + nxt.a_off : cA; const char* nB = has_next ? (const char*)g.Bt + nxt.b_off : cB;
        if constexpr (GATHER) { if (has_next) { PG8_GLOAD(gvn, nxt); } else {
#pragma unroll
            for (int _h = 0; _h < 2; ++_h)
#pragma unroll
                for (int _i = 0; _i < 2; ++_i) gvn[_h][_i] = gvc[_h][_i]; } }
        for (int t = 0; t < nt; t += 2) {
            const bool last = (t == nt - 2);
            const char* a1 = cA + (size_t)(t + 1) * kstep;
            const char* a2 = last ? nA : cA + (size_t)(t + 2) * kstep; const char* b2 = last ? nB : cB + (size_t)(t + 2) * kstep;
            const char* a3 = a2 + kstep; const char* b3 = b2 + kstep;
            if constexpr (Epi::MID) { if (t == Epi::MID_T0 || t == Epi::MID_T1) {
                if (wr == 0) PG8_BAR;
#define PG8_MIDROW(ai, m) do { f32x4 v_[2][2] = {{acc[ai][0][m][0], acc[ai][0][m][1]}, {acc[ai][1][m][0], acc[ai][1][m][1]}}; \
                int r_ = cur.pm * BM + (ai) * HALF + wr * 64 + (m) * 16 + fr; asm volatile("" : "+v"(r_)); E.mid_row(cur, r_, t, wc, fq, v_); \
                acc[ai][0][m][0] = v_[0][0]; acc[ai][0][m][1] = v_[0][1]; acc[ai][1][m][0] = v_[1][0]; acc[ai][1][m][1] = v_[1][1]; asm volatile("" ::: "memory"); } while (0)
                PG8_MIDROW(0, 0); PG8_MIDROW(0, 1); PG8_MIDROW(0, 2); PG8_MIDROW(0, 3); PG8_MIDROW(1, 0); PG8_MIDROW(1, 1); PG8_MIDROW(1, 2); PG8_MIDROW(1, 3);
#undef PG8_MIDROW
                if (wr == 1) PG8_BAR;
            } }
            PG8_LDB(B0, 0, 0); PG8_LDB(B1, 0, 1); PG8_SCHED; PG8_LDA(At, 0, 0); PG8_STAGE_A(PG8_SA(1, 1), a1, 1, false);
            PG8_WAIT_V(8); PG8_WAIT_L(0); PG8_BAR; PG8_MMA(0, 0, At, B0); PG8_MMA(0, 1, At, B1); PG8_BAR; PG8_SCHED;
            PG8_LDA(At, 0, 1); PG8_STAGE(PG8_SB(0, 0), b2, voffB); PG8_STAGE(PG8_SB(0, 1), b2 + hstepB, voffB); PG8_STAGE_A(PG8_SA(0, 0), a2, 0, last);
            PG8_WAIT_V(8); PG8_WAIT_L(0); PG8_BAR; PG8_MMA(1, 0, At, B0); PG8_MMA(1, 1, At, B1); PG8_BAR; PG8_SCHED;
            PG8_LDB(B0, 1, 0); PG8_LDB(B1, 1, 1); PG8_SCHED; PG8_LDA(At, 1, 0); PG8_STAGE_A(PG8_SA(0, 1), a2, 1, last);
            PG8_WAIT_V(8); PG8_WAIT_L(0); PG8_BAR; PG8_MMA(0, 0, At, B0); PG8_MMA(0, 1, At, B1); PG8_BAR; PG8_SCHED;
            PG8_LDA(At, 1, 1); PG8_STAGE(PG8_SB(1, 0), b3, voffB); PG8_STAGE(PG8_SB(1, 1), b3 + hstepB, voffB); PG8_STAGE_A(PG8_SA(1, 0), a3, 0, last);
            PG8_WAIT_V(8); PG8_WAIT_L(0); PG8_BAR; PG8_MMA(1, 0, At, B0); PG8_MMA(1, 1, At, B1); PG8_BAR; PG8_SCHED;
        }
        if constexpr (FP8) asm volatile("s_nop 15\n\ts_nop 15" ::: "memory");
        if (wr == 0) PG8_BAR;
        {
#define PG8_ROW(ai, m) do { const f32x4 v_[2][2] = {{acc[ai][0][m][0], acc[ai][0][m][1]}, {acc[ai][1][m][0], acc[ai][1][m][1]}}; \
            int r_ = cur.pm * BM + (ai) * HALF + wr * 64 + (m) * 16 + fr; asm volatile("" : "+v"(r_)); E.row(cur, r_, (ai) * 4 + (m), wc, fq, v_); asm volatile("" ::: "memory"); } while (0)
            PG8_ROW(0, 0); PG8_ROW(0, 1); PG8_ROW(0, 2); PG8_ROW(0, 3); PG8_ROW(1, 0); PG8_ROW(1, 1); PG8_ROW(1, 2); PG8_ROW(1, 3);
#undef PG8_ROW
        }
        if (!has_next) break;
#pragma unroll
        for (int a = 0; a < 2; ++a)
#pragma unroll
            for (int b = 0; b < 2; ++b)
#pragma unroll
                for (int m = 0; m < 4; ++m)
#pragma unroll
                    for (int n = 0; n < 2; ++n) acc[a][b][m][n] = (f32x4){0.f, 0.f, 0.f, 0.f};
        cur = nxt; cA = nA; cB = nB; ++ui;
        if constexpr (GATHER) {
#pragma unroll
            for (int _h = 0; _h < 2; ++_h)
#pragma unroll
                for (int _i = 0; _i < 2; ++_i) gvc[_h][_i] = gvn[_h][_i]; }
        if (wr == 1) PG8_BAR;
    }
    PG8_WAIT_V(0);
    PG8_BAR;
#undef PG8_SA
#undef PG8_SB
#undef PG8_STAGE
#undef PG8_STAGE_A
#undef PG8_LDA
#undef PG8_LD8
#undef PG8_LDB
#undef PG8_MMA
#undef PG8_WAIT_V
#undef PG8_WAIT_L
#undef PG8_BAR
#undef PG8_SCHED
#undef PG8_GLOAD
}

template <bool PERM>
__device__ __forceinline__ void small_tile(PG8_LAS unsigned char* lds, const bf16_t* A16, int lda, const bf16_t* Bt, int ldb, int K, int pn, int wc, f32x4 (&v)[2][2], int wave0) {
    const int tid = make_tid(wave0), wid = __builtin_amdgcn_readfirstlane(tid >> 6), lane = tid & 63, fr = lane & 15, fq = lane >> 4;
    const int kper = K >> 3, k0 = wid * kper;
    f32x4 acc[2][2];
#pragma unroll
    for (int bj = 0; bj < 2; ++bj)
#pragma unroll
        for (int n = 0; n < 2; ++n) acc[bj][n] = (f32x4){0.f, 0.f, 0.f, 0.f};
    const bf16_t* ap = A16 + (size_t)fr * lda + k0 + 8 * fq;
    const bf16_t* bp[2][2];
#pragma unroll
    for (int bj = 0; bj < 2; ++bj)
#pragma unroll
        for (int n = 0; n < 2; ++n) { const int rr = PERM ? perm32(16 * n + fr) : 16 * n + fr; bp[bj][n] = Bt + (size_t)(pn * 256 + bj * 128 + wc * 32 + rr) * ldb + k0 + 8 * fq; }
    for (int k = 0; k < kper; k += 32) {
        const bf16x8 a = *(const bf16x8*)(ap + k);
#pragma unroll
        for (int bj = 0; bj < 2; ++bj)
#pragma unroll
            for (int n = 0; n < 2; ++n) { const bf16x8 b = *(const bf16x8*)(bp[bj][n] + k); acc[bj][n] = __builtin_amdgcn_mfma_f32_16x16x32_bf16(b, a, acc[bj][n], 0, 0, 0); }
    }
    PG8_LAS f32x4* red = (PG8_LAS f32x4*)lds;
#pragma unroll
    for (int bj = 0; bj < 2; ++bj)
#pragma unroll
        for (int n = 0; n < 2; ++n) red[(wid * 4 + bj * 2 + n) * 64 + lane] = acc[bj][n];
    __syncthreads();
    if (wid == 0) {
#pragma unroll
        for (int bj = 0; bj < 2; ++bj)
#pragma unroll
            for (int n = 0; n < 2; ++n) { f32x4 s = red[(bj * 2 + n) * 64 + lane];
#pragma unroll
                for (int w = 1; w < 8; ++w) s += red[(w * 4 + bj * 2 + n) * 64 + lane];
                v[bj][n] = s; }
    }
    __syncthreads();
}
}
namespace attn_body {
using bf16=__hip_bfloat16;
using bf16x8=__attribute__((ext_vector_type(8)))short;
using s16x4=__attribute__((ext_vector_type(4)))short;
using f32x16=__attribute__((ext_vector_type(16)))float;
using u32x4=__attribute__((ext_vector_type(4)))unsigned;
constexpr int BATCH=4,SEQ=4352,D=64,QKP=1024,VP=512,OP=1024;
constexpr int NW=8,QBLK=32,QB=QBLK*NW,KVBLK=64,NQB=SEQ/QB;
constexpr int ATTN_UNIT_ROWS=QB;
__device__ __forceinline__ int crow(int r,int hi){return (r&3)+8*(r>>2)+4*hi;}
#define SBAR() __builtin_amdgcn_sched_barrier(0)
__device__ __forceinline__ void cmask(f32x16&p0,f32x16&p1,int jb,int qrel,int hi){
  const float NEG=-INFINITY; int kb=64*jb+4*hi;
  #pragma unroll
  for(int r=0;r<16;++r){int kv=kb+(r&3)+8*(r>>2); if(kv>qrel)p0[r]=NEG; if(kv+32>qrel)p1[r]=NEG;}
}

__device__ __forceinline__ void biasmask(f32x16&p0,f32x16&p1,int jb,int qrel,int hi,const __attribute__((address_space(3))) float*tab){
  const float NEG=-INFINITY; const int kb=64*jb+4*hi;
  #pragma unroll
  for(int r=0;r<16;++r){const int n0=qrel-(kb+(r&3)+8*(r>>2)),n1=n0-32;
    const float b0=tab[n0<0?0:(n0>127?127:n0)],b1=tab[n1<0?0:(n1>127?127:n1)];
    p0[r]=n0<0?NEG:p0[r]+b0; p1[r]=n1<0?NEG:p1[r]+b1;}
}
constexpr int NSLOT=3, SLOTB=8192;
constexpr int VSLOTB=2*SLOTB;
constexpr int LDS_K=0, LDS_V=NSLOT*SLOTB, LDS_WS=LDS_V+NSLOT*VSLOTB, LDS_TAB=LDS_WS+NW*64*4, LDS_OST=0  , LDS_BYTES=LDS_TAB+2048;
constexpr float C2=0.125f*1.4426950408889634f;
__device__ __forceinline__ void glds16(const void*gsrc,unsigned lds_dst){unsigned keep;
  asm volatile("s_mov_b32 %0, m0\n\ts_mov_b32 m0, %2\n\ts_nop 0\n\tglobal_load_lds_dwordx4 %1, off\n\ts_mov_b32 m0, %0":"=&s"(keep):"v"(gsrc),"s"(lds_dst):"memory");}
__device__ __forceinline__ float max3f(float a,float b,float c){float r;asm("v_max3_f32 %0, %1, %2, %3":"=v"(r):"v"(a),"v"(b),"v"(c));return r;}
__device__ __forceinline__ float max2f(float a,float b){float r;asm("v_max_f32_e32 %0, %1, %2":"=v"(r):"v"(a),"v"(b));return r;}
__device__ __forceinline__ float fadd_s(float a,float b){float r;asm("v_add_f32_e32 %0, %1, %2":"=v"(r):"v"(a),"v"(b));return r;}
__device__ __forceinline__ float fsub_s(float a,float b){float r;asm("v_sub_f32_e32 %0, %1, %2":"=v"(r):"v"(a),"v"(b));return r;}
typedef float f32x2_t __attribute__((ext_vector_type(2))); typedef __bf16 bf16x2_t __attribute__((ext_vector_type(2)));
__device__ __forceinline__ unsigned cvtpk_s(float lo,float hi){f32x2_t v={lo,hi};bf16x2_t b=__builtin_convertvector(v,bf16x2_t);return __builtin_bit_cast(unsigned,b);}
#define WAIT_BAR(N) asm volatile("s_waitcnt vmcnt(" #N ") lgkmcnt(0)\n\ts_barrier":::"memory")

__device__ __forceinline__ void qkt(f32x16&p0,f32x16&p1,const char*Kslot,const bf16x8*qr,const f32x16&negm,int r32,int hi){
  const char*kb=Kslot+hi*1024+r32*16;
  #pragma unroll
  for(int d0=0;d0<4;++d0){
    const bf16x8 b0=*reinterpret_cast<const bf16x8*>(kb+d0*2048);
    const bf16x8 b1=*reinterpret_cast<const bf16x8*>(kb+d0*2048+512);
    if(d0==0){p0=__builtin_amdgcn_mfma_f32_32x32x16_bf16(b0,qr[0],negm,0,0,0);p1=__builtin_amdgcn_mfma_f32_32x32x16_bf16(b1,qr[0],negm,0,0,0);}
    else{p0=__builtin_amdgcn_mfma_f32_32x32x16_bf16(b0,qr[d0],p0,0,0,0);p1=__builtin_amdgcn_mfma_f32_32x32x16_bf16(b1,qr[d0],p1,0,0,0);}}
}
typedef __attribute__((address_space(3))) const char* lds_cptr;
typedef short v4i16_t __attribute__((ext_vector_type(4)));
__device__ __forceinline__ void kload8(bf16x8*kf,lds_cptr kp){
  kf[0]=*(const __attribute__((address_space(3))) bf16x8*)(kp);      kf[1]=*(const __attribute__((address_space(3))) bf16x8*)(kp+512);
  kf[2]=*(const __attribute__((address_space(3))) bf16x8*)(kp+2048); kf[3]=*(const __attribute__((address_space(3))) bf16x8*)(kp+2560);
  kf[4]=*(const __attribute__((address_space(3))) bf16x8*)(kp+4096); kf[5]=*(const __attribute__((address_space(3))) bf16x8*)(kp+4608);
  kf[6]=*(const __attribute__((address_space(3))) bf16x8*)(kp+6144); kf[7]=*(const __attribute__((address_space(3))) bf16x8*)(kp+6656);
}
__device__ __forceinline__ void kload2(bf16x8*kf,lds_cptr kp,int j){ kf[2*j]=*(const __attribute__((address_space(3))) bf16x8*)(kp+j*2048); kf[2*j+1]=*(const __attribute__((address_space(3))) bf16x8*)(kp+j*2048+512); }
__device__ __forceinline__ s16x4 vtr(lds_cptr p){ return __builtin_bit_cast(s16x4,__builtin_amdgcn_ds_read_tr16_b64_v4i16((__attribute__((address_space(3))) v4i16_t*)p)); }
__device__ __forceinline__ float rowmax(const f32x16&p0,const f32x16&p1){
  float a=max3f(p0[0],p0[1],p1[0]),b=max3f(p0[2],p0[3],p1[1]);a=max3f(a,p1[2],p1[3]);
  #pragma unroll
  for(int r=4;r<16;r+=4){a=max3f(a,p0[r],p0[r+1]);b=max3f(b,p0[r+2],p0[r+3]);a=max3f(a,p1[r],p1[r+1]);b=max3f(b,p1[r+2],p1[r+3]);}
  const float m=max2f(a,b);
  auto rr=__builtin_amdgcn_permlane32_swap(__float_as_uint(m),__float_as_uint(m),false,false);
  return max2f(__uint_as_float(rr[0]),__uint_as_float(rr[1]));
}
__device__ __forceinline__ void pv(f32x16*o,int vb,bf16x8 pa0,bf16x8 pa1,bf16x8 pa2,bf16x8 pa3){
  #pragma unroll
  for(int d0=0;d0<4;++d0){s16x4 lo[4],hi[4];
    #pragma unroll
    for(int ks=0;ks<4;++ks){
      asm volatile("ds_read_b64_tr_b16 %0,%1 offset:%c2":"=&v"(lo[ks]):"v"(vb),"i"(d0*4096+ks*1024):"memory");
      asm volatile("ds_read_b64_tr_b16 %0,%1 offset:%c2":"=&v"(hi[ks]):"v"(vb),"i"(d0*4096+ks*1024+512):"memory");}
    asm volatile("s_waitcnt lgkmcnt(0)":::"memory");SBAR();
    #define PK(k) (bf16x8){lo[k][0],lo[k][1],lo[k][2],lo[k][3],hi[k][0],hi[k][1],hi[k][2],hi[k][3]}
    o[d0]=__builtin_amdgcn_mfma_f32_32x32x16_bf16(pa0,PK(0),o[d0],0,0,0);
    o[d0]=__builtin_amdgcn_mfma_f32_32x32x16_bf16(pa1,PK(1),o[d0],0,0,0);
    o[d0]=__builtin_amdgcn_mfma_f32_32x32x16_bf16(pa2,PK(2),o[d0],0,0,0);
    o[d0]=__builtin_amdgcn_mfma_f32_32x32x16_bf16(pa3,PK(3),o[d0],0,0,0);
    #undef PK
  }
}

#ifndef ATTN_STORE16
#define ATTN_STORE16(p,v) (*(u32x4*)(p)=(v))
#endif
template<int THRL> __device__ __forceinline__ void attn_unit(int b,int vh,int qb,const bf16*__restrict__ QK,const bf16*__restrict__ V,bf16*O,char*shm,int wave0){
  const int mp=vh>>2,hh=vh&3; const int qcol=(mp*4+hh)*64,kcol=512+(mp*4+hh)*64,vcol=hh*128,ocol=mp*512+hh*128;
  const int tid=pg8::make_tid(wave0),lane=tid&63,r32=lane&31,hi=lane>>5; const int wid=__builtin_amdgcn_readfirstlane(tid>>6);
  const long rowbase=(long)b*SEQ; const int q0=qb*QB;
  const bf16*Qw=QK+(rowbase+q0+wid*QBLK)*QKP+qcol;
  const bf16*Kh=QK+rowbase*QKP+kcol,*Vh=V+rowbase*VP+vcol;
  const __attribute__((address_space(3))) float*tab=(const __attribute__((address_space(3))) float*)((__attribute__((address_space(3))) char*)shm+LDS_TAB)+hh*128;
  const unsigned lds0=(unsigned)(uintptr_t)shm;
  float*wsf=(float*)(shm+LDS_WS)+wid*64;
  const bf16*ksrc=Kh+(long)lane*QKP+wid*8;
  const bf16*vsrc=Vh+(long)(16*(wid&3)+(lane>>2))*VP+(wid>>2)*32+(lane&3)*8;
  const unsigned kdst=lds0+LDS_K+wid*1024, vdst=lds0+LDS_V+wid*1024;
  #define DMA_K(t,slot) glds16(ksrc+(long)(t)*KVBLK*QKP,(unsigned)__builtin_amdgcn_readfirstlane(kdst+(slot)))
  #define DMA_V(t,slot) do{ glds16(vsrc+(long)(t)*KVBLK*VP,(unsigned)__builtin_amdgcn_readfirstlane(vdst+2*(slot))); glds16(vsrc+64+(long)(t)*KVBLK*VP,(unsigned)__builtin_amdgcn_readfirstlane(vdst+2*(slot)+8192)); }while(0)
  const int vb0=(int)(lds0+LDS_V)+((lane>>4)&1)*32+(lane&3)*8+(4*hi+((lane&15)>>2))*64;
  const char*Kbase=shm+LDS_K; bf16x8 kf[8];
  const lds_cptr shm3=(lds_cptr)shm; const lds_cptr kp0=shm3+LDS_K+hi*1024+r32*16; const lds_cptr vp0=shm3+LDS_V+((lane>>4)&1)*32+(lane&3)*8+(4*hi+((lane&15)>>2))*64;
  const int NT=(q0+QB)/KVBLK;
  DMA_K(0,0);DMA_V(0,0);DMA_K(1,SLOTB);
  bf16x8 qr[4];
  #pragma unroll
  for(int d0=0;d0<4;++d0)qr[d0]=*reinterpret_cast<const bf16x8*>(&Qw[(long)r32*QKP+d0*16+hi*8]);
  float mhat=0.f,l_reg=0.f;f32x16 o[4];o[0]=f32x16{};o[1]=f32x16{};o[2]=f32x16{};o[3]=f32x16{};f32x16 negm=f32x16{};asm volatile("":"+v"(negm));
  const int qrel=wid*QBLK+r32;
  #define CMASK(P0,P1,t) do{int jb_=(t)-(NT-4); if(jb_>=-2)biasmask(P0,P1,jb_,qrel,hi,tab);}while(0)
  bool resc=false;
  #define START(P0,P1) do{ const float rm=rowmax(P0,P1); resc=false; \
    { const float dl=rm; mhat=fadd_s(mhat,dl); \
      _Pragma("unroll") for(int r=0;r<16;++r){P0[r]=fsub_s(P0[r],dl);P1[r]=fsub_s(P1[r],dl);} \
      _Pragma("unroll") for(int r=0;r<16;++r)negm[r]=-mhat; asm volatile("":"+v"(negm)); } \
    _Pragma("unroll") for(int r=0;r<16;++r)P0[r]=__builtin_amdgcn_exp2f(P0[r]); }while(0)
  #define RESC() do{ if(resc){ asm volatile("s_waitcnt lgkmcnt(0)":::"memory"); \
      _Pragma("unroll") for(int d_=0;d_<4;++d_) _Pragma("unroll") for(int r=0;r<16;++r)o[d_][r]*=wsf[crow(r,hi)]; } }while(0)
  f32x16 pA0,pA1,pB0,pB1;
  int sl_prev=0,sl_cur=0,sl_next=SLOTB;
  #define ROT() do{sl_prev=sl_cur;sl_cur=sl_next;sl_next=(sl_next==(NSLOT-1)*SLOTB)?0:sl_next+SLOTB;}while(0)
  DMA_K(2,2*SLOTB);
  WAIT_BAR(4);
  qkt(pA0,pA1,Kbase,qr,negm,r32,hi);asm volatile("s_nop 15\n\ts_nop 7":"+v"(pA0),"+v"(pA1));CMASK(pA0,pA1,0);
  START(pA0,pA1);
  _Pragma("unroll") for(int r=0;r<16;++r)pA1[r]=__builtin_amdgcn_exp2f(pA1[r]);
  WAIT_BAR(0);
  DMA_K(3,0);DMA_V(1,SLOTB);
  ROT();
  kload8(kf,kp0+sl_cur);
  WAIT_BAR(3);
  s16x4 vlo[4],vhi[4]; u32x4 pw0,pw1,pw2,pw3;
  #define PKW(P,B) cvtpk_s(P[B],P[B+1])
  #define PAF(k) __builtin_bit_cast(bf16x8,pw##k)
  #define VFR(i) (bf16x8){vlo[i][0],vlo[i][1],vlo[i][2],vlo[i][3],vhi[i][0],vhi[i][1],vhi[i][2],vhi[i][3]}
  #define PIN(x) asm volatile("":"+v"(x))
  #define MX3(a,b,c) __builtin_fmaxf(__builtin_fmaxf((a),(b)),(c))
  #define GAPA(MF,A0,A1,A2,A3,W0,W1,PW) do{ MF; sacc+=A0; sacc+=A1; sacc+=A2; sacc+=A3; PIN(sacc); W0; W1; PIN(PW); SBAR(); }while(0)
  #define EX(v) __builtin_amdgcn_exp2f(v)
  #define GAPB(MF,VR,X,B) do{ MF; VR; X[B]=EX(X[B]); X[B+1]=EX(X[B+1]); PIN(X); SBAR(); }while(0)
  #define VRJ(kg,d0) do{ vlo[d0]=vtr(vp_+((d0)*4096+(kg)*1024)); vhi[d0]=vtr(vp_+((d0)*4096+(kg)*1024+512)); }while(0)
  #define KRD(G,j) do{ if(G){ kload2(kf,kp0+sl_next,j); SBAR(); } }while(0)
  #define STEP(C0,C1,P0,P1,t,GK,GV,GL) do{ SBAR(); \
    const lds_cptr vp_=vp0+2*sl_prev; \
    float sacc=(P0[0]+P0[1]); \
    GAPA(C0=__builtin_amdgcn_mfma_f32_32x32x16_bf16(kf[0],qr[0],negm,0,0,0), P0[2],P0[3],P0[4],P0[5],     pw0[0]=PKW(P0,0), pw0[1]=PKW(P0,2), pw0); \
    GAPA(C1=__builtin_amdgcn_mfma_f32_32x32x16_bf16(kf[1],qr[0],negm,0,0,0), P0[6],P0[7],P0[8],P0[9],     pw0[2]=PKW(P0,4), pw0[3]=PKW(P0,6), pw0); \
    GAPA(C0=__builtin_amdgcn_mfma_f32_32x32x16_bf16(kf[2],qr[1],C0,0,0,0),   P0[10],P0[11],P0[12],P0[13], pw1[0]=PKW(P0,8), pw1[1]=PKW(P0,10), pw1); \
    GAPA(C1=__builtin_amdgcn_mfma_f32_32x32x16_bf16(kf[3],qr[1],C1,0,0,0),   P0[14],P0[15],P1[0],P1[1],   pw1[2]=PKW(P0,12),pw1[3]=PKW(P0,14), pw1); \
    GAPA(C0=__builtin_amdgcn_mfma_f32_32x32x16_bf16(kf[4],qr[2],C0,0,0,0),   P1[2],P1[3],P1[4],P1[5],     pw2[0]=PKW(P1,0), pw2[1]=PKW(P1,2), pw2); \
    GAPA(C1=__builtin_amdgcn_mfma_f32_32x32x16_bf16(kf[5],qr[2],C1,0,0,0),   P1[6],P1[7],P1[8],P1[9],     pw2[2]=PKW(P1,4), pw2[3]=PKW(P1,6), pw2); \
    GAPA(C0=__builtin_amdgcn_mfma_f32_32x32x16_bf16(kf[6],qr[3],C0,0,0,0),   P1[10],P1[11],P1[12],P1[13], pw3[0]=PKW(P1,8), pw3[1]=PKW(P1,10), pw3); \
    GAPA(C1=__builtin_amdgcn_mfma_f32_32x32x16_bf16(kf[7],qr[3],C1,0,0,0),   P1[14],P1[15],0.f,0.f,       pw3[2]=PKW(P1,12),pw3[3]=PKW(P1,14), pw3); \
    l_reg+=sacc; \
    if(GK){DMA_K((t)+3,sl_cur);} if(GV){DMA_V((t)+1,sl_next);} \
    VRJ(0,0); VRJ(0,1); VRJ(0,2); VRJ(0,3); SBAR(); \
    CMASK(C0,C1,t); \
    { float a=MX3(C0[0],C0[1],C1[0]),b=MX3(C0[2],C0[3],C1[1]); a=MX3(a,C1[2],C1[3]); \
      _Pragma("unroll") for(int r=4;r<16;r+=4){a=MX3(a,C0[r],C0[r+1]);b=MX3(b,C0[r+2],C0[r+3]);a=MX3(a,C1[r],C1[r+1]);b=MX3(b,C1[r+2],C1[r+3]);} \
      float rm=__builtin_fmaxf(a,b); { auto rr=__builtin_amdgcn_permlane32_swap(__float_as_uint(rm),__float_as_uint(rm),false,false); rm=__builtin_fmaxf(__uint_as_float(rr[0]),__uint_as_float(rr[1])); } \
      resc=false; \
      if(__builtin_expect(__any(rm>(float)THRL),0)){ const float dl=__builtin_fmaxf(rm,0.f); mhat+=dl; \
        _Pragma("unroll") for(int r=0;r<16;++r){C0[r]-=dl;C1[r]-=dl;} \
        _Pragma("unroll") for(int r=0;r<16;++r)negm[r]=-mhat; asm volatile("":"+v"(negm)); \
        const float f=__builtin_amdgcn_exp2f(-dl); l_reg*=f; if(hi==0)wsf[r32]=f; resc=true; } } \
    SBAR(); \
    GAPB(o[0]=__builtin_amdgcn_mfma_f32_32x32x16_bf16(PAF(0),VFR(0),o[0],0,0,0), VRJ(1,0), C0,0); \
    GAPB(o[1]=__builtin_amdgcn_mfma_f32_32x32x16_bf16(PAF(0),VFR(1),o[1],0,0,0), VRJ(1,1), C0,2); \
    GAPB(o[2]=__builtin_amdgcn_mfma_f32_32x32x16_bf16(PAF(0),VFR(2),o[2],0,0,0), VRJ(1,2), C0,4); \
    GAPB(o[3]=__builtin_amdgcn_mfma_f32_32x32x16_bf16(PAF(0),VFR(3),o[3],0,0,0), VRJ(1,3), C0,6); \
    GAPB(o[0]=__builtin_amdgcn_mfma_f32_32x32x16_bf16(PAF(1),VFR(0),o[0],0,0,0), VRJ(2,0), C0,8); \
    KRD(GL,0); GAPB(o[1]=__builtin_amdgcn_mfma_f32_32x32x16_bf16(PAF(1),VFR(1),o[1],0,0,0), VRJ(2,1), C0,10); \
    GAPB(o[2]=__builtin_amdgcn_mfma_f32_32x32x16_bf16(PAF(1),VFR(2),o[2],0,0,0), VRJ(2,2), C0,12); \
    KRD(GL,1); GAPB(o[3]=__builtin_amdgcn_mfma_f32_32x32x16_bf16(PAF(1),VFR(3),o[3],0,0,0), VRJ(2,3), C0,14); \
    GAPB(o[0]=__builtin_amdgcn_mfma_f32_32x32x16_bf16(PAF(2),VFR(0),o[0],0,0,0), VRJ(3,0), C1,0); \
    KRD(GL,2); GAPB(o[1]=__builtin_amdgcn_mfma_f32_32x32x16_bf16(PAF(2),VFR(1),o[1],0,0,0), VRJ(3,1), C1,2); \
    GAPB(o[2]=__builtin_amdgcn_mfma_f32_32x32x16_bf16(PAF(2),VFR(2),o[2],0,0,0), VRJ(3,2), C1,4); \
    KRD(GL,3); GAPB(o[3]=__builtin_amdgcn_mfma_f32_32x32x16_bf16(PAF(2),VFR(3),o[3],0,0,0), VRJ(3,3), C1,6); \
    GAPB(o[0]=__builtin_amdgcn_mfma_f32_32x32x16_bf16(PAF(3),VFR(0),o[0],0,0,0), (void)0, C1,8); \
    GAPB(o[1]=__builtin_amdgcn_mfma_f32_32x32x16_bf16(PAF(3),VFR(1),o[1],0,0,0), (void)0, C1,10); \
    GAPB(o[2]=__builtin_amdgcn_mfma_f32_32x32x16_bf16(PAF(3),VFR(2),o[2],0,0,0), (void)0, C1,12); \
    GAPB(o[3]=__builtin_amdgcn_mfma_f32_32x32x16_bf16(PAF(3),VFR(3),o[3],0,0,0), (void)0, C1,14); \
    }while(0)
  int t=1;
  #undef CMASK
  #define CMASK(P0,P1,t) do{}while(0)
  for(;t+7<NT;t+=2){
    STEP(pB0,pB1,pA0,pA1,t,true,true,true);     WAIT_BAR(3); RESC(); ROT();
    STEP(pA0,pA1,pB0,pB1,t+1,true,true,true);   WAIT_BAR(3); RESC(); ROT();
  }
  #undef CMASK
  #define CMASK(P0,P1,t) do{int jb_=(t)-(NT-4); if(jb_>=-2)biasmask(P0,P1,jb_,qrel,hi,tab);}while(0)
  #define ENDW(tt) do{ if((tt)+3<NT){WAIT_BAR(3);} else if((tt)+2<NT){WAIT_BAR(2);} else {WAIT_BAR(0);} }while(0)
  for(;t+1<NT;t+=2){
    STEP(pB0,pB1,pA0,pA1,t,(t+3<NT),(t+1<NT),(t+1<NT));       ENDW(t);   RESC(); ROT();
    STEP(pA0,pA1,pB0,pB1,t+1,(t+4<NT),(t+2<NT),(t+2<NT));     ENDW(t+1); RESC(); ROT();
  }
  STEP(pB0,pB1,pA0,pA1,NT-1,false,false,false); RESC();
  { float sacc=pB0[0]+pB0[1]; _Pragma("unroll") for(int r=2;r<16;++r)sacc+=pB0[r]; _Pragma("unroll") for(int r=0;r<16;++r)sacc+=pB1[r]; l_reg+=sacc;
    pw0=(u32x4){PKW(pB0,0),PKW(pB0,2),PKW(pB0,4),PKW(pB0,6)};pw1=(u32x4){PKW(pB0,8),PKW(pB0,10),PKW(pB0,12),PKW(pB0,14)};pw2=(u32x4){PKW(pB1,0),PKW(pB1,2),PKW(pB1,4),PKW(pB1,6)};pw3=(u32x4){PKW(pB1,8),PKW(pB1,10),PKW(pB1,12),PKW(pB1,14)};
    SBAR(); pv(o,vb0+2*sl_cur,PAF(0),PAF(1),PAF(2),PAF(3)); }
  #undef PKW
  #undef PAF
  #undef VFR
  #undef PIN
  #undef MX3
  #undef GAPA
  #undef GAPB
  #undef EX
  #undef VRJ
  #undef KRD
  #undef STEP
  #undef ENDW
  {auto rr=__builtin_amdgcn_permlane32_swap(__float_as_uint(l_reg),__float_as_uint(l_reg),false,false);l_reg=__uint_as_float(rr[0])+__uint_as_float(rr[1]);}
  if(hi==0)wsf[32+r32]=l_reg;asm volatile("s_waitcnt lgkmcnt(0)":::"memory");
  float rli[16];
  #pragma unroll
  for(int r=0;r<16;++r)rli[r]=__builtin_amdgcn_rcpf(wsf[32+crow(r,hi)]);
  bf16*Ow=O+(rowbase+q0+wid*QBLK)*OP+ocol;
  asm volatile("s_waitcnt lgkmcnt(0)\n\ts_barrier":::"memory");
  { bf16*stg=(bf16*)(shm+LDS_OST)+wid*4096;
    #pragma unroll
    for(int r=0;r<16;++r){const int orow=crow(r,hi);
      #pragma unroll
      for(int d0=0;d0<4;++d0)stg[orow*128+d0*32+r32]=__float2bfloat16(o[d0][r]*rli[r]);}
    asm volatile("s_waitcnt lgkmcnt(0)":::"memory");
    #pragma unroll
    for(int i=0;i<8;++i){const int row=i*4+(lane>>4),ch=lane&15; const u32x4 v=*(const u32x4*)(stg+row*128+ch*8); ATTN_STORE16(Ow+(long)row*OP+ch*8,v);} }
  asm volatile("s_waitcnt lgkmcnt(0)\n\ts_barrier":::"memory");
  #undef DMA_K
  #undef DMA_V
  #undef CMASK
  #undef START
  #undef RESC
  #undef ROT
}
constexpr int ATTN_LDS_BYTES=LDS_BYTES;
__device__ __forceinline__ bool attn_next(int G,int vcu,int i,int&b,int&vh,int&qb){
  if(G==256){ const int g=vcu&7, bv=vcu>>3; int q=-1;
    if(g<7){ q=(i==0)?16-g:(i==1)?1+g:-1; } else { q=(i==0)?9:(i==1)?8:(i==2)?0:-1; }
    if(q<0)return false; b=bv>>3; vh=bv&7; qb=q; return true; }
  const int u=vcu+i*G; if(u>=BATCH*8*17)return false; b=u/(8*17); vh=(u/17)&7; qb=u%17; return true;
}
#undef SBAR
#undef WAIT_BAR
}
namespace mk {
using pg8::bf16_t; using pg8::bf16x8; using pg8::f32x4; using pg8::u32x4; using pg8::u32x2; using pg8::Unit; using pg8::Gemm; using pg8::cvt_pk_bf16;
constexpr int NWAVES = 8;
constexpr int D = 1024, NB = 4, SEQ = 4096, NM = 16, MR = NB * SEQ  , MROWS = MR + NM  , MPAD = 16640;
constexpr int TP = 4352, MATT = NB * TP;
constexpr int INC = 8192, FFD = 2816, FFE = 3584, NE = 8;
constexpr float EPS = 1e-6f, LOG2E = 1.4426950408889634f, C2 = 0.125f * LOG2E;
constexpr size_t MiB = 1u << 20;
constexpr size_t WS_CTL = 0, CTL_ZERO_BYTES = 1 * MiB;
constexpr size_t WS_SMALL = 1 * MiB;
constexpr size_t WS_HN = 3 * MiB;
constexpr size_t WS_WIN = 36 * MiB, WS_WBR = 52 * MiB, WS_WO = 55 * MiB, WS_WGU0 = 57 * MiB, WS_WD0 = 68 * MiB;
constexpr size_t WS_U = 74 * MiB;
constexpr size_t WS_O = 123 * MiB, WS_ST = 157 * MiB, WS_HQ = 190 * MiB, WS_LOGF = 207 * MiB, WS_HG = 240 * MiB;
constexpr size_t WS_QK = 257 * MiB, WS_V = 291 * MiB, WS_CONV = 308 * MiB, WS_HV = 357 * MiB, WS_DS = 374 * MiB;
constexpr size_t WS_GATES = 257 * MiB, WS_MIXED = 355 * MiB, WS_MSCR = 388 * MiB;
constexpr size_t WS_H0 = 123 * MiB;
constexpr size_t WS_DEC = 440 * MiB;
constexpr size_t WS_HQ2 = 441 * MiB, WS_OI = 458 * MiB;
constexpr size_t WS_MGU = 36 * MiB, WS_MD = 148 * MiB, WS_MH = 204 * MiB, WS_MY = 442 * MiB;
constexpr size_t WS_HN8 = 491 * MiB, WS_WIN8 = 508 * MiB;
constexpr size_t WS_SLAB = 36 * MiB;
constexpr int LISTCAP = 16640;
constexpr size_t SMB_LIST = 128 * 1024, SMB_TOK = 704 * 1024;
constexpr int CW_CNT = 8192;
constexpr int SM_SCAL = 0;
constexpr int SM_LOGLB = 64, SM_LOG1M = 64 + 1024;
constexpr int SM_TAB = 64 + 2048;
constexpr int SM_METAHS = 4096;
constexpr int RING_OFF = 0, RING_BYTES = 131072, LDSCTL_OFF = RING_BYTES, MISC_OFF = LDSCTL_OFF + 320, LDS_BYTES = 147456;

#define GAS __attribute__((address_space(1)))
#define LAS __attribute__((address_space(3)))
typedef GAS unsigned gu32;
#define RLX_AGENT __ATOMIC_RELAXED, __HIP_MEMORY_SCOPE_AGENT
#define LDS_WAIT() asm volatile("s_waitcnt lgkmcnt(0)" ::: "memory")
__device__ __forceinline__ unsigned f2bf(float f) { unsigned u = __builtin_bit_cast(unsigned, f); return (u + 0x7fffu + ((u >> 16) & 1u)) >> 16; }
__device__ __forceinline__ unsigned pk2(float lo, float hi) { return cvt_pk_bf16(lo, hi); }
__device__ __forceinline__ unsigned f2bf_hw(float f) { return cvt_pk_bf16(f, 0.f) & 0xffffu; }
__device__ __forceinline__ float bf2f(unsigned short b) { return __builtin_bit_cast(float, (unsigned)b << 16); }
__device__ __forceinline__ float bflo(unsigned w) { return __builtin_bit_cast(float, w << 16); }
__device__ __forceinline__ float bfhi(unsigned w) { return __builtin_bit_cast(float, w & 0xffff0000u); }
#ifdef SLOWMATH
__device__ __forceinline__ float sigm(float x) { return 1.f / (1.f + __expf(-x)); }
__device__ __forceinline__ float silu(float x) { return x / (1.f + __expf(-x)); }
#else
__device__ __forceinline__ float sigm(float x) { return __builtin_amdgcn_rcpf(1.f + __expf(-x)); }
__device__ __forceinline__ float silu(float x) { return x * __builtin_amdgcn_rcpf(1.f + __expf(-x)); }
#endif
#ifdef SLOWMATH
__device__ __forceinline__ float logf_gate(float z, float la, float lm) { const float ls = fminf(z, 0.f) - log1pf(expf(-fabsf(z))), bb = lm + ls; return (la == -INFINITY) ? bb : fmaxf(la, bb) + log1pf(expf(-fabsf(la - bb))); }
#else
__device__ __forceinline__ float logf_gate(float z, float la, float lm) { const float ls = fminf(z, 0.f) - __logf(1.f + __expf(-fabsf(z))), bb = lm + ls; return (la == -INFINITY) ? bb : fmaxf(la, bb) + __logf(1.f + __expf(-fabsf(la - bb))); }
#endif
template <int O> __device__ __forceinline__ float xadd(float v) {
    if constexpr (O < 32) return v + __builtin_bit_cast(float, __builtin_amdgcn_ds_swizzle(__builtin_bit_cast(int, v), (O << 10) | 0x1f));
    else { const int l = pg8::lane_id(); return v + __builtin_bit_cast(float, __builtin_amdgcn_ds_bpermute((l ^ 32) << 2, __builtin_bit_cast(int, v))); }
}
__device__ __forceinline__ float wave_sum(float v) { v = xadd<1>(v); v = xadd<2>(v); v = xadd<4>(v); v = xadd<8>(v); v = xadd<16>(v); return xadd<32>(v); }

#define XB_TMO      128
#define XB_XCNT(j)  (256  + 64 * (j))
#define XB_XSUB(j)  (1280 + 64 * (j))
#define XB_XGEN(j)  (2304 + 64 * (j))
#define XB_TOP      3328
#define XB_TOPGEN   3392
#define XCD_BAR_WORDS 3456
#define XB_SPIN_CAP (1u << 18)
__device__ __forceinline__ unsigned xb_ld(unsigned* p)              { return __hip_atomic_load(p, __ATOMIC_RELAXED, __HIP_MEMORY_SCOPE_AGENT); }
__device__ __forceinline__ unsigned xb_add(unsigned* p, unsigned v) { return __hip_atomic_fetch_add(p, v, __ATOMIC_RELAXED, __HIP_MEMORY_SCOPE_AGENT); }
__device__ __forceinline__ unsigned xb_xcc_id() { return (unsigned)__builtin_amdgcn_s_getreg((3 << 11) | 20) & 0xFu; }
#define XB_SPIN(cond, bar) do { unsigned _sp = 0; while (cond) { __builtin_amdgcn_s_sleep(1); \
    if ((++_sp & 255u) == 0u) { if (xb_ld(&(bar)[XB_TMO])) break; if (_sp > XB_SPIN_CAP) { atomicAdd(&(bar)[XB_TMO], 1u); break; } } } } while (0)
struct XcdBarrier { unsigned* bar; unsigned x; volatile LAS unsigned* st; };
__device__ __forceinline__ XcdBarrier xcd_barrier_post(unsigned* bar, volatile LAS unsigned* st, int tid) {
    XcdBarrier b; b.bar = bar; b.x = xb_xcc_id(); b.st = st;
    if (tid == 0) (void)xb_add(&bar[XB_XCNT(b.x)], 1u);
    return b;
}
__device__ __forceinline__ void xcd_barrier_complete(unsigned* bar, unsigned x, unsigned& nloc, unsigned& nx) {
    const unsigned G = gridDim.x * gridDim.y * gridDim.z;
    unsigned sum, cnt, mine, sp = 0u;
    for (;;) {
        sum = 0u; cnt = 0u; mine = 0u;
#pragma unroll
        for (unsigned j = 0; j < 16; ++j) { const unsigned c = xb_ld(&bar[XB_XCNT(j)]); sum += c; cnt += (c > 0u) ? 1u : 0u; mine = (j == x) ? c : mine; }
        if (sum == G) break;
        __builtin_amdgcn_s_sleep(1);
        if ((++sp & 255u) == 0u) { if (xb_ld(&bar[XB_TMO])) break; if (sp > XB_SPIN_CAP) { atomicAdd(&bar[XB_TMO], 1u); break; } }
    }
    nloc = mine > 0u ? mine : 1u; nx = cnt > 0u ? cnt : 1u;
}
__device__ __forceinline__ void xcd_barrier(const XcdBarrier& b, int tid) {
    asm volatile("s_waitcnt vmcnt(0)" ::: "memory");
    __syncthreads();
    if (tid == 0) {
        unsigned* bar = b.bar;
        __builtin_amdgcn_s_waitcnt(0);
        unsigned nloc = b.st[0], nx = b.st[1];
        if (nloc == 0u) { xcd_barrier_complete(bar, b.x, nloc, nx); b.st[0] = nloc; b.st[1] = nx; }
        const unsigned old = xb_add(&bar[XB_XSUB(b.x)], 1u);
        const unsigned gen = old / nloc, tgt = (gen + 1u) * nx;
        if (old + 1u == (gen + 1u) * nloc) {
            __builtin_amdgcn_fence(__ATOMIC_RELEASE, "agent");
            asm volatile("s_waitcnt vmcnt(0)" ::: "memory");
            (void)xb_add(&bar[XB_TOP], 1u);
        }
        XB_SPIN(xb_ld(&bar[XB_TOP]) < tgt, bar);
        __builtin_amdgcn_fence(__ATOMIC_ACQUIRE, "agent");
        asm volatile("s_waitcnt vmcnt(0)" ::: "memory");
    }
    __syncthreads();
}

struct Frame {
    LAS unsigned char* lds; unsigned char* lds_gen;
    int tid, lane, wave, vcu, G;
    const float* const* in; float* out; unsigned char* ws;
};
#define WSP(T, off) ((T*)(F.ws + (off)))
#define SMALLF (WSP(float, WS_SMALL))

__device__ __forceinline__ void cvt_block(const float* W, int ldw, int k0, int c0, bf16_t* WT, int ldt, int r0, LAS float* scr, int lane) {
    float wv[32];
    const float* wp = W + (size_t)(k0 + (lane >> 5)) * ldw + c0 + (lane & 31);
#pragma unroll
    for (int i = 0; i < 32; ++i) wv[i] = __builtin_nontemporal_load(wp + (size_t)(2 * i) * ldw);
#pragma unroll
    for (int i = 0; i < 32; ++i) scr[(2 * i + (lane >> 5)) * 33 + (lane & 31)] = wv[i];
    LDS_WAIT(); asm volatile("" ::: "memory");
    const int c = lane & 7;
#pragma unroll
    for (int j = 0; j < 4; ++j) { const int n = (lane >> 3) + 8 * j; const LAS float* s = scr + (8 * c) * 33 + n;
        u32x4 o; o.x = pk2(s[0 * 33], s[1 * 33]); o.y = pk2(s[2 * 33], s[3 * 33]); o.z = pk2(s[4 * 33], s[5 * 33]); o.w = pk2(s[6 * 33], s[7 * 33]);
        *(GAS u32x4*)(WT + (size_t)(r0 + n) * ldt + k0 + 8 * c) = o; }
    LDS_WAIT(); asm volatile("" ::: "memory");
}
constexpr float W8_SCALE = 32.f, H8_SCALE = 4.f, WD8_SCALE = 64.f;
__device__ __forceinline__ unsigned pk4_fp8(float a, float b, float c, float d) { int r = __builtin_amdgcn_cvt_pk_fp8_f32(a, b, 0, false); r = __builtin_amdgcn_cvt_pk_fp8_f32(c, d, r, true); return (unsigned)r; }
__device__ __forceinline__ void cvt_block_fp8(const float* W, int ldw, int k0, int c0, unsigned char* WT, int ldt, int r0, LAS float* scr, int lane, float wscale) {
    float wv[32];
    const float* wp = W + (size_t)(k0 + (lane >> 5)) * ldw + c0 + (lane & 31);
#pragma unroll
    for (int i = 0; i < 32; ++i) wv[i] = __builtin_nontemporal_load(wp + (size_t)(2 * i) * ldw);
#pragma unroll
    for (int i = 0; i < 32; ++i) scr[(2 * i + (lane >> 5)) * 33 + (lane & 31)] = wv[i] * wscale;
    LDS_WAIT(); asm volatile("" ::: "memory");
    const int c = lane & 7;
#pragma unroll
    for (int j = 0; j < 4; ++j) { const int n = (lane >> 3) + 8 * j; const LAS float* s = scr + (8 * c) * 33 + n;
        u32x2 o; o.x = pk4_fp8(s[0 * 33], s[1 * 33], s[2 * 33], s[3 * 33]); o.y = pk4_fp8(s[4 * 33], s[5 * 33], s[6 * 33], s[7 * 33]);
        *(GAS u32x2*)(WT + (size_t)(r0 + n) * ldt + k0 + 8 * c) = o; }
    LDS_WAIT(); asm volatile("" ::: "memory");
}
struct CvtItem { const float* W; int ldw, k0, c0; void* WT; int ldt, r0; };
__device__ __forceinline__ void cvt_load(float (&wv)[32], const CvtItem& c, int lane) {
    const float* wp = c.W + (size_t)(c.k0 + (lane >> 5)) * c.ldw + c.c0 + (lane & 31);
#pragma unroll
    for (int i = 0; i < 32; ++i) wv[i] = __builtin_nontemporal_load(wp + (size_t)(2 * i) * c.ldw);
}
template <bool FP8> __device__ __forceinline__ void cvt_store(const float (&wv)[32], const CvtItem& c, LAS float* scr, int lane, float wscale) {
#pragma unroll
    for (int i = 0; i < 32; ++i) scr[(2 * i + (lane >> 5)) * 33 + (lane & 31)] = FP8 ? wv[i] * wscale : wv[i];
    LDS_WAIT(); asm volatile("" ::: "memory");
    const int cc = lane & 7;
#pragma unroll
    for (int j = 0; j < 4; ++j) { const int n = (lane >> 3) + 8 * j; const LAS float* q = scr + (8 * cc) * 33 + n;
        if constexpr (FP8) { u32x2 o; o.x = pk4_fp8(q[0 * 33], q[1 * 33], q[2 * 33], q[3 * 33]); o.y = pk4_fp8(q[4 * 33], q[5 * 33], q[6 * 33], q[7 * 33]);
            *(GAS u32x2*)((unsigned char*)c.WT + (size_t)(c.r0 + n) * c.ldt + c.k0 + 8 * cc) = o; }
        else { u32x4 o; o.x = pk2(q[0 * 33], q[1 * 33]); o.y = pk2(q[2 * 33], q[3 * 33]); o.z = pk2(q[4 * 33], q[5 * 33]); o.w = pk2(q[6 * 33], q[7 * 33]);
            *(GAS u32x4*)((bf16_t*)c.WT + (size_t)(c.r0 + n) * c.ldt + c.k0 + 8 * cc) = o; } }
    LDS_WAIT(); asm volatile("" ::: "memory");
}
template <bool FP8, class Dec> __device__ __forceinline__ void cvt_run(int it0, int stride, int n, const Dec& dec, LAS float* scr, int lane, float wscale) {
    for (int it = it0; it < n; it += 2 * stride) {
        float a[32], b[32]; const CvtItem ca = dec(it); cvt_load(a, ca, lane);
        const int it2 = it + stride; const bool hb = it2 < n; CvtItem cb = ca; if (hb) { cb = dec(it2); cvt_load(b, cb, lane); }
        cvt_store<FP8>(a, ca, scr, lane, wscale); if (hb) cvt_store<FP8>(b, cb, scr, lane, wscale);
    }
}
__device__ __forceinline__ int win_src_col(int db) { const int r0 = db * 32, tile = r0 >> 8, loc = r0 & 255; if (tile >= 4) return r0; const int bj = loc >> 7, wc = (loc & 127) >> 5; return tile * 256 + 64 * wc + 32 * bj; }

__device__ __forceinline__ void convert_layer_weights(Frame& F, int l, int widx = -1, int nw = 0, int part = 0) {
    LAS float* scr = (LAS float*)(F.lds + RING_OFF + F.wave * 16384);
    const int gw = widx >= 0 ? widx : F.vcu * NWAVES + F.wave, NGW = widx >= 0 ? nw : F.G * NWAVES;
    const float* w_in = F.in[4] + (size_t)l * D * INC; const float* w_br = F.in[13] + (size_t)l * 3 * 512 * D; const float* w_o = F.in[14] + (size_t)l * D * D;
    constexpr int I_IN = 16 * 256, I_BR = 3 * 8 * 32, I_O = 16 * 32, I_GU = 16 * 176, I_DN = 44 * 32;
    const int nitems = I_IN + I_BR + I_O + (l == 0 ? I_GU + I_DN : 0);
    const auto dec = [&](int it) -> CvtItem { int r = it;
        if (r < I_IN) { const int kb = r >> 8, db = r & 255; return CvtItem{w_in, INC, kb * 64, win_src_col(db), WSP(bf16_t, WS_WIN), D, db * 32}; } r -= I_IN;
        if (r < I_BR) { const int br = r / 256, q = r % 256, kb = q >> 5, db = q & 31; return CvtItem{w_br + (size_t)br * 512 * D, D, kb * 64, db * 32, WSP(bf16_t, WS_WBR) + 512 * br, 1536, db * 32}; }   r -= I_BR;
        if (r < I_O) { const int kb = r >> 5, db = r & 31; return CvtItem{w_o, D, kb * 64, db * 32, WSP(bf16_t, WS_WO), D, db * 32}; } r -= I_O;
        if (r < I_GU) { const int kb = r / 176, db = r % 176, tile = db >> 3, l32 = db & 7; const float* src = (l32 < 4) ? F.in[15] : F.in[16];
            return CvtItem{src, FFD, kb * 64, tile * 128 + (l32 & 3) * 32, WSP(bf16_t, WS_WGU0), D, db * 32}; } r -= I_GU;
        const int kb = r >> 5, db = r & 31; return CvtItem{F.in[17], D, kb * 64, db * 32, WSP(bf16_t, WS_WD0), FFD, db * 32}; };
    const int it_lo = part == 2 ? I_IN + I_BR + I_O : 0, it_hi = part == 1 ? I_IN + I_BR + I_O : nitems;
    cvt_run<false>(it_lo + gw, NGW, it_hi, dec, scr, F.lane, 1.f);
    if (part == 2) return;
    const auto dec8 = [&](int it) -> CvtItem { const int kb = it / 96, db = it % 96; return CvtItem{w_in, INC, kb * 64, (160 + db) * 32, F.ws + WS_WIN8, D, db * 32}; };
    cvt_run<true>(gw, NGW, 16 * 96, dec8, scr, F.lane, W8_SCALE);
}
__device__ __forceinline__ void setup_small(Frame& F, bool tables = true) {
    float* sm = SMALLF;
    if (blockIdx.x == 0 && tables) {
        if (F.tid < 2) { const int l = F.tid; const float* lp = F.in[7] + l * 256; float s1 = 0.f, s2 = 0.f;
            for (int i = 0; i < 64; ++i) { s1 += lp[i] * lp[64 + i]; s2 += lp[128 + i] * lp[192 + i]; }
            const float li = 0.8f - 0.6f * expf(-0.3f * (float)l); sm[SM_SCAL + l * 4] = expf(s1) - expf(s2) + li; sm[SM_SCAL + l * 4 + 1] = 1.f - li; }
        { const int c = F.tid; const float a = F.in[11][c], b = F.in[11][512 + c], mx = fmaxf(a, b), e0 = expf(a - mx), e1 = expf(b - mx), lb1 = e1 / (e0 + e1);
            sm[SM_LOGLB + c] = -INFINITY; sm[SM_LOG1M + c] = 0.f; sm[SM_LOGLB + 512 + c] = logf(lb1); sm[SM_LOG1M + 512 + c] = log1pf(-lb1); }
        { const int h = F.tid >> 7, n = F.tid & 127; int bk = n; if (n >= 16) { bk = 16 + (int)(logf((float)n / 16.f) / 2.0794415416798357f * 16.f); bk = bk < 31 ? bk : 31; }
            sm[SM_TAB + h * 128 + n] = (F.in[9][bk * 4 + h] - F.in[9][31 * 4 + h]) * LOG2E; }
    }
    const int gt = F.vcu * 512 + F.tid, NT = F.G * 512;
    for (int i = gt; i < NE * LISTCAP; i += NT) ((int*)(F.ws + WS_SMALL + SMB_LIST))[i] = 0;
    for (int i = gt; i < NB * 240 * (1024 / 8); i += NT) { const int row = i / 128, c = i % 128, b = row / 240, p = 4112 + row % 240; *(GAS u32x4*)(WSP(bf16_t, WS_QK) + ((size_t)(b * TP + p)) * 1024 + c * 8) = (u32x4){0u, 0u, 0u, 0u}; }
    for (int i = gt; i < NB * 240 * (512 / 8); i += NT) { const int row = i / 64, c = i % 64, b = row / 240, p = 4112 + row % 240; *(GAS u32x4*)(WSP(bf16_t, WS_V) + ((size_t)(b * TP + p)) * 512 + c * 8) = (u32x4){0u, 0u, 0u, 0u}; }
}
__device__ __forceinline__ const float* res_row(Frame& F, int r, bool first) {
    if (r < MR) return (first ? F.in[0] : (const float*)F.out) + (size_t)r * D;
    return (first ? F.in[1] : (const float*)(SMALLF + SM_METAHS)) + (size_t)(r - MR) * D;
}
__device__ __forceinline__ float* res_row_w(Frame& F, int r) { return (r < MR) ? F.out + (size_t)r * D : SMALLF + SM_METAHS + (size_t)(r - MR) * D; }
__device__ __forceinline__ void norm_pass(Frame& F, const float* gain, bool first, bool copy8) {
    const int gw = F.vcu * NWAVES + F.wave, NGW = F.G * NWAVES;
    f32x4 gv[4];
#pragma unroll
    for (int j = 0; j < 4; ++j) gv[j] = ((const f32x4*)gain)[F.lane + 64 * j];
    for (int r = gw; r < MROWS; r += NGW) {
        const GAS f32x4* xr = (const GAS f32x4*)res_row(F, r, first) + F.lane;
        f32x4 v[4]; float s = 0.f;
#pragma unroll
        for (int j = 0; j < 4; ++j) { v[j] = xr[64 * j]; s += (v[j].x * v[j].x + v[j].y * v[j].y) + (v[j].z * v[j].z + v[j].w * v[j].w); }
        const float sc = rsqrtf(wave_sum(s) * (1.f / D) + EPS);
        GAS u32x2* o = (GAS u32x2*)(WSP(bf16_t, WS_HN) + (size_t)r * D) + F.lane;
#pragma unroll
        for (int j = 0; j < 4; ++j) { u32x2 w; w.x = pk2(v[j].x * sc * gv[j].x, v[j].y * sc * gv[j].y); w.y = pk2(v[j].z * sc * gv[j].z, v[j].w * sc * gv[j].w); o[64 * j] = w; }
        if (copy8 && r < MR) { GAS unsigned* o8 = (GAS unsigned*)(F.ws + WS_HN8 + (size_t)r * D) + F.lane;
#pragma unroll
            for (int j = 0; j < 4; ++j) o8[64 * j] = pk4_fp8(v[j].x * sc * gv[j].x, v[j].y * sc * gv[j].y, v[j].z * sc * gv[j].z, v[j].w * sc * gv[j].w); }
    }
}

struct TileOrder {
    int nM, nN, nwg, G, c, pn0; long lda2, ldb2;
    __device__ void init(int nM_, int nN_, int pn0_, int G_, int c_, int lda, int ldb) { nM = nM_; nN = nN_; nwg = nM * nN; G = G_; c = c_; pn0 = pn0_; lda2 = 2L * lda; ldb2 = 2L * ldb; }
    __device__ __forceinline__ bool next(int i, Unit& u) const {
        const long L = (long)i * G + c; if (L >= nwg) return false;
        int wgid = (int)L; { const int q = nwg / 8, r = nwg % 8, xcd = wgid % 8, off = wgid / 8; wgid = (xcd < r ? xcd * (q + 1) : r * (q + 1) + (xcd - r) * q) + off; }
        const int nig = 8 * nN, gid = wgid / nig, fm = gid * 8, gsz = (nM - fm) < 8 ? (nM - fm) : 8;
        u.pm = fm + ((wgid % nig) % gsz); u.pn = pn0 + (wgid % nig) / gsz; u.z = 0; u.a_off = (unsigned)((long)u.pm * 256 * lda2); u.b_off = (unsigned)((long)u.pn * 256 * ldb2); u.gidx = nullptr; return true;
    }
};
__device__ __forceinline__ u32x4 pack8(const f32x4 a, const f32x4 b) { u32x4 w; w.x = cvt_pk_bf16(a[0], a[1]); w.y = cvt_pk_bf16(a[2], a[3]); w.z = cvt_pk_bf16(b[0], b[1]); w.w = cvt_pk_bf16(b[2], b[3]); return w; }
__device__ __forceinline__ void store_att(bf16_t* buf, int pitch, int r, int col, u32x4 w) {
    if (r < MR) { const int ar = (r >> 12) * TP + NM + (r & 4095); *(u32x4*)(buf + (size_t)ar * pitch + col) = w; }
    else { const int j = r - MR;
#pragma unroll
        for (int b = 0; b < NB; ++b) *(u32x4*)(buf + (size_t)(b * TP + j) * pitch + col) = w; }
}
struct EpiProj {
    static constexpr bool PERM = true, MID = false;
    unsigned char* ws; const float *qg, *kg; int l; float gsc;
    __device__ __forceinline__ void row(const Unit& u, int r, int slot, int wc, int fq, const f32x4 (&v)[2][2]) const {
        const int pn = u.pn;
        bf16_t* QK = (bf16_t*)(ws + WS_QK); bf16_t* V = (bf16_t*)(ws + WS_V); bf16_t* CONV = (bf16_t*)(ws + WS_CONV); bf16_t* HQ = (bf16_t*)(ws + WS_HQ); bf16_t* HV = (bf16_t*)(ws + WS_HV); bf16_t* HG = (bf16_t*)(ws + WS_HG);
        bf16_t* GATES = (bf16_t*)(ws + WS_GATES); float* LOGF = (float*)(ws + WS_LOGF); const float* loglb = (const float*)(ws + WS_SMALL) + SM_LOGLB + l * 512; const float* log1m = (const float*)(ws + WS_SMALL) + SM_LOG1M + l * 512;
        if (pn < 4) {
            float ss = 0.f;
#pragma unroll
            for (int bj = 0; bj < 2; ++bj)
#pragma unroll
                for (int n = 0; n < 2; ++n) ss += (v[bj][n][0] * v[bj][n][0] + v[bj][n][1] * v[bj][n][1]) + (v[bj][n][2] * v[bj][n][2] + v[bj][n][3] * v[bj][n][3]);
            ss = xadd<16>(ss); ss = xadd<32>(ss);
            const float sc = rsqrtf(ss * (1.f / 64.f) + EPS) * (pn < 2 ? C2 : 1.f); const float* gv = pn < 2 ? qg : kg;
#pragma unroll
            for (int bj = 0; bj < 2; ++bj) { const int d0 = 32 * bj + 8 * fq; const f32x4 g0 = *(const f32x4*)(gv + d0), g1 = *(const f32x4*)(gv + d0 + 4);
                store_att(QK, 1024, r, pn * 256 + 64 * wc + d0, pack8(v[bj][0] * g0 * sc, v[bj][1] * g1 * sc)); }
            return;
        }
#pragma unroll
        for (int bj = 0; bj < 2; ++bj) {
            const int cl = 128 * bj + 32 * wc + 8 * fq; f32x4 a = v[bj][0], b = v[bj][1];
            if (pn < 6) { store_att(V, 512, r, (pn - 4) * 256 + cl, pack8(a, b)); }
            else if (pn < 12) { *(u32x4*)(CONV + (size_t)r * 1536 + (pn - 6) * 256 + cl) = pack8(a, b); }
            else if (pn < 14 || (pn >= 18 && pn < 20)) {
#pragma unroll
                for (int e = 0; e < 4; ++e) { a[e] = silu(a[e]); b[e] = silu(b[e]); }
                bf16_t* dst = (pn < 14) ? HQ + (size_t)r * 512 + (pn - 12) * 256 + cl : HG + (size_t)r * 512 + (pn - 18) * 256 + cl; *(u32x4*)dst = pack8(a, b); }
            else if (pn < 16) {
                const int c = (pn - 14) * 256 + cl; const f32x4 la0 = *(const f32x4*)(loglb + c), la1 = *(const f32x4*)(loglb + c + 4), lm0 = *(const f32x4*)(log1m + c), lm1 = *(const f32x4*)(log1m + c + 4);
                f32x4 o0, o1;
#pragma unroll
                for (int e = 0; e < 4; ++e) {
                    o0[e] = logf_gate(a[e], la0[e], lm0[e]); o1[e] = logf_gate(b[e], la1[e], lm1[e]);
                }
                float* dst = LOGF + (size_t)r * 512 + c; *(f32x4*)dst = o0; *(f32x4*)(dst + 4) = o1; }
            else if (pn < 18) { *(u32x4*)(HV + (size_t)r * 512 + (pn - 16) * 256 + cl) = pack8(a, b); }
            else {
#pragma unroll
                for (int e = 0; e < 4; ++e) { a[e] = sigm(a[e] * gsc); b[e] = sigm(b[e] * gsc); }
                *(u32x4*)(GATES + (size_t)r * 3072 + (pn - 20) * 256 + cl) = pack8(a, b); }
        }
    }
};
struct EpiMerge {
    static constexpr bool PERM = true, MID = true; static constexpr int MID_T0 = 8, MID_T1 = 16;
    const bf16_t* GATES; bf16_t* MIXED;
    __device__ __forceinline__ void mid_row(const Unit& u, int r, int t, int wc, int fq, f32x4 (&v)[2][2]) const {
        const int b = (t >> 3) - 1;
#pragma unroll
        for (int bj = 0; bj < 2; ++bj) {
            const bf16_t* gp = GATES + (size_t)r * 3072 + b * 1024 + u.pn * 256 + 128 * bj + 32 * wc + 8 * fq; const u32x4 ga = *(const u32x4*)gp, gb = *(const u32x4*)(gp + 1024);
#define MK_RT(x, y) ((x) * __builtin_amdgcn_rcpf(fmaxf((y), 1e-20f)))
            v[bj][0][0] *= MK_RT(bflo(ga.x), bflo(gb.x)); v[bj][0][1] *= MK_RT(bfhi(ga.x), bfhi(gb.x)); v[bj][0][2] *= MK_RT(bflo(ga.y), bflo(gb.y)); v[bj][0][3] *= MK_RT(bfhi(ga.y), bfhi(gb.y));
            v[bj][1][0] *= MK_RT(bflo(ga.z), bflo(gb.z)); v[bj][1][1] *= MK_RT(bfhi(ga.z), bfhi(gb.z)); v[bj][1][2] *= MK_RT(bflo(ga.w), bflo(gb.w)); v[bj][1][3] *= MK_RT(bfhi(ga.w), bfhi(gb.w));
#undef MK_RT
        }
    }
    __device__ __forceinline__ void row(const Unit& u, int r, int slot, int wc, int fq, const f32x4 (&v)[2][2]) const {
#pragma unroll
        for (int bj = 0; bj < 2; ++bj) {
            const int cl = 128 * bj + 32 * wc + 8 * fq; const u32x4 gw = *(const u32x4*)(GATES + (size_t)r * 3072 + 2048 + u.pn * 256 + cl);
            f32x4 a = v[bj][0], b = v[bj][1];
            a[0] *= bflo(gw.x); a[1] *= bfhi(gw.x); a[2] *= bflo(gw.y); a[3] *= bfhi(gw.y); b[0] *= bflo(gw.z); b[1] *= bfhi(gw.z); b[2] *= bflo(gw.w); b[3] *= bfhi(gw.w);
            *(u32x4*)(MIXED + (size_t)r * D + u.pn * 256 + cl) = pack8(a, b);
        }
    }
};
struct EpiRes {
    static constexpr bool PERM = false, MID = false;
    const float* base; float* out; const float* mbase; float* mout;
    __device__ __forceinline__ void row(const Unit& u, int r, int slot, int wc, int fq, const f32x4 (&v)[2][2]) const {
        const float* bp = (r < MR) ? base + (size_t)r * D : mbase + (size_t)(r - MR) * D; float* op = (r < MR) ? out + (size_t)r * D : mout + (size_t)(r - MR) * D;
#pragma unroll
        for (int bj = 0; bj < 2; ++bj)
#pragma unroll
            for (int n = 0; n < 2; ++n) { const int col = u.pn * 256 + 128 * bj + 32 * wc + 16 * n + 4 * fq; *(f32x4*)(op + col) = *(const f32x4*)(bp + col) + v[bj][n]; }
    }
};
struct EpiGU {
    static constexpr bool PERM = true, MID = false;
    bf16_t* H; int ldh; float sc;
    __device__ __forceinline__ void row(const Unit& u, int r, int slot, int wc, int fq, const f32x4 (&v)[2][2]) const {
        f32x4 a, b;
#pragma unroll
        for (int e = 0; e < 4; ++e) { a[e] = silu(v[0][0][e] * sc) * (v[1][0][e] * sc); b[e] = silu(v[0][1][e] * sc) * (v[1][1][e] * sc); }
        *(u32x4*)(H + (size_t)r * ldh + u.pn * 128 + 32 * wc + 8 * fq) = pack8(a, b);
    }
};

struct EpiGU8 {
    static constexpr bool PERM = true, MID = false;
    unsigned char* H; int ldh; float sc;
    __device__ __forceinline__ void row(const Unit& u, int r, int slot, int wc, int fq, const f32x4 (&v)[2][2]) const {
        f32x4 a, b;
#pragma unroll
        for (int e = 0; e < 4; ++e) { a[e] = silu(v[0][0][e] * sc) * (v[1][0][e] * (sc * H8_SCALE)); b[e] = silu(v[0][1][e] * sc) * (v[1][1][e] * (sc * H8_SCALE)); }
#pragma unroll
        for (int e = 0; e < 4; ++e) { a[e] = __builtin_amdgcn_fmed3f(a[e], -448.f, 448.f); b[e] = __builtin_amdgcn_fmed3f(b[e], -448.f, 448.f); }
        u32x2 o; o.x = pk4_fp8(a[0], a[1], a[2], a[3]); o.y = pk4_fp8(b[0], b[1], b[2], b[3]);
        *(u32x2*)(H + (size_t)r * ldh + u.pn * 128 + 32 * wc + 8 * fq) = o;
    }
};
template <class Epi>
__device__ __forceinline__ void meta_gemm(Frame& F, const bf16_t* A16, int lda, const bf16_t* Bt, int ldb, int K, int pn_lo, int pn_hi, const Epi& E) {
    const int fr = F.lane & 15, fq = F.lane >> 4;
    for (int task = pn_lo * 4 + F.vcu; task < pn_hi * 4; task += F.G) {
        const int pn = task >> 2, wc = task & 3; f32x4 v[2][2];
        pg8::small_tile<Epi::PERM>(F.lds + RING_OFF, A16, lda, Bt, ldb, K, pn, wc, v, F.wave);
        if (F.wave == 0) { Unit u; u.pm = 64; u.pn = pn; u.z = 0; u.a_off = 0; u.b_off = 0; u.gidx = nullptr; E.row(u, MR + fr, 0, wc, fq, v); }
    }
}
__device__ __forceinline__ void meta_merge(Frame& F, const bf16_t* U16, const bf16_t* Wbr, const bf16_t* GATES, bf16_t* MIXED) {
    const int fr = F.lane & 15, fq = F.lane >> 4;
    for (int task = F.vcu; task < 16; task += F.G) {
        const int pn = task >> 2, wc = task & 3; f32x4 tot[2][2];
#pragma unroll
        for (int bj = 0; bj < 2; ++bj)
#pragma unroll
            for (int n = 0; n < 2; ++n) tot[bj][n] = (f32x4){0.f, 0.f, 0.f, 0.f};
        for (int z = 0; z < 3; ++z) {
            f32x4 v[2][2];
            pg8::small_tile<true>(F.lds + RING_OFF, U16 + 512 * z, 1536, Wbr + 512 * z, 1536, 512, pn, wc, v, F.wave);
            if (F.wave == 0) {
#pragma unroll
                for (int bj = 0; bj < 2; ++bj) { const int cl = 128 * bj + 32 * wc + 8 * fq; const u32x4 gw = *(const u32x4*)(GATES + (size_t)(MR + fr) * 3072 + z * 1024 + pn * 256 + cl);
                    f32x4 a = v[bj][0], b = v[bj][1];
                    a[0] *= bflo(gw.x); a[1] *= bfhi(gw.x); a[2] *= bflo(gw.y); a[3] *= bfhi(gw.y); b[0] *= bflo(gw.z); b[1] *= bfhi(gw.z); b[2] *= bflo(gw.w); b[3] *= bfhi(gw.w);
                    tot[bj][0] += a; tot[bj][1] += b; }
            }
        }
        if (F.wave == 0) {
#pragma unroll
            for (int bj = 0; bj < 2; ++bj) { const int cl = 128 * bj + 32 * wc + 8 * fq; *(u32x4*)(MIXED + (size_t)(MR + fr) * D + pn * 256 + cl) = pack8(tot[bj][0], tot[bj][1]); }
        }
    }
}

__device__ __forceinline__ int prev_row(int r, int d) {
    if (r >= MR) { const int j = r - MR - d; return j >= 0 ? MR + j : -1; }
    const int s = r & 4095; if (s >= d) return r - d; return MR + NM + s - d;
}
__device__ __forceinline__ void conv_pass(Frame& F, const float* cw) {
    const bf16_t* CONV = WSP(bf16_t, WS_CONV); bf16_t* U = WSP(bf16_t, WS_U);
    const int gt = F.vcu * 512 + F.tid, NT = F.G * 512;
    for (int i = gt; i < MROWS * 64; i += NT) {
        const int r = i >> 6, c8 = (i & 63) * 8; float y[8];
#pragma unroll
        for (int e = 0; e < 8; ++e) y[e] = 0.f;
#pragma unroll
        for (int k = 0; k < 3; ++k) { const int rr = (k == 2) ? r : prev_row(r, 2 - k); if (rr < 0) continue;
            const u32x4 cv = *(const u32x4*)(CONV + (size_t)rr * 1536 + 512 + c8), hv = *(const u32x4*)(CONV + (size_t)rr * 1536 + 1024 + c8);
            const f32x4 w0 = *(const f32x4*)(cw + k * 512 + c8), w1 = *(const f32x4*)(cw + k * 512 + c8 + 4);
            y[0] += w0[0] * bflo(cv.x) * bflo(hv.x); y[1] += w0[1] * bfhi(cv.x) * bfhi(hv.x); y[2] += w0[2] * bflo(cv.y) * bflo(hv.y); y[3] += w0[3] * bfhi(cv.y) * bfhi(hv.y);
            y[4] += w1[0] * bflo(cv.z) * bflo(hv.z); y[5] += w1[1] * bfhi(cv.z) * bfhi(hv.z); y[6] += w1[2] * bflo(cv.w) * bflo(hv.w); y[7] += w1[3] * bfhi(cv.w) * bfhi(hv.w); }
        const u32x4 bv = *(const u32x4*)(CONV + (size_t)r * 1536 + c8);
        u32x4 o; o.x = pk2(bflo(bv.x) * y[0], bfhi(bv.x) * y[1]); o.y = pk2(bflo(bv.y) * y[2], bfhi(bv.y) * y[3]); o.z = pk2(bflo(bv.z) * y[4], bfhi(bv.z) * y[5]); o.w = pk2(bflo(bv.w) * y[6], bfhi(bv.w) * y[7]);
        *(u32x4*)(U + (size_t)r * 1536 + 512 + c8) = o;
    }
}
__device__ __forceinline__ void attcomb_pass(Frame& F, const float* sg, int l) {
    const bf16_t* O = WSP(bf16_t, WS_O); bf16_t* U = WSP(bf16_t, WS_U);
    const int gw = F.vcu * NWAVES + F.wave, NGW = F.G * NWAVES;
    const float lam = SMALLF[SM_SCAL + l * 4], oml = SMALLF[SM_SCAL + l * 4 + 1];
    const int c8 = F.lane * 8; const f32x4 g0 = *(const f32x4*)(sg + (c8 & 127)), g1 = *(const f32x4*)(sg + (c8 & 127) + 4);
    for (int r = gw; r < MROWS; r += NGW) {
        const int ar = (r < MR) ? (r >> 12) * TP + NM + (r & 4095) : (r - MR);
        const u32x4 a = *(const u32x4*)(O + (size_t)ar * 1024 + c8), b = *(const u32x4*)(O + (size_t)ar * 1024 + 512 + c8);
        float d[8]; d[0] = bflo(a.x) - lam * bflo(b.x); d[1] = bfhi(a.x) - lam * bfhi(b.x); d[2] = bflo(a.y) - lam * bflo(b.y); d[3] = bfhi(a.y) - lam * bfhi(b.y);
        d[4] = bflo(a.z) - lam * bflo(b.z); d[5] = bfhi(a.z) - lam * bfhi(b.z); d[6] = bflo(a.w) - lam * bflo(b.w); d[7] = bfhi(a.w) - lam * bfhi(b.w);
        float ss = 0.f;
#pragma unroll
        for (int e = 0; e < 8; ++e) ss += d[e] * d[e];
        ss = xadd<1>(ss); ss = xadd<2>(ss); ss = xadd<4>(ss); ss = xadd<8>(ss);
        const float sc = rsqrtf(ss * (1.f / 128.f) + EPS) * oml;
        u32x4 o; o.x = pk2(d[0] * sc * g0[0], d[1] * sc * g0[1]); o.y = pk2(d[2] * sc * g0[2], d[3] * sc * g0[3]); o.z = pk2(d[4] * sc * g1[0], d[5] * sc * g1[1]); o.w = pk2(d[6] * sc * g1[2], d[7] * sc * g1[3]);
        *(u32x4*)(U + (size_t)r * 1536 + c8) = o;
    }
}

constexpr int HA_QP = 0, HA_KP = 43520, HA_KT = HA_KP + 17408, HA_VT = HA_KT + 18432, HA_PB = HA_VT + 18432, HA_TOT = HA_PB + 9216;
__device__ __forceinline__ int qp_base(int j) { return j == 0 ? 0 : (j == 1 ? 64 : (j == 2 ? 112 : 144)); }
struct HgIn { float lf[16], qv[16], vv[16]; };
__device__ __forceinline__ void hgrnA_load(Frame& F, int id, HgIn& in) {
    const bool meta = id >= 1024; const int bh = meta ? 0 : id >> 6, c = id & 63, h = meta ? id - 1024 : bh & 3, b = bh >> 2;
    const int row0 = meta ? MR : b * SEQ + c * 64, nvalid = meta ? NM : 64;
    const int d = F.tid & 127, i = F.tid >> 7;
    const bf16_t* HQ = WSP(bf16_t, WS_HQ); const bf16_t* HV = WSP(bf16_t, WS_HV); const float* LOGF = WSP(float, WS_LOGF);
#pragma unroll
    for (int j = 0; j < 16; ++j) { const int t = 16 * i + j; const bool ok = t < nvalid; const size_t off = (size_t)(row0 + (ok ? t : 0)) * 512 + h * 128 + d;
        const float a = LOGF[off]; const unsigned short q = HQ[off], v = HV[off]; in.lf[j] = ok ? a : 0.f; in.qv[j] = ok ? bf2f(q) : 0.f; in.vv[j] = ok ? bf2f(v) : 0.f; }
}
#ifndef HG_NORAW
#define HG_BAR() do { asm volatile("s_waitcnt lgkmcnt(0)" ::: "memory"); __builtin_amdgcn_s_barrier(); asm volatile("" ::: "memory"); } while (0)
#else
#define HG_BAR() __syncthreads()
#endif
#define HG_BAR_UNUSED()
__device__ __forceinline__ void hgrnA_compute(Frame& F, int id, const HgIn& in) {
    const bool meta = id >= 1024; const int bh = meta ? 0 : id >> 6, c = id & 63, h = meta ? id - 1024 : bh & 3, b = bh >> 2;
    const int row0 = meta ? MR : b * SEQ + c * 64, nvalid = meta ? NM : 64;
    const int d = F.tid & 127, i = F.tid >> 7;
    LAS unsigned char* L = F.lds + RING_OFF;
    const float (&lf)[16] = in.lf; const float (&qv)[16] = in.qv; const float (&vv)[16] = in.vv;
    float Lc[16]; { float s = 0.f;
#pragma unroll
        for (int j = 0; j < 16; ++j) { s += lf[j]; Lc[j] = s; } }
    LAS float* TOT = (LAS float*)(L + HA_TOT);
    TOT[i * 128 + d] = Lc[15];
    HG_BAR();
    float rho[4]; { float s = 0.f;
#pragma unroll
        for (int j = 0; j < 4; ++j) { s += TOT[j * 128 + d]; rho[j] = s; } }
    const float rhoi = (i == 0) ? rho[0] : (i == 1) ? rho[1] : (i == 2) ? rho[2] : rho[3], ri = (i == 0) ? 0.f : (i == 1) ? rho[0] : (i == 2) ? rho[1] : rho[2], glast = rho[3];
    const float fK2 = __expf(glast - rhoi), fQ2 = __expf(rhoi);
    float fQ[4];
#pragma unroll
    for (int jj = 0; jj < 4; ++jj) fQ[jj] = (jj <= i) ? __expf(rhoi - rho[jj]) : 0.f;
    LAS bf16_t* KP = (LAS bf16_t*)(L + HA_KP); LAS bf16_t* QP = (LAS bf16_t*)(L + HA_QP);
    unsigned kt[8], vt[8];
#pragma unroll
    for (int j = 0; j < 16; j += 2) {
        float kp[2], qe[2];
#pragma unroll
        for (int q = 0; q < 2; ++q) { const float G = ri + Lc[j + q], E = __expf(G - rhoi), k = 1.f - __expf(lf[j + q]); kp[q] = k * __builtin_amdgcn_rcpf(E); qe[q] = qv[j + q] * E; }
        const int t = 16 * i + j;
        { const unsigned w = cvt_pk_bf16(kp[0], kp[1]); KP[t * 136 + d] = (bf16_t)(w & 0xffffu); KP[(t + 1) * 136 + d] = (bf16_t)(w >> 16); }
        kt[j >> 1] = cvt_pk_bf16(kp[0] * fK2, kp[1] * fK2); vt[j >> 1] = cvt_pk_bf16(vv[j], vv[j + 1]);
#pragma unroll
        for (int jj = 0; jj < 4; ++jj) if (jj <= i) { const unsigned w = cvt_pk_bf16(qe[0] * fQ[jj], qe[1] * fQ[jj]); const int rb = qp_base(jj) + t - 16 * jj; QP[rb * 136 + d] = (bf16_t)(w & 0xffffu); QP[(rb + 1) * 136 + d] = (bf16_t)(w >> 16); }
        { const unsigned w = cvt_pk_bf16(qe[0] * fQ2, qe[1] * fQ2); bf16_t* hq2 = WSP(bf16_t, WS_HQ2) + (size_t)(row0 + t) * 512 + h * 128 + d;
          if (t < nvalid) hq2[0] = (bf16_t)(w & 0xffffu); if (t + 1 < nvalid) hq2[512] = (bf16_t)(w >> 16); }
    }
    { LAS u32x4* ktp = (LAS u32x4*)(L + HA_KT + d * 144 + i * 32); ktp[0] = (u32x4){kt[0], kt[1], kt[2], kt[3]}; ktp[1] = (u32x4){kt[4], kt[5], kt[6], kt[7]};
      LAS u32x4* vtp = (LAS u32x4*)(L + HA_VT + d * 144 + i * 32); vtp[0] = (u32x4){vt[0], vt[1], vt[2], vt[3]}; vtp[1] = (u32x4){vt[4], vt[5], vt[6], vt[7]}; }
    if (i == 0) WSP(float, WS_DEC)[(size_t)id * 128 + d] = __expf(glast);
    HG_BAR();
    const int w = F.wave, fr = F.lane & 15, fq = F.lane >> 4;
    {
        LAS unsigned char* PB = L + HA_PB;
        for (int blk = w; blk < 16; blk += 8) {
            int it, js;
            if (blk < 10) { it = (blk >= 6) ? 3 : (blk >= 3) ? 2 : (blk >= 1) ? 1 : 0; js = blk - ((it * (it + 1)) >> 1); }
            else { const int q = blk - 10; it = (q < 3) ? 0 : (q < 5) ? 1 : 2; js = (q < 3) ? q + 1 : (q < 5) ? q - 1 : 3; }
            f32x4 acc = (f32x4){0.f, 0.f, 0.f, 0.f};
            if (blk < 10) {
#pragma unroll
                for (int ks = 0; ks < 4; ++ks) {
                    const bf16x8 qa = *(const LAS bf16x8*)(L + HA_QP + ((qp_base(js) + 16 * it - 16 * js + fr) * 136 + 32 * ks + 8 * fq) * 2);
                    const bf16x8 kb = *(const LAS bf16x8*)(L + HA_KP + ((16 * js + fr) * 136 + 32 * ks + 8 * fq) * 2);
                    acc = __builtin_amdgcn_mfma_f32_16x16x32_bf16(kb, qa, acc, 0, 0, 0);
                }
                if (it == js) {
#pragma unroll
                    for (int e = 0; e < 4; ++e) if (4 * fq + e > fr) acc[e] = 0.f;
                }
            }
            u32x2 pw; pw.x = pk2(acc[0], acc[1]); pw.y = pk2(acc[2], acc[3]);
            *(LAS u32x2*)(PB + (16 * it + fr) * 144 + (16 * js + 4 * fq) * 2) = pw;
        }
    }
    HG_BAR();
    {
        const int tb = w >> 1, dv0 = (w & 1) * 4;
        f32x4 acc[4];
#pragma unroll
        for (int q = 0; q < 4; ++q) acc[q] = (f32x4){0.f, 0.f, 0.f, 0.f};
#pragma unroll
        for (int ks = 0; ks < 2; ++ks) {
            const bf16x8 pa = *(const LAS bf16x8*)(L + HA_PB + (16 * tb + fr) * 144 + (32 * ks + 8 * fq) * 2);
#pragma unroll
            for (int q = 0; q < 4; ++q) { const bf16x8 vb = *(const LAS bf16x8*)(L + HA_VT + (16 * (dv0 + q) + fr) * 144 + (32 * ks + 8 * fq) * 2);
                acc[q] = __builtin_amdgcn_mfma_f32_16x16x32_bf16(vb, pa, acc[q], 0, 0, 0); }
        }
        const int t = 16 * tb + fr;
        if (t < nvalid) {
#pragma unroll
            for (int q = 0; q < 4; ++q) *(f32x4*)(WSP(float, WS_OI) + (size_t)(row0 + t) * 512 + h * 128 + 16 * (dv0 + q) + 4 * fq) = acc[q];
        }
    }
    {
        f32x4 acc[8];
#pragma unroll
        for (int q = 0; q < 8; ++q) acc[q] = (f32x4){0.f, 0.f, 0.f, 0.f};
#pragma unroll
        for (int ks = 0; ks < 2; ++ks) {
            const bf16x8 va = *(const LAS bf16x8*)(L + HA_VT + (16 * w + fr) * 144 + (32 * ks + 8 * fq) * 2);
#pragma unroll
            for (int q = 0; q < 8; ++q) { const bf16x8 kb = *(const LAS bf16x8*)(L + HA_KT + (16 * q + fr) * 144 + (32 * ks + 8 * fq) * 2);
                acc[q] = __builtin_amdgcn_mfma_f32_16x16x32_bf16(kb, va, acc[q], 0, 0, 0); }
        }
        float* DS = WSP(float, WS_DS) + (size_t)id * 16384 + (size_t)(16 * w + fr) * 128;
#pragma unroll
        for (int q = 0; q < 8; ++q) *(f32x4*)(DS + 16 * q + 4 * fq) = acc[q];
    }
    HG_BAR();
}
__device__ __forceinline__ void hgrn_scan(Frame& F) {
    const float* DS = WSP(float, WS_DS); const float* DEC = WSP(float, WS_DEC); bf16_t* ST = WSP(bf16_t, WS_ST);
    const int gt = F.vcu * 512 + F.tid, NT = F.G * 512;
    typedef float f32x2 __attribute__((ext_vector_type(2)));
    for (int idx = gt; idx < 16 * 8192; idx += NT) {
        const int bh = idx >> 13, e2 = (idx & 8191) * 2, dk = e2 & 127, h = bh & 3;
        f32x2 s = *(const f32x2*)(DS + (size_t)(1024 + h) * 16384 + e2);
#pragma unroll 8
        for (int c = 0; c < 64; ++c) {
            const size_t id = (size_t)bh * 64 + c;
            *(unsigned*)(ST + id * 16384 + e2) = pk2(s.x, s.y);
            const f32x2 dd = *(const f32x2*)(DEC + id * 128 + dk), ds = *(const f32x2*)(DS + id * 16384 + e2);
            s = dd * s + ds;
        }
    }
}
__device__ __forceinline__ void hgrnC_pass(Frame& F, const float* og) {
    const bf16_t* HQ = WSP(bf16_t, WS_HQ2); const bf16_t* HG = WSP(bf16_t, WS_HG); const float* OI = WSP(float, WS_OI); const bf16_t* ST = WSP(bf16_t, WS_ST); bf16_t* U = WSP(bf16_t, WS_U);
    const int gw = F.vcu * NWAVES + F.wave, NGW = F.G * NWAVES, fr = F.lane & 15, fq = F.lane >> 4;
    for (int task = gw; task < 1024 * 4 + 4; task += NGW) {
        const bool meta = task >= 4096; const int id = meta ? 0 : task >> 2, tb = meta ? 0 : task & 3, bh = id >> 6, c = id & 63, h = meta ? task - 4096 : bh & 3, b = bh >> 2;
        const int row = (meta ? MR : b * SEQ + c * 64 + 16 * tb) + fr;
        f32x4 acc[8];
#pragma unroll
        for (int q = 0; q < 8; ++q) acc[q] = *(const f32x4*)(OI + (size_t)row * 512 + h * 128 + 16 * q + 4 * fq);
        if (!meta) {
            const bf16_t* Sb = ST + (size_t)id * 16384;
#pragma unroll
            for (int ks = 0; ks < 4; ++ks) {
                const bf16x8 qa = *(const bf16x8*)(HQ + (size_t)row * 512 + h * 128 + 32 * ks + 8 * fq);
#pragma unroll
                for (int q = 0; q < 8; ++q) { const bf16x8 sb = *(const bf16x8*)(Sb + (size_t)(16 * q + fr) * 128 + 32 * ks + 8 * fq);
                    acc[q] = __builtin_amdgcn_mfma_f32_16x16x32_bf16(sb, qa, acc[q], 0, 0, 0); }
            }
        }
        float ss = 0.f;
#pragma unroll
        for (int q = 0; q < 8; ++q) ss += (acc[q][0] * acc[q][0] + acc[q][1] * acc[q][1]) + (acc[q][2] * acc[q][2] + acc[q][3] * acc[q][3]);
        ss = xadd<16>(ss); ss = xadd<32>(ss);
        const float sc = rsqrtf(ss * (1.f / 128.f) + EPS);
#pragma unroll
        for (int q = 0; q < 8; ++q) { const int dv = 16 * q + 4 * fq; const f32x4 g = *(const f32x4*)(og + dv); const u32x2 gg = *(const u32x2*)(HG + (size_t)row * 512 + h * 128 + dv);
            u32x2 o; o.x = pk2(acc[q][0] * sc * g[0] * bflo(gg.x), acc[q][1] * sc * g[1] * bfhi(gg.x)); o.y = pk2(acc[q][2] * sc * g[2] * bflo(gg.y), acc[q][3] * sc * g[3] * bfhi(gg.y));
            *(u32x2*)(U + (size_t)row * 1536 + 1024 + h * 128 + dv) = o; }
    }
}
struct TokInfo { int e1, s1, e2, s2; float w1, w2; int pad0, pad1; };
__device__ __forceinline__ void convert_moe_gu(Frame& F, int early = -1, int widx = 0, int nw = 1, int skip = -1) {
    LAS float* scr = early >= 0 ? (LAS float*)(F.lds + RING_OFF + F.wave * 16384) : (LAS float*)(F.lds + RING_OFF + 32768 + F.wave * 8704);
    const int gw = early >= 0 ? widx : F.vcu * NWAVES + F.wave, NGW = early >= 0 ? nw : F.G * NWAVES;
    constexpr int I_GU = 16 * 224;
    const int ne = early >= 0 ? 1 : (skip >= 0 ? NE - 1 : NE);
    const auto dec = [&](int it) -> CvtItem { int e = it / I_GU; const int r = it - e * I_GU, kb = r / 224, db = r % 224, tile = db >> 3, l32 = db & 7;
        e = early >= 0 ? early : (skip >= 0 && e >= skip ? e + 1 : e);
        const float* src = ((l32 < 4) ? F.in[19] : F.in[20]) + (size_t)e * D * FFE;
        return CvtItem{src, FFE, kb * 64, tile * 128 + (l32 & 3) * 32, F.ws + WS_MGU + (size_t)e * 7168 * D, D, db * 32}; };
    cvt_run<true>(gw, NGW, ne * I_GU, dec, scr, F.lane, W8_SCALE);
}
__device__ __forceinline__ void convert_moe_down(Frame& F, int widx, int nw) {
    LAS float* scr = (LAS float*)(F.lds + RING_OFF + F.wave * 16384);
    constexpr int I_DN = 56 * 32;
    const auto dec = [&](int it) -> CvtItem { const int e = it / I_DN, r = it - e * I_DN, kb = r >> 5, db = r & 31;
        return CvtItem{F.in[21] + (size_t)e * FFE * D, D, kb * 64, db * 32, F.ws + WS_MD + (size_t)e * D * FFE, FFE, db * 32}; };
    cvt_run<true>(widx, nw, NE * I_DN, dec, scr, F.lane, WD8_SCALE);
}
__device__ __forceinline__ void norm_route_pass(Frame& F, const float* gain) {
    LAS float* rwl = (LAS float*)(F.lds + RING_OFF);
    for (int i = F.tid; i < D * NE / 4; i += 512) ((LAS f32x4*)rwl)[i] = ((const f32x4*)F.in[18])[i];
    __syncthreads();
    const int gw = F.vcu * NWAVES + F.wave, NGW = F.G * NWAVES;
    f32x4 gv[4];
#pragma unroll
    for (int j = 0; j < 4; ++j) gv[j] = ((const f32x4*)gain)[F.lane + 64 * j];
    unsigned* cnt = (unsigned*)(F.ws + WS_CTL) + CW_CNT; int* lists = (int*)(F.ws + WS_SMALL + SMB_LIST); TokInfo* ti = (TokInfo*)(F.ws + WS_SMALL + SMB_TOK);
    for (int r = gw; r < MR; r += NGW) {
        const GAS f32x4* xr = (const GAS f32x4*)(F.out + (size_t)r * D) + F.lane;
        f32x4 v[4]; float s = 0.f;
#pragma unroll
        for (int j = 0; j < 4; ++j) { v[j] = xr[64 * j]; s += (v[j].x * v[j].x + v[j].y * v[j].y) + (v[j].z * v[j].z + v[j].w * v[j].w); }
        const float sc = rsqrtf(wave_sum(s) * (1.f / D) + EPS);
        GAS unsigned* o = (GAS unsigned*)(F.ws + WS_HN + (size_t)r * D) + F.lane;
        float lg[8];
#pragma unroll
        for (int e = 0; e < 8; ++e) lg[e] = 0.f;
#pragma unroll
        for (int j = 0; j < 4; ++j) {
            v[j] = v[j] * sc * gv[j];
            o[64 * j] = pk4_fp8(v[j].x, v[j].y, v[j].z, v[j].w);
#pragma unroll
            for (int q = 0; q < 4; ++q) { const int d = (F.lane + 64 * j) * 4 + q; const f32x4 r0 = *(const LAS f32x4*)(rwl + d * 8), r1 = *(const LAS f32x4*)(rwl + d * 8 + 4); const float x = v[j][q];
                lg[0] += x * r0[0]; lg[1] += x * r0[1]; lg[2] += x * r0[2]; lg[3] += x * r0[3]; lg[4] += x * r1[0]; lg[5] += x * r1[1]; lg[6] += x * r1[2]; lg[7] += x * r1[3]; }
        }
#pragma unroll
        for (int e = 0; e < 8; ++e) lg[e] = wave_sum(lg[e]);
        int i1 = 0; float m1 = lg[0];
#pragma unroll
        for (int e = 1; e < 8; ++e) if (lg[e] > m1) { m1 = lg[e]; i1 = e; }
        int i2 = -1; float m2 = -INFINITY;
#pragma unroll
        for (int e = 0; e < 8; ++e) if (e != i1 && lg[e] > m2) { m2 = lg[e]; i2 = e; }
        if (F.lane == 0) {
            const float w1 = 1.f / (1.f + expf(m2 - m1));
            const unsigned s1 = __hip_atomic_fetch_add(cnt + 64 * i1, 1u, RLX_AGENT), s2 = __hip_atomic_fetch_add(cnt + 64 * i2, 1u, RLX_AGENT);
            lists[i1 * LISTCAP + s1] = r; lists[i2 * LISTCAP + s2] = r;
            TokInfo t; t.e1 = i1; t.s1 = (int)s1; t.e2 = i2; t.s2 = (int)s2; t.w1 = w1; t.w2 = 1.f - w1; t.pad0 = 0; t.pad1 = 0; ti[r] = t;
        }
    }
}
struct MoeTiles { int ts[9]; };
__device__ __forceinline__ MoeTiles moe_tiles(Frame& F) {
    MoeTiles m; const unsigned* cnt = (const unsigned*)(F.ws + WS_CTL) + CW_CNT; int a = 0;
#pragma unroll
    for (int e = 0; e < 8; ++e) { m.ts[e] = a; const unsigned c = (unsigned)__builtin_amdgcn_readfirstlane((int)__hip_atomic_load(cnt + 64 * e, RLX_AGENT)); a += (int)((c + 255u) >> 8); }
    m.ts[8] = a; return m;
}
__device__ __forceinline__ int moe_expert_of(const MoeTiles& m, int rt) { int e = 0;
#pragma unroll
    for (int k = 1; k < 8; ++k) e += (rt >= m.ts[k]) ? 1 : 0;
    return e; }
struct MoeGuOrder {
    MoeTiles m; int G, c; const int* lists;
    __device__ __forceinline__ bool next(int i, Unit& u) const {
        const int L = i * G + c; if (L >= m.ts[8] * 28) return false;
        const int rt = L / 28, pn = L - rt * 28, e = moe_expert_of(m, rt);
        int tsb = 0;
#pragma unroll
        for (int k = 0; k < 8; ++k) tsb = (k == e) ? m.ts[k] : tsb;
        u.pm = rt; u.pn = pn; u.z = e; u.a_off = 0u; u.b_off = (unsigned)(((long)e * 7168 + pn * 256) * D); u.gidx = lists + e * LISTCAP + (rt - tsb) * 256; return true;
    }
};
struct MoeDownOrder {
    MoeTiles m; int G, c;
    __device__ __forceinline__ bool next(int i, Unit& u) const {
        const int nt = m.ts[8] < 128 ? m.ts[8] : 128; const int L = i * G + c; if (L >= nt * 4) return false;
        const int rt = L >> 2, pn = L & 3, e = moe_expert_of(m, rt);
        u.pm = rt; u.pn = pn; u.z = e; u.a_off = (unsigned)((long)rt * 256 * FFE); u.b_off = (unsigned)(((long)e * D + pn * 256) * FFE); u.gidx = nullptr; return true;
    }
};
struct MoeSlabOrder {
    MoeTiles m; int G, c, S, Kp;
    __device__ __forceinline__ bool next(int i, Unit& u) const {
        const int nleft = (m.ts[8] - 128) * 4; const int q = i * G + c; if (q >= nleft * S) return false;
        const int up = q / S, sl = q - up * S, rt = 128 + (up >> 2), pn = up & 3, e = moe_expert_of(m, rt);
        u.pm = rt; u.pn = pn; u.z = q; u.a_off = (unsigned)((long)rt * 256 * FFE + (long)sl * Kp * 2); u.b_off = (unsigned)(((long)e * D + pn * 256) * FFE + (long)sl * Kp * 2); u.gidx = nullptr; return true;
    }
};
struct EpiSlab {
    static constexpr bool PERM = false, MID = false;
    float* SL; float sc;
    __device__ __forceinline__ void row(const Unit& u, int r, int slot, int wc, int fq, const f32x4 (&v)[2][2]) const {
        float* p = SL + (size_t)u.z * 65536 + (size_t)(r & 255) * 256 + 32 * wc + 4 * fq;
#pragma unroll
        for (int bj = 0; bj < 2; ++bj)
#pragma unroll
            for (int n = 0; n < 2; ++n) *(f32x4*)(p + 128 * bj + 16 * n) = v[bj][n] * sc;
    }
};
__device__ __forceinline__ void moe_slab_split(int tiles, int G, int& S, int& Kp) { S = 7; Kp = 256; }
struct EpiY {
    static constexpr bool PERM = true, MID = false;
    bf16_t* Y; float sc;
    __device__ __forceinline__ void row(const Unit& u, int r, int slot, int wc, int fq, const f32x4 (&v)[2][2]) const {
#pragma unroll
        for (int bj = 0; bj < 2; ++bj) *(u32x4*)(Y + (size_t)r * D + u.pn * 256 + 128 * bj + 32 * wc + 8 * fq) = pack8(v[bj][0] * sc, v[bj][1] * sc);
    }
};
__device__ __forceinline__ f32x4 moe_y4(const bf16_t* Y, const float* SL, int S, size_t R, int j, int lane) {
    if (R < 32768) { const u32x2 y = *((const GAS u32x2*)(Y + R * D) + lane + 64 * j); return (f32x4){bflo(y.x), bfhi(y.x), bflo(y.y), bfhi(y.y)}; }
    const float* p = SL + ((size_t)(((R >> 8) - 128) * 4 + j) * S) * 65536 + (R & 255) * 256 + 4 * lane; f32x4 a = (f32x4){0.f, 0.f, 0.f, 0.f};
    for (int s0 = 0; s0 < S; s0 += 7) {
        f32x4 q[7];
#pragma unroll
        for (int sl = 0; sl < 7; ++sl) q[sl] = *(const f32x4*)(p + (size_t)(s0 + sl) * 65536);
#pragma unroll
        for (int sl = 0; sl < 7; ++sl) a += q[sl];
    }
    return a;
}
__device__ __forceinline__ void moe_combine_pass(Frame& F) {
    const MoeTiles m = moe_tiles(F); const TokInfo* ti = (const TokInfo*)(F.ws + WS_SMALL + SMB_TOK); const bf16_t* Y = WSP(bf16_t, WS_MY); const float* SL = WSP(float, WS_SLAB);
    int S, Kp; moe_slab_split(m.ts[8], F.G, S, Kp);
    const int gw = F.vcu * NWAVES + F.wave, NGW = F.G * NWAVES;
    TokInfo tn = ti[gw < MR ? gw : 0];
    for (int r = gw; r < MR; r += NGW) {
        const TokInfo t = tn; { const int rn = r + NGW; tn = ti[rn < MR ? rn : r]; }
        int b1 = 0, b2 = 0;
#pragma unroll
        for (int k = 0; k < 8; ++k) { b1 = (k == t.e1) ? m.ts[k] : b1; b2 = (k == t.e2) ? m.ts[k] : b2; }
        const size_t r1 = (size_t)b1 * 256 + t.s1, r2 = (size_t)b2 * 256 + t.s2;
        GAS f32x4* o = (GAS f32x4*)(F.out + (size_t)r * D) + F.lane;
        if (r1 < 32768 && r2 < 32768) {
            u32x2 y1[4], y2[4]; f32x4 x[4];
#pragma unroll
            for (int j = 0; j < 4; ++j) { y1[j] = *((const GAS u32x2*)(Y + r1 * D) + F.lane + 64 * j); y2[j] = *((const GAS u32x2*)(Y + r2 * D) + F.lane + 64 * j); x[j] = o[64 * j]; }
#pragma unroll
            for (int j = 0; j < 4; ++j) { x[j][0] += t.w1 * bflo(y1[j].x) + t.w2 * bflo(y2[j].x); x[j][1] += t.w1 * bfhi(y1[j].x) + t.w2 * bfhi(y2[j].x); x[j][2] += t.w1 * bflo(y1[j].y) + t.w2 * bflo(y2[j].y); x[j][3] += t.w1 * bfhi(y1[j].y) + t.w2 * bfhi(y2[j].y); o[64 * j] = x[j]; }
        } else {
#pragma unroll
            for (int j = 0; j < 4; ++j) { const f32x4 y1 = moe_y4(Y, SL, S, r1, j, F.lane), y2 = moe_y4(Y, SL, S, r2, j, F.lane); o[64 * j] = o[64 * j] + y1 * t.w1 + y2 * t.w2; }
        }
    }
}
}
namespace mk {
enum { P_CVT = 0, P_NORM1, P_PROJ, P_MIX, P_SCAN, P_FIN, P_GATES, P_MERGE, P_WOUT, P_NORM2, P_GU, P_DOWN, P_COMB, P_NPH };
struct Args { const float* in[22]; float* out; unsigned char* ws; unsigned pmask; int l0, l1; unsigned dup; };

#define PH(k) ((a.pmask >> (k)) & 1u)
#define PHASE_FRAME() Frame F = F0; { const int t_ = pg8::make_tid(F0.wave); F.tid = t_; F.lane = t_ & 63; F.wave = F0.wave; unsigned char* w_ = F0.ws; asm volatile("" : "+s"(w_)); F.ws = w_; int g_ = F0.G, v_ = F0.vcu; asm volatile("" : "+s"(g_), "+s"(v_)); F.G = g_; F.vcu = v_; } float* sm = SMALLF; (void)sm
#define GRID_BAR() xcd_barrier(bar, F.tid)
template <int l> __device__ __forceinline__ void layer_body(const Args& a, const Frame& F0, const XcdBarrier& bar, unsigned char* lds) {
    constexpr bool first = (l == 0);
#ifndef NO_P_CVT
        if (PH(P_CVT) && l == 0) for (int rep_ = 0; rep_ <= (int)((a.dup >> (16 + l)) & (a.dup >> P_CVT) & 1u); ++rep_) { PHASE_FRAME(); setup_small(F); if (F.G == 256) { if (F.vcu != 0) convert_layer_weights(F, 0, (F.vcu - 1) * NWAVES + F.wave, (F.G - 1) * NWAVES, 1); }   else convert_layer_weights(F, 0, -1, 0, 0); }
#endif
#ifndef NO_P_NORM1
        if (PH(P_NORM1)) for (int rep_ = 0; rep_ <= (int)((a.dup >> (16 + l)) & (a.dup >> P_NORM1) & 1u); ++rep_) { PHASE_FRAME(); norm_pass(F, F.in[2] + l * D, first, true); GRID_BAR(); }
#endif
#ifndef NO_P_PROJ
        if (PH(P_PROJ)) for (int rep_ = 0; rep_ <= (int)((a.dup >> (16 + l)) & (a.dup >> P_PROJ) & 1u); ++rep_) { PHASE_FRAME();
            Gemm g{WSP(bf16_t, WS_HN), WSP(bf16_t, WS_WIN), D, D, D}; TileOrder S; S.init(64, 20, 0, F.G, (int)blockIdx.x, D, D);
            EpiProj E{F.ws, F.in[5] + l * 64, F.in[6] + l * 64, l, 1.f};
            pg8::gemm_phase<EpiProj, TileOrder>(F.lds + RING_OFF, g, S, E, F.wave);
            meta_gemm(F, WSP(bf16_t, WS_HN) + (size_t)MR * D, D, WSP(bf16_t, WS_WIN), D, D, 0, 20, E);
            GRID_BAR();
        }
#endif
#ifndef NO_P_MIX
        if (PH(P_MIX)) for (int rep_ = 0; rep_ <= (int)((a.dup >> (16 + l)) & (a.dup >> P_MIX) & 1u); ++rep_) { PHASE_FRAME();
            if (!(a.dup & 0x8000u) || rep_ == 0) {
                if (F.G == 256) {
                    const bool hm = (F.vcu & 7) == 0 && F.vcu < 32; const int idm = 1024 + (F.vcu >> 3);
                    HgIn A, B; hgrnA_load(F, F.vcu, A); hgrnA_load(F, F.vcu + 256, B); hgrnA_compute(F, F.vcu, A);
                    hgrnA_load(F, F.vcu + 512, A); hgrnA_compute(F, F.vcu + 256, B); hgrnA_load(F, F.vcu + 768, B); hgrnA_compute(F, F.vcu + 512, A);
                    if (hm) hgrnA_load(F, idm, A);
                    hgrnA_compute(F, F.vcu + 768, B); if (hm) hgrnA_compute(F, idm, A); }
                else for (int id = F.vcu; id < 1028; id += F.G) { HgIn A; hgrnA_load(F, id, A); hgrnA_compute(F, id, A); }
            }
            if (rep_ == 1 && !(a.dup & 0x8000u)) { GRID_BAR(); continue; }
            conv_pass(F, F.in[10] + l * 1536);
            { LAS float* tabl = (LAS float*)(F.lds + RING_OFF + attn_body::LDS_TAB); tabl[F.tid] = sm[SM_TAB + F.tid]; }
            __syncthreads();
            { int b, vh, qb;
              for (int i = 0; attn_body::attn_next(F.G, F.vcu, i, b, vh, qb); ++i)
                  attn_body::attn_unit<8>(b, vh, qb, (const attn_body::bf16*)WSP(bf16_t, WS_QK), (const attn_body::bf16*)WSP(bf16_t, WS_V), (attn_body::bf16*)WSP(bf16_t, WS_O), (char*)lds + RING_OFF, F.wave); }
            if (l == 0 && F.G == 256) {
                const int g = F.vcu & 7, bv = F.vcu >> 3;
                if (g != 7 && !(g == 0 && bv < 4)) { const int idx = bv < 4 ? bv * 6 + (g - 1) : 24 + (bv - 4) * 7 + g; convert_layer_weights(F, 0, idx * NWAVES + F.wave, 220 * NWAVES, 2); } }
            if (l == 1 && F.G == 256) {
                const int g = F.vcu & 7, bv = F.vcu >> 3;
                if (g != 7 && !(g == 0 && bv < 4)) { const int idx = bv < 4 ? bv * 6 + (g - 1) : 24 + (bv - 4) * 7 + g; convert_moe_gu(F, 3, idx * NWAVES + F.wave, 220 * NWAVES); } }
            GRID_BAR();
        }
#endif
#ifndef NO_P_SCAN
        if (PH(P_SCAN)) for (int rep_ = 0; rep_ <= (int)((a.dup >> (16 + l)) & (a.dup >> P_SCAN) & 1u); ++rep_) { PHASE_FRAME(); hgrn_scan(F); GRID_BAR(); }
#endif
#ifndef NO_P_FIN
        if (PH(P_FIN)) for (int rep_ = 0; rep_ <= (int)((a.dup >> (16 + l)) & (a.dup >> P_FIN) & 1u); ++rep_) { PHASE_FRAME(); hgrnC_pass(F, F.in[12] + l * 128); attcomb_pass(F, F.in[8] + l * 128, l); }
#endif
#ifndef NO_P_GATES
        if (PH(P_GATES)) for (int rep_ = 0; rep_ <= (int)((a.dup >> (16 + l)) & (a.dup >> P_GATES) & 1u); ++rep_) { PHASE_FRAME();
            Gemm g{(const bf16_t*)(F.ws + WS_HN8), (const bf16_t*)(F.ws + WS_WIN8 - (size_t)20 * 256 * D), D / 2, D / 2, D / 2}; TileOrder S; S.init(64, 12, 20, F.G, (int)blockIdx.x, D / 2, D / 2);
            EpiProj E{F.ws, F.in[5] + l * 64, F.in[6] + l * 64, l, 1.f / W8_SCALE};
            pg8::gemm_phase<EpiProj, TileOrder, false, true>(F.lds + RING_OFF, g, S, E, F.wave);
            if (l == 0) { EpiProj Em{F.ws, F.in[5] + l * 64, F.in[6] + l * 64, l, 1.f}; meta_gemm(F, WSP(bf16_t, WS_HN) + (size_t)MR * D, D, WSP(bf16_t, WS_WIN), D, D, 20, 32, Em); }
            GRID_BAR();
        }
#endif
#ifndef NO_P_MERGE
        if (PH(P_MERGE)) for (int rep_ = 0; rep_ <= (int)((a.dup >> (16 + l)) & (a.dup >> P_MERGE) & 1u); ++rep_) { PHASE_FRAME();
            Gemm g{WSP(bf16_t, WS_U), WSP(bf16_t, WS_WBR), 1536, 1536, 1536}; TileOrder S; S.init(64, 4, 0, F.G, (int)blockIdx.x, 1536, 1536);
            EpiMerge E{WSP(bf16_t, WS_GATES), WSP(bf16_t, WS_MIXED)};
            pg8::gemm_phase<EpiMerge, TileOrder>(F.lds + RING_OFF, g, S, E, F.wave);
            if (l == 0) meta_merge(F, WSP(bf16_t, WS_U) + (size_t)MR * 1536, WSP(bf16_t, WS_WBR), WSP(bf16_t, WS_GATES), WSP(bf16_t, WS_MIXED));
            GRID_BAR();
        }
#endif
#ifndef NO_P_WOUT
        if (PH(P_WOUT)) for (int rep_ = 0; rep_ <= (int)((a.dup >> (16 + l)) & (a.dup >> P_WOUT) & 1u); ++rep_) { PHASE_FRAME();
            Gemm g{WSP(bf16_t, WS_MIXED), WSP(bf16_t, WS_WO), D, D, D}; TileOrder S; S.init(64, 4, 0, F.G, (int)blockIdx.x, D, D);
            EpiRes E{first ? F.in[0] : (const float*)F.out, F.out, first ? F.in[1] : (const float*)(sm + SM_METAHS), sm + SM_METAHS};
            pg8::gemm_phase<EpiRes, TileOrder>(F.lds + RING_OFF, g, S, E, F.wave);
            if (l == 0) meta_gemm(F, WSP(bf16_t, WS_MIXED) + (size_t)MR * D, D, WSP(bf16_t, WS_WO), D, D, 0, 4, E);
            GRID_BAR();
        }
#endif
#ifndef NO_P_NORM2
        if (PH(P_NORM2) && l == 0) for (int rep_ = 0; rep_ <= (int)((a.dup >> (16 + l)) & (a.dup >> P_NORM2) & 1u); ++rep_) { PHASE_FRAME(); norm_pass(F, F.in[3] + l * D, false, false); if (PH(P_CVT)) setup_small(F, false); GRID_BAR(); }
        if (PH(P_NORM2) && l == 1) for (int rep_ = 0; rep_ <= (int)((a.dup >> (16 + l)) & (a.dup >> P_NORM2) & 1u); ++rep_) { PHASE_FRAME(); norm_route_pass(F, F.in[3] + l * D); convert_moe_gu(F, -1, 0, 1, F.G == 256 ? 3 : -1); GRID_BAR(); }
#endif
#ifndef NO_P_GU
        if (PH(P_GU) && l == 0) for (int rep_ = 0; rep_ <= (int)((a.dup >> (16 + l)) & (a.dup >> P_GU) & 1u); ++rep_) { PHASE_FRAME();
            Gemm g{WSP(bf16_t, WS_HN), WSP(bf16_t, WS_WGU0), D, D, D}; TileOrder S; S.init(64, 22, 0, F.G, (int)blockIdx.x, D, D);
            EpiGU E{WSP(bf16_t, WS_H0), FFD, 1.f};
            pg8::gemm_phase<EpiGU, TileOrder>(F.lds + RING_OFF, g, S, E, F.wave);
            meta_gemm(F, WSP(bf16_t, WS_HN) + (size_t)MR * D, D, WSP(bf16_t, WS_WGU0), D, D, 0, 22, E);
            if (PH(P_CVT) && rep_ == 0) { const int total = 64 * 22, rem = total % F.G, bx = (int)blockIdx.x;
              if (rem == 0) convert_layer_weights(F, 1, bx * NWAVES + F.wave, F.G * NWAVES); else if (bx >= rem) convert_layer_weights(F, 1, (bx - rem) * NWAVES + F.wave, (F.G - rem) * NWAVES); }
            GRID_BAR();
        }
#endif
#ifndef NO_P_DOWN
        if (PH(P_DOWN) && l == 0) for (int rep_ = 0; rep_ <= (int)((a.dup >> (16 + l)) & (a.dup >> P_DOWN) & 1u); ++rep_) { PHASE_FRAME();
            Gemm g{WSP(bf16_t, WS_H0), WSP(bf16_t, WS_WD0), FFD, FFD, FFD}; TileOrder S; S.init(64, 4, 0, F.G, (int)blockIdx.x, FFD, FFD);
            EpiRes E{(const float*)F.out, F.out, (const float*)(sm + SM_METAHS), sm + SM_METAHS};
            pg8::gemm_phase<EpiRes, TileOrder>(F.lds + RING_OFF, g, S, E, F.wave);
            meta_gemm(F, WSP(bf16_t, WS_H0) + (size_t)MR * FFD, FFD, WSP(bf16_t, WS_WD0), FFD, FFD, 0, 4, E);
            GRID_BAR();
        }
#endif
#ifndef NO_P_MOE
        if (PH(P_GU) && l == 1) for (int rep_ = 0; rep_ <= (int)((a.dup >> (16 + l)) & (a.dup >> P_GU) & 1u); ++rep_) { PHASE_FRAME();
            Gemm g{WSP(bf16_t, WS_HN), WSP(bf16_t, WS_MGU), D / 2, D / 2, D / 2};   MoeGuOrder S{moe_tiles(F), F.G, (int)blockIdx.x, (const int*)(F.ws + WS_SMALL + SMB_LIST)};
            EpiGU8 E{F.ws + WS_MH, FFE, 1.f / W8_SCALE};
            pg8::gemm_phase<EpiGU8, MoeGuOrder, true, true>(F.lds + RING_OFF, g, S, E, F.wave);
            { const int total = S.m.ts[8] * 28, rem = total % F.G, bx = (int)blockIdx.x;
              if (rem == 0) convert_moe_down(F, bx * NWAVES + F.wave, F.G * NWAVES); else if (bx >= rem) convert_moe_down(F, (bx - rem) * NWAVES + F.wave, (F.G - rem) * NWAVES); }
            GRID_BAR();
        }
        if (PH(P_DOWN) && l == 1) for (int rep_ = 0; rep_ <= (int)((a.dup >> (16 + l)) & (a.dup >> P_DOWN) & 1u); ++rep_) { PHASE_FRAME();
            Gemm g{WSP(bf16_t, WS_MH), WSP(bf16_t, WS_MD), FFE / 2, FFE / 2, FFE / 2};   MoeDownOrder S{moe_tiles(F), F.G, (int)blockIdx.x};
            EpiY E{WSP(bf16_t, WS_MY), 1.f / (H8_SCALE * WD8_SCALE)};
            pg8::gemm_phase<EpiY, MoeDownOrder, false, true>(F.lds + RING_OFF, g, S, E, F.wave);
            { int SS, Kp; moe_slab_split(S.m.ts[8], F.G, SS, Kp);
              Gemm g2{WSP(bf16_t, WS_MH), WSP(bf16_t, WS_MD), FFE / 2, FFE / 2, Kp}; MoeSlabOrder S2{S.m, F.G, (int)blockIdx.x, SS, Kp}; EpiSlab E2{WSP(float, WS_SLAB), 1.f / (H8_SCALE * WD8_SCALE)};
              pg8::gemm_phase<EpiSlab, MoeSlabOrder, false, true>(F.lds + RING_OFF, g2, S2, E2, F.wave); }
            GRID_BAR();
        }
        if (PH(P_COMB) && l == 1) for (int rep_ = 0; rep_ <= (int)((a.dup >> (16 + l)) & (a.dup >> P_COMB) & 1u); ++rep_) { PHASE_FRAME(); moe_combine_pass(F); if (rep_ < (int)((a.dup >> (16 + l)) & (a.dup >> P_COMB) & 1u)) GRID_BAR(); }
#endif
}
__global__ void __launch_bounds__(NWAVES * 64, 2) mega(Args a) {
    extern __shared__ __attribute__((aligned(16))) unsigned char lds[];
    Frame F0; Frame& F = F0;
    F.lds = (LAS unsigned char*)lds; F.lds_gen = lds;
    F.wave = __builtin_amdgcn_readfirstlane((int)threadIdx.x >> 6); F.tid = pg8::make_tid(F.wave); F.lane = F.tid & 63;
    F.G = gridDim.x; { const int bx = blockIdx.x; F.vcu = (F.G % 8 == 0) ? (bx % 8) * (F.G / 8) + bx / 8 : bx; }
    F.in = a.in; F.out = a.out; F.ws = a.ws;
    for (int u = F.tid; u < (LDS_BYTES - LDSCTL_OFF) / 4; u += NWAVES * 64) ((LAS unsigned*)(F.lds + LDSCTL_OFF))[u] = 0u;
    __syncthreads();
    volatile LAS unsigned* MISC = (volatile LAS unsigned*)(F.lds + MISC_OFF);
    XcdBarrier bar = xcd_barrier_post((unsigned*)(F.ws + WS_CTL) + 4096, MISC + 8, F.tid);
    if (a.l0 <= 0 && 0 < a.l1) layer_body<0>(a, F0, bar, lds);
    if (a.l0 <= 1 && 1 < a.l1) layer_body<1>(a, F0, bar, lds);
}
#undef PH
#undef GRID_BAR


#ifndef MK_DUP
#define MK_DUP 0u
#endif
static int g_grid = 0;
static bool mega_init() {
    if (g_grid) return g_grid > 0;
    int dev = 0, cus = 0, per_cu = 0;
    if (hipGetDevice(&dev) != hipSuccess || hipDeviceGetAttribute(&cus, hipDeviceAttributeMultiprocessorCount, dev) != hipSuccess) { g_grid = -1; return false; }
    if (hipFuncSetAttribute((const void*)mega, hipFuncAttributeMaxDynamicSharedMemorySize, LDS_BYTES) != hipSuccess) { g_grid = -1; return false; }
    if (hipOccupancyMaxActiveBlocksPerMultiprocessor(&per_cu, (const void*)mega, NWAVES * 64, LDS_BYTES) != hipSuccess || per_cu < 1) { fprintf(stderr, "mega: occupancy query says %d\n", per_cu); }
    (void)hipGetLastError();
    g_grid = cus;
    return true;
}
static void mega_launch(void* const* d_in, float* out, unsigned char* ws, unsigned pmask, int l0, int l1, hipStream_t st) {
    if (!mega_init()) return;
    (void)hipMemsetAsync(ws + WS_CTL, 0, CTL_ZERO_BYTES, st);
    Args a{};
    for (int i = 0; i < 22; ++i) a.in[i] = (const float*)d_in[i];
    a.out = out; a.ws = ws; a.pmask = pmask; a.l0 = l0; a.l1 = l1; a.dup = MK_DUP;
    hipLaunchKernelGGL(mega, dim3(g_grid), dim3(NWAVES * 64), LDS_BYTES, st, a);
}
}
extern "C" void kernel_launch(void* const* d_in, const int* in_sizes, int n_in, void* d_out, int out_size, void* d_ws, size_t ws_size, hipStream_t stream) {
    (void)in_sizes; (void)n_in; (void)out_size;
    if (ws_size < (size_t)512 * (1u << 20)) { fprintf(stderr, "kernel_launch: workspace too small (%zu)\n", ws_size); return; }
    mk::mega_launch(d_in, (float*)d_out, (unsigned char*)d_ws, (1u << mk::P_NPH) - 1u, 0, 2, stream);
}
```

```cpp
#include <hip/hip_runtime.h>
#include <cstdio>
#include <cstdint>
#include <cmath>
#include <hip/hip_bf16.h>
namespace pg8 {
#define PG8_LAS __attribute__((address_space(3)))
typedef unsigned short bf16_t;
typedef short bf16x8 __attribute__((ext_vector_type(8)));
typedef float f32x4 __attribute__((ext_vector_type(4)));
typedef unsigned u32x4 __attribute__((ext_vector_type(4)));
typedef unsigned u32x2 __attribute__((ext_vector_type(2)));
typedef int v4i_t __attribute__((ext_vector_type(4)));
typedef int v8i_t __attribute__((ext_vector_type(8)));
constexpr int BM = 256, BK = 64, HALF = 128, HTB = HALF * BK * 2, STAGE_BYTES = 8 * HTB;

__host__ __device__ __forceinline__ int lds_byte(int r, int c) { const int st = (r >> 4) * 2 + (c >> 5), rr = r & 15, cc = c & 31, ob = rr * 64 + cc * 2; return st * 1024 + (ob ^ (((ob >> 9) & 1) << 5)); }
__host__ __device__ __forceinline__ void stage_rc(int b, int& R, int& C) { const int st = b / 1024, sb = b % 1024, swz = sb ^ (((sb >> 9) & 1) << 5); R = (st >> 1) * 16 + swz / 64; C = (st & 1) * 32 + (swz % 64) / 2; }
__host__ __device__ __forceinline__ int perm32(int rho) { const int n = rho >> 4, i = rho & 15; return 8 * (i >> 2) + 4 * n + (i & 3); }

struct Unit { int pm, pn, z; unsigned a_off, b_off; const int* gidx; };
struct Gemm { const bf16_t* A; const bf16_t* Bt; int lda, ldb, K; };

__device__ __forceinline__ int lane_id() { unsigned m = ~0u; asm volatile("" : "+s"(m)); return (int)__builtin_amdgcn_mbcnt_hi(m, __builtin_amdgcn_mbcnt_lo(m, 0u)); }
__device__ __forceinline__ int make_tid(int wave) { int t = (wave << 6) | lane_id(); asm volatile("" : "+v"(t)); return t; }
typedef float f32x2_cv __attribute__((ext_vector_type(2))); typedef __bf16 bf16x2_cv __attribute__((ext_vector_type(2)));
__device__ __forceinline__ unsigned cvt_pk_bf16(float lo, float hi) { const f32x2_cv v = {lo, hi}; const bf16x2_cv b = __builtin_convertvector(v, bf16x2_cv); return __builtin_bit_cast(unsigned, b); }

template <class Epi, class Sched, bool GATHER = false, bool FP8 = false>
__device__ __forceinline__ void gemm_phase(PG8_LAS unsigned char* lds, const Gemm g, const Sched& S, const Epi& E, int wave0) {
    const int tid = make_tid(wave0),
              wid = __builtin_amdgcn_readfirstlane(tid >> 6), lane = tid & 63, wr = wid >> 2, wc = wid & 3, fr = lane & 15, fq = lane >> 4;
    const int K = g.K, nt = K / BK;
    unsigned voffA[2], voffB[2];
#pragma unroll
    for (int i = 0; i < 2; ++i) { int R, C; stage_rc(tid * 16 + i * 8192, R, C); const int Rb = Epi::PERM ? ((R & ~31) + perm32(R & 31)) : R;
        voffA[i] = (unsigned)(R * g.lda + C) * 2u; voffB[i] = (unsigned)(Rb * g.ldb + C) * 2u; }
    const size_t kstep = (size_t)(BK * 2);
    const size_t hstepA = GATHER ? 0 : (size_t)HALF * g.lda * 2, hstepB = (size_t)HALF * g.ldb * 2;
    const unsigned ldsw = (unsigned)wid * 1024u;
    const int aoff = lds_byte(wr * 64 + fr, fq * 8), boff = lds_byte(wc * 32 + fr, fq * 8);
    unsigned gvc[2][2], gvn[2][2];
#define PG8_SA(b, h) (((b) * 2 + (h)) * HTB)
#define PG8_SB(b, h) ((4 + (b) * 2 + (h)) * HTB)
#define PG8_STAGE(bufoff, gbase, voff) do { _Pragma("unroll") for (int _i = 0; _i < 2; ++_i) \
        __builtin_amdgcn_global_load_lds((const unsigned*)((const char*)(gbase) + (voff)[_i]), (PG8_LAS unsigned*)(lds + (bufoff) + ldsw + _i * 8192), 16, 0, 0); } while (0)
#define PG8_STAGE_A(bufoff, base, h, nx) do { if constexpr (GATHER) { if (nx) PG8_STAGE(bufoff, base, gvn[h]); else PG8_STAGE(bufoff, base, gvc[h]); } else { PG8_STAGE(bufoff, (base) + (h) * hstepA, voffA); } } while (0)
#define PG8_LD8(a_) __builtin_shufflevector(*(const PG8_LAS v4i_t*)(a_), *(const PG8_LAS v4i_t*)((a_) + 1024), 0, 1, 2, 3, 4, 5, 6, 7)
#define PG8_LDA(dst, b, h) do { if constexpr (FP8) { _Pragma("unroll") for (int m = 0; m < 4; ++m) dst##8[m] = PG8_LD8(lds + PG8_SA(b, h) + aoff + m * 2048); } else { \
        _Pragma("unroll") for (int m = 0; m < 4; ++m) _Pragma("unroll") for (int k = 0; k < 2; ++k) dst[m][k] = *(const PG8_LAS bf16x8*)(lds + PG8_SA(b, h) + aoff + m * 2048 + k * 1024); } } while (0)
#define PG8_LDB(dst, b, h) do { if constexpr (FP8) { _Pragma("unroll") for (int n = 0; n < 2; ++n) dst##8[n] = PG8_LD8(lds + PG8_SB(b, h) + boff + n * 2048); } else { \
        _Pragma("unroll") for (int n = 0; n < 2; ++n) _Pragma("unroll") for (int k = 0; k < 2; ++k) dst[n][k] = *(const PG8_LAS bf16x8*)(lds + PG8_SB(b, h) + boff + n * 2048 + k * 1024); } } while (0)
#define PG8_MMA(ai, bj, At, Bt) do { __builtin_amdgcn_s_setprio(1); if constexpr (FP8) { _Pragma("unroll") for (int m = 0; m < 4; ++m) _Pragma("unroll") for (int n = 0; n < 2; ++n) \
        asm volatile("v_mfma_scale_f32_16x16x128_f8f6f4 %0, %1, %2, %0, %3, %3 op_sel_hi:[0,0,0]" : "+v"(acc[ai][bj][m][n]) : "v"(Bt##8[n]), "v"(At##8[m]), "v"(one8)); } else { \
        _Pragma("unroll") for (int m = 0; m < 4; ++m) _Pragma("unroll") for (int n = 0; n < 2; ++n) _Pragma("unroll") for (int k = 0; k < 2; ++k) \
        acc[ai][bj][m][n] = __builtin_amdgcn_mfma_f32_16x16x32_bf16(Bt[n][k], At[m][k], acc[ai][bj][m][n], 0, 0, 0); } __builtin_amdgcn_s_setprio(0); } while (0)
#define PG8_WAIT_V(n) asm volatile("s_waitcnt vmcnt(" #n ")" ::: "memory")
#define PG8_WAIT_L(n) asm volatile("s_waitcnt lgkmcnt(" #n ")" ::: "memory")
#define PG8_BAR __builtin_amdgcn_s_barrier()
#define PG8_SCHED __builtin_amdgcn_sched_barrier(0)
#define PG8_GLOAD(dst, u) do { if constexpr (GATHER) { const int t2_ = make_tid(wave0); _Pragma("unroll") for (int _i = 0; _i < 2; ++_i) { int R_, C_; stage_rc(t2_ * 16 + _i * 8192, R_, C_); \
        _Pragma("unroll") for (int _h = 0; _h < 2; ++_h) dst[_h][_i] = (unsigned)((u).gidx[_h * HALF + R_] * g.lda + C_) * 2u; } } } while (0)
    Unit cur, nxt; int ui = 0;
    if (!S.next(0, cur)) return;
    f32x4 acc[2][2][4][2];
#pragma unroll
    for (int a = 0; a < 2; ++a)
#pragma unroll
        for (int b = 0; b < 2; ++b)
#pragma unroll
            for (int m = 0; m < 4; ++m)
#pragma unroll
                for (int n = 0; n < 2; ++n) acc[a][b][m][n] = (f32x4){0.f, 0.f, 0.f, 0.f};
    bf16x8 At[4][2], B0[2][2], B1[2][2]; v8i_t At8[4], B08[2], B18[2];
    int one8 = 0x7f7f7f7f; asm volatile("" : "+v"(one8));
    const char* cA = (const char*)g.A + cur.a_off; const char* cB = (const char*)g.Bt + cur.b_off;
    PG8_GLOAD(gvc, cur);
#pragma unroll
    for (int _h = 0; _h < 2; ++_h)
#pragma unroll
        for (int _i = 0; _i < 2; ++_i) gvn[_h][_i] = 0u;
    PG8_STAGE(PG8_SB(0, 0), cB, voffB); PG8_STAGE(PG8_SB(0, 1), cB + hstepB, voffB); PG8_STAGE_A(PG8_SA(0, 0), cA, 0, false); PG8_STAGE_A(PG8_SA(0, 1), cA, 1, false);
    if (wr == 1) PG8_BAR;
    PG8_WAIT_V(2); PG8_BAR;
    PG8_STAGE(PG8_SB(1, 0), cB + kstep, voffB); PG8_STAGE_A(PG8_SA(1, 0), cA + kstep, 0, false); PG8_STAGE(PG8_SB(1, 1), cB + hstepB + kstep, voffB);
    PG8_WAIT_V(6); PG8_BAR;
    for (;;) {
        const bool has_next = S.next(ui + 1, nxt);
        const char* nA = has_next ? (const char*)g.A + nxt.a_off : cA; const char* nB = has_next ? (const char*)g.Bt + nxt.b_off : cB;
        if constexpr (GATHER) { if (has_next) { PG8_GLOAD(gvn, nxt); } else {
#pragma unroll
            for (int _h = 0; _h < 2; ++_h)
#pragma unroll
                for (int _i = 0; _i < 2; ++_i) gvn[_h][_i] = gvc[_h][_i]; } }
        for (int t = 0; t < nt; t += 2) {
            const bool last = (t == nt - 2);
            const char* a1 = cA + (size_t)(t + 1) * kstep;
            const char* a2 = last ? nA : cA + (size_t)(t + 2) * kstep; const char* b2 = last ? nB : cB + (size_t)(t + 2) * kstep;
            const char* a3 = a2 + kstep; const char* b3 = b2 + kstep;
            if constexpr (Epi::MID) { if (t == Epi::MID_T0 || t == Epi::MID_T1) {
                if (wr == 0) PG8_BAR;
#define PG8_MIDROW(ai, m) do { f32x4 v_[2][2] = {{acc[ai][0][m][0], acc[ai][0][m][1]}, {acc[ai][1][m][0], acc[ai][1][m][1]}}; \
                int r_ = cur.pm * BM + (ai) * HALF + wr * 64 + (m) * 16 + fr; asm volatile("" : "+v"(r_)); E.mid_row(cur, r_, t, wc, fq, v_); \
                acc[ai][0][m][0] = v_[0][0]; acc[ai][0][m][1] = v_[0][1]; acc[ai][1][m][0] = v_[1][0]; acc[ai][1][m][1] = v_[1][1]; asm volatile("" ::: "memory"); } while (0)
                PG8_MIDROW(0, 0); PG8_MIDROW(0, 1); PG8_MIDROW(0, 2); PG8_MIDROW(0, 3); PG8_MIDROW(1, 0); PG8_MIDROW(1, 1); PG8_MIDROW(1, 2); PG8_MIDROW(1, 3);
#undef PG8_MIDROW
                if (wr == 1) PG8_BAR;
            } }
            PG8_LDB(B0, 0, 0); PG8_LDB(B1, 0, 1); PG8_SCHED; PG8_LDA(At, 0, 0); PG8_STAGE_A(PG8_SA(1, 1), a1, 1, false);
            PG8_WAIT_V(8); PG8_WAIT_L(0); PG8_BAR; PG8_MMA(0, 0, At, B0); PG8_MMA(0, 1, At, B1); PG8_BAR; PG8_SCHED;
            PG8_LDA(At, 0, 1); PG8_STAGE(PG8_SB(0, 0), b2, voffB); PG8_STAGE(PG8_SB(0, 1), b2 + hstepB, voffB); PG8_STAGE_A(PG8_SA(0, 0), a2, 0, last);
            PG8_WAIT_V(8); PG8_WAIT_L(0); PG8_BAR; PG8_MMA(1, 0, At, B0); PG8_MMA(1, 1, At, B1); PG8_BAR; PG8_SCHED;
            PG8_LDB(B0, 1, 0); PG8_LDB(B1, 1, 1); PG8_SCHED; PG8_LDA(At, 1, 0); PG8_STAGE_A(PG8_SA(0, 1), a2, 1, last);
            PG8_WAIT_V(8); PG8_WAIT_L(0); PG8_BAR; PG8_MMA(0, 0, At, B0); PG8_MMA(0, 1, At, B1); PG8_BAR; PG8_SCHED;
            PG8_LDA(At, 1, 1); PG8_STAGE(PG8_SB(1, 0), b3, voffB); PG8_STAGE(PG8_SB(1, 1), b3 + hstepB, voffB); PG8_STAGE_A(PG8_SA(1, 0), a3, 0, last);
            PG8_WAIT_V(8); PG8_WAIT_L(0); PG8_BAR; PG8_MMA(1, 0, At, B0); PG8_MMA(1, 1, At, B1); PG8_BAR; PG8_SCHED;
        }
        if constexpr (FP8) asm volatile("s_nop 15\n\ts_nop 15" ::: "memory");
        if (wr == 0) PG8_BAR;
        {
#define PG8_ROW(ai, m) do { const f32x4 v_[2][2] = {{acc[ai][0][m][0], acc[ai][0][m][1]}, {acc[ai][1][m][0], acc[ai][1][m][1]}}; \
            int r_ = cur.pm * BM + (ai) * HALF + wr * 64 + (m) * 16 + fr; asm volatile("" : "+v"(r_)); E.row(cur, r_, (ai) * 4 + (m), wc, fq, v_); asm volatile("" ::: "memory"); } while (0)
            PG8_ROW(0, 0); PG8_ROW(0, 1); PG8_ROW(0, 2); PG8_ROW(0, 3); PG8_ROW(1, 0); PG8_ROW(1, 1); PG8_ROW(1, 2); PG8_ROW(1, 3);
#undef PG8_ROW
        }
        if (!has_next) break;
#pragma unroll
        for (int a = 0; a < 2; ++a)
#pragma unroll
            for (int b = 0; b < 2; ++b)
#pragma unroll
                for (int m = 0; m < 4; ++m)
#pragma unroll
                    for (int n = 0; n < 2; ++n) acc[a][b][m][n] = (f32x4){0.f, 0.f, 0.f, 0.f};
        cur = nxt; cA = nA; cB = nB; ++ui;
        if constexpr (GATHER) {
#pragma unroll
            for (int _h = 0; _h < 2; ++_h)
#pragma unroll
                for (int _i = 0; _i < 2; ++_i) gvc[_h][_i] = gvn[_h][_i]; }
        if (wr == 1) PG8_BAR;
    }
    PG8_WAIT_V(0);
    PG8_BAR;
#undef PG8_SA
#undef PG8_SB
#undef PG8_STAGE
#undef PG8_STAGE_A
#undef PG8_LDA
#undef PG8_LD8
#undef PG8_LDB
#undef PG8_MMA
#undef PG8_WAIT_V
#undef PG8_WAIT_L
#undef PG8_BAR
#undef PG8_SCHED
#undef PG8_GLOAD
}

template <bool PERM>
__device__ __forceinline__ void small_tile(PG8_LAS unsigned char* lds, const bf16_t* A16, int lda, const bf16_t* Bt, int ldb, int K, int pn, int wc, f32x4 (&v)[2][2], int wave0) {
    const int tid = make_tid(wave0), wid = __builtin_amdgcn_readfirstlane(tid >> 6), lane = tid & 63, fr = lane & 15, fq = lane >> 4;
    const int kper = K >> 3, k0 = wid * kper;
    f32x4 acc[2][2];
#pragma unroll
    for (int bj = 0; bj < 2; ++bj)
#pragma unroll
        for (int n = 0; n < 2; ++n) acc[bj][n] = (f32x4){0.f, 0.f, 0.f, 0.f};
    const bf16_t* ap = A16 + (size_t)fr * lda + k0 + 8 * fq;
    const bf16_t* bp[2][2];
#pragma unroll
    for (int bj = 0; bj < 2; ++bj)
#pragma unroll
        for (int n = 0; n < 2; ++n) { const int rr = PERM ? perm32(16 * n + fr) : 16 * n + fr; bp[bj][n] = Bt + (size_t)(pn * 256 + bj * 128 + wc * 32 + rr) * ldb + k0 + 8 * fq; }
    for (int k = 0; k < kper; k += 32) {
        const bf16x8 a = *(const bf16x8*)(ap + k);
#pragma unroll
        for (int bj = 0; bj < 2; ++bj)
#pragma unroll
            for (int n = 0; n < 2; ++n) { const bf16x8 b = *(const bf16x8*)(bp[bj][n] + k); acc[bj][n] = __builtin_amdgcn_mfma_f32_16x16x32_bf16(b, a, acc[bj][n], 0, 0, 0); }
    }
    PG8_LAS f32x4* red = (PG8_LAS f32x4*)lds;
#pragma unroll
    for (int bj = 0; bj < 2; ++bj)
#pragma unroll
        for (int n = 0; n < 2; ++n) red[(wid * 4 + bj * 2 + n) * 64 + lane] = acc[bj][n];
    __syncthreads();
    if (wid == 0) {
#pragma unroll
        for (int bj = 0; bj < 2; ++bj)
#pragma unroll
            for (int n = 0; n < 2; ++n) { f32x4 s = red[(bj * 2 + n) * 64 + lane];
#pragma unroll
                for (int w = 1; w < 8; ++w) s += red[(w * 4 + bj * 2 + n) * 64 + lane];
                v[bj][n] = s; }
    }
    __syncthreads();
}
}
namespace attn_body {
using bf16=__hip_bfloat16;
using bf16x8=__attribute__((ext_vector_type(8)))short;
using s16x4=__attribute__((ext_vector_type(4)))short;
using f32x16=__attribute__((ext_vector_type(16)))float;
using u32x4=__attribute__((ext_vector_type(4)))unsigned;
constexpr int BATCH=4,SEQ=4352,D=64,QKP=1024,VP=512,OP=1024;
constexpr int NW=8,QBLK=32,QB=QBLK*NW,KVBLK=64,NQB=SEQ/QB;
constexpr int ATTN_UNIT_ROWS=QB;
__device__ __forceinline__ int crow(int r,int hi){return (r&3)+8*(r>>2)+4*hi;}
#define SBAR() __builtin_amdgcn_sched_barrier(0)
__device__ __forceinline__ void cmask(f32x16&p0,f32x16&p1,int jb,int qrel,int hi){
  const float NEG=-INFINITY; int kb=64*jb+4*hi;
  #pragma unroll
  for(int r=0;r<16;++r){int kv=kb+(r&3)+8*(r>>2); if(kv>qrel)p0[r]=NEG; if(kv+32>qrel)p1[r]=NEG;}
}

__device__ __forceinline__ void biasmask(f32x16&p0,f32x16&p1,int jb,int qrel,int hi,const __attribute__((address_space(3))) float*tab){
  const float NEG=-INFINITY; const int kb=64*jb+4*hi;
  #pragma unroll
  for(int r=0;r<16;++r){const int n0=qrel-(kb+(r&3)+8*(r>>2)),n1=n0-32;
    const float b0=tab[n0<0?0:(n0>127?127:n0)],b1=tab[n1<0?0:(n1>127?127:n1)];
    p0[r]=n0<0?NEG:p0[r]+b0; p1[r]=n1<0?NEG:p1[r]+b1;}
}
constexpr int NSLOT=3, SLOTB=8192;
constexpr int VSLOTB=2*SLOTB;
constexpr int LDS_K=0, LDS_V=NSLOT*SLOTB, LDS_WS=LDS_V+NSLOT*VSLOTB, LDS_TAB=LDS_WS+NW*64*4, LDS_OST=0  , LDS_BYTES=LDS_TAB+2048;
constexpr float C2=0.125f*1.4426950408889634f;
__device__ __forceinline__ void glds16(const void*gsrc,unsigned lds_dst){unsigned keep;
  asm volatile("s_mov_b32 %0, m0\n\ts_mov_b32 m0, %2\n\ts_nop 0\n\tglobal_load_lds_dwordx4 %1, off\n\ts_mov_b32 m0, %0":"=&s"(keep):"v"(gsrc),"s"(lds_dst):"memory");}
__device__ __forceinline__ float max3f(float a,float b,float c){float r;asm("v_max3_f32 %0, %1, %2, %3":"=v"(r):"v"(a),"v"(b),"v"(c));return r;}
__device__ __forceinline__ float max2f(float a,float b){float r;asm("v_max_f32_e32 %0, %1, %2":"=v"(r):"v"(a),"v"(b));return r;}
__device__ __forceinline__ float fadd_s(float a,float b){float r;asm("v_add_f32_e32 %0, %1, %2":"=v"(r):"v"(a),"v"(b));return r;}
__device__ __forceinline__ float fsub_s(float a,float b){float r;asm("v_sub_f32_e32 %0, %1, %2":"=v"(r):"v"(a),"v"(b));return r;}
typedef float f32x2_t __attribute__((ext_vector_type(2))); typedef __bf16 bf16x2_t __attribute__((ext_vector_type(2)));
__device__ __forceinline__ unsigned cvtpk_s(float lo,float hi){f32x2_t v={lo,hi};bf16x2_t b=__builtin_convertvector(v,bf16x2_t);return __builtin_bit_cast(unsigned,b);}
#define WAIT_BAR(N) asm volatile("s_waitcnt vmcnt(" #N ") lgkmcnt(0)\n\ts_barrier":::"memory")

__device__ __forceinline__ void qkt(f32x16&p0,f32x16&p1,const char*Kslot,const bf16x8*qr,const f32x16&negm,int r32,int hi){
  const char*kb=Kslot+hi*1024+r32*16;
  #pragma unroll
  for(int d0=0;d0<4;++d0){
    const bf16x8 b0=*reinterpret_cast<const bf16x8*>(kb+d0*2048);
    const bf16x8 b1=*reinterpret_cast<const bf16x8*>(kb+d0*2048+512);
    if(d0==0){p0=__builtin_amdgcn_mfma_f32_32x32x16_bf16(b0,qr[0],negm,0,0,0);p1=__builtin_amdgcn_mfma_f32_32x32x16_bf16(b1,qr[0],negm,0,0,0);}
    else{p0=__builtin_amdgcn_mfma_f32_32x32x16_bf16(b0,qr[d0],p0,0,0,0);p1=__builtin_amdgcn_mfma_f32_32x32x16_bf16(b1,qr[d0],p1,0,0,0);}}
}
typedef __attribute__((address_space(3))) const char* lds_cptr;
typedef short v4i16_t __attribute__((ext_vector_type(4)));
__device__ __forceinline__ void kload8(bf16x8*kf,lds_cptr kp){
  kf[0]=*(const __attribute__((address_space(3))) bf16x8*)(kp);      kf[1]=*(const __attribute__((address_space(3))) bf16x8*)(kp+512);
  kf[2]=*(const __attribute__((address_space(3))) bf16x8*)(kp+2048); kf[3]=*(const __attribute__((address_space(3))) bf16x8*)(kp+2560);
  kf[4]=*(const __attribute__((address_space(3))) bf16x8*)(kp+4096); kf[5]=*(const __attribute__((address_space(3))) bf16x8*)(kp+4608);
  kf[6]=*(const __attribute__((address_space(3))) bf16x8*)(kp+6144); kf[7]=*(const __attribute__((address_space(3))) bf16x8*)(kp+6656);
}
__device__ __forceinline__ void kload2(bf16x8*kf,lds_cptr kp,int j){ kf[2*j]=*(const __attribute__((address_space(3))) bf16x8*)(kp+j*2048); kf[2*j+1]=*(const __attribute__((address_space(3))) bf16x8*)(kp+j*2048+512); }
__device__ __forceinline__ s16x4 vtr(lds_cptr p){ return __builtin_bit_cast(s16x4,__builtin_amdgcn_ds_read_tr16_b64_v4i16((__attribute__((address_space(3))) v4i16_t*)p)); }
__device__ __forceinline__ float rowmax(const f32x16&p0,const f32x16&p1){
  float a=max3f(p0[0],p0[1],p1[0]),b=max3f(p0[2],p0[3],p1[1]);a=max3f(a,p1[2],p1[3]);
  #pragma unroll
  for(int r=4;r<16;r+=4){a=max3f(a,p0[r],p0[r+1]);b=max3f(b,p0[r+2],p0[r+3]);a=max3f(a,p1[r],p1[r+1]);b=max3f(b,p1[r+2],p1[r+3]);}
  const float m=max2f(a,b);
  auto rr=__builtin_amdgcn_permlane32_swap(__float_as_uint(m),__float_as_uint(m),false,false);
  return max2f(__uint_as_float(rr[0]),__uint_as_float(rr[1]));
}
__device__ __forceinline__ void pv(f32x16*o,int vb,bf16x8 pa0,bf16x8 pa1,bf16x8 pa2,bf16x8 pa3){
  #pragma unroll
  for(int d0=0;d0<4;++d0){s16x4 lo[4],hi[4];
    #pragma unroll
    for(int ks=0;ks<4;++ks){
      asm volatile("ds_read_b64_tr_b16 %0,%1 offset:%c2":"=&v"(lo[ks]):"v"(vb),"i"(d0*4096+ks*1024):"memory");
      asm volatile("ds_read_b64_tr_b16 %0,%1 offset:%c2":"=&v"(hi[ks]):"v"(vb),"i"(d0*4096+ks*1024+512):"memory");}
    asm volatile("s_waitcnt lgkmcnt(0)":::"memory");SBAR();
    #define PK(k) (bf16x8){lo[k][0],lo[k][1],lo[k][2],lo[k][3],hi[k][0],hi[k][1],hi[k][2],hi[k][3]}
    o[d0]=__builtin_amdgcn_mfma_f32_32x32x16_bf16(pa0,PK(0),o[d0],0,0,0);
    o[d0]=__builtin_amdgcn_mfma_f32_32x32x16_bf16(pa1,PK(1),o[d0],0,0,0);
    o[d0]=__builtin_amdgcn_mfma_f32_32x32x16_bf16(pa2,PK(2),o[d0],0,0,0);
    o[d0]=__builtin_amdgcn_mfma_f32_32x32x16_bf16(pa3,PK(3),o[d0],0,0,0);
    #undef PK
  }
}

#ifndef ATTN_STORE16
#define ATTN_STORE16(p,v) (*(u32x4*)(p)=(v))
#endif
template<int THRL> __device__ __forceinline__ void attn_unit(int b,int vh,int qb,const bf16*__restrict__ QK,const bf16*__restrict__ V,bf16*O,char*shm,int wave0){
  const int mp=vh>>2,hh=vh&3; const int qcol=(mp*4+hh)*64,kcol=512+(mp*4+hh)*64,vcol=hh*128,ocol=mp*512+hh*128;
  const int tid=pg8::make_tid(wave0),lane=tid&63,r32=lane&31,hi=lane>>5; const int wid=__builtin_amdgcn_readfirstlane(tid>>6);
  const long rowbase=(long)b*SEQ; const int q0=qb*QB;
  const bf16*Qw=QK+(rowbase+q0+wid*QBLK)*QKP+qcol;
  const bf16*Kh=QK+rowbase*QKP+kcol,*Vh=V+rowbase*VP+vcol;
  const __attribute__((address_space(3))) float*tab=(const __attribute__((address_space(3))) float*)((__attribute__((address_space(3))) char*)shm+LDS_TAB)+hh*128;
  const unsigned lds0=(unsigned)(uintptr_t)shm;
  float*wsf=(float*)(shm+LDS_WS)+wid*64;
  const bf16*ksrc=Kh+(long)lane*QKP+wid*8;
  const bf16*vsrc=Vh+(long)(16*(wid&3)+(lane>>2))*VP+(wid>>2)*32+(lane&3)*8;
  const unsigned kdst=lds0+LDS_K+wid*1024, vdst=lds0+LDS_V+wid*1024;
  #define DMA_K(t,slot) glds16(ksrc+(long)(t)*KVBLK*QKP,(unsigned)__builtin_amdgcn_readfirstlane(kdst+(slot)))
  #define DMA_V(t,slot) do{ glds16(vsrc+(long)(t)*KVBLK*VP,(unsigned)__builtin_amdgcn_readfirstlane(vdst+2*(slot))); glds16(vsrc+64+(long)(t)*KVBLK*VP,(unsigned)__builtin_amdgcn_readfirstlane(vdst+2*(slot)+8192)); }while(0)
  const int vb0=(int)(lds0+LDS_V)+((lane>>4)&1)*32+(lane&3)*8+(4*hi+((lane&15)>>2))*64;
  const char*Kbase=shm+LDS_K; bf16x8 kf[8];
  const lds_cptr shm3=(lds_cptr)shm; const lds_cptr kp0=shm3+LDS_K+hi*1024+r32*16; const lds_cptr vp0=shm3+LDS_V+((lane>>4)&1)*32+(lane&3)*8+(4*hi+((lane&15)>>2))*64;
  const int NT=(q0+QB)/KVBLK;
  DMA_K(0,0);DMA_V(0,0);DMA_K(1,SLOTB);
  bf16x8 qr[4];
  #pragma unroll
  for(int d0=0;d0<4;++d0)qr[d0]=*reinterpret_cast<const bf16x8*>(&Qw[(long)r32*QKP+d0*16+hi*8]);
  float mhat=0.f,l_reg=0.f;f32x16 o[4];o[0]=f32x16{};o[1]=f32x16{};o[2]=f32x16{};o[3]=f32x16{};f32x16 negm=f32x16{};asm volatile("":"+v"(negm));
  const int qrel=wid*QBLK+r32;
  #define CMASK(P0,P1,t) do{int jb_=(t)-(NT-4); if(jb_>=-2)biasmask(P0,P1,jb_,qrel,hi,tab);}while(0)
  bool resc=false;
  #define START(P0,P1) do{ const float rm=rowmax(P0,P1); resc=false; \
    { const float dl=rm; mhat=fadd_s(mhat,dl); \
      _Pragma("unroll") for(int r=0;r<16;++r){P0[r]=fsub_s(P0[r],dl);P1[r]=fsub_s(P1[r],dl);} \
      _Pragma("unroll") for(int r=0;r<16;++r)negm[r]=-mhat; asm volatile("":"+v"(negm)); } \
    _Pragma("unroll") for(int r=0;r<16;++r)P0[r]=__builtin_amdgcn_exp2f(P0[r]); }while(0)
  #define RESC() do{ if(resc){ asm volatile("s_waitcnt lgkmcnt(0)":::"memory"); \
      _Pragma("unroll") for(int d_=0;d_<4;++d_) _Pragma("unroll") for(int r=0;r<16;++r)o[d_][r]*=wsf[crow(r,hi)]; } }while(0)
  f32x16 pA0,pA1,pB0,pB1;
  int sl_prev=0,sl_cur=0,sl_next=SLOTB;
  #define ROT() do{sl_prev=sl_cur;sl_cur=sl_next;sl_next=(sl_next==(NSLOT-1)*SLOTB)?0:sl_next+SLOTB;}while(0)
  DMA_K(2,2*SLOTB);
  WAIT_BAR(4);
  qkt(pA0,pA1,Kbase,qr,negm,r32,hi);asm volatile("s_nop 15\n\ts_nop 7":"+v"(pA0),"+v"(pA1));CMASK(pA0,pA1,0);
  START(pA0,pA1);
  _Pragma("unroll") for(int r=0;r<16;++r)pA1[r]=__builtin_amdgcn_exp2f(pA1[r]);
  WAIT_BAR(0);
  DMA_K(3,0);DMA_V(1,SLOTB);
  ROT();
  kload8(kf,kp0+sl_cur);
  WAIT_BAR(3);
  s16x4 vlo[4],vhi[4]; u32x4 pw0,pw1,pw2,pw3;
  #define PKW(P,B) cvtpk_s(P[B],P[B+1])
  #define PAF(k) __builtin_bit_cast(bf16x8,pw##k)
  #define VFR(i) (bf16x8){vlo[i][0],vlo[i][1],vlo[i][2],vlo[i][3],vhi[i][0],vhi[i][1],vhi[i][2],vhi[i][3]}
  #define PIN(x) asm volatile("":"+v"(x))
  #define MX3(a,b,c) __builtin_fmaxf(__builtin_fmaxf((a),(b)),(c))
  #define GAPA(MF,A0,A1,A2,A3,W0,W1,PW) do{ MF; sacc+=A0; sacc+=A1; sacc+=A2; sacc+=A3; PIN(sacc); W0; W1; PIN(PW); SBAR(); }while(0)
  #define EX(v) __builtin_amdgcn_exp2f(v)
  #define GAPB(MF,VR,X,B) do{ MF; VR; X[B]=EX(X[B]); X[B+1]=EX(X[B+1]); PIN(X); SBAR(); }while(0)
  #define VRJ(kg,d0) do{ vlo[d0]=vtr(vp_+((d0)*4096+(kg)*1024)); vhi[d0]=vtr(vp_+((d0)*4096+(kg)*1024+512)); }while(0)
  #define KRD(G,j) do{ if(G){ kload2(kf,kp0+sl_next,j); SBAR(); } }while(0)
  #define STEP(C0,C1,P0,P1,t,GK,GV,GL) do{ SBAR(); \
    const lds_cptr vp_=vp0+2*sl_prev; \
    float sacc=(P0[0]+P0[1]); \
    GAPA(C0=__builtin_amdgcn_mfma_f32_32x32x16_bf16(kf[0],qr[0],negm,0,0,0), P0[2],P0[3],P0[4],P0[5],     pw0[0]=PKW(P0,0), pw0[1]=PKW(P0,2), pw0); \
    GAPA(C1=__builtin_amdgcn_mfma_f32_32x32x16_bf16(kf[1],qr[0],negm,0,0,0), P0[6],P0[7],P0[8],P0[9],     pw0[2]=PKW(P0,4), pw0[3]=PKW(P0,6), pw0); \
    GAPA(C0=__builtin_amdgcn_mfma_f32_32x32x16_bf16(kf[2],qr[1],C0,0,0,0),   P0[10],P0[11],P0[12],P0[13], pw1[0]=PKW(P0,8), pw1[1]=PKW(P0,10), pw1); \
    GAPA(C1=__builtin_amdgcn_mfma_f32_32x32x16_bf16(kf[3],qr[1],C1,0,0,0),   P0[14],P0[15],P1[0],P1[1],   pw1[2]=PKW(P0,12),pw1[3]=PKW(P0,14), pw1); \
    GAPA(C0=__builtin_amdgcn_mfma_f32_32x32x16_bf16(kf[4],qr[2],C0,0,0,0),   P1[2],P1[3],P1[4],P1[5],     pw2[0]=PKW(P1,0), pw2[1]=PKW(P1,2), pw2); \
    GAPA(C1=__builtin_amdgcn_mfma_f32_32x32x16_bf16(kf[5],qr[2],C1,0,0,0),   P1[6],P1[7],P1[8],P1[9],     pw2[2]=PKW(P1,4), pw2[3]=PKW(P1,6), pw2); \
    GAPA(C0=__builtin_amdgcn_mfma_f32_32x32x16_bf16(kf[6],qr[3],C0,0,0,0),   P1[10],P1[11],P1[12],P1[13], pw3[0]=PKW(P1,8), pw3[1]=PKW(P1,10), pw3); \
    GAPA(C1=__builtin_amdgcn_mfma_f32_32x32x16_bf16(kf[7],qr[3],C1,0,0,0),   P1[14],P1[15],0.f,0.f,       pw3[2]=PKW(P1,12),pw3[3]=PKW(P1,14), pw3); \
    l_reg+=sacc; \
    if(GK){DMA_K((t)+3,sl_cur);} if(GV){DMA_V((t)+1,sl_next);} \
    VRJ(0,0); VRJ(0,1); VRJ(0,2); VRJ(0,3); SBAR(); \
    CMASK(C0,C1,t); \
    { float a=MX3(C0[0],C0[1],C1[0]),b=MX3(C0[2],C0[3],C1[1]); a=MX3(a,C1[2],C1[3]); \
      _Pragma("unroll") for(int r=4;r<16;r+=4){a=MX3(a,C0[r],C0[r+1]);b=MX3(b,C0[r+2],C0[r+3]);a=MX3(a,C1[r],C1[r+1]);b=MX3(b,C1[r+2],C1[r+3]);} \
      float rm=__builtin_fmaxf(a,b); { auto rr=__builtin_amdgcn_permlane32_swap(__float_as_uint(rm),__float_as_uint(rm),false,false); rm=__builtin_fmaxf(__uint_as_float(rr[0]),__uint_as_float(rr[1])); } \
      resc=false; \
      if(__builtin_expect(__any(rm>(float)THRL),0)){ const float dl=__builtin_fmaxf(rm,0.f); mhat+=dl; \
        _Pragma("unroll") for(int r=0;r<16;++r){C0[r]-=dl;C1[r]-=dl;} \
        _Pragma("unroll") for(int r=0;r<16;++r)negm[r]=-mhat; asm volatile("":"+v"(negm)); \
        const float f=__builtin_amdgcn_exp2f(-dl); l_reg*=f; if(hi==0)wsf[r32]=f; resc=true; } } \
    SBAR(); \
    GAPB(o[0]=__builtin_amdgcn_mfma_f32_32x32x16_bf16(PAF(0),VFR(0),o[0],0,0,0), VRJ(1,0), C0,0); \
    GAPB(o[1]=__builtin_amdgcn_mfma_f32_32x32x16_bf16(PAF(0),VFR(1),o[1],0,0,0), VRJ(1,1), C0,2); \
    GAPB(o[2]=__builtin_amdgcn_mfma_f32_32x32x16_bf16(PAF(0),VFR(2),o[2],0,0,0), VRJ(1,2), C0,4); \
    GAPB(o[3]=__builtin_amdgcn_mfma_f32_32x32x16_bf16(PAF(0),VFR(3),o[3],0,0,0), VRJ(1,3), C0,6); \
    GAPB(o[0]=__builtin_amdgcn_mfma_f32_32x32x16_bf16(PAF(1),VFR(0),o[0],0,0,0), VRJ(2,0), C0,8); \
    KRD(GL,0); GAPB(o[1]=__builtin_amdgcn_mfma_f32_32x32x16_bf16(PAF(1),VFR(1),o[1],0,0,0), VRJ(2,1), C0,10); \
    GAPB(o[2]=__builtin_amdgcn_mfma_f32_32x32x16_bf16(PAF(1),VFR(2),o[2],0,0,0), VRJ(2,2), C0,12); \
    KRD(GL,1); GAPB(o[3]=__builtin_amdgcn_mfma_f32_32x32x16_bf16(PAF(1),VFR(3),o[3],0,0,0), VRJ(2,3), C0,14); \
    GAPB(o[0]=__builtin_amdgcn_mfma_f32_32x32x16_bf16(PAF(2),VFR(0),o[0],0,0,0), VRJ(3,0), C1,0); \
    KRD(GL,2); GAPB(o[1]=__builtin_amdgcn_mfma_f32_32x32x16_bf16(PAF(2),VFR(1),o[1],0,0,0), VRJ(3,1), C1,2); \
    GAPB(o[2]=__builtin_amdgcn_mfma_f32_32x32x16_bf16(PAF(2),VFR(2),o[2],0,0,0), VRJ(3,2), C1,4); \
    KRD(GL,3); GAPB(o[3]=__builtin_amdgcn_mfma_f32_32x32x16_bf16(PAF(2),VFR(3),o[3],0,0,0), VRJ(3,3), C1,6); \
    GAPB(o[0]=__builtin_amdgcn_mfma_f32_32x32x16_bf16(PAF(3),VFR(0),o[0],0,0,0), (void)0, C1,8); \
    GAPB(o[1]=__builtin_amdgcn_mfma_f32_32x32x16_bf16(PAF(3),VFR(1),o[1],0,0,0), (void)0, C1,10); \
    GAPB(o[2]=__builtin_amdgcn_mfma_f32_32x32x16_bf16(PAF(3),VFR(2),o[2],0,0,0), (void)0, C1,12); \
    GAPB(o[3]=__builtin_amdgcn_mfma_f32_32x32x16_bf16(PAF(3),VFR(3),o[3],0,0,0), (void)0, C1,14); \
    }while(0)
  int t=1;
  #undef CMASK
  #define CMASK(P0,P1,t) do{}while(0)
  for(;t+7<NT;t+=2){
    STEP(pB0,pB1,pA0,pA1,t,true,true,true);     WAIT_BAR(3); RESC(); ROT();
    STEP(pA0,pA1,pB0,pB1,t+1,true,true,true);   WAIT_BAR(3); RESC(); ROT();
  }
  #undef CMASK
  #define CMASK(P0,P1,t) do{int jb_=(t)-(NT-4); if(jb_>=-2)biasmask(P0,P1,jb_,qrel,hi,tab);}while(0)
  #define ENDW(tt) do{ if((tt)+3<NT){WAIT_BAR(3);} else if((tt)+2<NT){WAIT_BAR(2);} else {WAIT_BAR(0);} }while(0)
  for(;t+1<NT;t+=2){
    STEP(pB0,pB1,pA0,pA1,t,(t+3<NT),(t+1<NT),(t+1<NT));       ENDW(t);   RESC(); ROT();
    STEP(pA0,pA1,pB0,pB1,t+1,(t+4<NT),(t+2<NT),(t+2<NT));     ENDW(t+1); RESC(); ROT();
  }
  STEP(pB0,pB1,pA0,pA1,NT-1,false,false,false); RESC();
  { float sacc=pB0[0]+pB0[1]; _Pragma("unroll") for(int r=2;r<16;++r)sacc+=pB0[r]; _Pragma("unroll") for(int r=0;r<16;++r)sacc+=pB1[r]; l_reg+=sacc;
    pw0=(u32x4){PKW(pB0,0),PKW(pB0,2),PKW(pB0,4),PKW(pB0,6)};pw1=(u32x4){PKW(pB0,8),PKW(pB0,10),PKW(pB0,12),PKW(pB0,14)};pw2=(u32x4){PKW(pB1,0),PKW(pB1,2),PKW(pB1,4),PKW(pB1,6)};pw3=(u32x4){PKW(pB1,8),PKW(pB1,10),PKW(pB1,12),PKW(pB1,14)};
    SBAR(); pv(o,vb0+2*sl_cur,PAF(0),PAF(1),PAF(2),PAF(3)); }
  #undef PKW
  #undef PAF
  #undef VFR
  #undef PIN
  #undef MX3
  #undef GAPA
  #undef GAPB
  #undef EX
  #undef VRJ
  #undef KRD
  #undef STEP
  #undef ENDW
  {auto rr=__builtin_amdgcn_permlane32_swap(__float_as_uint(l_reg),__float_as_uint(l_reg),false,false);l_reg=__uint_as_float(rr[0])+__uint_as_float(rr[1]);}
  if(hi==0)wsf[32+r32]=l_reg;asm volatile("s_waitcnt lgkmcnt(0)":::"memory");
  float rli[16];
  #pragma unroll
  for(int r=0;r<16;++r)rli[r]=__builtin_amdgcn_rcpf(wsf[32+crow(r,hi)]);
  bf16*Ow=O+(rowbase+q0+wid*QBLK)*OP+ocol;
  asm volatile("s_waitcnt lgkmcnt(0)\n\ts_barrier":::"memory");
  { bf16*stg=(bf16*)(shm+LDS_OST)+wid*4096;
    #pragma unroll
    for(int r=0;r<16;++r){const int orow=crow(r,hi);
      #pragma unroll
      for(int d0=0;d0<4;++d0)stg[orow*128+d0*32+r32]=__float2bfloat16(o[d0][r]*rli[r]);}
    asm volatile("s_waitcnt lgkmcnt(0)":::"memory");
    #pragma unroll
    for(int i=0;i<8;++i){const int row=i*4+(lane>>4),ch=lane&15; const u32x4 v=*(const u32x4*)(stg+row*128+ch*8); ATTN_STORE16(Ow+(long)row*OP+ch*8,v);} }
  asm volatile("s_waitcnt lgkmcnt(0)\n\ts_barrier":::"memory");
  #undef DMA_K
  #undef DMA_V
  #undef CMASK
  #undef START
  #undef RESC
  #undef ROT
}
constexpr int ATTN_LDS_BYTES=LDS_BYTES;
__device__ __forceinline__ bool attn_next(int G,int vcu,int i,int&b,int&vh,int&qb){
  if(G==256){ const int g=vcu&7, bv=vcu>>3; int q=-1;
    if(g<7){ q=(i==0)?16-g:(i==1)?1+g:-1; } else { q=(i==0)?9:(i==1)?8:(i==2)?0:-1; }
    if(q<0)return false; b=bv>>3; vh=bv&7; qb=q; return true; }
  const int u=vcu+i*G; if(u>=BATCH*8*17)return false; b=u/(8*17); vh=(u/17)&7; qb=u%17; return true;
}
#undef SBAR
#undef WAIT_BAR
}
namespace mk {
using pg8::bf16_t; using pg8::bf16x8; using pg8::f32x4; using pg8::u32x4; using pg8::u32x2; using pg8::Unit; using pg8::Gemm; using pg8::cvt_pk_bf16;
constexpr int NWAVES = 8;
constexpr int D = 1024, NB = 4, SEQ = 4096, NM = 16, MR = NB * SEQ  , MROWS = MR + NM  , MPAD = 16640;
constexpr int TP = 4352, MATT = NB * TP;
constexpr int INC = 8192, FFD = 2816, FFE = 3584, NE = 8;
constexpr float EPS = 1e-6f, LOG2E = 1.4426950408889634f, C2 = 0.125f * LOG2E;
constexpr size_t MiB = 1u << 20;
constexpr size_t WS_CTL = 0, CTL_ZERO_BYTES = 1 * MiB;
constexpr size_t WS_SMALL = 1 * MiB;
constexpr size_t WS_HN = 3 * MiB;
constexpr size_t WS_WIN = 36 * MiB, WS_WBR = 52 * MiB, WS_WO = 55 * MiB, WS_WGU0 = 57 * MiB, WS_WD0 = 68 * MiB;
constexpr size_t WS_U = 74 * MiB;
constexpr size_t WS_O = 123 * MiB, WS_ST = 157 * MiB, WS_HQ = 190 * MiB, WS_LOGF = 207 * MiB, WS_HG = 240 * MiB;
constexpr size_t WS_QK = 257 * MiB, WS_V = 291 * MiB, WS_CONV = 308 * MiB, WS_HV = 357 * MiB, WS_DS = 374 * MiB;
constexpr size_t WS_GATES = 257 * MiB, WS_MIXED = 355 * MiB, WS_MSCR = 388 * MiB;
constexpr size_t WS_H0 = 123 * MiB;
constexpr size_t WS_DEC = 440 * MiB;
constexpr size_t WS_HQ2 = 441 * MiB, WS_OI = 458 * MiB;
constexpr size_t WS_MGU = 36 * MiB, WS_MD = 148 * MiB, WS_MH = 204 * MiB, WS_MY = 442 * MiB;
constexpr size_t WS_HN8 = 491 * MiB, WS_WIN8 = 508 * MiB;
constexpr size_t WS_SLAB = 36 * MiB;
constexpr int LISTCAP = 16640;
constexpr size_t SMB_LIST = 128 * 1024, SMB_TOK = 704 * 1024;
constexpr int CW_CNT = 8192;
constexpr int SM_SCAL = 0;
constexpr int SM_LOGLB = 64, SM_LOG1M = 64 + 1024;
constexpr int SM_TAB = 64 + 2048;
constexpr int SM_METAHS = 4096;
constexpr int RING_OFF = 0, RING_BYTES = 131072, LDSCTL_OFF = RING_BYTES, MISC_OFF = LDSCTL_OFF + 320, LDS_BYTES = 147456;

#define GAS __attribute__((address_space(1)))
#define LAS __attribute__((address_space(3)))
typedef GAS unsigned gu32;
#define RLX_AGENT __ATOMIC_RELAXED, __HIP_MEMORY_SCOPE_AGENT
#define LDS_WAIT() asm volatile("s_waitcnt lgkmcnt(0)" ::: "memory")
__device__ __forceinline__ unsigned f2bf(float f) { unsigned u = __builtin_bit_cast(unsigned, f); return (u + 0x7fffu + ((u >> 16) & 1u)) >> 16; }
__device__ __forceinline__ unsigned pk2(float lo, float hi) { return cvt_pk_bf16(lo, hi); }
__device__ __forceinline__ unsigned f2bf_hw(float f) { return cvt_pk_bf16(f, 0.f) & 0xffffu; }
__device__ __forceinline__ float bf2f(unsigned short b) { return __builtin_bit_cast(float, (unsigned)b << 16); }
__device__ __forceinline__ float bflo(unsigned w) { return __builtin_bit_cast(float, w << 16); }
__device__ __forceinline__ float bfhi(unsigned w) { return __builtin_bit_cast(float, w & 0xffff0000u); }
#ifdef SLOWMATH
__device__ __forceinline__ float sigm(float x) { return 1.f / (1.f + __expf(-x)); }
__device__ __forceinline__ float silu(float x) { return x / (1.f + __expf(-x)); }
#else
__device__ __forceinline__ float sigm(float x) { return __builtin_amdgcn_rcpf(1.f + __expf(-x)); }
__device__ __forceinline__ float silu(float x) { return x * __builtin_amdgcn_rcpf(1.f + __expf(-x)); }
#endif
#ifdef SLOWMATH
__device__ __forceinline__ float logf_gate(float z, float la, float lm) { const float ls = fminf(z, 0.f) - log1pf(expf(-fabsf(z))), bb = lm + ls; return (la == -INFINITY) ? bb : fmaxf(la, bb) + log1pf(expf(-fabsf(la - bb))); }
#else
__device__ __forceinline__ float logf_gate(float z, float la, float lm) { const float ls = fminf(z, 0.f) - __logf(1.f + __expf(-fabsf(z))), bb = lm + ls; return (la == -INFINITY) ? bb : fmaxf(la, bb) + __logf(1.f + __expf(-fabsf(la - bb))); }
#endif
template <int O> __device__ __forceinline__ float xadd(float v) {
    if constexpr (O < 32) return v + __builtin_bit_cast(float, __builtin_amdgcn_ds_swizzle(__builtin_bit_cast(int, v), (O << 10) | 0x1f));
    else { const int l = pg8::lane_id(); return v + __builtin_bit_cast(float, __builtin_amdgcn_ds_bpermute((l ^ 32) << 2, __builtin_bit_cast(int, v))); }
}
__device__ __forceinline__ float wave_sum(float v) { v = xadd<1>(v); v = xadd<2>(v); v = xadd<4>(v); v = xadd<8>(v); v = xadd<16>(v); return xadd<32>(v); }

#define XB_TMO      128
#define XB_XCNT(j)  (256  + 64 * (j))
#define XB_XSUB(j)  (1280 + 64 * (j))
#define XB_XGEN(j)  (2304 + 64 * (j))
#define XB_TOP      3328
#define XB_TOPGEN   3392
#define XCD_BAR_WORDS 3456
#define XB_SPIN_CAP (1u << 18)
__device__ __forceinline__ unsigned xb_ld(unsigned* p)              { return __hip_atomic_load(p, __ATOMIC_RELAXED, __HIP_MEMORY_SCOPE_AGENT); }
__device__ __forceinline__ unsigned xb_add(unsigned* p, unsigned v) { return __hip_atomic_fetch_add(p, v, __ATOMIC_RELAXED, __HIP_MEMORY_SCOPE_AGENT); }
__device__ __forceinline__ unsigned xb_xcc_id() { return (unsigned)__builtin_amdgcn_s_getreg((3 << 11) | 20) & 0xFu; }
#define XB_SPIN(cond, bar) do { unsigned _sp = 0; while (cond) { __builtin_amdgcn_s_sleep(1); \
    if ((++_sp & 255u) == 0u) { if (xb_ld(&(bar)[XB_TMO])) break; if (_sp > XB_SPIN_CAP) { atomicAdd(&(bar)[XB_TMO], 1u); break; } } } } while (0)
struct XcdBarrier { unsigned* bar; unsigned x; volatile LAS unsigned* st; };
__device__ __forceinline__ XcdBarrier xcd_barrier_post(unsigned* bar, volatile LAS unsigned* st, int tid) {
    XcdBarrier b; b.bar = bar; b.x = xb_xcc_id(); b.st = st;
    if (tid == 0) (void)xb_add(&bar[XB_XCNT(b.x)], 1u);
    return b;
}
__device__ __forceinline__ void xcd_barrier_complete(unsigned* bar, unsigned x, unsigned& nloc, unsigned& nx) {
    const unsigned G = gridDim.x * gridDim.y * gridDim.z;
    unsigned sum, cnt, mine, sp = 0u;
    for (;;) {
        sum = 0u; cnt = 0u; mine = 0u;
#pragma unroll
        for (unsigned j = 0; j < 16; ++j) { const unsigned c = xb_ld(&bar[XB_XCNT(j)]); sum += c; cnt += (c > 0u) ? 1u : 0u; mine = (j == x) ? c : mine; }
        if (sum == G) break;
        __builtin_amdgcn_s_sleep(1);
        if ((++sp & 255u) == 0u) { if (xb_ld(&bar[XB_TMO])) break; if (sp > XB_SPIN_CAP) { atomicAdd(&bar[XB_TMO], 1u); break; } }
    }
    nloc = mine > 0u ? mine : 1u; nx = cnt > 0u ? cnt : 1u;
}
__device__ __forceinline__ void xcd_barrier(const XcdBarrier& b, int tid) {
    asm volatile("s_waitcnt vmcnt(0)" ::: "memory");
    __syncthreads();
    if (tid == 0) {
        unsigned* bar = b.bar;
        __builtin_amdgcn_s_waitcnt(0);
        unsigned nloc = b.st[0], nx = b.st[1];
        if (nloc == 0u) { xcd_barrier_complete(bar, b.x, nloc, nx); b.st[0] = nloc; b.st[1] = nx; }
        const unsigned old = xb_add(&bar[XB_XSUB(b.x)], 1u);
        const unsigned gen = old / nloc, tgt = (gen + 1u) * nx;
        if (old + 1u == (gen + 1u) * nloc) {
            __builtin_amdgcn_fence(__ATOMIC_RELEASE, "agent");
            asm volatile("s_waitcnt vmcnt(0)" ::: "memory");
            (void)xb_add(&bar[XB_TOP], 1u);
        }
        XB_SPIN(xb_ld(&bar[XB_TOP]) < tgt, bar);
        __builtin_amdgcn_fence(__ATOMIC_ACQUIRE, "agent");
        asm volatile("s_waitcnt vmcnt(0)" ::: "memory");
    }
    __syncthreads();
}

struct Frame {
    LAS unsigned char* lds; unsigned char* lds_gen;
    int tid, lane, wave, vcu, G;
    const float* const* in; float* out; unsigned char* ws;
};
#define WSP(T, off) ((T*)(F.ws + (off)))
#define SMALLF (WSP(float, WS_SMALL))

__device__ __forceinline__ void cvt_block(const float* W, int ldw, int k0, int c0, bf16_t* WT, int ldt, int r0, LAS float* scr, int lane) {
    float wv[32];
    const float* wp = W + (size_t)(k0 + (lane >> 5)) * ldw + c0 + (lane & 31);
#pragma unroll
    for (int i = 0; i < 32; ++i) wv[i] = __builtin_nontemporal_load(wp + (size_t)(2 * i) * ldw);
#pragma unroll
    for (int i = 0; i < 32; ++i) scr[(2 * i + (lane >> 5)) * 33 + (lane & 31)] = wv[i];
    LDS_WAIT(); asm volatile("" ::: "memory");
    const int c = lane & 7;
#pragma unroll
    for (int j = 0; j < 4; ++j) { const int n = (lane >> 3) + 8 * j; const LAS float* s = scr + (8 * c) * 33 + n;
        u32x4 o; o.x = pk2(s[0 * 33], s[1 * 33]); o.y = pk2(s[2 * 33], s[3 * 33]); o.z = pk2(s[4 * 33], s[5 * 33]); o.w = pk2(s[6 * 33], s[7 * 33]);
        *(GAS u32x4*)(WT + (size_t)(r0 + n) * ldt + k0 + 8 * c) = o; }
    LDS_WAIT(); asm volatile("" ::: "memory");
}
constexpr float W8_SCALE = 32.f, H8_SCALE = 4.f, WD8_SCALE = 64.f;
__device__ __forceinline__ unsigned pk4_fp8(float a, float b, float c, float d) { int r = __builtin_amdgcn_cvt_pk_fp8_f32(a, b, 0, false); r = __builtin_amdgcn_cvt_pk_fp8_f32(c, d, r, true); return (unsigned)r; }
__device__ __forceinline__ void cvt_block_fp8(const float* W, int ldw, int k0, int c0, unsigned char* WT, int ldt, int r0, LAS float* scr, int lane, float wscale) {
    float wv[32];
    const float* wp = W + (size_t)(k0 + (lane >> 5)) * ldw + c0 + (lane & 31);
#pragma unroll
    for (int i = 0; i < 32; ++i) wv[i] = __builtin_nontemporal_load(wp + (size_t)(2 * i) * ldw);
#pragma unroll
    for (int i = 0; i < 32; ++i) scr[(2 * i + (lane >> 5)) * 33 + (lane & 31)] = wv[i] * wscale;
    LDS_WAIT(); asm volatile("" ::: "memory");
    const int c = lane & 7;
#pragma unroll
    for (int j = 0; j < 4; ++j) { const int n = (lane >> 3) + 8 * j; const LAS float* s = scr + (8 * c) * 33 + n;
        u32x2 o; o.x = pk4_fp8(s[0 * 33], s[1 * 33], s[2 * 33], s[3 * 33]); o.y = pk4_fp8(s[4 * 33], s[5 * 33], s[6 * 33], s[7 * 33]);
        *(GAS u32x2*)(WT + (size_t)(r0 + n) * ldt + k0 + 8 * c) = o; }
    LDS_WAIT(); asm volatile("" ::: "memory");
}
struct CvtItem { const float* W; int ldw, k0, c0; void* WT; int ldt, r0; };
__device__ __forceinline__ void cvt_load(float (&wv)[32], const CvtItem& c, int lane) {
    const float* wp = c.W + (size_t)(c.k0 + (lane >> 5)) * c.ldw + c.c0 + (lane & 31);
#pragma unroll
    for (int i = 0; i < 32; ++i) wv[i] = __builtin_nontemporal_load(wp + (size_t)(2 * i) * c.ldw);
}
template <bool FP8> __device__ __forceinline__ void cvt_store(const float (&wv)[32], const CvtItem& c, LAS float* scr, int lane, float wscale) {
#pragma unroll
    for (int i = 0; i < 32; ++i) scr[(2 * i + (lane >> 5)) * 33 + (lane & 31)] = FP8 ? wv[i] * wscale : wv[i];
    LDS_WAIT(); asm volatile("" ::: "memory");
    const int cc = lane & 7;
#pragma unroll
    for (int j = 0; j < 4; ++j) { const int n = (lane >> 3) + 8 * j; const LAS float* q = scr + (8 * cc) * 33 + n;
        if constexpr (FP8) { u32x2 o; o.x = pk4_fp8(q[0 * 33], q[1 * 33], q[2 * 33], q[3 * 33]); o.y = pk4_fp8(q[4 * 33], q[5 * 33], q[6 * 33], q[7 * 33]);
            *(GAS u32x2*)((unsigned char*)c.WT + (size_t)(c.r0 + n) * c.ldt + c.k0 + 8 * cc) = o; }
        else { u32x4 o; o.x = pk2(q[0 * 33], q[1 * 33]); o.y = pk2(q[2 * 33], q[3 * 33]); o.z = pk2(q[4 * 33], q[5 * 33]); o.w = pk2(q[6 * 33], q[7 * 33]);
            *(GAS u32x4*)((bf16_t*)c.WT + (size_t)(c.r0 + n) * c.ldt + c.k0 + 8 * cc) = o; } }
    LDS_WAIT(); asm volatile("" ::: "memory");
}
template <bool FP8, class Dec> __device__ __forceinline__ void cvt_run(int it0, int stride, int n, const Dec& dec, LAS float* scr, int lane, float wscale) {
    for (int it = it0; it < n; it += 2 * stride) {
        float a[32], b[32]; const CvtItem ca = dec(it); cvt_load(a, ca, lane);
        const int it2 = it + stride; const bool hb = it2 < n; CvtItem cb = ca; if (hb) { cb = dec(it2); cvt_load(b, cb, lane); }
        cvt_store<FP8>(a, ca, scr, lane, wscale); if (hb) cvt_store<FP8>(b, cb, scr, lane, wscale);
    }
}
__device__ __forceinline__ int win_src_col(int db) { const int r0 = db * 32, tile = r0 >> 8, loc = r0 & 255; if (tile >= 4) return r0; const int bj = loc >> 7, wc = (loc & 127) >> 5; return tile * 256 + 64 * wc + 32 * bj; }

__device__ __forceinline__ void convert_layer_weights(Frame& F, int l, int widx = -1, int nw = 0, int part = 0) {
    LAS float* scr = (LAS float*)(F.lds + RING_OFF + F.wave * 16384);
    const int gw = widx >= 0 ? widx : F.vcu * NWAVES + F.wave, NGW = widx >= 0 ? nw : F.G * NWAVES;
    const float* w_in = F.in[4] + (size_t)l * D * INC; const float* w_br = F.in[13] + (size_t)l * 3 * 512 * D; const float* w_o = F.in[14] + (size_t)l * D * D;
    constexpr int I_IN = 16 * 256, I_BR = 3 * 8 * 32, I_O = 16 * 32, I_GU = 16 * 176, I_DN = 44 * 32;
    const int nitems = I_IN + I_BR + I_O + (l == 0 ? I_GU + I_DN : 0);
    const auto dec = [&](int it) -> CvtItem { int r = it;
        if (r < I_IN) { const int kb = r >> 8, db = r & 255; return CvtItem{w_in, INC, kb * 64, win_src_col(db), WSP(bf16_t, WS_WIN), D, db * 32}; } r -= I_IN;
        if (r < I_BR) { const int br = r / 256, q = r % 256, kb = q >> 5, db = q & 31; return CvtItem{w_br + (size_t)br * 512 * D, D, kb * 64, db * 32, WSP(bf16_t, WS_WBR) + 512 * br, 1536, db * 32}; }   r -= I_BR;
        if (r < I_O) { const int kb = r >> 5, db = r & 31; return CvtItem{w_o, D, kb * 64, db * 32, WSP(bf16_t, WS_WO), D, db * 32}; } r -= I_O;
        if (r < I_GU) { const int kb = r / 176, db = r % 176, tile = db >> 3, l32 = db & 7; const float* src = (l32 < 4) ? F.in[15] : F.in[16];
            return CvtItem{src, FFD, kb * 64, tile * 128 + (l32 & 3) * 32, WSP(bf16_t, WS_WGU0), D, db * 32}; } r -= I_GU;
        const int kb = r >> 5, db = r & 31; return CvtItem{F.in[17], D, kb * 64, db * 32, WSP(bf16_t, WS_WD0), FFD, db * 32}; };
    const int it_lo = part == 2 ? I_IN + I_BR + I_O : 0, it_hi = part == 1 ? I_IN + I_BR + I_O : nitems;
    cvt_run<false>(it_lo + gw, NGW, it_hi, dec, scr, F.lane, 1.f);
    if (part == 2) return;
    const auto dec8 = [&](int it) -> CvtItem { const int kb = it / 96, db = it % 96; return CvtItem{w_in, INC, kb * 64, (160 + db) * 32, F.ws + WS_WIN8, D, db * 32}; };
    cvt_run<true>(gw, NGW, 16 * 96, dec8, scr, F.lane, W8_SCALE);
}
__device__ __forceinline__ void setup_small(Frame& F, bool tables = true) {
    float* sm = SMALLF;
    if (blockIdx.x == 0 && tables) {
        if (F.tid < 2) { const int l = F.tid; const float* lp = F.in[7] + l * 256; float s1 = 0.f, s2 = 0.f;
            for (int i = 0; i < 64; ++i) { s1 += lp[i] * lp[64 + i]; s2 += lp[128 + i] * lp[192 + i]; }
            const float li = 0.8f - 0.6f * expf(-0.3f * (float)l); sm[SM_SCAL + l * 4] = expf(s1) - expf(s2) + li; sm[SM_SCAL + l * 4 + 1] = 1.f - li; }
        { const int c = F.tid; const float a = F.in[11][c], b = F.in[11][512 + c], mx = fmaxf(a, b), e0 = expf(a - mx), e1 = expf(b - mx), lb1 = e1 / (e0 + e1);
            sm[SM_LOGLB + c] = -INFINITY; sm[SM_LOG1M + c] = 0.f; sm[SM_LOGLB + 512 + c] = logf(lb1); sm[SM_LOG1M + 512 + c] = log1pf(-lb1); }
        { const int h = F.tid >> 7, n = F.tid & 127; int bk = n; if (n >= 16) { bk = 16 + (int)(logf((float)n / 16.f) / 2.0794415416798357f * 16.f); bk = bk < 31 ? bk : 31; }
            sm[SM_TAB + h * 128 + n] = (F.in[9][bk * 4 + h] - F.in[9][31 * 4 + h]) * LOG2E; }
    }
    const int gt = F.vcu * 512 + F.tid, NT = F.G * 512;
    for (int i = gt; i < NE * LISTCAP; i += NT) ((int*)(F.ws + WS_SMALL + SMB_LIST))[i] = 0;
    for (int i = gt; i < NB * 240 * (1024 / 8); i += NT) { const int row = i / 128, c = i % 128, b = row / 240, p = 4112 + row % 240; *(GAS u32x4*)(WSP(bf16_t, WS_QK) + ((size_t)(b * TP + p)) * 1024 + c * 8) = (u32x4){0u, 0u, 0u, 0u}; }
    for (int i = gt; i < NB * 240 * (512 / 8); i += NT) { const int row = i / 64, c = i % 64, b = row / 240, p = 4112 + row % 240; *(GAS u32x4*)(WSP(bf16_t, WS_V) + ((size_t)(b * TP + p)) * 512 + c * 8) = (u32x4){0u, 0u, 0u, 0u}; }
}
__device__ __forceinline__ const float* res_row(Frame& F, int r, bool first) {
    if (r < MR) return (first ? F.in[0] : (const float*)F.out) + (size_t)r * D;
    return (first ? F.in[1] : (const float*)(SMALLF + SM_METAHS)) + (size_t)(r - MR) * D;
}
__device__ __forceinline__ float* res_row_w(Frame& F, int r) { return (r < MR) ? F.out + (size_t)r * D : SMALLF + SM_METAHS + (size_t)(r - MR) * D; }
__device__ __forceinline__ void norm_pass(Frame& F, const float* gain, bool first, bool copy8) {
    const int gw = F.vcu * NWAVES + F.wave, NGW = F.G * NWAVES;
    f32x4 gv[4];
#pragma unroll
    for (int j = 0; j < 4; ++j) gv[j] = ((const f32x4*)gain)[F.lane + 64 * j];
    for (int r = gw; r < MROWS; r += NGW) {
        const GAS f32x4* xr = (const GAS f32x4*)res_row(F, r, first) + F.lane;
        f32x4 v[4]; float s = 0.f;
#pragma unroll
        for (int j = 0; j < 4; ++j) { v[j] = xr[64 * j]; s += (v[j].x * v[j].x + v[j].y * v[j].y) + (v[j].z * v[j].z + v[j].w * v[j].w); }
        const float sc = rsqrtf(wave_sum(s) * (1.f / D) + EPS);
        GAS u32x2* o = (GAS u32x2*)(WSP(bf16_t, WS_HN) + (size_t)r * D) + F.lane;
#pragma unroll
        for (int j = 0; j < 4; ++j) { u32x2 w; w.x = pk2(v[j].x * sc * gv[j].x, v[j].y * sc * gv[j].y); w.y = pk2(v[j].z * sc * gv[j].z, v[j].w * sc * gv[j].w); o[64 * j] = w; }
        if (copy8 && r < MR) { GAS unsigned* o8 = (GAS unsigned*)(F.ws + WS_HN8 + (size_t)r * D) + F.lane;
#pragma unroll
            for (int j = 0; j < 4; ++j) o8[64 * j] = pk4_fp8(v[j].x * sc * gv[j].x, v[j].y * sc * gv[j].y, v[j].z * sc * gv[j].z, v[j].w * sc * gv[j].w); }
    }
}

struct TileOrder {
    int nM, nN, nwg, G, c, pn0; long lda2, ldb2;
    __device__ void init(int nM_, int nN_, int pn0_, int G_, int c_, int lda, int ldb) { nM = nM_; nN = nN_; nwg = nM * nN; G = G_; c = c_; pn0 = pn0_; lda2 = 2L * lda; ldb2 = 2L * ldb; }
    __device__ __forceinline__ bool next(int i, Unit& u) const {
        const long L = (long)i * G + c; if (L >= nwg) return false;
        int wgid = (int)L; { const int q = nwg / 8, r = nwg % 8, xcd = wgid % 8, off = wgid / 8; wgid = (xcd < r ? xcd * (q + 1) : r * (q + 1) + (xcd - r) * q) + off; }
        const int nig = 8 * nN, gid = wgid / nig, fm = gid * 8, gsz = (nM - fm) < 8 ? (nM - fm) : 8;
        u.pm = fm + ((wgid % nig) % gsz); u.pn = pn0 + (wgid % nig) / gsz; u.z = 0; u.a_off = (unsigned)((long)u.pm * 256 * lda2); u.b_off = (unsigned)((long)u.pn * 256 * ldb2); u.gidx = nullptr; return true;
    }
};
__device__ __forceinline__ u32x4 pack8(const f32x4 a, const f32x4 b) { u32x4 w; w.x = cvt_pk_bf16(a[0], a[1]); w.y = cvt_pk_bf16(a[2], a[3]); w.z = cvt_pk_bf16(b[0], b[1]); w.w = cvt_pk_bf16(b[2], b[3]); return w; }
__device__ __forceinline__ void store_att(bf16_t* buf, int pitch, int r, int col, u32x4 w) {
    if (r < MR) { const int ar = (r >> 12) * TP + NM + (r & 4095); *(u32x4*)(buf + (size_t)ar * pitch + col) = w; }
    else { const int j = r - MR;
#pragma unroll
        for (int b = 0; b < NB; ++b) *(u32x4*)(buf + (size_t)(b * TP + j) * pitch + col) = w; }
}
struct EpiProj {
    static constexpr bool PERM = true, MID = false;
    unsigned char* ws; const float *qg, *kg; int l; float gsc;
    __device__ __forceinline__ void row(const Unit& u, int r, int slot, int wc, int fq, const f32x4 (&v)[2][2]) const {
        const int pn = u.pn;
        bf16_t* QK = (bf16_t*)(ws + WS_QK); bf16_t* V = (bf16_t*)(ws + WS_V); bf16_t* CONV = (bf16_t*)(ws + WS_CONV); bf16_t* HQ = (bf16_t*)(ws + WS_HQ); bf16_t* HV = (bf16_t*)(ws + WS_HV); bf16_t* HG = (bf16_t*)(ws + WS_HG);
        bf16_t* GATES = (bf16_t*)(ws + WS_GATES); float* LOGF = (float*)(ws + WS_LOGF); const float* loglb = (const float*)(ws + WS_SMALL) + SM_LOGLB + l * 512; const float* log1m = (const float*)(ws + WS_SMALL) + SM_LOG1M + l * 512;
        if (pn < 4) {
            float ss = 0.f;
#pragma unroll
            for (int bj = 0; bj < 2; ++bj)
#pragma unroll
                for (int n = 0; n < 2; ++n) ss += (v[bj][n][0] * v[bj][n][0] + v[bj][n][1] * v[bj][n][1]) + (v[bj][n][2] * v[bj][n][2] + v[bj][n][3] * v[bj][n][3]);
            ss = xadd<16>(ss); ss = xadd<32>(ss);
            const float sc = rsqrtf(ss * (1.f / 64.f) + EPS) * (pn < 2 ? C2 : 1.f); const float* gv = pn < 2 ? qg : kg;
#pragma unroll
            for (int bj = 0; bj < 2; ++bj) { const int d0 = 32 * bj + 8 * fq; const f32x4 g0 = *(const f32x4*)(gv + d0), g1 = *(const f32x4*)(gv + d0 + 4);
                store_att(QK, 1024, r, pn * 256 + 64 * wc + d0, pack8(v[bj][0] * g0 * sc, v[bj][1] * g1 * sc)); }
            return;
        }
#pragma unroll
        for (int bj = 0; bj < 2; ++bj) {
            const int cl = 128 * bj + 32 * wc + 8 * fq; f32x4 a = v[bj][0], b = v[bj][1];
            if (pn < 6) { store_att(V, 512, r, (pn - 4) * 256 + cl, pack8(a, b)); }
            else if (pn < 12) { *(u32x4*)(CONV + (size_t)r * 1536 + (pn - 6) * 256 + cl) = pack8(a, b); }
            else if (pn < 14 || (pn >= 18 && pn < 20)) {
#pragma unroll
                for (int e = 0; e < 4; ++e) { a[e] = silu(a[e]); b[e] = silu(b[e]); }
                bf16_t* dst = (pn < 14) ? HQ + (size_t)r * 512 + (pn - 12) * 256 + cl : HG + (size_t)r * 512 + (pn - 18) * 256 + cl; *(u32x4*)dst = pack8(a, b); }
            else if (pn < 16) {
                const int c = (pn - 14) * 256 + cl; const f32x4 la0 = *(const f32x4*)(loglb + c), la1 = *(const f32x4*)(loglb + c + 4), lm0 = *(const f32x4*)(log1m + c), lm1 = *(const f32x4*)(log1m + c + 4);
                f32x4 o0, o1;
#pragma unroll
                for (int e = 0; e < 4; ++e) {
                    o0[e] = logf_gate(a[e], la0[e], lm0[e]); o1[e] = logf_gate(b[e], la1[e], lm1[e]);
                }
                float* dst = LOGF + (size_t)r * 512 + c; *(f32x4*)dst = o0; *(f32x4*)(dst + 4) = o1; }
            else if (pn < 18) { *(u32x4*)(HV + (size_t)r * 512 + (pn - 16) * 256 + cl) = pack8(a, b); }
            else {
#pragma unroll
                for (int e = 0; e < 4; ++e) { a[e] = sigm(a[e] * gsc); b[e] = sigm(b[e] * gsc); }
                *(u32x4*)(GATES + (size_t)r * 3072 + (pn - 20) * 256 + cl) = pack8(a, b); }
        }
    }
};
struct EpiMerge {
    static constexpr bool PERM = true, MID = true; static constexpr int MID_T0 = 8, MID_T1 = 16;
    const bf16_t* GATES; bf16_t* MIXED;
    __device__ __forceinline__ void mid_row(const Unit& u, int r, int t, int wc, int fq, f32x4 (&v)[2][2]) const {
        const int b = (t >> 3) - 1;
#pragma unroll
        for (int bj = 0; bj < 2; ++bj) {
            const bf16_t* gp = GATES + (size_t)r * 3072 + b * 1024 + u.pn * 256 + 128 * bj + 32 * wc + 8 * fq; const u32x4 ga = *(const u32x4*)gp, gb = *(const u32x4*)(gp + 1024);
#define MK_RT(x, y) ((x) * __builtin_amdgcn_rcpf(fmaxf((y), 1e-20f)))
            v[bj][0][0] *= MK_RT(bflo(ga.x), bflo(gb.x)); v[bj][0][1] *= MK_RT(bfhi(ga.x), bfhi(gb.x)); v[bj][0][2] *= MK_RT(bflo(ga.y), bflo(gb.y)); v[bj][0][3] *= MK_RT(bfhi(ga.y), bfhi(gb.y));
            v[bj][1][0] *= MK_RT(bflo(ga.z), bflo(gb.z)); v[bj][1][1] *= MK_RT(bfhi(ga.z), bfhi(gb.z)); v[bj][1][2] *= MK_RT(bflo(ga.w), bflo(gb.w)); v[bj][1][3] *= MK_RT(bfhi(ga.w), bfhi(gb.w));
#undef MK_RT
        }
    }
    __device__ __forceinline__ void row(const Unit& u, int r, int slot, int wc, int fq, const f32x4 (&v)[2][2]) const {
#pragma unroll
        for (int bj = 0; bj < 2; ++bj) {
            const int cl = 128 * bj + 32 * wc + 8 * fq; const u32x4 gw = *(const u32x4*)(GATES + (size_t)r * 3072 + 2048 + u.pn * 256 + cl);
            f32x4 a = v[bj][0], b = v[bj][1];
            a[0] *= bflo(gw.x); a[1] *= bfhi(gw.x); a[2] *= bflo(gw.y); a[3] *= bfhi(gw.y); b[0] *= bflo(gw.z); b[1] *= bfhi(gw.z); b[2] *= bflo(gw.w); b[3] *= bfhi(gw.w);
            *(u32x4*)(MIXED + (size_t)r * D + u.pn * 256 + cl) = pack8(a, b);
        }
    }
};
struct EpiRes {
    static constexpr bool PERM = false, MID = false;
    const float* base; float* out; const float* mbase; float* mout;
    __device__ __forceinline__ void row(const Unit& u, int r, int slot, int wc, int fq, const f32x4 (&v)[2][2]) const {
        const float* bp = (r < MR) ? base + (size_t)r * D : mbase + (size_t)(r - MR) * D; float* op = (r < MR) ? out + (size_t)r * D : mout + (size_t)(r - MR) * D;
#pragma unroll
        for (int bj = 0; bj < 2; ++bj)
#pragma unroll
            for (int n = 0; n < 2; ++n) { const int col = u.pn * 256 + 128 * bj + 32 * wc + 16 * n + 4 * fq; *(f32x4*)(op + col) = *(const f32x4*)(bp + col) + v[bj][n]; }
    }
};
struct EpiGU {
    static constexpr bool PERM = true, MID = false;
    bf16_t* H; int ldh; float sc;
    __device__ __forceinline__ void row(const Unit& u, int r, int slot, int wc, int fq, const f32x4 (&v)[2][2]) const {
        f32x4 a, b;
#pragma unroll
        for (int e = 0; e < 4; ++e) { a[e] = silu(v[0][0][e] * sc) * (v[1][0][e] * sc); b[e] = silu(v[0][1][e] * sc) * (v[1][1][e] * sc); }
        *(u32x4*)(H + (size_t)r * ldh + u.pn * 128 + 32 * wc + 8 * fq) = pack8(a, b);
    }
};

struct EpiGU8 {
    static constexpr bool PERM = true, MID = false;
    unsigned char* H; int ldh; float sc;
    __device__ __forceinline__ void row(const Unit& u, int r, int slot, int wc, int fq, const f32x4 (&v)[2][2]) const {
        f32x4 a, b;
#pragma unroll
        for (int e = 0; e < 4; ++e) { a[e] = silu(v[0][0][e] * sc) * (v[1][0][e] * (sc * H8_SCALE)); b[e] = silu(v[0][1][e] * sc) * (v[1][1][e] * (sc * H8_SCALE)); }
#pragma unroll
        for (int e = 0; e < 4; ++e) { a[e] = __builtin_amdgcn_fmed3f(a[e], -448.f, 448.f); b[e] = __builtin_amdgcn_fmed3f(b[e], -448.f, 448.f); }
        u32x2 o; o.x = pk4_fp8(a[0], a[1], a[2], a[3]); o.y = pk4_fp8(b[0], b[1], b[2], b[3]);
        *(u32x2*)(H + (size_t)r * ldh + u.pn * 128 + 32 * wc + 8 * fq) = o;
    }
};
template <class Epi>
__device__ __forceinline__ void meta_gemm(Frame& F, const bf16_t* A16, int lda, const bf16_t* Bt, int ldb, int K, int pn_lo, int pn_hi, const Epi& E, int widx = -1, int nw = 0) {
    const int fr = F.lane & 15, fq = F.lane >> 4;
    for (int task = pn_lo * 4 + (widx >= 0 ? widx : F.vcu); task < pn_hi * 4; task += (widx >= 0 ? nw : F.G)) {
        const int pn = task >> 2, wc = task & 3; f32x4 v[2][2];
        pg8::small_tile<Epi::PERM>(F.lds + RING_OFF, A16, lda, Bt, ldb, K, pn, wc, v, F.wave);
        if (F.wave == 0) { Unit u; u.pm = 64; u.pn = pn; u.z = 0; u.a_off = 0; u.b_off = 0; u.gidx = nullptr; E.row(u, MR + fr, 0, wc, fq, v); }
    }
}
__device__ __forceinline__ void meta_merge(Frame& F, const bf16_t* U16, const bf16_t* Wbr, const bf16_t* GATES, bf16_t* MIXED) {
    const int fr = F.lane & 15, fq = F.lane >> 4;
    for (int task = F.vcu; task < 16; task += F.G) {
        const int pn = task >> 2, wc = task & 3; f32x4 tot[2][2];
#pragma unroll
        for (int bj = 0; bj < 2; ++bj)
#pragma unroll
            for (int n = 0; n < 2; ++n) tot[bj][n] = (f32x4){0.f, 0.f, 0.f, 0.f};
        for (int z = 0; z < 3; ++z) {
            f32x4 v[2][2];
            pg8::small_tile<true>(F.lds + RING_OFF, U16 + 512 * z, 1536, Wbr + 512 * z, 1536, 512, pn, wc, v, F.wave);
            if (F.wave == 0) {
#pragma unroll
                for (int bj = 0; bj < 2; ++bj) { const int cl = 128 * bj + 32 * wc + 8 * fq; const u32x4 gw = *(const u32x4*)(GATES + (size_t)(MR + fr) * 3072 + z * 1024 + pn * 256 + cl);
                    f32x4 a = v[bj][0], b = v[bj][1];
                    a[0] *= bflo(gw.x); a[1] *= bfhi(gw.x); a[2] *= bflo(gw.y); a[3] *= bfhi(gw.y); b[0] *= bflo(gw.z); b[1] *= bfhi(gw.z); b[2] *= bflo(gw.w); b[3] *= bfhi(gw.w);
                    tot[bj][0] += a; tot[bj][1] += b; }
            }
        }
        if (F.wave == 0) {
#pragma unroll
            for (int bj = 0; bj < 2; ++bj) { const int cl = 128 * bj + 32 * wc + 8 * fq; *(u32x4*)(MIXED + (size_t)(MR + fr) * D + pn * 256 + cl) = pack8(tot[bj][0], tot[bj][1]); }
        }
    }
}

__device__ __forceinline__ int prev_row(int r, int d) {
    if (r >= MR) { const int j = r - MR - d; return j >= 0 ? MR + j : -1; }
    const int s = r & 4095; if (s >= d) return r - d; return MR + NM + s - d;
}
__device__ __forceinline__ void conv_pass(Frame& F, const float* cw) {
    const bf16_t* CONV = WSP(bf16_t, WS_CONV); bf16_t* U = WSP(bf16_t, WS_U);
    const int gt = F.vcu * 512 + F.tid, NT = F.G * 512;
    for (int i = gt; i < MROWS * 64; i += NT) {
        const int r = i >> 6, c8 = (i & 63) * 8; float y[8];
#pragma unroll
        for (int e = 0; e < 8; ++e) y[e] = 0.f;
#pragma unroll
        for (int k = 0; k < 3; ++k) { const int rr = (k == 2) ? r : prev_row(r, 2 - k); if (rr < 0) continue;
            const u32x4 cv = *(const u32x4*)(CONV + (size_t)rr * 1536 + 512 + c8), hv = *(const u32x4*)(CONV + (size_t)rr * 1536 + 1024 + c8);
            const f32x4 w0 = *(const f32x4*)(cw + k * 512 + c8), w1 = *(const f32x4*)(cw + k * 512 + c8 + 4);
            y[0] += w0[0] * bflo(cv.x) * bflo(hv.x); y[1] += w0[1] * bfhi(cv.x) * bfhi(hv.x); y[2] += w0[2] * bflo(cv.y) * bflo(hv.y); y[3] += w0[3] * bfhi(cv.y) * bfhi(hv.y);
            y[4] += w1[0] * bflo(cv.z) * bflo(hv.z); y[5] += w1[1] * bfhi(cv.z) * bfhi(hv.z); y[6] += w1[2] * bflo(cv.w) * bflo(hv.w); y[7] += w1[3] * bfhi(cv.w) * bfhi(hv.w); }
        const u32x4 bv = *(const u32x4*)(CONV + (size_t)r * 1536 + c8);
        u32x4 o; o.x = pk2(bflo(bv.x) * y[0], bfhi(bv.x) * y[1]); o.y = pk2(bflo(bv.y) * y[2], bfhi(bv.y) * y[3]); o.z = pk2(bflo(bv.z) * y[4], bfhi(bv.z) * y[5]); o.w = pk2(bflo(bv.w) * y[6], bfhi(bv.w) * y[7]);
        *(u32x4*)(U + (size_t)r * 1536 + 512 + c8) = o;
    }
}
__device__ __forceinline__ void attcomb_pass(Frame& F, const float* sg, int l) {
    const bf16_t* O = WSP(bf16_t, WS_O); bf16_t* U = WSP(bf16_t, WS_U);
    const int gw = F.vcu * NWAVES + F.wave, NGW = F.G * NWAVES;
    const float lam = SMALLF[SM_SCAL + l * 4], oml = SMALLF[SM_SCAL + l * 4 + 1];
    const int c8 = F.lane * 8; const f32x4 g0 = *(const f32x4*)(sg + (c8 & 127)), g1 = *(const f32x4*)(sg + (c8 & 127) + 4);
    for (int r = gw; r < MROWS; r += NGW) {
        const int ar = (r < MR) ? (r >> 12) * TP + NM + (r & 4095) : (r - MR);
        const u32x4 a = *(const u32x4*)(O + (size_t)ar * 1024 + c8), b = *(const u32x4*)(O + (size_t)ar * 1024 + 512 + c8);
        float d[8]; d[0] = bflo(a.x) - lam * bflo(b.x); d[1] = bfhi(a.x) - lam * bfhi(b.x); d[2] = bflo(a.y) - lam * bflo(b.y); d[3] = bfhi(a.y) - lam * bfhi(b.y);
        d[4] = bflo(a.z) - lam * bflo(b.z); d[5] = bfhi(a.z) - lam * bfhi(b.z); d[6] = bflo(a.w) - lam * bflo(b.w); d[7] = bfhi(a.w) - lam * bfhi(b.w);
        float ss = 0.f;
#pragma unroll
        for (int e = 0; e < 8; ++e) ss += d[e] * d[e];
        ss = xadd<1>(ss); ss = xadd<2>(ss); ss = xadd<4>(ss); ss = xadd<8>(ss);
        const float sc = rsqrtf(ss * (1.f / 128.f) + EPS) * oml;
        u32x4 o; o.x = pk2(d[0] * sc * g0[0], d[1] * sc * g0[1]); o.y = pk2(d[2] * sc * g0[2], d[3] * sc * g0[3]); o.z = pk2(d[4] * sc * g1[0], d[5] * sc * g1[1]); o.w = pk2(d[6] * sc * g1[2], d[7] * sc * g1[3]);
        *(u32x4*)(U + (size_t)r * 1536 + c8) = o;
    }
}

constexpr int HA_QP = 0, HA_KP = 43520, HA_KT = HA_KP + 17408, HA_VT = HA_KT + 18432, HA_PB = HA_VT + 18432, HA_TOT = HA_PB + 9216;
__device__ __forceinline__ int qp_base(int j) { return j == 0 ? 0 : (j == 1 ? 64 : (j == 2 ? 112 : 144)); }
struct HgIn { float lf[16], qv[16], vv[16]; };
__device__ __forceinline__ void hgrnA_load(Frame& F, int id, HgIn& in) {
    const bool meta = id >= 1024; const int bh = meta ? 0 : id >> 6, c = id & 63, h = meta ? id - 1024 : bh & 3, b = bh >> 2;
    const int row0 = meta ? MR : b * SEQ + c * 64, nvalid = meta ? NM : 64;
    const int d = F.tid & 127, i = F.tid >> 7;
    const bf16_t* HQ = WSP(bf16_t, WS_HQ); const bf16_t* HV = WSP(bf16_t, WS_HV); const float* LOGF = WSP(float, WS_LOGF);
#pragma unroll
    for (int j = 0; j < 16; ++j) { const int t = 16 * i + j; const bool ok = t < nvalid; const size_t off = (size_t)(row0 + (ok ? t : 0)) * 512 + h * 128 + d;
        const float a = LOGF[off]; const unsigned short q = HQ[off], v = HV[off]; in.lf[j] = ok ? a : 0.f; in.qv[j] = ok ? bf2f(q) : 0.f; in.vv[j] = ok ? bf2f(v) : 0.f; }
}
#ifndef HG_NORAW
#define HG_BAR() do { asm volatile("s_waitcnt lgkmcnt(0)" ::: "memory"); __builtin_amdgcn_s_barrier(); asm volatile("" ::: "memory"); } while (0)
#else
#define HG_BAR() __syncthreads()
#endif
#define HG_BAR_UNUSED()
__device__ __forceinline__ void hgrnA_compute(Frame& F, int id, const HgIn& in) {
    const bool meta = id >= 1024; const int bh = meta ? 0 : id >> 6, c = id & 63, h = meta ? id - 1024 : bh & 3, b = bh >> 2;
    const int row0 = meta ? MR : b * SEQ + c * 64, nvalid = meta ? NM : 64;
    const int d = F.tid & 127, i = F.tid >> 7;
    LAS unsigned char* L = F.lds + RING_OFF;
    const float (&lf)[16] = in.lf; const float (&qv)[16] = in.qv; const float (&vv)[16] = in.vv;
    float Lc[16]; { float s = 0.f;
#pragma unroll
        for (int j = 0; j < 16; ++j) { s += lf[j]; Lc[j] = s; } }
    LAS float* TOT = (LAS float*)(L + HA_TOT);
    TOT[i * 128 + d] = Lc[15];
    HG_BAR();
    float rho[4]; { float s = 0.f;
#pragma unroll
        for (int j = 0; j < 4; ++j) { s += TOT[j * 128 + d]; rho[j] = s; } }
    const float rhoi = (i == 0) ? rho[0] : (i == 1) ? rho[1] : (i == 2) ? rho[2] : rho[3], ri = (i == 0) ? 0.f : (i == 1) ? rho[0] : (i == 2) ? rho[1] : rho[2], glast = rho[3];
    const float fK2 = __expf(glast - rhoi), fQ2 = __expf(rhoi);
    float fQ[4];
#pragma unroll
    for (int jj = 0; jj < 4; ++jj) fQ[jj] = (jj <= i) ? __expf(rhoi - rho[jj]) : 0.f;
    LAS bf16_t* KP = (LAS bf16_t*)(L + HA_KP); LAS bf16_t* QP = (LAS bf16_t*)(L + HA_QP);
    unsigned kt[8], vt[8];
#pragma unroll
    for (int j = 0; j < 16; j += 2) {
        float kp[2], qe[2];
#pragma unroll
        for (int q = 0; q < 2; ++q) { const float G = ri + Lc[j + q], E = __expf(G - rhoi), k = 1.f - __expf(lf[j + q]); kp[q] = k * __builtin_amdgcn_rcpf(E); qe[q] = qv[j + q] * E; }
        const int t = 16 * i + j;
        { const unsigned w = cvt_pk_bf16(kp[0], kp[1]); KP[t * 136 + d] = (bf16_t)(w & 0xffffu); KP[(t + 1) * 136 + d] = (bf16_t)(w >> 16); }
        kt[j >> 1] = cvt_pk_bf16(kp[0] * fK2, kp[1] * fK2); vt[j >> 1] = cvt_pk_bf16(vv[j], vv[j + 1]);
#pragma unroll
        for (int jj = 0; jj < 4; ++jj) if (jj <= i) { const unsigned w = cvt_pk_bf16(qe[0] * fQ[jj], qe[1] * fQ[jj]); const int rb = qp_base(jj) + t - 16 * jj; QP[rb * 136 + d] = (bf16_t)(w & 0xffffu); QP[(rb + 1) * 136 + d] = (bf16_t)(w >> 16); }
        { const unsigned w = cvt_pk_bf16(qe[0] * fQ2, qe[1] * fQ2); bf16_t* hq2 = WSP(bf16_t, WS_HQ2) + (size_t)(row0 + t) * 512 + h * 128 + d;
          if (t < nvalid) hq2[0] = (bf16_t)(w & 0xffffu); if (t + 1 < nvalid) hq2[512] = (bf16_t)(w >> 16); }
    }
    { LAS u32x4* ktp = (LAS u32x4*)(L + HA_KT + d * 144 + i * 32); ktp[0] = (u32x4){kt[0], kt[1], kt[2], kt[3]}; ktp[1] = (u32x4){kt[4], kt[5], kt[6], kt[7]};
      LAS u32x4* vtp = (LAS u32x4*)(L + HA_VT + d * 144 + i * 32); vtp[0] = (u32x4){vt[0], vt[1], vt[2], vt[3]}; vtp[1] = (u32x4){vt[4], vt[5], vt[6], vt[7]}; }
    if (i == 0) WSP(float, WS_DEC)[(size_t)id * 128 + d] = __expf(glast);
    HG_BAR();
    const int w = F.wave, fr = F.lane & 15, fq = F.lane >> 4;
    {
        LAS unsigned char* PB = L + HA_PB;
        for (int blk = w; blk < 16; blk += 8) {
            int it, js;
            if (blk < 10) { it = (blk >= 6) ? 3 : (blk >= 3) ? 2 : (blk >= 1) ? 1 : 0; js = blk - ((it * (it + 1)) >> 1); }
            else { const int q = blk - 10; it = (q < 3) ? 0 : (q < 5) ? 1 : 2; js = (q < 3) ? q + 1 : (q < 5) ? q - 1 : 3; }
            f32x4 acc = (f32x4){0.f, 0.f, 0.f, 0.f};
            if (blk < 10) {
#pragma unroll
                for (int ks = 0; ks < 4; ++ks) {
                    const bf16x8 qa = *(const LAS bf16x8*)(L + HA_QP + ((qp_base(js) + 16 * it - 16 * js + fr) * 136 + 32 * ks + 8 * fq) * 2);
                    const bf16x8 kb = *(const LAS bf16x8*)(L + HA_KP + ((16 * js + fr) * 136 + 32 * ks + 8 * fq) * 2);
                    acc = __builtin_amdgcn_mfma_f32_16x16x32_bf16(kb, qa, acc, 0, 0, 0);
                }
                if (it == js) {
#pragma unroll
                    for (int e = 0; e < 4; ++e) if (4 * fq + e > fr) acc[e] = 0.f;
                }
            }
            u32x2 pw; pw.x = pk2(acc[0], acc[1]); pw.y = pk2(acc[2], acc[3]);
            *(LAS u32x2*)(PB + (16 * it + fr) * 144 + (16 * js + 4 * fq) * 2) = pw;
        }
    }
    HG_BAR();
    {
        const int tb = w >> 1, dv0 = (w & 1) * 4;
        f32x4 acc[4];
#pragma unroll
        for (int q = 0; q < 4; ++q) acc[q] = (f32x4){0.f, 0.f, 0.f, 0.f};
#pragma unroll
        for (int ks = 0; ks < 2; ++ks) {
            const bf16x8 pa = *(const LAS bf16x8*)(L + HA_PB + (16 * tb + fr) * 144 + (32 * ks + 8 * fq) * 2);
#pragma unroll
            for (int q = 0; q < 4; ++q) { const bf16x8 vb = *(const LAS bf16x8*)(L + HA_VT + (16 * (dv0 + q) + fr) * 144 + (32 * ks + 8 * fq) * 2);
                acc[q] = __builtin_amdgcn_mfma_f32_16x16x32_bf16(vb, pa, acc[q], 0, 0, 0); }
        }
        const int t = 16 * tb + fr;
        if (t < nvalid) {
#pragma unroll
            for (int q = 0; q < 4; ++q) *(f32x4*)(WSP(float, WS_OI) + (size_t)(row0 + t) * 512 + h * 128 + 16 * (dv0 + q) + 4 * fq) = acc[q];
        }
    }
    {
        f32x4 acc[8];
#pragma unroll
        for (int q = 0; q < 8; ++q) acc[q] = (f32x4){0.f, 0.f, 0.f, 0.f};
#pragma unroll
        for (int ks = 0; ks < 2; ++ks) {
            const bf16x8 va = *(const LAS bf16x8*)(L + HA_VT + (16 * w + fr) * 144 + (32 * ks + 8 * fq) * 2);
#pragma unroll
            for (int q = 0; q < 8; ++q) { const bf16x8 kb = *(const LAS bf16x8*)(L + HA_KT + (16 * q + fr) * 144 + (32 * ks + 8 * fq) * 2);
                acc[q] = __builtin_amdgcn_mfma_f32_16x16x32_bf16(kb, va, acc[q], 0, 0, 0); }
        }
        float* DS = WSP(float, WS_DS) + (size_t)id * 16384 + (size_t)(16 * w + fr) * 128;
#pragma unroll
        for (int q = 0; q < 8; ++q) *(f32x4*)(DS + 16 * q + 4 * fq) = acc[q];
    }
    HG_BAR();
}
__device__ __forceinline__ void hgrn_scan(Frame& F) {
    const float* DS = WSP(float, WS_DS); const float* DEC = WSP(float, WS_DEC); bf16_t* ST = WSP(bf16_t, WS_ST);
    const int gt = F.vcu * 512 + F.tid, NT = F.G * 512;
    typedef float f32x2 __attribute__((ext_vector_type(2)));
    for (int idx = gt; idx < 16 * 8192; idx += NT) {
        const int bh = idx >> 13, e2 = (idx & 8191) * 2, dk = e2 & 127, h = bh & 3;
        f32x2 s = *(const f32x2*)(DS + (size_t)(1024 + h) * 16384 + e2);
#pragma unroll 8
        for (int c = 0; c < 64; ++c) {
            const size_t id = (size_t)bh * 64 + c;
            *(unsigned*)(ST + id * 16384 + e2) = pk2(s.x, s.y);
            const f32x2 dd = *(const f32x2*)(DEC + id * 128 + dk), ds = *(const f32x2*)(DS + id * 16384 + e2);
            s = dd * s + ds;
        }
    }
}
__device__ __forceinline__ void hgrnC_pass(Frame& F, const float* og) {
    const bf16_t* HQ = WSP(bf16_t, WS_HQ2); const bf16_t* HG = WSP(bf16_t, WS_HG); const float* OI = WSP(float, WS_OI); const bf16_t* ST = WSP(bf16_t, WS_ST); bf16_t* U = WSP(bf16_t, WS_U);
    const int gw = F.vcu * NWAVES + F.wave, NGW = F.G * NWAVES, fr = F.lane & 15, fq = F.lane >> 4;
    for (int task = gw; task < 1024 * 4 + 4; task += NGW) {
        const bool meta = task >= 4096; const int id = meta ? 0 : task >> 2, tb = meta ? 0 : task & 3, bh = id >> 6, c = id & 63, h = meta ? task - 4096 : bh & 3, b = bh >> 2;
        const int row = (meta ? MR : b * SEQ + c * 64 + 16 * tb) + fr;
        f32x4 acc[8];
#pragma unroll
        for (int q = 0; q < 8; ++q) acc[q] = *(const f32x4*)(OI + (size_t)row * 512 + h * 128 + 16 * q + 4 * fq);
        if (!meta) {
            const bf16_t* Sb = ST + (size_t)id * 16384;
#pragma unroll
            for (int ks = 0; ks < 4; ++ks) {
                const bf16x8 qa = *(const bf16x8*)(HQ + (size_t)row * 512 + h * 128 + 32 * ks + 8 * fq);
#pragma unroll
                for (int q = 0; q < 8; ++q) { const bf16x8 sb = *(const bf16x8*)(Sb + (size_t)(16 * q + fr) * 128 + 32 * ks + 8 * fq);
                    acc[q] = __builtin_amdgcn_mfma_f32_16x16x32_bf16(sb, qa, acc[q], 0, 0, 0); }
            }
        }
        float ss = 0.f;
#pragma unroll
        for (int q = 0; q < 8; ++q) ss += (acc[q][0] * acc[q][0] + acc[q][1] * acc[q][1]) + (acc[q][2] * acc[q][2] + acc[q][3] * acc[q][3]);
        ss = xadd<16>(ss); ss = xadd<32>(ss);
        const float sc = rsqrtf(ss * (1.f / 128.f) + EPS);
#pragma unroll
        for (int q = 0; q < 8; ++q) { const int dv = 16 * q + 4 * fq; const f32x4 g = *(const f32x4*)(og + dv); const u32x2 gg = *(const u32x2*)(HG + (size_t)row * 512 + h * 128 + dv);
            u32x2 o; o.x = pk2(acc[q][0] * sc * g[0] * bflo(gg.x), acc[q][1] * sc * g[1] * bfhi(gg.x)); o.y = pk2(acc[q][2] * sc * g[2] * bflo(gg.y), acc[q][3] * sc * g[3] * bfhi(gg.y));
            *(u32x2*)(U + (size_t)row * 1536 + 1024 + h * 128 + dv) = o; }
    }
}
struct TokInfo { int e1, s1, e2, s2; float w1, w2; int pad0, pad1; };
__device__ __forceinline__ void convert_moe_gu(Frame& F, int early = -1, int widx = 0, int nw = 1, int skip = -1) {
    LAS float* scr = early >= 0 ? (LAS float*)(F.lds + RING_OFF + F.wave * 16384) : (LAS float*)(F.lds + RING_OFF + 32768 + F.wave * 8704);
    const int gw = early >= 0 ? widx : F.vcu * NWAVES + F.wave, NGW = early >= 0 ? nw : F.G * NWAVES;
    constexpr int I_GU = 16 * 224;
    const int ne = early >= 0 ? 1 : (skip >= 0 ? NE - 1 : NE);
    const auto dec = [&](int it) -> CvtItem { int e = it / I_GU; const int r = it - e * I_GU, kb = r / 224, db = r % 224, tile = db >> 3, l32 = db & 7;
        e = early >= 0 ? early : (skip >= 0 && e >= skip ? e + 1 : e);
        const float* src = ((l32 < 4) ? F.in[19] : F.in[20]) + (size_t)e * D * FFE;
        return CvtItem{src, FFE, kb * 64, tile * 128 + (l32 & 3) * 32, F.ws + WS_MGU + (size_t)e * 7168 * D, D, db * 32}; };
    cvt_run<true>(gw, NGW, ne * I_GU, dec, scr, F.lane, W8_SCALE);
}
__device__ __forceinline__ void convert_moe_down(Frame& F, int widx, int nw) {
    LAS float* scr = (LAS float*)(F.lds + RING_OFF + F.wave * 16384);
    constexpr int I_DN = 56 * 32;
    const auto dec = [&](int it) -> CvtItem { const int e = it / I_DN, r = it - e * I_DN, kb = r >> 5, db = r & 31;
        return CvtItem{F.in[21] + (size_t)e * FFE * D, D, kb * 64, db * 32, F.ws + WS_MD + (size_t)e * D * FFE, FFE, db * 32}; };
    cvt_run<true>(widx, nw, NE * I_DN, dec, scr, F.lane, WD8_SCALE);
}
__device__ __forceinline__ void norm_route_pass(Frame& F, const float* gain) {
    LAS float* rwl = (LAS float*)(F.lds + RING_OFF);
    for (int i = F.tid; i < D * NE / 4; i += 512) ((LAS f32x4*)rwl)[i] = ((const f32x4*)F.in[18])[i];
    __syncthreads();
    const int gw = F.vcu * NWAVES + F.wave, NGW = F.G * NWAVES;
    f32x4 gv[4];
#pragma unroll
    for (int j = 0; j < 4; ++j) gv[j] = ((const f32x4*)gain)[F.lane + 64 * j];
    unsigned* cnt = (unsigned*)(F.ws + WS_CTL) + CW_CNT; int* lists = (int*)(F.ws + WS_SMALL + SMB_LIST); TokInfo* ti = (TokInfo*)(F.ws + WS_SMALL + SMB_TOK);
    for (int r = gw; r < MR; r += NGW) {
        const GAS f32x4* xr = (const GAS f32x4*)(F.out + (size_t)r * D) + F.lane;
        f32x4 v[4]; float s = 0.f;
#pragma unroll
        for (int j = 0; j < 4; ++j) { v[j] = xr[64 * j]; s += (v[j].x * v[j].x + v[j].y * v[j].y) + (v[j].z * v[j].z + v[j].w * v[j].w); }
        const float sc = rsqrtf(wave_sum(s) * (1.f / D) + EPS);
        GAS unsigned* o = (GAS unsigned*)(F.ws + WS_HN + (size_t)r * D) + F.lane;
        float lg[8];
#pragma unroll
        for (int e = 0; e < 8; ++e) lg[e] = 0.f;
#pragma unroll
        for (int j = 0; j < 4; ++j) {
            v[j] = v[j] * sc * gv[j];
            o[64 * j] = pk4_fp8(v[j].x, v[j].y, v[j].z, v[j].w);
#pragma unroll
            for (int q = 0; q < 4; ++q) { const int d = (F.lane + 64 * j) * 4 + q; const f32x4 r0 = *(const LAS f32x4*)(rwl + d * 8), r1 = *(const LAS f32x4*)(rwl + d * 8 + 4); const float x = v[j][q];
                lg[0] += x * r0[0]; lg[1] += x * r0[1]; lg[2] += x * r0[2]; lg[3] += x * r0[3]; lg[4] += x * r1[0]; lg[5] += x * r1[1]; lg[6] += x * r1[2]; lg[7] += x * r1[3]; }
        }
#pragma unroll
        for (int e = 0; e < 8; ++e) lg[e] = wave_sum(lg[e]);
        int i1 = 0; float m1 = lg[0];
#pragma unroll
        for (int e = 1; e < 8; ++e) if (lg[e] > m1) { m1 = lg[e]; i1 = e; }
        int i2 = -1; float m2 = -INFINITY;
#pragma unroll
        for (int e = 0; e < 8; ++e) if (e != i1 && lg[e] > m2) { m2 = lg[e]; i2 = e; }
        if (F.lane == 0) {
            const float w1 = 1.f / (1.f + expf(m2 - m1));
            const unsigned s1 = __hip_atomic_fetch_add(cnt + 64 * i1, 1u, RLX_AGENT), s2 = __hip_atomic_fetch_add(cnt + 64 * i2, 1u, RLX_AGENT);
            lists[i1 * LISTCAP + s1] = r; lists[i2 * LISTCAP + s2] = r;
            TokInfo t; t.e1 = i1; t.s1 = (int)s1; t.e2 = i2; t.s2 = (int)s2; t.w1 = w1; t.w2 = 1.f - w1; t.pad0 = 0; t.pad1 = 0; ti[r] = t;
        }
    }
}
struct MoeTiles { int ts[9]; };
__device__ __forceinline__ MoeTiles moe_tiles(Frame& F) {
    MoeTiles m; const unsigned* cnt = (const unsigned*)(F.ws + WS_CTL) + CW_CNT; int a = 0;
#pragma unroll
    for (int e = 0; e < 8; ++e) { m.ts[e] = a; const unsigned c = (unsigned)__builtin_amdgcn_readfirstlane((int)__hip_atomic_load(cnt + 64 * e, RLX_AGENT)); a += (int)((c + 255u) >> 8); }
    m.ts[8] = a; return m;
}
__device__ __forceinline__ int moe_expert_of(const MoeTiles& m, int rt) { int e = 0;
#pragma unroll
    for (int k = 1; k < 8; ++k) e += (rt >= m.ts[k]) ? 1 : 0;
    return e; }
struct MoeGuOrder {
    MoeTiles m; int G, c; const int* lists;
    __device__ __forceinline__ bool next(int i, Unit& u) const {
        const int L = i * G + c; if (L >= m.ts[8] * 28) return false;
        const int rt = L / 28, pn = L - rt * 28, e = moe_expert_of(m, rt);
        int tsb = 0;
#pragma unroll
        for (int k = 0; k < 8; ++k) tsb = (k == e) ? m.ts[k] : tsb;
        u.pm = rt; u.pn = pn; u.z = e; u.a_off = 0u; u.b_off = (unsigned)(((long)e * 7168 + pn * 256) * D); u.gidx = lists + e * LISTCAP + (rt - tsb) * 256; return true;
    }
};
struct MoeDownOrder {
    MoeTiles m; int G, c;
    __device__ __forceinline__ bool next(int i, Unit& u) const {
        const int nt = m.ts[8] < 128 ? m.ts[8] : 128; const int L = i * G + c; if (L >= nt * 4) return false;
        const int rt = L >> 2, pn = L & 3, e = moe_expert_of(m, rt);
        u.pm = rt; u.pn = pn; u.z = e; u.a_off = (unsigned)((long)rt * 256 * FFE); u.b_off = (unsigned)(((long)e * D + pn * 256) * FFE); u.gidx = nullptr; return true;
    }
};
struct MoeSlabOrder {
    MoeTiles m; int G, c, S, Kp;
    __device__ __forceinline__ bool next(int i, Unit& u) const {
        const int nleft = (m.ts[8] - 128) * 4; const int q = i * G + c; if (q >= nleft * S) return false;
        const int up = q / S, sl = q - up * S, rt = 128 + (up >> 2), pn = up & 3, e = moe_expert_of(m, rt);
        u.pm = rt; u.pn = pn; u.z = q; u.a_off = (unsigned)((long)rt * 256 * FFE + (long)sl * Kp * 2); u.b_off = (unsigned)(((long)e * D + pn * 256) * FFE + (long)sl * Kp * 2); u.gidx = nullptr; return true;
    }
};
struct EpiSlab {
    static constexpr bool PERM = false, MID = false;
    float* SL; float sc;
    __device__ __forceinline__ void row(const Unit& u, int r, int slot, int wc, int fq, const f32x4 (&v)[2][2]) const {
        float* p = SL + (size_t)u.z * 65536 + (size_t)(r & 255) * 256 + 32 * wc + 4 * fq;
#pragma unroll
        for (int bj = 0; bj < 2; ++bj)
#pragma unroll
            for (int n = 0; n < 2; ++n) *(f32x4*)(p + 128 * bj + 16 * n) = v[bj][n] * sc;
    }
};
__device__ __forceinline__ void moe_slab_split(int tiles, int G, int& S, int& Kp) { S = 7; Kp = 256; }
struct EpiY {
    static constexpr bool PERM = true, MID = false;
    bf16_t* Y; float sc;
    __device__ __forceinline__ void row(const Unit& u, int r, int slot, int wc, int fq, const f32x4 (&v)[2][2]) const {
#pragma unroll
        for (int bj = 0; bj < 2; ++bj) *(u32x4*)(Y + (size_t)r * D + u.pn * 256 + 128 * bj + 32 * wc + 8 * fq) = pack8(v[bj][0] * sc, v[bj][1] * sc);
    }
};
__device__ __forceinline__ f32x4 moe_y4(const bf16_t* Y, const float* SL, int S, size_t R, int j, int lane) {
    if (R < 32768) { const u32x2 y = *((const GAS u32x2*)(Y + R * D) + lane + 64 * j); return (f32x4){bflo(y.x), bfhi(y.x), bflo(y.y), bfhi(y.y)}; }
    const float* p = SL + ((size_t)(((R >> 8) - 128) * 4 + j) * S) * 65536 + (R & 255) * 256 + 4 * lane; f32x4 a = (f32x4){0.f, 0.f, 0.f, 0.f};
    for (int s0 = 0; s0 < S; s0 += 7) {
        f32x4 q[7];
#pragma unroll
        for (int sl = 0; sl < 7; ++sl) q[sl] = *(const f32x4*)(p + (size_t)(s0 + sl) * 65536);
#pragma unroll
        for (int sl = 0; sl < 7; ++sl) a += q[sl];
    }
    return a;
}
__device__ __forceinline__ void moe_combine_pass(Frame& F) {
    const MoeTiles m = moe_tiles(F); const TokInfo* ti = (const TokInfo*)(F.ws + WS_SMALL + SMB_TOK); const bf16_t* Y = WSP(bf16_t, WS_MY); const float* SL = WSP(float, WS_SLAB);
    int S, Kp; moe_slab_split(m.ts[8], F.G, S, Kp);
    const int gw = F.vcu * NWAVES + F.wave, NGW = F.G * NWAVES;
    TokInfo tn = ti[gw < MR ? gw : 0];
    for (int r = gw; r < MR; r += NGW) {
        const TokInfo t = tn; { const int rn = r + NGW; tn = ti[rn < MR ? rn : r]; }
        int b1 = 0, b2 = 0;
#pragma unroll
        for (int k = 0; k < 8; ++k) { b1 = (k == t.e1) ? m.ts[k] : b1; b2 = (k == t.e2) ? m.ts[k] : b2; }
        const size_t r1 = (size_t)b1 * 256 + t.s1, r2 = (size_t)b2 * 256 + t.s2;
        GAS f32x4* o = (GAS f32x4*)(F.out + (size_t)r * D) + F.lane;
        if (r1 < 32768 && r2 < 32768) {
            u32x2 y1[4], y2[4]; f32x4 x[4];
#pragma unroll
            for (int j = 0; j < 4; ++j) { y1[j] = *((const GAS u32x2*)(Y + r1 * D) + F.lane + 64 * j); y2[j] = *((const GAS u32x2*)(Y + r2 * D) + F.lane + 64 * j); x[j] = o[64 * j]; }
#pragma unroll
            for (int j = 0; j < 4; ++j) { x[j][0] += t.w1 * bflo(y1[j].x) + t.w2 * bflo(y2[j].x); x[j][1] += t.w1 * bfhi(y1[j].x) + t.w2 * bfhi(y2[j].x); x[j][2] += t.w1 * bflo(y1[j].y) + t.w2 * bflo(y2[j].y); x[j][3] += t.w1 * bfhi(y1[j].y) + t.w2 * bfhi(y2[j].y); o[64 * j] = x[j]; }
        } else {
#pragma unroll
            for (int j = 0; j < 4; ++j) { const f32x4 y1 = moe_y4(Y, SL, S, r1, j, F.lane), y2 = moe_y4(Y, SL, S, r2, j, F.lane); o[64 * j] = o[64 * j] + y1 * t.w1 + y2 * t.w2; }
        }
    }
}
}
namespace mk {
enum { P_CVT = 0, P_NORM1, P_PROJ, P_MIX, P_SCAN, P_FIN, P_GATES, P_MERGE, P_WOUT, P_NORM2, P_GU, P_DOWN, P_COMB, P_NPH };
struct Args { const float* in[22]; float* out; unsigned char* ws; unsigned pmask; int l0, l1; unsigned dup; };

#define PH(k) ((a.pmask >> (k)) & 1u)
#define PHASE_FRAME() Frame F = F0; { const int t_ = pg8::make_tid(F0.wave); F.tid = t_; F.lane = t_ & 63; F.wave = F0.wave; unsigned char* w_ = F0.ws; asm volatile("" : "+s"(w_)); F.ws = w_; int g_ = F0.G, v_ = F0.vcu; asm volatile("" : "+s"(g_), "+s"(v_)); F.G = g_; F.vcu = v_; } float* sm = SMALLF; (void)sm
#define GRID_BAR() xcd_barrier(bar, F.tid)
template <int l> __device__ __forceinline__ void layer_body(const Args& a, const Frame& F0, const XcdBarrier& bar, unsigned char* lds) {
    constexpr bool first = (l == 0);
#ifndef NO_P_CVT
        if (PH(P_CVT) && l == 0) for (int rep_ = 0; rep_ <= (int)((a.dup >> (16 + l)) & (a.dup >> P_CVT) & 1u); ++rep_) { PHASE_FRAME(); setup_small(F); if (F.G == 256) { if (F.vcu != 0) convert_layer_weights(F, 0, (F.vcu - 1) * NWAVES + F.wave, (F.G - 1) * NWAVES, 1); }   else convert_layer_weights(F, 0, -1, 0, 0); }
#endif
#ifndef NO_P_NORM1
        if (PH(P_NORM1)) for (int rep_ = 0; rep_ <= (int)((a.dup >> (16 + l)) & (a.dup >> P_NORM1) & 1u); ++rep_) { PHASE_FRAME(); norm_pass(F, F.in[2] + l * D, first, true); GRID_BAR(); }
#endif
#ifndef NO_P_PROJ
        if (PH(P_PROJ)) for (int rep_ = 0; rep_ <= (int)((a.dup >> (16 + l)) & (a.dup >> P_PROJ) & 1u); ++rep_) { PHASE_FRAME();
            Gemm g{WSP(bf16_t, WS_HN), WSP(bf16_t, WS_WIN), D, D, D}; TileOrder S; S.init(64, 20, 0, F.G, (int)blockIdx.x, D, D);
            EpiProj E{F.ws, F.in[5] + l * 64, F.in[6] + l * 64, l, 1.f};
            pg8::gemm_phase<EpiProj, TileOrder>(F.lds + RING_OFF, g, S, E, F.wave);
            meta_gemm(F, WSP(bf16_t, WS_HN) + (size_t)MR * D, D, WSP(bf16_t, WS_WIN), D, D, 0, 20, E);
            GRID_BAR();
        }
#endif
#ifndef NO_P_MIX
        if (PH(P_MIX)) for (int rep_ = 0; rep_ <= (int)((a.dup >> (16 + l)) & (a.dup >> P_MIX) & 1u); ++rep_) { PHASE_FRAME();
            if (!(a.dup & 0x8000u) || rep_ == 0) {
                if (F.G == 256) {
                    const bool hm = (F.vcu & 7) == 0 && F.vcu < 32; const int idm = 1024 + (F.vcu >> 3);
                    HgIn A, B; hgrnA_load(F, F.vcu, A); hgrnA_load(F, F.vcu + 256, B); hgrnA_compute(F, F.vcu, A);
                    hgrnA_load(F, F.vcu + 512, A); hgrnA_compute(F, F.vcu + 256, B); hgrnA_load(F, F.vcu + 768, B); hgrnA_compute(F, F.vcu + 512, A);
                    if (hm) hgrnA_load(F, idm, A);
                    hgrnA_compute(F, F.vcu + 768, B); if (hm) hgrnA_compute(F, idm, A); }
                else for (int id = F.vcu; id < 1028; id += F.G) { HgIn A; hgrnA_load(F, id, A); hgrnA_compute(F, id, A); }
            }
            if (rep_ == 1 && !(a.dup & 0x8000u)) { GRID_BAR(); continue; }
            conv_pass(F, F.in[10] + l * 1536);
            { LAS float* tabl = (LAS float*)(F.lds + RING_OFF + attn_body::LDS_TAB); tabl[F.tid] = sm[SM_TAB + F.tid]; }
            __syncthreads();
            { int b, vh, qb;
              for (int i = 0; attn_body::attn_next(F.G, F.vcu, i, b, vh, qb); ++i)
                  attn_body::attn_unit<8>(b, vh, qb, (const attn_body::bf16*)WSP(bf16_t, WS_QK), (const attn_body::bf16*)WSP(bf16_t, WS_V), (attn_body::bf16*)WSP(bf16_t, WS_O), (char*)lds + RING_OFF, F.wave); }
            if (l == 0 && F.G == 256) {
                const int g = F.vcu & 7, bv = F.vcu >> 3;
                if (g != 7 && !(g == 0 && bv < 4)) { const int idx = bv < 4 ? bv * 6 + (g - 1) : 24 + (bv - 4) * 7 + g; convert_layer_weights(F, 0, idx * NWAVES + F.wave, 220 * NWAVES, 2); } }
            if (l == 1 && F.G == 256) {
                const int g = F.vcu & 7, bv = F.vcu >> 3;
                if (g != 7 && !(g == 0 && bv < 4)) { const int idx = bv < 4 ? bv * 6 + (g - 1) : 24 + (bv - 4) * 7 + g; convert_moe_gu(F, 3, idx * NWAVES + F.wave, 220 * NWAVES); } }
            GRID_BAR();
        }
#endif
#ifndef NO_P_SCAN
        if (PH(P_SCAN)) for (int rep_ = 0; rep_ <= (int)((a.dup >> (16 + l)) & (a.dup >> P_SCAN) & 1u); ++rep_) { PHASE_FRAME(); hgrn_scan(F); GRID_BAR(); }
#endif
#ifndef NO_P_FIN
        if (PH(P_FIN)) for (int rep_ = 0; rep_ <= (int)((a.dup >> (16 + l)) & (a.dup >> P_FIN) & 1u); ++rep_) { PHASE_FRAME(); hgrnC_pass(F, F.in[12] + l * 128); attcomb_pass(F, F.in[8] + l * 128, l); }
#endif
#ifndef NO_P_GATES
        if (PH(P_GATES)) for (int rep_ = 0; rep_ <= (int)((a.dup >> (16 + l)) & (a.dup >> P_GATES) & 1u); ++rep_) { PHASE_FRAME();
            Gemm g{(const bf16_t*)(F.ws + WS_HN8), (const bf16_t*)(F.ws + WS_WIN8 - (size_t)20 * 256 * D), D / 2, D / 2, D / 2}; TileOrder S; S.init(64, 12, 20, F.G, (int)blockIdx.x, D / 2, D / 2);
            EpiProj E{F.ws, F.in[5] + l * 64, F.in[6] + l * 64, l, 1.f / W8_SCALE};
            pg8::gemm_phase<EpiProj, TileOrder, false, true>(F.lds + RING_OFF, g, S, E, F.wave);
            if (l == 0) { EpiProj Em{F.ws, F.in[5] + l * 64, F.in[6] + l * 64, l, 1.f}; meta_gemm(F, WSP(bf16_t, WS_HN) + (size_t)MR * D, D, WSP(bf16_t, WS_WIN), D, D, 20, 32, Em); }
            GRID_BAR();
        }
#endif
#ifndef NO_P_MERGE
        if (PH(P_MERGE)) for (int rep_ = 0; rep_ <= (int)((a.dup >> (16 + l)) & (a.dup >> P_MERGE) & 1u); ++rep_) { PHASE_FRAME();
            Gemm g{WSP(bf16_t, WS_U), WSP(bf16_t, WS_WBR), 1536, 1536, 1536}; TileOrder S; S.init(64, 4, 0, F.G, (int)blockIdx.x, 1536, 1536);
            EpiMerge E{WSP(bf16_t, WS_GATES), WSP(bf16_t, WS_MIXED)};
            pg8::gemm_phase<EpiMerge, TileOrder>(F.lds + RING_OFF, g, S, E, F.wave);
            if (l == 0) meta_merge(F, WSP(bf16_t, WS_U) + (size_t)MR * 1536, WSP(bf16_t, WS_WBR), WSP(bf16_t, WS_GATES), WSP(bf16_t, WS_MIXED));
            GRID_BAR();
        }
#endif
#ifndef NO_P_WOUT
        if (PH(P_WOUT)) for (int rep_ = 0; rep_ <= (int)((a.dup >> (16 + l)) & (a.dup >> P_WOUT) & 1u); ++rep_) { PHASE_FRAME();
            Gemm g{WSP(bf16_t, WS_MIXED), WSP(bf16_t, WS_WO), D, D, D}; TileOrder S; S.init(64, 4, 0, F.G, (int)blockIdx.x, D, D);
            EpiRes E{first ? F.in[0] : (const float*)F.out, F.out, first ? F.in[1] : (const float*)(sm + SM_METAHS), sm + SM_METAHS};
            pg8::gemm_phase<EpiRes, TileOrder>(F.lds + RING_OFF, g, S, E, F.wave);
            if (l == 0) meta_gemm(F, WSP(bf16_t, WS_MIXED) + (size_t)MR * D, D, WSP(bf16_t, WS_WO), D, D, 0, 4, E);
            GRID_BAR();
        }
#endif
#ifndef NO_P_NORM2
        if (PH(P_NORM2) && l == 0) for (int rep_ = 0; rep_ <= (int)((a.dup >> (16 + l)) & (a.dup >> P_NORM2) & 1u); ++rep_) { PHASE_FRAME(); norm_pass(F, F.in[3] + l * D, false, false); if (PH(P_CVT)) setup_small(F, false); GRID_BAR(); }
        if (PH(P_NORM2) && l == 1) for (int rep_ = 0; rep_ <= (int)((a.dup >> (16 + l)) & (a.dup >> P_NORM2) & 1u); ++rep_) { PHASE_FRAME(); convert_moe_gu(F, -1, 0, 1, F.G == 256 ? 3 : -1); __syncthreads(); norm_route_pass(F, F.in[3] + l * D);     GRID_BAR(); }
#endif
#ifndef NO_P_GU
        if (PH(P_GU) && l == 0) for (int rep_ = 0; rep_ <= (int)((a.dup >> (16 + l)) & (a.dup >> P_GU) & 1u); ++rep_) { PHASE_FRAME();
            Gemm g{WSP(bf16_t, WS_HN), WSP(bf16_t, WS_WGU0), D, D, D}; TileOrder S; S.init(64, 22, 0, F.G, (int)blockIdx.x, D, D);
            EpiGU E{WSP(bf16_t, WS_H0), FFD, 1.f};
            pg8::gemm_phase<EpiGU, TileOrder>(F.lds + RING_OFF, g, S, E, F.wave);
            { const int rem_ = (64 * 22) % F.G, bx_ = (int)blockIdx.x;
              if (rem_ == 0) meta_gemm(F, WSP(bf16_t, WS_HN) + (size_t)MR * D, D, WSP(bf16_t, WS_WGU0), D, D, 0, 22, E);
              else if (bx_ >= rem_) meta_gemm(F, WSP(bf16_t, WS_HN) + (size_t)MR * D, D, WSP(bf16_t, WS_WGU0), D, D, 0, 22, E, bx_ - rem_, F.G - rem_); }
            if (PH(P_CVT) && rep_ == 0) { const int total = 64 * 22, rem = total % F.G, bx = (int)blockIdx.x;
              if (rem == 0) convert_layer_weights(F, 1, bx * NWAVES + F.wave, F.G * NWAVES); else if (bx >= rem) convert_layer_weights(F, 1, (bx - rem) * NWAVES + F.wave, (F.G - rem) * NWAVES); }
            GRID_BAR();
        }
#endif
#ifndef NO_P_DOWN
        if (PH(P_DOWN) && l == 0) for (int rep_ = 0; rep_ <= (int)((a.dup >> (16 + l)) & (a.dup >> P_DOWN) & 1u); ++rep_) { PHASE_FRAME();
            Gemm g{WSP(bf16_t, WS_H0), WSP(bf16_t, WS_WD0), FFD, FFD, FFD}; TileOrder S; S.init(64, 4, 0, F.G, (int)blockIdx.x, FFD, FFD);
            EpiRes E{(const float*)F.out, F.out, (const float*)(sm + SM_METAHS), sm + SM_METAHS};
            pg8::gemm_phase<EpiRes, TileOrder>(F.lds + RING_OFF, g, S, E, F.wave);
            meta_gemm(F, WSP(bf16_t, WS_H0) + (size_t)MR * FFD, FFD, WSP(bf16_t, WS_WD0), FFD, FFD, 0, 4, E);
            GRID_BAR();
        }
#endif
#ifndef NO_P_MOE
        if (PH(P_GU) && l == 1) for (int rep_ = 0; rep_ <= (int)((a.dup >> (16 + l)) & (a.dup >> P_GU) & 1u); ++rep_) { PHASE_FRAME();
            Gemm g{WSP(bf16_t, WS_HN), WSP(bf16_t, WS_MGU), D / 2, D / 2, D / 2};   MoeGuOrder S{moe_tiles(F), F.G, (int)blockIdx.x, (const int*)(F.ws + WS_SMALL + SMB_LIST)};
            EpiGU8 E{F.ws + WS_MH, FFE, 1.f / W8_SCALE};
            pg8::gemm_phase<EpiGU8, MoeGuOrder, true, true>(F.lds + RING_OFF, g, S, E, F.wave);
            { const int total = S.m.ts[8] * 28, rem = total % F.G, bx = (int)blockIdx.x;
              if (rem == 0) convert_moe_down(F, bx * NWAVES + F.wave, F.G * NWAVES); else if (bx >= rem) convert_moe_down(F, (bx - rem) * NWAVES + F.wave, (F.G - rem) * NWAVES); }
            GRID_BAR();
        }
        if (PH(P_DOWN) && l == 1) for (int rep_ = 0; rep_ <= (int)((a.dup >> (16 + l)) & (a.dup >> P_DOWN) & 1u); ++rep_) { PHASE_FRAME();
            Gemm g{WSP(bf16_t, WS_MH), WSP(bf16_t, WS_MD), FFE / 2, FFE / 2, FFE / 2};   MoeDownOrder S{moe_tiles(F), F.G, (int)blockIdx.x};
            EpiY E{WSP(bf16_t, WS_MY), 1.f / (H8_SCALE * WD8_SCALE)};
            pg8::gemm_phase<EpiY, MoeDownOrder, false, true>(F.lds + RING_OFF, g, S, E, F.wave);
            { int SS, Kp; moe_slab_split(S.m.ts[8], F.G, SS, Kp);
              Gemm g2{WSP(bf16_t, WS_MH), WSP(bf16_t, WS_MD), FFE / 2, FFE / 2, Kp}; MoeSlabOrder S2{S.m, F.G, (int)blockIdx.x, SS, Kp}; EpiSlab E2{WSP(float, WS_SLAB), 1.f / (H8_SCALE * WD8_SCALE)};
              pg8::gemm_phase<EpiSlab, MoeSlabOrder, false, true>(F.lds + RING_OFF, g2, S2, E2, F.wave); }
            GRID_BAR();
        }
        if (PH(P_COMB) && l == 1) for (int rep_ = 0; rep_ <= (int)((a.dup >> (16 + l)) & (a.dup >> P_COMB) & 1u); ++rep_) { PHASE_FRAME(); moe_combine_pass(F); if (rep_ < (int)((a.dup >> (16 + l)) & (a.dup >> P_COMB) & 1u)) GRID_BAR(); }
#endif
}
__global__ void __launch_bounds__(NWAVES * 64, 2) mega(Args a) {
    extern __shared__ __attribute__((aligned(16))) unsigned char lds[];
    Frame F0; Frame& F = F0;
    F.lds = (LAS unsigned char*)lds; F.lds_gen = lds;
    F.wave = __builtin_amdgcn_readfirstlane((int)threadIdx.x >> 6); F.tid = pg8::make_tid(F.wave); F.lane = F.tid & 63;
    F.G = gridDim.x; { const int bx = blockIdx.x; F.vcu = (F.G % 8 == 0) ? (bx % 8) * (F.G / 8) + bx / 8 : bx; }
    F.in = a.in; F.out = a.out; F.ws = a.ws;
    for (int u = F.tid; u < (LDS_BYTES - LDSCTL_OFF) / 4; u += NWAVES * 64) ((LAS unsigned*)(F.lds + LDSCTL_OFF))[u] = 0u;
    __syncthreads();
    volatile LAS unsigned* MISC = (volatile LAS unsigned*)(F.lds + MISC_OFF);
    XcdBarrier bar = xcd_barrier_post((unsigned*)(F.ws + WS_CTL) + 4096, MISC + 8, F.tid);
    if (a.l0 <= 0 && 0 < a.l1) layer_body<0>(a, F0, bar, lds);
    if (a.l0 <= 1 && 1 < a.l1) layer_body<1>(a, F0, bar, lds);
}
#undef PH
#undef GRID_BAR


#ifndef MK_DUP
#define MK_DUP 0u
#endif
static int g_grid = 0;
static bool mega_init() {
    if (g_grid) return g_grid > 0;
    int dev = 0, cus = 0, per_cu = 0;
    if (hipGetDevice(&dev) != hipSuccess || hipDeviceGetAttribute(&cus, hipDeviceAttributeMultiprocessorCount, dev) != hipSuccess) { g_grid = -1; return false; }
    if (hipFuncSetAttribute((const void*)mega, hipFuncAttributeMaxDynamicSharedMemorySize, LDS_BYTES) != hipSuccess) { g_grid = -1; return false; }
    if (hipOccupancyMaxActiveBlocksPerMultiprocessor(&per_cu, (const void*)mega, NWAVES * 64, LDS_BYTES) != hipSuccess || per_cu < 1) { fprintf(stderr, "mega: occupancy query says %d\n", per_cu); }
    (void)hipGetLastError();
    g_grid = cus;
    return true;
}
static void mega_launch(void* const* d_in, float* out, unsigned char* ws, unsigned pmask, int l0, int l1, hipStream_t st) {
    if (!mega_init()) return;
    (void)hipMemsetAsync(ws + WS_CTL, 0, CTL_ZERO_BYTES, st);
    Args a{};
    for (int i = 0; i < 22; ++i) a.in[i] = (const float*)d_in[i];
    a.out = out; a.ws = ws; a.pmask = pmask; a.l0 = l0; a.l1 = l1; a.dup = MK_DUP;
    hipLaunchKernelGGL(mega, dim3(g_grid), dim3(NWAVES * 64), LDS_BYTES, st, a);
}
}
extern "C" void kernel_launch(void* const* d_in, const int* in_sizes, int n_in, void* d_out, int out_size, void* d_ws, size_t ws_size, hipStream_t stream) {
    (void)in_sizes; (void)n_in; (void)out_size;
    if (ws_size < (size_t)512 * (1u << 20)) { fprintf(stderr, "kernel_launch: workspace too small (%zu)\n", ws_size); return; }
    mk::mega_launch(d_in, (float*)d_out, (unsigned char*)d_ws, (1u << mk::P_NPH) - 1u, 0, 2, stream);
}
```

```cpp
#include <hip/hip_runtime.h>
#include <cstdio>
#include <cstdint>
#include <cmath>
#include <hip/hip_bf16.h>
namespace pg8 {
#define PG8_LAS __attribute__((address_space(3)))
typedef unsigned short bf16_t;
typedef short bf16x8 __attribute__((ext_vector_type(8)));
typedef float f32x4 __attribute__((ext_vector_type(4)));
typedef unsigned u32x4 __attribute__((ext_vector_type(4)));
typedef unsigned u32x2 __attribute__((ext_vector_type(2)));
typedef int v4i_t __attribute__((ext_vector_type(4)));
typedef int v8i_t __attribute__((ext_vector_type(8)));
constexpr int BM = 256, BK = 64, HALF = 128, HTB = HALF * BK * 2, STAGE_BYTES = 8 * HTB;

__host__ __device__ __forceinline__ int lds_byte(int r, int c) { const int st = (r >> 4) * 2 + (c >> 5), rr = r & 15, cc = c & 31, ob = rr * 64 + cc * 2; return st * 1024 + (ob ^ (((ob >> 9) & 1) << 5)); }
__host__ __device__ __forceinline__ void stage_rc(int b, int& R, int& C) { const int st = b / 1024, sb = b % 1024, swz = sb ^ (((sb >> 9) & 1) << 5); R = (st >> 1) * 16 + swz / 64; C = (st & 1) * 32 + (swz % 64) / 2; }
__host__ __device__ __forceinline__ int perm32(int rho) { const int n = rho >> 4, i = rho & 15; return 8 * (i >> 2) + 4 * n + (i & 3); }

struct Unit { int pm, pn, z; unsigned a_off, b_off; const int* gidx; };
struct Gemm { const bf16_t* A; const bf16_t* Bt; int lda, ldb, K; };

__device__ __forceinline__ int lane_id() { unsigned m = ~0u; asm volatile("" : "+s"(m)); return (int)__builtin_amdgcn_mbcnt_hi(m, __builtin_amdgcn_mbcnt_lo(m, 0u)); }
__device__ __forceinline__ int make_tid(int wave) { int t = (wave << 6) | lane_id(); asm volatile("" : "+v"(t)); return t; }
typedef float f32x2_cv __attribute__((ext_vector_type(2))); typedef __bf16 bf16x2_cv __attribute__((ext_vector_type(2)));
__device__ __forceinline__ unsigned cvt_pk_bf16(float lo, float hi) { const f32x2_cv v = {lo, hi}; const bf16x2_cv b = __builtin_convertvector(v, bf16x2_cv); return __builtin_bit_cast(unsigned, b); }

template <class Epi, class Sched, bool GATHER = false, bool FP8 = false>
__device__ __forceinline__ void gemm_phase(PG8_LAS unsigned char* lds, const Gemm g, const Sched& S, const Epi& E, int wave0) {
    const int tid = make_tid(wave0),
              wid = __builtin_amdgcn_readfirstlane(tid >> 6), lane = tid & 63, wr = wid >> 2, wc = wid & 3, fr = lane & 15, fq = lane >> 4;
    const int K = g.K, nt = K / BK;
    unsigned voffA[2], voffB[2];
#pragma unroll
    for (int i = 0; i < 2; ++i) { int R, C; stage_rc(tid * 16 + i * 8192, R, C); const int Rb = Epi::PERM ? ((R & ~31) + perm32(R & 31)) : R;
        voffA[i] = (unsigned)(R * g.lda + C) * 2u; voffB[i] = (unsigned)(Rb * g.ldb + C) * 2u; }
    const size_t kstep = (size_t)(BK * 2);
    const size_t hstepA = GATHER ? 0 : (size_t)HALF * g.lda * 2, hstepB = (size_t)HALF * g.ldb * 2;
    const unsigned ldsw = (unsigned)wid * 1024u;
    const int aoff = lds_byte(wr * 64 + fr, fq * 8), boff = lds_byte(wc * 32 + fr, fq * 8);
    unsigned gvc[2][2], gvn[2][2];
#define PG8_SA(b, h) (((b) * 2 + (h)) * HTB)
#define PG8_SB(b, h) ((4 + (b) * 2 + (h)) * HTB)
#define PG8_STAGE(bufoff, gbase, voff) do { _Pragma("unroll") for (int _i = 0; _i < 2; ++_i) \
        __builtin_amdgcn_global_load_lds((const unsigned*)((const char*)(gbase) + (voff)[_i]), (PG8_LAS unsigned*)(lds + (bufoff) + ldsw + _i * 8192), 16, 0, 0); } while (0)
#define PG8_STAGE_A(bufoff, base, h, nx) do { if constexpr (GATHER) { if (nx) PG8_STAGE(bufoff, base, gvn[h]); else PG8_STAGE(bufoff, base, gvc[h]); } else { PG8_STAGE(bufoff, (base) + (h) * hstepA, voffA); } } while (0)
#define PG8_LD8(a_) __builtin_shufflevector(*(const PG8_LAS v4i_t*)(a_), *(const PG8_LAS v4i_t*)((a_) + 1024), 0, 1, 2, 3, 4, 5, 6, 7)
#define PG8_LDA(dst, b, h) do { if constexpr (FP8) { _Pragma("unroll") for (int m = 0; m < 4; ++m) dst##8[m] = PG8_LD8(lds + PG8_SA(b, h) + aoff + m * 2048); } else { \
        _Pragma("unroll") for (int m = 0; m < 4; ++m) _Pragma("unroll") for (int k = 0; k < 2; ++k) dst[m][k] = *(const PG8_LAS bf16x8*)(lds + PG8_SA(b, h) + aoff + m * 2048 + k * 1024); } } while (0)
#define PG8_LDB(dst, b, h) do { if constexpr (FP8) { _Pragma("unroll") for (int n = 0; n < 2; ++n) dst##8[n] = PG8_LD8(lds + PG8_SB(b, h) + boff + n * 2048); } else { \
        _Pragma("unroll") for (int n = 0; n < 2; ++n) _Pragma("unroll") for (int k = 0; k < 2; ++k) dst[n][k] = *(const PG8_LAS bf16x8*)(lds + PG8_SB(b, h) + boff + n * 2048 + k * 1024); } } while (0)
#define PG8_MMA(ai, bj, At, Bt) do { __builtin_amdgcn_s_setprio(1); if constexpr (FP8) { _Pragma("unroll") for (int m = 0; m < 4; ++m) _Pragma("unroll") for (int n = 0; n < 2; ++n) \
        asm volatile("v_mfma_scale_f32_16x16x128_f8f6f4 %0, %1, %2, %0, %3, %3 op_sel_hi:[0,0,0]" : "+v"(acc[ai][bj][m][n]) : "v"(Bt##8[n]), "v"(At##8[m]), "v"(one8)); } else { \
        _Pragma("unroll") for (int m = 0; m < 4; ++m) _Pragma("unroll") for (int n = 0; n < 2; ++n) _Pragma("unroll") for (int k = 0; k < 2; ++k) \
        acc[ai][bj][m][n] = __builtin_amdgcn_mfma_f32_16x16x32_bf16(Bt[n][k], At[m][k], acc[ai][bj][m][n], 0, 0, 0); } __builtin_amdgcn_s_setprio(0); } while (0)
#define PG8_WAIT_V(n) asm volatile("s_waitcnt vmcnt(" #n ")" ::: "memory")
#define PG8_WAIT_L(n) asm volatile("s_waitcnt lgkmcnt(" #n ")" ::: "memory")
#define PG8_BAR __builtin_amdgcn_s_barrier()
#define PG8_SCHED __builtin_amdgcn_sched_barrier(0)
#define PG8_GLOAD(dst, u) do { if constexpr (GATHER) { const int t2_ = make_tid(wave0); _Pragma("unroll") for (int _i = 0; _i < 2; ++_i) { int R_, C_; stage_rc(t2_ * 16 + _i * 8192, R_, C_); \
        _Pragma("unroll") for (int _h = 0; _h < 2; ++_h) dst[_h][_i] = (unsigned)((u).gidx[_h * HALF + R_] * g.lda + C_) * 2u; } } } while (0)
    Unit cur, nxt; int ui = 0;
    if (!S.next(0, cur)) return;
    f32x4 acc[2][2][4][2];
#pragma unroll
    for (int a = 0; a < 2; ++a)
#pragma unroll
        for (int b = 0; b < 2; ++b)
#pragma unroll
            for (int m = 0; m < 4; ++m)
#pragma unroll
                for (int n = 0; n < 2; ++n) acc[a][b][m][n] = (f32x4){0.f, 0.f, 0.f, 0.f};
    bf16x8 At[4][2], B0[2][2], B1[2][2]; v8i_t At8[4], B08[2], B18[2];
    int one8 = 0x7f7f7f7f; asm volatile("" : "+v"(one8));
    const char* cA = (const char*)g.A + cur.a_off; const char* cB = (const char*)g.Bt + cur.b_off;
    PG8_GLOAD(gvc, cur);
#pragma unroll
    for (int _h = 0; _h < 2; ++_h)
#pragma unroll
        for (int _i = 0; _i < 2; ++_i) gvn[_h][_i] = 0u;
    PG8_STAGE(PG8_SB(0, 0), cB, voffB); PG8_STAGE(PG8_SB(0, 1), cB + hstepB, voffB); PG8_STAGE_A(PG8_SA(0, 0), cA, 0, false); PG8_STAGE_A(PG8_SA(0, 1), cA, 1, false);
    if (wr == 1) PG8_BAR;
    PG8_WAIT_V(2); PG8_BAR;
    PG8_STAGE(PG8_SB(1, 0), cB + kstep, voffB); PG8_STAGE_A(PG8_SA(1, 0), cA + kstep, 0, false); PG8_STAGE(PG8_SB(1, 1), cB + hstepB + kstep, voffB);
    PG8_WAIT_V(6); PG8_BAR;
    for (;;) {
        const bool has_next = S.next(ui + 1, nxt);
        const char* nA = has_next ? (const char*)g.A + nxt.a_off : cA; const char* nB = has_next ? (const char*)g.Bt + nxt.b_off : cB;
        if constexpr (GATHER) { if (has_next) { PG8_GLOAD(gvn, nxt); } else {
#pragma unroll
            for (int _h = 0; _h < 2; ++_h)
#pragma unroll
                for (int _i = 0; _i < 2; ++_i) gvn[_h][_i] = gvc[_h][_i]; } }
        for (int t = 0; t < nt; t += 2) {
            const bool last = (t == nt - 2);
            const char* a1 = cA + (size_t)(t + 1) * kstep;
            const char* a2 = last ? nA : cA + (size_t)(t + 2) * kstep; const char* b2 = last ? nB : cB + (size_t)(t + 2) * kstep;
            const char* a3 = a2 + kstep; const char* b3 = b2 + kstep;
            if constexpr (Epi::MID) { if (t == Epi::MID_T0 || t == Epi::MID_T1) {
                if (wr == 0) PG8_BAR;
#define PG8_MIDROW(ai, m) do { f32x4 v_[2][2] = {{acc[ai][0][m][0], acc[ai][0][m][1]}, {acc[ai][1][m][0], acc[ai][1][m][1]}}; \
                int r_ = cur.pm * BM + (ai) * HALF + wr * 64 + (m) * 16 + fr; asm volatile("" : "+v"(r_)); E.mid_row(cur, r_, t, wc, fq, v_); \
                acc[ai][0][m][0] = v_[0][0]; acc[ai][0][m][1] = v_[0][1]; acc[ai][1][m][0] = v_[1][0]; acc[ai][1][m][1] = v_[1][1]; asm volatile("" ::: "memory"); } while (0)
                PG8_MIDROW(0, 0); PG8_MIDROW(0, 1); PG8_MIDROW(0, 2); PG8_MIDROW(0, 3); PG8_MIDROW(1, 0); PG8_MIDROW(1, 1); PG8_MIDROW(1, 2); PG8_MIDROW(1, 3);
#undef PG8_MIDROW
                if (wr == 1) PG8_BAR;
            } }
            PG8_LDB(B0, 0, 0); PG8_LDB(B1, 0, 1); PG8_SCHED; PG8_LDA(At, 0, 0); PG8_STAGE_A(PG8_SA(1, 1), a1, 1, false);
            PG8_WAIT_V(8); PG8_WAIT_L(0); PG8_BAR; PG8_MMA(0, 0, At, B0); PG8_MMA(0, 1, At, B1); PG8_BAR; PG8_SCHED;
            PG8_LDA(At, 0, 1); PG8_STAGE(PG8_SB(0, 0), b2, voffB); PG8_STAGE(PG8_SB(0, 1), b2 + hstepB, voffB); PG8_STAGE_A(PG8_SA(0, 0), a2, 0, last);
            PG8_WAIT_V(8); PG8_WAIT_L(0); PG8_BAR; PG8_MMA(1, 0, At, B0); PG8_MMA(1, 1, At, B1); PG8_BAR; PG8_SCHED;
            PG8_LDB(B0, 1, 0); PG8_LDB(B1, 1, 1); PG8_SCHED; PG8_LDA(At, 1, 0); PG8_STAGE_A(PG8_SA(0, 1), a2, 1, last);
            PG8_WAIT_V(8); PG8_WAIT_L(0); PG8_BAR; PG8_MMA(0, 0, At, B0); PG8_MMA(0, 1, At, B1); PG8_BAR; PG8_SCHED;
            PG8_LDA(At, 1, 1); PG8_STAGE(PG8_SB(1, 0), b3, voffB); PG8_STAGE(PG8_SB(1, 1), b3 + hstepB, voffB); PG8_STAGE_A(PG8_SA(1, 0), a3, 0, last);
            PG8_WAIT_V(8); PG8_WAIT_L(0); PG8_BAR; PG8_MMA(1, 0, At, B0); PG8_MMA(1, 1, At, B1); PG8_BAR; PG8_SCHED;
        }
        if constexpr (FP8) asm volatile("s_nop 15\n\ts_nop 15" ::: "memory");
        if (wr == 0) PG8_BAR;
        {
#define PG8_ROW(ai, m) do { const f32x4 v_[2][2] = {{acc[ai][0][m][0], acc[ai][0][m][1]}, {acc[ai][1][m][0], acc[ai][1][m][1]}}; \
            int r_ = cur.pm * BM + (ai) * HALF + wr * 64 + (m) * 16 + fr; asm volatile("" : "+v"(r_)); E.row(cur, r_, (ai) * 4 + (m), wc, fq, v_); asm volatile("" ::: "memory"); } while (0)
            PG8_ROW(0, 0); PG8_ROW(0, 1); PG8_ROW(0, 2); PG8_ROW(0, 3); PG8_ROW(1, 0); PG8_ROW(1, 1); PG8_ROW(1, 2); PG8_ROW(1, 3);
#undef PG8_ROW
        }
        if (!has_next) break;
#pragma unroll
        for (int a = 0; a < 2; ++a)
#pragma unroll
            for (int b = 0; b < 2; ++b)
#pragma unroll
                for (int m = 0; m < 4; ++m)
#pragma unroll
                    for (int n = 0; n < 2; ++n) acc[a][b][m][n] = (f32x4){0.f, 0.f, 0.f, 0.f};
        cur = nxt; cA = nA; cB = nB; ++ui;
        if constexpr (GATHER) {
#pragma unroll
            for (int _h = 0; _h < 2; ++_h)
#pragma unroll
                for (int _i = 0; _i < 2; ++_i) gvc[_h][_i] = gvn[_h][_i]; }
        if (wr == 1) PG8_BAR;
    }
    PG8_WAIT_V(0);
    PG8_BAR;
#undef PG8_SA
#undef PG8_SB
#undef PG8_STAGE
#undef PG8_STAGE_A
#undef PG8_LDA
#undef PG8_LD8
#undef PG8_LDB
#undef PG8_MMA
#undef PG8_WAIT_V
#undef PG8_WAIT_L
#undef PG8_BAR
#undef PG8_SCHED
#undef PG8_GLOAD
}

template <bool PERM>
__device__ __forceinline__ void small_tile(PG8_LAS unsigned char* lds, const bf16_t* A16, int lda, const bf16_t* Bt, int ldb, int K, int pn, int wc, f32x4 (&v)[2][2], int wave0) {
    const int tid = make_tid(wave0), wid = __builtin_amdgcn_readfirstlane(tid >> 6), lane = tid & 63, fr = lane & 15, fq = lane >> 4;
    const int kper = K >> 3, k0 = wid * kper;
    f32x4 acc[2][2];
#pragma unroll
    for (int bj = 0; bj < 2; ++bj)
#pragma unroll
        for (int n = 0; n < 2; ++n) acc[bj][n] = (f32x4){0.f, 0.f, 0.f, 0.f};
    const bf16_t* ap = A16 + (size_t)fr * lda + k0 + 8 * fq;
    const bf16_t* bp[2][2];
#pragma unroll
    for (int bj = 0; bj < 2; ++bj)
#pragma unroll
        for (int n = 0; n < 2; ++n) { const int rr = PERM ? perm32(16 * n + fr) : 16 * n + fr; bp[bj][n] = Bt + (size_t)(pn * 256 + bj * 128 + wc * 32 + rr) * ldb + k0 + 8 * fq; }
    for (int k = 0; k < kper; k += 32) {
        const bf16x8 a = *(const bf16x8*)(ap + k);
#pragma unroll
        for (int bj = 0; bj < 2; ++bj)
#pragma unroll
            for (int n = 0; n < 2; ++n) { const bf16x8 b = *(const bf16x8*)(bp[bj][n] + k); acc[bj][n] = __builtin_amdgcn_mfma_f32_16x16x32_bf16(b, a, acc[bj][n], 0, 0, 0); }
    }
    PG8_LAS f32x4* red = (PG8_LAS f32x4*)lds;
#pragma unroll
    for (int bj = 0; bj < 2; ++bj)
#pragma unroll
        for (int n = 0; n < 2; ++n) red[(wid * 4 + bj * 2 + n) * 64 + lane] = acc[bj][n];
    __syncthreads();
    if (wid == 0) {
#pragma unroll
        for (int bj = 0; bj < 2; ++bj)
#pragma unroll
            for (int n = 0; n < 2; ++n) { f32x4 s = red[(bj * 2 + n) * 64 + lane];
#pragma unroll
                for (int w = 1; w < 8; ++w) s += red[(w * 4 + bj * 2 + n) * 64 + lane];
                v[bj][n] = s; }
    }
    __syncthreads();
}
}
namespace attn_body {
using bf16=__hip_bfloat16;
using bf16x8=__attribute__((ext_vector_type(8)))short;
using s16x4=__attribute__((ext_vector_type(4)))short;
using f32x16=__attribute__((ext_vector_type(16)))float;
using u32x4=__attribute__((ext_vector_type(4)))unsigned;
constexpr int BATCH=4,SEQ=4352,D=64,QKP=1024,VP=512,OP=1024;
constexpr int NW=8,QBLK=32,QB=QBLK*NW,KVBLK=64,NQB=SEQ/QB;
constexpr int ATTN_UNIT_ROWS=QB;
__device__ __forceinline__ int crow(int r,int hi){return (r&3)+8*(r>>2)+4*hi;}
#define SBAR() __builtin_amdgcn_sched_barrier(0)
__device__ __forceinline__ void cmask(f32x16&p0,f32x16&p1,int jb,int qrel,int hi){
  const float NEG=-INFINITY; int kb=64*jb+4*hi;
  #pragma unroll
  for(int r=0;r<16;++r){int kv=kb+(r&3)+8*(r>>2); if(kv>qrel)p0[r]=NEG; if(kv+32>qrel)p1[r]=NEG;}
}

__device__ __forceinline__ void biasmask(f32x16&p0,f32x16&p1,int jb,int qrel,int hi,const __attribute__((address_space(3))) float*tab){
  const float NEG=-INFINITY; const int kb=64*jb+4*hi;
  #pragma unroll
  for(int r=0;r<16;++r){const int n0=qrel-(kb+(r&3)+8*(r>>2)),n1=n0-32;
    const float b0=tab[n0<0?0:(n0>127?127:n0)],b1=tab[n1<0?0:(n1>127?127:n1)];
    p0[r]=n0<0?NEG:p0[r]+b0; p1[r]=n1<0?NEG:p1[r]+b1;}
}
constexpr int NSLOT=3, SLOTB=8192;
constexpr int VSLOTB=2*SLOTB;
constexpr int LDS_K=0, LDS_V=NSLOT*SLOTB, LDS_WS=LDS_V+NSLOT*VSLOTB, LDS_TAB=LDS_WS+NW*64*4, LDS_OST=0  , LDS_BYTES=LDS_TAB+2048;
constexpr float C2=0.125f*1.4426950408889634f;
__device__ __forceinline__ void glds16(const void*gsrc,unsigned lds_dst){unsigned keep;
  asm volatile("s_mov_b32 %0, m0\n\ts_mov_b32 m0, %2\n\ts_nop 0\n\tglobal_load_lds_dwordx4 %1, off\n\ts_mov_b32 m0, %0":"=&s"(keep):"v"(gsrc),"s"(lds_dst):"memory");}
__device__ __forceinline__ float max3f(float a,float b,float c){float r;asm("v_max3_f32 %0, %1, %2, %3":"=v"(r):"v"(a),"v"(b),"v"(c));return r;}
__device__ __forceinline__ float max2f(float a,float b){float r;asm("v_max_f32_e32 %0, %1, %2":"=v"(r):"v"(a),"v"(b));return r;}
__device__ __forceinline__ float fadd_s(float a,float b){float r;asm("v_add_f32_e32 %0, %1, %2":"=v"(r):"v"(a),"v"(b));return r;}
__device__ __forceinline__ float fsub_s(float a,float b){float r;asm("v_sub_f32_e32 %0, %1, %2":"=v"(r):"v"(a),"v"(b));return r;}
typedef float f32x2_t __attribute__((ext_vector_type(2))); typedef __bf16 bf16x2_t __attribute__((ext_vector_type(2)));
__device__ __forceinline__ unsigned cvtpk_s(float lo,float hi){f32x2_t v={lo,hi};bf16x2_t b=__builtin_convertvector(v,bf16x2_t);return __builtin_bit_cast(unsigned,b);}
#define WAIT_BAR(N) asm volatile("s_waitcnt vmcnt(" #N ") lgkmcnt(0)\n\ts_barrier":::"memory")

__device__ __forceinline__ void qkt(f32x16&p0,f32x16&p1,const char*Kslot,const bf16x8*qr,const f32x16&negm,int r32,int hi){
  const char*kb=Kslot+hi*1024+r32*16;
  #pragma unroll
  for(int d0=0;d0<4;++d0){
    const bf16x8 b0=*reinterpret_cast<const bf16x8*>(kb+d0*2048);
    const bf16x8 b1=*reinterpret_cast<const bf16x8*>(kb+d0*2048+512);
    if(d0==0){p0=__builtin_amdgcn_mfma_f32_32x32x16_bf16(b0,qr[0],negm,0,0,0);p1=__builtin_amdgcn_mfma_f32_32x32x16_bf16(b1,qr[0],negm,0,0,0);}
    else{p0=__builtin_amdgcn_mfma_f32_32x32x16_bf16(b0,qr[d0],p0,0,0,0);p1=__builtin_amdgcn_mfma_f32_32x32x16_bf16(b1,qr[d0],p1,0,0,0);}}
}
typedef __attribute__((address_space(3))) const char* lds_cptr;
typedef short v4i16_t __attribute__((ext_vector_type(4)));
__device__ __forceinline__ void kload8(bf16x8*kf,lds_cptr kp){
  kf[0]=*(const __attribute__((address_space(3))) bf16x8*)(kp);      kf[1]=*(const __attribute__((address_space(3))) bf16x8*)(kp+512);
  kf[2]=*(const __attribute__((address_space(3))) bf16x8*)(kp+2048); kf[3]=*(const __attribute__((address_space(3))) bf16x8*)(kp+2560);
  kf[4]=*(const __attribute__((address_space(3))) bf16x8*)(kp+4096); kf[5]=*(const __attribute__((address_space(3))) bf16x8*)(kp+4608);
  kf[6]=*(const __attribute__((address_space(3))) bf16x8*)(kp+6144); kf[7]=*(const __attribute__((address_space(3))) bf16x8*)(kp+6656);
}
__device__ __forceinline__ void kload2(bf16x8*kf,lds_cptr kp,int j){ kf[2*j]=*(const __attribute__((address_space(3))) bf16x8*)(kp+j*2048); kf[2*j+1]=*(const __attribute__((address_space(3))) bf16x8*)(kp+j*2048+512); }
__device__ __forceinline__ s16x4 vtr(lds_cptr p){ return __builtin_bit_cast(s16x4,__builtin_amdgcn_ds_read_tr16_b64_v4i16((__attribute__((address_space(3))) v4i16_t*)p)); }
__device__ __forceinline__ float rowmax(const f32x16&p0,const f32x16&p1){
  float a=max3f(p0[0],p0[1],p1[0]),b=max3f(p0[2],p0[3],p1[1]);a=max3f(a,p1[2],p1[3]);
  #pragma unroll
  for(int r=4;r<16;r+=4){a=max3f(a,p0[r],p0[r+1]);b=max3f(b,p0[r+2],p0[r+3]);a=max3f(a,p1[r],p1[r+1]);b=max3f(b,p1[r+2],p1[r+3]);}
  const float m=max2f(a,b);
  auto rr=__builtin_amdgcn_permlane32_swap(__float_as_uint(m),__float_as_uint(m),false,false);
  return max2f(__uint_as_float(rr[0]),__uint_as_float(rr[1]));
}
__device__ __forceinline__ void pv(f32x16*o,int vb,bf16x8 pa0,bf16x8 pa1,bf16x8 pa2,bf16x8 pa3){
  #pragma unroll
  for(int d0=0;d0<4;++d0){s16x4 lo[4],hi[4];
    #pragma unroll
    for(int ks=0;ks<4;++ks){
      asm volatile("ds_read_b64_tr_b16 %0,%1 offset:%c2":"=&v"(lo[ks]):"v"(vb),"i"(d0*4096+ks*1024):"memory");
      asm volatile("ds_read_b64_tr_b16 %0,%1 offset:%c2":"=&v"(hi[ks]):"v"(vb),"i"(d0*4096+ks*1024+512):"memory");}
    asm volatile("s_waitcnt lgkmcnt(0)":::"memory");SBAR();
    #define PK(k) (bf16x8){lo[k][0],lo[k][1],lo[k][2],lo[k][3],hi[k][0],hi[k][1],hi[k][2],hi[k][3]}
    o[d0]=__builtin_amdgcn_mfma_f32_32x32x16_bf16(pa0,PK(0),o[d0],0,0,0);
    o[d0]=__builtin_amdgcn_mfma_f32_32x32x16_bf16(pa1,PK(1),o[d0],0,0,0);
    o[d0]=__builtin_amdgcn_mfma_f32_32x32x16_bf16(pa2,PK(2),o[d0],0,0,0);
    o[d0]=__builtin_amdgcn_mfma_f32_32x32x16_bf16(pa3,PK(3),o[d0],0,0,0);
    #undef PK
  }
}

#ifndef ATTN_STORE16
#define ATTN_STORE16(p,v) (*(u32x4*)(p)=(v))
#endif
template<int THRL> __device__ __forceinline__ void attn_unit(int b,int vh,int qb,const bf16*__restrict__ QK,const bf16*__restrict__ V,bf16*O,char*shm,int wave0){
  const int mp=vh>>2,hh=vh&3; const int qcol=(mp*4+hh)*64,kcol=512+(mp*4+hh)*64,vcol=hh*128,ocol=mp*512+hh*128;
  const int tid=pg8::make_tid(wave0),lane=tid&63,r32=lane&31,hi=lane>>5; const int wid=__builtin_amdgcn_readfirstlane(tid>>6);
  const long rowbase=(long)b*SEQ; const int q0=qb*QB;
  const bf16*Qw=QK+(rowbase+q0+wid*QBLK)*QKP+qcol;
  const bf16*Kh=QK+rowbase*QKP+kcol,*Vh=V+rowbase*VP+vcol;
  const __attribute__((address_space(3))) float*tab=(const __attribute__((address_space(3))) float*)((__attribute__((address_space(3))) char*)shm+LDS_TAB)+hh*128;
  const unsigned lds0=(unsigned)(uintptr_t)shm;
  float*wsf=(float*)(shm+LDS_WS)+wid*64;
  const bf16*ksrc=Kh+(long)lane*QKP+wid*8;
  const bf16*vsrc=Vh+(long)(16*(wid&3)+(lane>>2))*VP+(wid>>2)*32+(lane&3)*8;
  const unsigned kdst=lds0+LDS_K+wid*1024, vdst=lds0+LDS_V+wid*1024;
  #define DMA_K(t,slot) glds16(ksrc+(long)(t)*KVBLK*QKP,(unsigned)__builtin_amdgcn_readfirstlane(kdst+(slot)))
  #define DMA_V(t,slot) do{ glds16(vsrc+(long)(t)*KVBLK*VP,(unsigned)__builtin_amdgcn_readfirstlane(vdst+2*(slot))); glds16(vsrc+64+(long)(t)*KVBLK*VP,(unsigned)__builtin_amdgcn_readfirstlane(vdst+2*(slot)+8192)); }while(0)
  const int vb0=(int)(lds0+LDS_V)+((lane>>4)&1)*32+(lane&3)*8+(4*hi+((lane&15)>>2))*64;
  const char*Kbase=shm+LDS_K; bf16x8 kf[8];
  const lds_cptr shm3=(lds_cptr)shm; const lds_cptr kp0=shm3+LDS_K+hi*1024+r32*16; const lds_cptr vp0=shm3+LDS_V+((lane>>4)&1)*32+(lane&3)*8+(4*hi+((lane&15)>>2))*64;
  const int NT=(q0+QB)/KVBLK;
  DMA_K(0,0);DMA_V(0,0);DMA_K(1,SLOTB);
  bf16x8 qr[4];
  #pragma unroll
  for(int d0=0;d0<4;++d0)qr[d0]=*reinterpret_cast<const bf16x8*>(&Qw[(long)r32*QKP+d0*16+hi*8]);
  float mhat=0.f,l_reg=0.f;f32x16 o[4];o[0]=f32x16{};o[1]=f32x16{};o[2]=f32x16{};o[3]=f32x16{};f32x16 negm=f32x16{};asm volatile("":"+v"(negm));
  const int qrel=wid*QBLK+r32;
  #define CMASK(P0,P1,t) do{int jb_=(t)-(NT-4); if(jb_>=-2)biasmask(P0,P1,jb_,qrel,hi,tab);}while(0)
  bool resc=false;
  #define START(P0,P1) do{ const float rm=rowmax(P0,P1); resc=false; \
    { const float dl=rm; mhat=fadd_s(mhat,dl); \
      _Pragma("unroll") for(int r=0;r<16;++r){P0[r]=fsub_s(P0[r],dl);P1[r]=fsub_s(P1[r],dl);} \
      _Pragma("unroll") for(int r=0;r<16;++r)negm[r]=-mhat; asm volatile("":"+v"(negm)); } \
    _Pragma("unroll") for(int r=0;r<16;++r)P0[r]=__builtin_amdgcn_exp2f(P0[r]); }while(0)
  #define RESC() do{ if(resc){ asm volatile("s_waitcnt lgkmcnt(0)":::"memory"); \
      _Pragma("unroll") for(int d_=0;d_<4;++d_) _Pragma("unroll") for(int r=0;r<16;++r)o[d_][r]*=wsf[crow(r,hi)]; } }while(0)
  f32x16 pA0,pA1,pB0,pB1;
  int sl_prev=0,sl_cur=0,sl_next=SLOTB;
  #define ROT() do{sl_prev=sl_cur;sl_cur=sl_next;sl_next=(sl_next==(NSLOT-1)*SLOTB)?0:sl_next+SLOTB;}while(0)
  DMA_K(2,2*SLOTB);
  WAIT_BAR(4);
  qkt(pA0,pA1,Kbase,qr,negm,r32,hi);asm volatile("s_nop 15\n\ts_nop 7":"+v"(pA0),"+v"(pA1));CMASK(pA0,pA1,0);
  START(pA0,pA1);
  _Pragma("unroll") for(int r=0;r<16;++r)pA1[r]=__builtin_amdgcn_exp2f(pA1[r]);
  WAIT_BAR(0);
  DMA_K(3,0);DMA_V(1,SLOTB);
  ROT();
  kload8(kf,kp0+sl_cur);
  WAIT_BAR(3);
  s16x4 vlo[4],vhi[4]; u32x4 pw0,pw1,pw2,pw3;
  #define PKW(P,B) cvtpk_s(P[B],P[B+1])
  #define PAF(k) __builtin_bit_cast(bf16x8,pw##k)
  #define VFR(i) (bf16x8){vlo[i][0],vlo[i][1],vlo[i][2],vlo[i][3],vhi[i][0],vhi[i][1],vhi[i][2],vhi[i][3]}
  #define PIN(x) asm volatile("":"+v"(x))
  #define MX3(a,b,c) __builtin_fmaxf(__builtin_fmaxf((a),(b)),(c))
  #define GAPA(MF,A0,A1,A2,A3,W0,W1,PW) do{ MF; sacc+=A0; sacc+=A1; sacc+=A2; sacc+=A3; PIN(sacc); W0; W1; PIN(PW); SBAR(); }while(0)
  #define EX(v) __builtin_amdgcn_exp2f(v)
  #define GAPB(MF,VR,X,B) do{ MF; VR; X[B]=EX(X[B]); X[B+1]=EX(X[B+1]); PIN(X); SBAR(); }while(0)
  #define VRJ(kg,d0) do{ vlo[d0]=vtr(vp_+((d0)*4096+(kg)*1024)); vhi[d0]=vtr(vp_+((d0)*4096+(kg)*1024+512)); }while(0)
  #define KRD(G,j) do{ if(G){ kload2(kf,kp0+sl_next,j); SBAR(); } }while(0)
  #define STEP(C0,C1,P0,P1,t,GK,GV,GL) do{ SBAR(); \
    const lds_cptr vp_=vp0+2*sl_prev; \
    float sacc=(P0[0]+P0[1]); \
    GAPA(C0=__builtin_amdgcn_mfma_f32_32x32x16_bf16(kf[0],qr[0],negm,0,0,0), P0[2],P0[3],P0[4],P0[5],     pw0[0]=PKW(P0,0), pw0[1]=PKW(P0,2), pw0); \
    GAPA(C1=__builtin_amdgcn_mfma_f32_32x32x16_bf16(kf[1],qr[0],negm,0,0,0), P0[6],P0[7],P0[8],P0[9],     pw0[2]=PKW(P0,4), pw0[3]=PKW(P0,6), pw0); \
    GAPA(C0=__builtin_amdgcn_mfma_f32_32x32x16_bf16(kf[2],qr[1],C0,0,0,0),   P0[10],P0[11],P0[12],P0[13], pw1[0]=PKW(P0,8), pw1[1]=PKW(P0,10), pw1); \
    GAPA(C1=__builtin_amdgcn_mfma_f32_32x32x16_bf16(kf[3],qr[1],C1,0,0,0),   P0[14],P0[15],P1[0],P1[1],   pw1[2]=PKW(P0,12),pw1[3]=PKW(P0,14), pw1); \
    GAPA(C0=__builtin_amdgcn_mfma_f32_32x32x16_bf16(kf[4],qr[2],C0,0,0,0),   P1[2],P1[3],P1[4],P1[5],     pw2[0]=PKW(P1,0), pw2[1]=PKW(P1,2), pw2); \
    GAPA(C1=__builtin_amdgcn_mfma_f32_32x32x16_bf16(kf[5],qr[2],C1,0,0,0),   P1[6],P1[7],P1[8],P1[9],     pw2[2]=PKW(P1,4), pw2[3]=PKW(P1,6), pw2); \
    GAPA(C0=__builtin_amdgcn_mfma_f32_32x32x16_bf16(kf[6],qr[3],C0,0,0,0),   P1[10],P1[11],P1[12],P1[13], pw3[0]=PKW(P1,8), pw3[1]=PKW(P1,10), pw3); \
    GAPA(C1=__builtin_amdgcn_mfma_f32_32x32x16_bf16(kf[7],qr[3],C1,0,0,0),   P1[14],P1[15],0.f,0.f,       pw3[2]=PKW(P1,12),pw3[3]=PKW(P1,14), pw3); \
    l_reg+=sacc; \
    if(GK){DMA_K((t)+3,sl_cur);} if(GV){DMA_V((t)+1,sl_next);} \
    VRJ(0,0); VRJ(0,1); VRJ(0,2); VRJ(0,3); SBAR(); \
    CMASK(C0,C1,t); \
    { float a=MX3(C0[0],C0[1],C1[0]),b=MX3(C0[2],C0[3],C1[1]); a=MX3(a,C1[2],C1[3]); \
      _Pragma("unroll") for(int r=4;r<16;r+=4){a=MX3(a,C0[r],C0[r+1]);b=MX3(b,C0[r+2],C0[r+3]);a=MX3(a,C1[r],C1[r+1]);b=MX3(b,C1[r+2],C1[r+3]);} \
      float rm=__builtin_fmaxf(a,b); { auto rr=__builtin_amdgcn_permlane32_swap(__float_as_uint(rm),__float_as_uint(rm),false,false); rm=__builtin_fmaxf(__uint_as_float(rr[0]),__uint_as_float(rr[1])); } \
      resc=false; \
      if(__builtin_expect(__any(rm>(float)THRL),0)){ const float dl=__builtin_fmaxf(rm,0.f); mhat+=dl; \
        _Pragma("unroll") for(int r=0;r<16;++r){C0[r]-=dl;C1[r]-=dl;} \
        _Pragma("unroll") for(int r=0;r<16;++r)negm[r]=-mhat; asm volatile("":"+v"(negm)); \
        const float f=__builtin_amdgcn_exp2f(-dl); l_reg*=f; if(hi==0)wsf[r32]=f; resc=true; } } \
    SBAR(); \
    GAPB(o[0]=__builtin_amdgcn_mfma_f32_32x32x16_bf16(PAF(0),VFR(0),o[0],0,0,0), VRJ(1,0), C0,0); \
    GAPB(o[1]=__builtin_amdgcn_mfma_f32_32x32x16_bf16(PAF(0),VFR(1),o[1],0,0,0), VRJ(1,1), C0,2); \
    GAPB(o[2]=__builtin_amdgcn_mfma_f32_32x32x16_bf16(PAF(0),VFR(2),o[2],0,0,0), VRJ(1,2), C0,4); \
    GAPB(o[3]=__builtin_amdgcn_mfma_f32_32x32x16_bf16(PAF(0),VFR(3),o[3],0,0,0), VRJ(1,3), C0,6); \
    GAPB(o[0]=__builtin_amdgcn_mfma_f32_32x32x16_bf16(PAF(1),VFR(0),o[0],0,0,0), VRJ(2,0), C0,8); \
    KRD(GL,0); GAPB(o[1]=__builtin_amdgcn_mfma_f32_32x32x16_bf16(PAF(1),VFR(1),o[1],0,0,0), VRJ(2,1), C0,10); \
    GAPB(o[2]=__builtin_amdgcn_mfma_f32_32x32x16_bf16(PAF(1),VFR(2),o[2],0,0,0), VRJ(2,2), C0,12); \
    KRD(GL,1); GAPB(o[3]=__builtin_amdgcn_mfma_f32_32x32x16_bf16(PAF(1),VFR(3),o[3],0,0,0), VRJ(2,3), C0,14); \
    GAPB(o[0]=__builtin_amdgcn_mfma_f32_32x32x16_bf16(PAF(2),VFR(0),o[0],0,0,0), VRJ(3,0), C1,0); \
    KRD(GL,2); GAPB(o[1]=__builtin_amdgcn_mfma_f32_32x32x16_bf16(PAF(2),VFR(1),o[1],0,0,0), VRJ(3,1), C1,2); \
    GAPB(o[2]=__builtin_amdgcn_mfma_f32_32x32x16_bf16(PAF(2),VFR(2),o[2],0,0,0), VRJ(3,2), C1,4); \
    KRD(GL,3); GAPB(o[3]=__builtin_amdgcn_mfma_f32_32x32x16_bf16(PAF(2),VFR(3),o[3],0,0,0), VRJ(3,3), C1,6); \
    GAPB(o[0]=__builtin_amdgcn_mfma_f32_32x32x16_bf16(PAF(3),VFR(0),o[0],0,0,0), (void)0, C1,8); \
    GAPB(o[1]=__builtin_amdgcn_mfma_f32_32x32x16_bf16(PAF(3),VFR(1),o[1],0,0,0), (void)0, C1,10); \
    GAPB(o[2]=__builtin_amdgcn_mfma_f32_32x32x16_bf16(PAF(3),VFR(2),o[2],0,0,0), (void)0, C1,12); \
    GAPB(o[3]=__builtin_amdgcn_mfma_f32_32x32x16_bf16(PAF(3),VFR(3),o[3],0,0,0), (void)0, C1,14); \
    }while(0)
  int t=1;
  #undef CMASK
  #define CMASK(P0,P1,t) do{}while(0)
  for(;t+7<NT;t+=2){
    STEP(pB0,pB1,pA0,pA1,t,true,true,true);     WAIT_BAR(3); RESC(); ROT();
    STEP(pA0,pA1,pB0,pB1,t+1,true,true,true);   WAIT_BAR(3); RESC(); ROT();
  }
  #undef CMASK
  #define CMASK(P0,P1,t) do{int jb_=(t)-(NT-4); if(jb_>=-2)biasmask(P0,P1,jb_,qrel,hi,tab);}while(0)
  #define ENDW(tt) do{ if((tt)+3<NT){WAIT_BAR(3);} else if((tt)+2<NT){WAIT_BAR(2);} else {WAIT_BAR(0);} }while(0)
  for(;t+1<NT;t+=2){
    STEP(pB0,pB1,pA0,pA1,t,(t+3<NT),(t+1<NT),(t+1<NT));       ENDW(t);   RESC(); ROT();
    STEP(pA0,pA1,pB0,pB1,t+1,(t+4<NT),(t+2<NT),(t+2<NT));     ENDW(t+1); RESC(); ROT();
  }
  STEP(pB0,pB1,pA0,pA1,NT-1,false,false,false); RESC();
  { float sacc=pB0[0]+pB0[1]; _Pragma("unroll") for(int r=2;r<16;++r)sacc+=pB0[r]; _Pragma("unroll") for(int r=0;r<16;++r)sacc+=pB1[r]; l_reg+=sacc;
    pw0=(u32x4){PKW(pB0,0),PKW(pB0,2),PKW(pB0,4),PKW(pB0,6)};pw1=(u32x4){PKW(pB0,8),PKW(pB0,10),PKW(pB0,12),PKW(pB0,14)};pw2=(u32x4){PKW(pB1,0),PKW(pB1,2),PKW(pB1,4),PKW(pB1,6)};pw3=(u32x4){PKW(pB1,8),PKW(pB1,10),PKW(pB1,12),PKW(pB1,14)};
    SBAR(); pv(o,vb0+2*sl_cur,PAF(0),PAF(1),PAF(2),PAF(3)); }
  #undef PKW
  #undef PAF
  #undef VFR
  #undef PIN
  #undef MX3
  #undef GAPA
  #undef GAPB
  #undef EX
  #undef VRJ
  #undef KRD
  #undef STEP
  #undef ENDW
  {auto rr=__builtin_amdgcn_permlane32_swap(__float_as_uint(l_reg),__float_as_uint(l_reg),false,false);l_reg=__uint_as_float(rr[0])+__uint_as_float(rr[1]);}
  if(hi==0)wsf[32+r32]=l_reg;asm volatile("s_waitcnt lgkmcnt(0)":::"memory");
  float rli[16];
  #pragma unroll
  for(int r=0;r<16;++r)rli[r]=__builtin_amdgcn_rcpf(wsf[32+crow(r,hi)]);
  bf16*Ow=O+(rowbase+q0+wid*QBLK)*OP+ocol;
  asm volatile("s_waitcnt lgkmcnt(0)\n\ts_barrier":::"memory");
  { bf16*stg=(bf16*)(shm+LDS_OST)+wid*4096;
    #pragma unroll
    for(int r=0;r<16;++r){const int orow=crow(r,hi);
      #pragma unroll
      for(int d0=0;d0<4;++d0)stg[orow*128+d0*32+r32]=__float2bfloat16(o[d0][r]*rli[r]);}
    asm volatile("s_waitcnt lgkmcnt(0)":::"memory");
    #pragma unroll
    for(int i=0;i<8;++i){const int row=i*4+(lane>>4),ch=lane&15; const u32x4 v=*(const u32x4*)(stg+row*128+ch*8); ATTN_STORE16(Ow+(long)row*OP+ch*8,v);} }
  asm volatile("s_waitcnt lgkmcnt(0)\n\ts_barrier":::"memory");
  #undef DMA_K
  #undef DMA_V
  #undef CMASK
  #undef START
  #undef RESC
  #undef ROT
}
constexpr int ATTN_LDS_BYTES=LDS_BYTES;
__device__ __forceinline__ bool attn_next(int G,int vcu,int i,int&b,int&vh,int&qb){
  if(G==256){ const int g=vcu&7, bv=vcu>>3; int q=-1;
    if(g<7){ q=(i==0)?16-g:(i==1)?1+g:-1; } else { q=(i==0)?9:(i==1)?8:(i==2)?0:-1; }
    if(q<0)return false; b=bv>>3; vh=bv&7; qb=q; return true; }
  const int u=vcu+i*G; if(u>=BATCH*8*17)return false; b=u/(8*17); vh=(u/17)&7; qb=u%17; return true;
}
#undef SBAR
#undef WAIT_BAR
}
namespace mk {
using pg8::bf16_t; using pg8::bf16x8; using pg8::f32x4; using pg8::u32x4; using pg8::u32x2; using pg8::Unit; using pg8::Gemm; using pg8::cvt_pk_bf16;
constexpr int NWAVES = 8;
constexpr int D = 1024, NB = 4, SEQ = 4096, NM = 16, MR = NB * SEQ  , MROWS = MR + NM  , MPAD = 16640;
constexpr int TP = 4352, MATT = NB * TP;
constexpr int INC = 8192, FFD = 2816, FFE = 3584, NE = 8;
constexpr float EPS = 1e-6f, LOG2E = 1.4426950408889634f, C2 = 0.125f * LOG2E;
constexpr size_t MiB = 1u << 20;
constexpr size_t WS_CTL = 0, CTL_ZERO_BYTES = 1 * MiB;
constexpr size_t WS_SMALL = 1 * MiB;
constexpr size_t WS_HN = 3 * MiB;
constexpr size_t WS_WIN = 36 * MiB, WS_WBR = 52 * MiB, WS_WO = 55 * MiB, WS_WGU0 = 57 * MiB, WS_WD0 = 68 * MiB;
constexpr size_t WS_U = 74 * MiB;
constexpr size_t WS_O = 123 * MiB, WS_ST = 157 * MiB, WS_HQ = 190 * MiB, WS_LOGF = 207 * MiB, WS_HG = 240 * MiB;
constexpr size_t WS_QK = 257 * MiB, WS_V = 291 * MiB, WS_CONV = 308 * MiB, WS_HV = 357 * MiB, WS_DS = 374 * MiB;
constexpr size_t WS_GATES = 257 * MiB, WS_MIXED = 355 * MiB, WS_MSCR = 388 * MiB;
constexpr size_t WS_H0 = 123 * MiB;
constexpr size_t WS_DEC = 440 * MiB;
constexpr size_t WS_HQ2 = 441 * MiB, WS_OI = 458 * MiB;
constexpr size_t WS_MGU = 36 * MiB, WS_MD = 148 * MiB, WS_MH = 204 * MiB, WS_MY = 442 * MiB;
constexpr size_t WS_HN8 = 491 * MiB, WS_WIN8 = 508 * MiB;
constexpr size_t WS_SLAB = 36 * MiB;
constexpr int LISTCAP = 16640;
constexpr size_t SMB_LIST = 128 * 1024, SMB_TOK = 704 * 1024;
constexpr int CW_CNT = 8192;
constexpr int SM_SCAL = 0;
constexpr int SM_LOGLB = 64, SM_LOG1M = 64 + 1024;
constexpr int SM_TAB = 64 + 2048;
constexpr int SM_METAHS = 4096;
constexpr int RING_OFF = 0, RING_BYTES = 131072, LDSCTL_OFF = RING_BYTES, MISC_OFF = LDSCTL_OFF + 320, LDS_BYTES = 147456;

#define GAS __attribute__((address_space(1)))
#define LAS __attribute__((address_space(3)))
typedef GAS unsigned gu32;
#define RLX_AGENT __ATOMIC_RELAXED, __HIP_MEMORY_SCOPE_AGENT
#define LDS_WAIT() asm volatile("s_waitcnt lgkmcnt(0)" ::: "memory")
__device__ __forceinline__ unsigned f2bf(float f) { unsigned u = __builtin_bit_cast(unsigned, f); return (u + 0x7fffu + ((u >> 16) & 1u)) >> 16; }
__device__ __forceinline__ unsigned pk2(float lo, float hi) { return cvt_pk_bf16(lo, hi); }
__device__ __forceinline__ unsigned f2bf_hw(float f) { return cvt_pk_bf16(f, 0.f) & 0xffffu; }
__device__ __forceinline__ float bf2f(unsigned short b) { return __builtin_bit_cast(float, (unsigned)b << 16); }
__device__ __forceinline__ float bflo(unsigned w) { return __builtin_bit_cast(float, w << 16); }
__device__ __forceinline__ float bfhi(unsigned w) { return __builtin_bit_cast(float, w & 0xffff0000u); }
#ifdef SLOWMATH
__device__ __forceinline__ float sigm(float x) { return 1.f / (1.f + __expf(-x)); }
__device__ __forceinline__ float silu(float x) { return x / (1.f + __expf(-x)); }
#else
__device__ __forceinline__ float sigm(float x) { return __builtin_amdgcn_rcpf(1.f + __expf(-x)); }
__device__ __forceinline__ float silu(float x) { return x * __builtin_amdgcn_rcpf(1.f + __expf(-x)); }
#endif
#ifdef SLOWMATH
__device__ __forceinline__ float logf_gate(float z, float la, float lm) { const float ls = fminf(z, 0.f) - log1pf(expf(-fabsf(z))), bb = lm + ls; return (la == -INFINITY) ? bb : fmaxf(la, bb) + log1pf(expf(-fabsf(la - bb))); }
#else
__device__ __forceinline__ float logf_gate(float z, float la, float lm) { const float ls = fminf(z, 0.f) - __logf(1.f + __expf(-fabsf(z))), bb = lm + ls; return (la == -INFINITY) ? bb : fmaxf(la, bb) + __logf(1.f + __expf(-fabsf(la - bb))); }
#endif
template <int O> __device__ __forceinline__ float xadd(float v) {
    if constexpr (O < 32) return v + __builtin_bit_cast(float, __builtin_amdgcn_ds_swizzle(__builtin_bit_cast(int, v), (O << 10) | 0x1f));
    else { const int l = pg8::lane_id(); return v + __builtin_bit_cast(float, __builtin_amdgcn_ds_bpermute((l ^ 32) << 2, __builtin_bit_cast(int, v))); }
}
__device__ __forceinline__ float wave_sum(float v) { v = xadd<1>(v); v = xadd<2>(v); v = xadd<4>(v); v = xadd<8>(v); v = xadd<16>(v); return xadd<32>(v); }

#define XB_TMO      128
#define XB_XCNT(j)  (256  + 64 * (j))
#define XB_XSUB(j)  (1280 + 64 * (j))
#define XB_XGEN(j)  (2304 + 64 * (j))
#define XB_TOP      3328
#define XB_TOPGEN   3392
#define XCD_BAR_WORDS 3456
#define XB_SPIN_CAP (1u << 18)
__device__ __forceinline__ unsigned xb_ld(unsigned* p)              { return __hip_atomic_load(p, __ATOMIC_RELAXED, __HIP_MEMORY_SCOPE_AGENT); }
__device__ __forceinline__ unsigned xb_add(unsigned* p, unsigned v) { return __hip_atomic_fetch_add(p, v, __ATOMIC_RELAXED, __HIP_MEMORY_SCOPE_AGENT); }
__device__ __forceinline__ unsigned xb_xcc_id() { return (unsigned)__builtin_amdgcn_s_getreg((3 << 11) | 20) & 0xFu; }
#define XB_SPIN(cond, bar) do { unsigned _sp = 0; while (cond) { __builtin_amdgcn_s_sleep(1); \
    if ((++_sp & 255u) == 0u) { if (xb_ld(&(bar)[XB_TMO])) break; if (_sp > XB_SPIN_CAP) { atomicAdd(&(bar)[XB_TMO], 1u); break; } } } } while (0)
struct XcdBarrier { unsigned* bar; unsigned x; volatile LAS unsigned* st; };
__device__ __forceinline__ XcdBarrier xcd_barrier_post(unsigned* bar, volatile LAS unsigned* st, int tid) {
    XcdBarrier b; b.bar = bar; b.x = xb_xcc_id(); b.st = st;
    if (tid == 0) (void)xb_add(&bar[XB_XCNT(b.x)], 1u);
    return b;
}
__device__ __forceinline__ void xcd_barrier_complete(unsigned* bar, unsigned x, unsigned& nloc, unsigned& nx) {
    const unsigned G = gridDim.x * gridDim.y * gridDim.z;
    unsigned sum, cnt, mine, sp = 0u;
    for (;;) {
        sum = 0u; cnt = 0u; mine = 0u;
#pragma unroll
        for (unsigned j = 0; j < 16; ++j) { const unsigned c = xb_ld(&bar[XB_XCNT(j)]); sum += c; cnt += (c > 0u) ? 1u : 0u; mine = (j == x) ? c : mine; }
        if (sum == G) break;
        __builtin_amdgcn_s_sleep(1);
        if ((++sp & 255u) == 0u) { if (xb_ld(&bar[XB_TMO])) break; if (sp > XB_SPIN_CAP) { atomicAdd(&bar[XB_TMO], 1u); break; } }
    }
    nloc = mine > 0u ? mine : 1u; nx = cnt > 0u ? cnt : 1u;
}
__device__ __forceinline__ void xcd_barrier(const XcdBarrier& b, int tid) {
    asm volatile("s_waitcnt vmcnt(0)" ::: "memory");
    __syncthreads();
    if (tid == 0) {
        unsigned* bar = b.bar;
        __builtin_amdgcn_s_waitcnt(0);
        unsigned nloc = b.st[0], nx = b.st[1];
        if (nloc == 0u) { xcd_barrier_complete(bar, b.x, nloc, nx); b.st[0] = nloc; b.st[1] = nx; }
        const unsigned old = xb_add(&bar[XB_XSUB(b.x)], 1u);
        const unsigned gen = old / nloc, tgt = (gen + 1u) * nx;
        if (old + 1u == (gen + 1u) * nloc) {
            __builtin_amdgcn_fence(__ATOMIC_RELEASE, "agent");
            asm volatile("s_waitcnt vmcnt(0)" ::: "memory");
            (void)xb_add(&bar[XB_TOP], 1u);
        }
        XB_SPIN(xb_ld(&bar[XB_TOP]) < tgt, bar);
        __builtin_amdgcn_fence(__ATOMIC_ACQUIRE, "agent");
        asm volatile("s_waitcnt vmcnt(0)" ::: "memory");
    }
    __syncthreads();
}

struct Frame {
    LAS unsigned char* lds; unsigned char* lds_gen;
    int tid, lane, wave, vcu, G;
    const float* const* in; float* out; unsigned char* ws;
};
#define WSP(T, off) ((T*)(F.ws + (off)))
#define SMALLF (WSP(float, WS_SMALL))

__device__ __forceinline__ void cvt_block(const float* W, int ldw, int k0, int c0, bf16_t* WT, int ldt, int r0, LAS float* scr, int lane) {
    float wv[32];
    const float* wp = W + (size_t)(k0 + (lane >> 5)) * ldw + c0 + (lane & 31);
#pragma unroll
    for (int i = 0; i < 32; ++i) wv[i] = __builtin_nontemporal_load(wp + (size_t)(2 * i) * ldw);
#pragma unroll
    for (int i = 0; i < 32; ++i) scr[(2 * i + (lane >> 5)) * 33 + (lane & 31)] = wv[i];
    LDS_WAIT(); asm volatile("" ::: "memory");
    const int c = lane & 7;
#pragma unroll
    for (int j = 0; j < 4; ++j) { const int n = (lane >> 3) + 8 * j; const LAS float* s = scr + (8 * c) * 33 + n;
        u32x4 o; o.x = pk2(s[0 * 33], s[1 * 33]); o.y = pk2(s[2 * 33], s[3 * 33]); o.z = pk2(s[4 * 33], s[5 * 33]); o.w = pk2(s[6 * 33], s[7 * 33]);
        *(GAS u32x4*)(WT + (size_t)(r0 + n) * ldt + k0 + 8 * c) = o; }
    LDS_WAIT(); asm volatile("" ::: "memory");
}
constexpr float W8_SCALE = 32.f, H8_SCALE = 4.f, WD8_SCALE = 64.f;
__device__ __forceinline__ unsigned pk4_fp8(float a, float b, float c, float d) { int r = __builtin_amdgcn_cvt_pk_fp8_f32(a, b, 0, false); r = __builtin_amdgcn_cvt_pk_fp8_f32(c, d, r, true); return (unsigned)r; }
__device__ __forceinline__ void cvt_block_fp8(const float* W, int ldw, int k0, int c0, unsigned char* WT, int ldt, int r0, LAS float* scr, int lane, float wscale) {
    float wv[32];
    const float* wp = W + (size_t)(k0 + (lane >> 5)) * ldw + c0 + (lane & 31);
#pragma unroll
    for (int i = 0; i < 32; ++i) wv[i] = __builtin_nontemporal_load(wp + (size_t)(2 * i) * ldw);
#pragma unroll
    for (int i = 0; i < 32; ++i) scr[(2 * i + (lane >> 5)) * 33 + (lane & 31)] = wv[i] * wscale;
    LDS_WAIT(); asm volatile("" ::: "memory");
    const int c = lane & 7;
#pragma unroll
    for (int j = 0; j < 4; ++j) { const int n = (lane >> 3) + 8 * j; const LAS float* s = scr + (8 * c) * 33 + n;
        u32x2 o; o.x = pk4_fp8(s[0 * 33], s[1 * 33], s[2 * 33], s[3 * 33]); o.y = pk4_fp8(s[4 * 33], s[5 * 33], s[6 * 33], s[7 * 33]);
        *(GAS u32x2*)(WT + (size_t)(r0 + n) * ldt + k0 + 8 * c) = o; }
    LDS_WAIT(); asm volatile("" ::: "memory");
}
struct CvtItem { const float* W; int ldw, k0, c0; void* WT; int ldt, r0; };
__device__ __forceinline__ void cvt_load(float (&wv)[32], const CvtItem& c, int lane) {
    const float* wp = c.W + (size_t)(c.k0 + (lane >> 5)) * c.ldw + c.c0 + (lane & 31);
#pragma unroll
    for (int i = 0; i < 32; ++i) wv[i] = __builtin_nontemporal_load(wp + (size_t)(2 * i) * c.ldw);
}
template <bool FP8> __device__ __forceinline__ void cvt_store(const float (&wv)[32], const CvtItem& c, LAS float* scr, int lane, float wscale) {
#pragma unroll
    for (int i = 0; i < 32; ++i) scr[(2 * i + (lane >> 5)) * 33 + (lane & 31)] = FP8 ? wv[i] * wscale : wv[i];
    LDS_WAIT(); asm volatile("" ::: "memory");
    const int cc = lane & 7;
#pragma unroll
    for (int j = 0; j < 4; ++j) { const int n = (lane >> 3) + 8 * j; const LAS float* q = scr + (8 * cc) * 33 + n;
        if constexpr (FP8) { u32x2 o; o.x = pk4_fp8(q[0 * 33], q[1 * 33], q[2 * 33], q[3 * 33]); o.y = pk4_fp8(q[4 * 33], q[5 * 33], q[6 * 33], q[7 * 33]);
            *(GAS u32x2*)((unsigned char*)c.WT + (size_t)(c.r0 + n) * c.ldt + c.k0 + 8 * cc) = o; }
        else { u32x4 o; o.x = pk2(q[0 * 33], q[1 * 33]); o.y = pk2(q[2 * 33], q[3 * 33]); o.z = pk2(q[4 * 33], q[5 * 33]); o.w = pk2(q[6 * 33], q[7 * 33]);
            *(GAS u32x4*)((bf16_t*)c.WT + (size_t)(c.r0 + n) * c.ldt + c.k0 + 8 * cc) = o; } }
    LDS_WAIT(); asm volatile("" ::: "memory");
}
template <bool FP8, class Dec> __device__ __forceinline__ void cvt_run(int it0, int stride, int n, const Dec& dec, LAS float* scr, int lane, float wscale) {
    for (int it = it0; it < n; it += 2 * stride) {
        float a[32], b[32]; const CvtItem ca = dec(it); cvt_load(a, ca, lane);
        const int it2 = it + stride; const bool hb = it2 < n; CvtItem cb = ca; if (hb) { cb = dec(it2); cvt_load(b, cb, lane); }
        cvt_store<FP8>(a, ca, scr, lane, wscale); if (hb) cvt_store<FP8>(b, cb, scr, lane, wscale);
    }
}
__device__ __forceinline__ int win_src_col(int db) { const int r0 = db * 32, tile = r0 >> 8, loc = r0 & 255; if (tile >= 4) return r0; const int bj = loc >> 7, wc = (loc & 127) >> 5; return tile * 256 + 64 * wc + 32 * bj; }

__device__ __forceinline__ void convert_layer_weights(Frame& F, int l, int widx = -1, int nw = 0, int part = 0) {
    LAS float* scr = (LAS float*)(F.lds + RING_OFF + F.wave * 16384);
    const int gw = widx >= 0 ? widx : F.vcu * NWAVES + F.wave, NGW = widx >= 0 ? nw : F.G * NWAVES;
    const float* w_in = F.in[4] + (size_t)l * D * INC; const float* w_br = F.in[13] + (size_t)l * 3 * 512 * D; const float* w_o = F.in[14] + (size_t)l * D * D;
    constexpr int I_IN = 16 * 256, I_BR = 3 * 8 * 32, I_O = 16 * 32, I_GU = 16 * 176, I_DN = 44 * 32;
    const int nitems = I_IN + I_BR + I_O + (l == 0 ? I_GU + I_DN : 0);
    const auto dec = [&](int it) -> CvtItem { int r = it;
        if (r < I_IN) { const int kb = r >> 8, db = r & 255; return CvtItem{w_in, INC, kb * 64, win_src_col(db), WSP(bf16_t, WS_WIN), D, db * 32}; } r -= I_IN;
        if (r < I_BR) { const int br = r / 256, q = r % 256, kb = q >> 5, db = q & 31; return CvtItem{w_br + (size_t)br * 512 * D, D, kb * 64, db * 32, WSP(bf16_t, WS_WBR) + 512 * br, 1536, db * 32}; }   r -= I_BR;
        if (r < I_O) { const int kb = r >> 5, db = r & 31; return CvtItem{w_o, D, kb * 64, db * 32, WSP(bf16_t, WS_WO), D, db * 32}; } r -= I_O;
        if (r < I_GU) { const int kb = r / 176, db = r % 176, tile = db >> 3, l32 = db & 7; const float* src = (l32 < 4) ? F.in[15] : F.in[16];
            return CvtItem{src, FFD, kb * 64, tile * 128 + (l32 & 3) * 32, WSP(bf16_t, WS_WGU0), D, db * 32}; } r -= I_GU;
        const int kb = r >> 5, db = r & 31; return CvtItem{F.in[17], D, kb * 64, db * 32, WSP(bf16_t, WS_WD0), FFD, db * 32}; };
    const int it_lo = part == 2 ? I_IN + I_BR + I_O : 0, it_hi = part == 1 ? I_IN + I_BR + I_O : nitems;
    cvt_run<false>(it_lo + gw, NGW, it_hi, dec, scr, F.lane, 1.f);
    if (part == 2) return;
    const auto dec8 = [&](int it) -> CvtItem { const int kb = it / 96, db = it % 96; return CvtItem{w_in, INC, kb * 64, (160 + db) * 32, F.ws + WS_WIN8, D, db * 32}; };
    cvt_run<true>(gw, NGW, 16 * 96, dec8, scr, F.lane, W8_SCALE);
}
__device__ __forceinline__ void setup_small(Frame& F) {
    float* sm = SMALLF;
    if (blockIdx.x == 0) {
        if (F.tid < 2) { const int l = F.tid; const float* lp = F.in[7] + l * 256; float s1 = 0.f, s2 = 0.f;
            for (int i = 0; i < 64; ++i) { s1 += lp[i] * lp[64 + i]; s2 += lp[128 + i] * lp[192 + i]; }
            const float li = 0.8f - 0.6f * expf(-0.3f * (float)l); sm[SM_SCAL + l * 4] = expf(s1) - expf(s2) + li; sm[SM_SCAL + l * 4 + 1] = 1.f - li; }
        { const int c = F.tid; const float a = F.in[11][c], b = F.in[11][512 + c], mx = fmaxf(a, b), e0 = expf(a - mx), e1 = expf(b - mx), lb1 = e1 / (e0 + e1);
            sm[SM_LOGLB + c] = -INFINITY; sm[SM_LOG1M + c] = 0.f; sm[SM_LOGLB + 512 + c] = logf(lb1); sm[SM_LOG1M + 512 + c] = log1pf(-lb1); }
        { const int h = F.tid >> 7, n = F.tid & 127; int bk = n; if (n >= 16) { bk = 16 + (int)(logf((float)n / 16.f) / 2.0794415416798357f * 16.f); bk = bk < 31 ? bk : 31; }
            sm[SM_TAB + h * 128 + n] = (F.in[9][bk * 4 + h] - F.in[9][31 * 4 + h]) * LOG2E; }
    }
    const int gt = F.vcu * 512 + F.tid, NT = F.G * 512;
    for (int i = gt; i < NE * LISTCAP; i += NT) ((int*)(F.ws + WS_SMALL + SMB_LIST))[i] = 0;
    for (int i = gt; i < NB * 240 * (1024 / 8); i += NT) { const int row = i / 128, c = i % 128, b = row / 240, p = 4112 + row % 240; *(GAS u32x4*)(WSP(bf16_t, WS_QK) + ((size_t)(b * TP + p)) * 1024 + c * 8) = (u32x4){0u, 0u, 0u, 0u}; }
    for (int i = gt; i < NB * 240 * (512 / 8); i += NT) { const int row = i / 64, c = i % 64, b = row / 240, p = 4112 + row % 240; *(GAS u32x4*)(WSP(bf16_t, WS_V) + ((size_t)(b * TP + p)) * 512 + c * 8) = (u32x4){0u, 0u, 0u, 0u}; }
}
__device__ __forceinline__ const float* res_row(Frame& F, int r, bool first) {
    if (r < MR) return (first ? F.in[0] : (const float*)F.out) + (size_t)r * D;
    return (first ? F.in[1] : (const float*)(SMALLF + SM_METAHS)) + (size_t)(r - MR) * D;
}
__device__ __forceinline__ float* res_row_w(Frame& F, int r) { return (r < MR) ? F.out + (size_t)r * D : SMALLF + SM_METAHS + (size_t)(r - MR) * D; }
__device__ __forceinline__ void norm_pass(Frame& F, const float* gain, bool first, bool copy8) {
    const int gw = F.vcu * NWAVES + F.wave, NGW = F.G * NWAVES;
    f32x4 gv[4];
#pragma unroll
    for (int j = 0; j < 4; ++j) gv[j] = ((const f32x4*)gain)[F.lane + 64 * j];
    for (int r = gw; r < MROWS; r += NGW) {
        const GAS f32x4* xr = (const GAS f32x4*)res_row(F, r, first) + F.lane;
        f32x4 v[4]; float s = 0.f;
#pragma unroll
        for (int j = 0; j < 4; ++j) { v[j] = xr[64 * j]; s += (v[j].x * v[j].x + v[j].y * v[j].y) + (v[j].z * v[j].z + v[j].w * v[j].w); }
        const float sc = rsqrtf(wave_sum(s) * (1.f / D) + EPS);
        GAS u32x2* o = (GAS u32x2*)(WSP(bf16_t, WS_HN) + (size_t)r * D) + F.lane;
#pragma unroll
        for (int j = 0; j < 4; ++j) { u32x2 w; w.x = pk2(v[j].x * sc * gv[j].x, v[j].y * sc * gv[j].y); w.y = pk2(v[j].z * sc * gv[j].z, v[j].w * sc * gv[j].w); o[64 * j] = w; }
        if (copy8 && r < MR) { GAS unsigned* o8 = (GAS unsigned*)(F.ws + WS_HN8 + (size_t)r * D) + F.lane;
#pragma unroll
            for (int j = 0; j < 4; ++j) o8[64 * j] = pk4_fp8(v[j].x * sc * gv[j].x, v[j].y * sc * gv[j].y, v[j].z * sc * gv[j].z, v[j].w * sc * gv[j].w); }
    }
}

struct TileOrder {
    int nM, nN, nwg, G, c, pn0; long lda2, ldb2;
    __device__ void init(int nM_, int nN_, int pn0_, int G_, int c_, int lda, int ldb) { nM = nM_; nN = nN_; nwg = nM * nN; G = G_; c = c_; pn0 = pn0_; lda2 = 2L * lda; ldb2 = 2L * ldb; }
    __device__ __forceinline__ bool next(int i, Unit& u) const {
        const long L = (long)i * G + c; if (L >= nwg) return false;
        int wgid = (int)L; { const int q = nwg / 8, r = nwg % 8, xcd = wgid % 8, off = wgid / 8; wgid = (xcd < r ? xcd * (q + 1) : r * (q + 1) + (xcd - r) * q) + off; }
        const int nig = 8 * nN, gid = wgid / nig, fm = gid * 8, gsz = (nM - fm) < 8 ? (nM - fm) : 8;
        u.pm = fm + ((wgid % nig) % gsz); u.pn = pn0 + (wgid % nig) / gsz; u.z = 0; u.a_off = (unsigned)((long)u.pm * 256 * lda2); u.b_off = (unsigned)((long)u.pn * 256 * ldb2); u.gidx = nullptr; return true;
    }
};
__device__ __forceinline__ u32x4 pack8(const f32x4 a, const f32x4 b) { u32x4 w; w.x = cvt_pk_bf16(a[0], a[1]); w.y = cvt_pk_bf16(a[2], a[3]); w.z = cvt_pk_bf16(b[0], b[1]); w.w = cvt_pk_bf16(b[2], b[3]); return w; }
__device__ __forceinline__ void store_att(bf16_t* buf, int pitch, int r, int col, u32x4 w) {
    if (r < MR) { const int ar = (r >> 12) * TP + NM + (r & 4095); *(u32x4*)(buf + (size_t)ar * pitch + col) = w; }
    else { const int j = r - MR;
#pragma unroll
        for (int b = 0; b < NB; ++b) *(u32x4*)(buf + (size_t)(b * TP + j) * pitch + col) = w; }
}
struct EpiProj {
    static constexpr bool PERM = true, MID = false;
    unsigned char* ws; const float *qg, *kg; int l; float gsc;
    __device__ __forceinline__ void row(const Unit& u, int r, int slot, int wc, int fq, const f32x4 (&v)[2][2]) const {
        const int pn = u.pn;
        bf16_t* QK = (bf16_t*)(ws + WS_QK); bf16_t* V = (bf16_t*)(ws + WS_V); bf16_t* CONV = (bf16_t*)(ws + WS_CONV); bf16_t* HQ = (bf16_t*)(ws + WS_HQ); bf16_t* HV = (bf16_t*)(ws + WS_HV); bf16_t* HG = (bf16_t*)(ws + WS_HG);
        bf16_t* GATES = (bf16_t*)(ws + WS_GATES); float* LOGF = (float*)(ws + WS_LOGF); const float* loglb = (const float*)(ws + WS_SMALL) + SM_LOGLB + l * 512; const float* log1m = (const float*)(ws + WS_SMALL) + SM_LOG1M + l * 512;
        if (pn < 4) {
            float ss = 0.f;
#pragma unroll
            for (int bj = 0; bj < 2; ++bj)
#pragma unroll
                for (int n = 0; n < 2; ++n) ss += (v[bj][n][0] * v[bj][n][0] + v[bj][n][1] * v[bj][n][1]) + (v[bj][n][2] * v[bj][n][2] + v[bj][n][3] * v[bj][n][3]);
            ss = xadd<16>(ss); ss = xadd<32>(ss);
            const float sc = rsqrtf(ss * (1.f / 64.f) + EPS) * (pn < 2 ? C2 : 1.f); const float* gv = pn < 2 ? qg : kg;
#pragma unroll
            for (int bj = 0; bj < 2; ++bj) { const int d0 = 32 * bj + 8 * fq; const f32x4 g0 = *(const f32x4*)(gv + d0), g1 = *(const f32x4*)(gv + d0 + 4);
                store_att(QK, 1024, r, pn * 256 + 64 * wc + d0, pack8(v[bj][0] * g0 * sc, v[bj][1] * g1 * sc)); }
            return;
        }
#pragma unroll
        for (int bj = 0; bj < 2; ++bj) {
            const int cl = 128 * bj + 32 * wc + 8 * fq; f32x4 a = v[bj][0], b = v[bj][1];
            if (pn < 6) { store_att(V, 512, r, (pn - 4) * 256 + cl, pack8(a, b)); }
            else if (pn < 12) { *(u32x4*)(CONV + (size_t)r * 1536 + (pn - 6) * 256 + cl) = pack8(a, b); }
            else if (pn < 14 || (pn >= 18 && pn < 20)) {
#pragma unroll
                for (int e = 0; e < 4; ++e) { a[e] = silu(a[e]); b[e] = silu(b[e]); }
                bf16_t* dst = (pn < 14) ? HQ + (size_t)r * 512 + (pn - 12) * 256 + cl : HG + (size_t)r * 512 + (pn - 18) * 256 + cl; *(u32x4*)dst = pack8(a, b); }
            else if (pn < 16) {
                const int c = (pn - 14) * 256 + cl; const f32x4 la0 = *(const f32x4*)(loglb + c), la1 = *(const f32x4*)(loglb + c + 4), lm0 = *(const f32x4*)(log1m + c), lm1 = *(const f32x4*)(log1m + c + 4);
                f32x4 o0, o1;
#pragma unroll
                for (int e = 0; e < 4; ++e) {
                    o0[e] = logf_gate(a[e], la0[e], lm0[e]); o1[e] = logf_gate(b[e], la1[e], lm1[e]);
                }
                float* dst = LOGF + (size_t)r * 512 + c; *(f32x4*)dst = o0; *(f32x4*)(dst + 4) = o1; }
            else if (pn < 18) { *(u32x4*)(HV + (size_t)r * 512 + (pn - 16) * 256 + cl) = pack8(a, b); }
            else {
#pragma unroll
                for (int e = 0; e < 4; ++e) { a[e] = sigm(a[e] * gsc); b[e] = sigm(b[e] * gsc); }
                *(u32x4*)(GATES + (size_t)r * 3072 + (pn - 20) * 256 + cl) = pack8(a, b); }
        }
    }
};
struct EpiMerge {
    static constexpr bool PERM = true, MID = true; static constexpr int MID_T0 = 8, MID_T1 = 16;
    const bf16_t* GATES; bf16_t* MIXED;
    __device__ __forceinline__ void mid_row(const Unit& u, int r, int t, int wc, int fq, f32x4 (&v)[2][2]) const {
        const int b = (t >> 3) - 1;
#pragma unroll
        for (int bj = 0; bj < 2; ++bj) {
            const bf16_t* gp = GATES + (size_t)r * 3072 + b * 1024 + u.pn * 256 + 128 * bj + 32 * wc + 8 * fq; const u32x4 ga = *(const u32x4*)gp, gb = *(const u32x4*)(gp + 1024);
#define MK_RT(x, y) ((x) * __builtin_amdgcn_rcpf(fmaxf((y), 1e-20f)))
            v[bj][0][0] *= MK_RT(bflo(ga.x), bflo(gb.x)); v[bj][0][1] *= MK_RT(bfhi(ga.x), bfhi(gb.x)); v[bj][0][2] *= MK_RT(bflo(ga.y), bflo(gb.y)); v[bj][0][3] *= MK_RT(bfhi(ga.y), bfhi(gb.y));
            v[bj][1][0] *= MK_RT(bflo(ga.z), bflo(gb.z)); v[bj][1][1] *= MK_RT(bfhi(ga.z), bfhi(gb.z)); v[bj][1][2] *= MK_RT(bflo(ga.w), bflo(gb.w)); v[bj][1][3] *= MK_RT(bfhi(ga.w), bfhi(gb.w));
#undef MK_RT
        }
    }
    __device__ __forceinline__ void row(const Unit& u, int r, int slot, int wc, int fq, const f32x4 (&v)[2][2]) const {
#pragma unroll
        for (int bj = 0; bj < 2; ++bj) {
            const int cl = 128 * bj + 32 * wc + 8 * fq; const u32x4 gw = *(const u32x4*)(GATES + (size_t)r * 3072 + 2048 + u.pn * 256 + cl);
            f32x4 a = v[bj][0], b = v[bj][1];
            a[0] *= bflo(gw.x); a[1] *= bfhi(gw.x); a[2] *= bflo(gw.y); a[3] *= bfhi(gw.y); b[0] *= bflo(gw.z); b[1] *= bfhi(gw.z); b[2] *= bflo(gw.w); b[3] *= bfhi(gw.w);
            *(u32x4*)(MIXED + (size_t)r * D + u.pn * 256 + cl) = pack8(a, b);
        }
    }
};
struct EpiRes {
    static constexpr bool PERM = false, MID = false;
    const float* base; float* out; const float* mbase; float* mout;
    __device__ __forceinline__ void row(const Unit& u, int r, int slot, int wc, int fq, const f32x4 (&v)[2][2]) const {
        const float* bp = (r < MR) ? base + (size_t)r * D : mbase + (size_t)(r - MR) * D; float* op = (r < MR) ? out + (size_t)r * D : mout + (size_t)(r - MR) * D;
#pragma unroll
        for (int bj = 0; bj < 2; ++bj)
#pragma unroll
            for (int n = 0; n < 2; ++n) { const int col = u.pn * 256 + 128 * bj + 32 * wc + 16 * n + 4 * fq; *(f32x4*)(op + col) = *(const f32x4*)(bp + col) + v[bj][n]; }
    }
};
struct EpiGU {
    static constexpr bool PERM = true, MID = false;
    bf16_t* H; int ldh; float sc;
    __device__ __forceinline__ void row(const Unit& u, int r, int slot, int wc, int fq, const f32x4 (&v)[2][2]) const {
        f32x4 a, b;
#pragma unroll
        for (int e = 0; e < 4; ++e) { a[e] = silu(v[0][0][e] * sc) * (v[1][0][e] * sc); b[e] = silu(v[0][1][e] * sc) * (v[1][1][e] * sc); }
        *(u32x4*)(H + (size_t)r * ldh + u.pn * 128 + 32 * wc + 8 * fq) = pack8(a, b);
    }
};

struct EpiGU8 {
    static constexpr bool PERM = true, MID = false;
    unsigned char* H; int ldh; float sc;
    __device__ __forceinline__ void row(const Unit& u, int r, int slot, int wc, int fq, const f32x4 (&v)[2][2]) const {
        f32x4 a, b;
#pragma unroll
        for (int e = 0; e < 4; ++e) { a[e] = silu(v[0][0][e] * sc) * (v[1][0][e] * (sc * H8_SCALE)); b[e] = silu(v[0][1][e] * sc) * (v[1][1][e] * (sc * H8_SCALE)); }
#pragma unroll
        for (int e = 0; e < 4; ++e) { a[e] = __builtin_amdgcn_fmed3f(a[e], -448.f, 448.f); b[e] = __builtin_amdgcn_fmed3f(b[e], -448.f, 448.f); }
        u32x2 o; o.x = pk4_fp8(a[0], a[1], a[2], a[3]); o.y = pk4_fp8(b[0], b[1], b[2], b[3]);
        *(u32x2*)(H + (size_t)r * ldh + u.pn * 128 + 32 * wc + 8 * fq) = o;
    }
};
template <class Epi>
__device__ __forceinline__ void meta_gemm(Frame& F, const bf16_t* A16, int lda, const bf16_t* Bt, int ldb, int K, int pn_lo, int pn_hi, const Epi& E) {
    const int fr = F.lane & 15, fq = F.lane >> 4;
    for (int task = pn_lo * 4 + F.vcu; task < pn_hi * 4; task += F.G) {
        const int pn = task >> 2, wc = task & 3; f32x4 v[2][2];
        pg8::small_tile<Epi::PERM>(F.lds + RING_OFF, A16, lda, Bt, ldb, K, pn, wc, v, F.wave);
        if (F.wave == 0) { Unit u; u.pm = 64; u.pn = pn; u.z = 0; u.a_off = 0; u.b_off = 0; u.gidx = nullptr; E.row(u, MR + fr, 0, wc, fq, v); }
    }
}
__device__ __forceinline__ void meta_merge(Frame& F, const bf16_t* U16, const bf16_t* Wbr, const bf16_t* GATES, bf16_t* MIXED) {
    const int fr = F.lane & 15, fq = F.lane >> 4;
    for (int task = F.vcu; task < 16; task += F.G) {
        const int pn = task >> 2, wc = task & 3; f32x4 tot[2][2];
#pragma unroll
        for (int bj = 0; bj < 2; ++bj)
#pragma unroll
            for (int n = 0; n < 2; ++n) tot[bj][n] = (f32x4){0.f, 0.f, 0.f, 0.f};
        for (int z = 0; z < 3; ++z) {
            f32x4 v[2][2];
            pg8::small_tile<true>(F.lds + RING_OFF, U16 + 512 * z, 1536, Wbr + 512 * z, 1536, 512, pn, wc, v, F.wave);
            if (F.wave == 0) {
#pragma unroll
                for (int bj = 0; bj < 2; ++bj) { const int cl = 128 * bj + 32 * wc + 8 * fq; const u32x4 gw = *(const u32x4*)(GATES + (size_t)(MR + fr) * 3072 + z * 1024 + pn * 256 + cl);
                    f32x4 a = v[bj][0], b = v[bj][1];
                    a[0] *= bflo(gw.x); a[1] *= bfhi(gw.x); a[2] *= bflo(gw.y); a[3] *= bfhi(gw.y); b[0] *= bflo(gw.z); b[1] *= bfhi(gw.z); b[2] *= bflo(gw.w); b[3] *= bfhi(gw.w);
                    tot[bj][0] += a; tot[bj][1] += b; }
            }
        }
        if (F.wave == 0) {
#pragma unroll
            for (int bj = 0; bj < 2; ++bj) { const int cl = 128 * bj + 32 * wc + 8 * fq; *(u32x4*)(MIXED + (size_t)(MR + fr) * D + pn * 256 + cl) = pack8(tot[bj][0], tot[bj][1]); }
        }
    }
}

__device__ __forceinline__ int prev_row(int r, int d) {
    if (r >= MR) { const int j = r - MR - d; return j >= 0 ? MR + j : -1; }
    const int s = r & 4095; if (s >= d) return r - d; return MR + NM + s - d;
}
__device__ __forceinline__ void conv_pass(Frame& F, const float* cw) {
    const bf16_t* CONV = WSP(bf16_t, WS_CONV); bf16_t* U = WSP(bf16_t, WS_U);
    const int gt = F.vcu * 512 + F.tid, NT = F.G * 512;
    for (int i = gt; i < MROWS * 64; i += NT) {
        const int r = i >> 6, c8 = (i & 63) * 8; float y[8];
#pragma unroll
        for (int e = 0; e < 8; ++e) y[e] = 0.f;
#pragma unroll
        for (int k = 0; k < 3; ++k) { const int rr = (k == 2) ? r : prev_row(r, 2 - k); if (rr < 0) continue;
            const u32x4 cv = *(const u32x4*)(CONV + (size_t)rr * 1536 + 512 + c8), hv = *(const u32x4*)(CONV + (size_t)rr * 1536 + 1024 + c8);
            const f32x4 w0 = *(const f32x4*)(cw + k * 512 + c8), w1 = *(const f32x4*)(cw + k * 512 + c8 + 4);
            y[0] += w0[0] * bflo(cv.x) * bflo(hv.x); y[1] += w0[1] * bfhi(cv.x) * bfhi(hv.x); y[2] += w0[2] * bflo(cv.y) * bflo(hv.y); y[3] += w0[3] * bfhi(cv.y) * bfhi(hv.y);
            y[4] += w1[0] * bflo(cv.z) * bflo(hv.z); y[5] += w1[1] * bfhi(cv.z) * bfhi(hv.z); y[6] += w1[2] * bflo(cv.w) * bflo(hv.w); y[7] += w1[3] * bfhi(cv.w) * bfhi(hv.w); }
        const u32x4 bv = *(const u32x4*)(CONV + (size_t)r * 1536 + c8);
        u32x4 o; o.x = pk2(bflo(bv.x) * y[0], bfhi(bv.x) * y[1]); o.y = pk2(bflo(bv.y) * y[2], bfhi(bv.y) * y[3]); o.z = pk2(bflo(bv.z) * y[4], bfhi(bv.z) * y[5]); o.w = pk2(bflo(bv.w) * y[6], bfhi(bv.w) * y[7]);
        *(u32x4*)(U + (size_t)r * 1536 + 512 + c8) = o;
    }
}
__device__ __forceinline__ void attcomb_pass(Frame& F, const float* sg, int l) {
    const bf16_t* O = WSP(bf16_t, WS_O); bf16_t* U = WSP(bf16_t, WS_U);
    const int gw = F.vcu * NWAVES + F.wave, NGW = F.G * NWAVES;
    const float lam = SMALLF[SM_SCAL + l * 4], oml = SMALLF[SM_SCAL + l * 4 + 1];
    const int c8 = F.lane * 8; const f32x4 g0 = *(const f32x4*)(sg + (c8 & 127)), g1 = *(const f32x4*)(sg + (c8 & 127) + 4);
    for (int r = gw; r < MROWS; r += NGW) {
        const int ar = (r < MR) ? (r >> 12) * TP + NM + (r & 4095) : (r - MR);
        const u32x4 a = *(const u32x4*)(O + (size_t)ar * 1024 + c8), b = *(const u32x4*)(O + (size_t)ar * 1024 + 512 + c8);
        float d[8]; d[0] = bflo(a.x) - lam * bflo(b.x); d[1] = bfhi(a.x) - lam * bfhi(b.x); d[2] = bflo(a.y) - lam * bflo(b.y); d[3] = bfhi(a.y) - lam * bfhi(b.y);
        d[4] = bflo(a.z) - lam * bflo(b.z); d[5] = bfhi(a.z) - lam * bfhi(b.z); d[6] = bflo(a.w) - lam * bflo(b.w); d[7] = bfhi(a.w) - lam * bfhi(b.w);
        float ss = 0.f;
#pragma unroll
        for (int e = 0; e < 8; ++e) ss += d[e] * d[e];
        ss = xadd<1>(ss); ss = xadd<2>(ss); ss = xadd<4>(ss); ss = xadd<8>(ss);
        const float sc = rsqrtf(ss * (1.f / 128.f) + EPS) * oml;
        u32x4 o; o.x = pk2(d[0] * sc * g0[0], d[1] * sc * g0[1]); o.y = pk2(d[2] * sc * g0[2], d[3] * sc * g0[3]); o.z = pk2(d[4] * sc * g1[0], d[5] * sc * g1[1]); o.w = pk2(d[6] * sc * g1[2], d[7] * sc * g1[3]);
        *(u32x4*)(U + (size_t)r * 1536 + c8) = o;
    }
}

constexpr int HA_QP = 0, HA_KP = 43520, HA_KT = HA_KP + 17408, HA_VT = HA_KT + 18432, HA_PB = HA_VT + 18432, HA_TOT = HA_PB + 9216;
__device__ __forceinline__ int qp_base(int j) { return j == 0 ? 0 : (j == 1 ? 64 : (j == 2 ? 112 : 144)); }
struct HgIn { float lf[16], qv[16], vv[16]; };
__device__ __forceinline__ void hgrnA_load(Frame& F, int id, HgIn& in) {
    const bool meta = id >= 1024; const int bh = meta ? 0 : id >> 6, c = id & 63, h = meta ? id - 1024 : bh & 3, b = bh >> 2;
    const int row0 = meta ? MR : b * SEQ + c * 64, nvalid = meta ? NM : 64;
    const int d = F.tid & 127, i = F.tid >> 7;
    const bf16_t* HQ = WSP(bf16_t, WS_HQ); const bf16_t* HV = WSP(bf16_t, WS_HV); const float* LOGF = WSP(float, WS_LOGF);
#pragma unroll
    for (int j = 0; j < 16; ++j) { const int t = 16 * i + j; const bool ok = t < nvalid; const size_t off = (size_t)(row0 + (ok ? t : 0)) * 512 + h * 128 + d;
        const float a = LOGF[off]; const unsigned short q = HQ[off], v = HV[off]; in.lf[j] = ok ? a : 0.f; in.qv[j] = ok ? bf2f(q) : 0.f; in.vv[j] = ok ? bf2f(v) : 0.f; }
}
#ifndef HG_NORAW
#define HG_BAR() do { asm volatile("s_waitcnt lgkmcnt(0)" ::: "memory"); __builtin_amdgcn_s_barrier(); asm volatile("" ::: "memory"); } while (0)
#else
#define HG_BAR() __syncthreads()
#endif
#define HG_BAR_UNUSED()
__device__ __forceinline__ void hgrnA_compute(Frame& F, int id, const HgIn& in) {
    const bool meta = id >= 1024; const int bh = meta ? 0 : id >> 6, c = id & 63, h = meta ? id - 1024 : bh & 3, b = bh >> 2;
    const int row0 = meta ? MR : b * SEQ + c * 64, nvalid = meta ? NM : 64;
    const int d = F.tid & 127, i = F.tid >> 7;
    LAS unsigned char* L = F.lds + RING_OFF;
    const float (&lf)[16] = in.lf; const float (&qv)[16] = in.qv; const float (&vv)[16] = in.vv;
    float Lc[16]; { float s = 0.f;
#pragma unroll
        for (int j = 0; j < 16; ++j) { s += lf[j]; Lc[j] = s; } }
    LAS float* TOT = (LAS float*)(L + HA_TOT);
    TOT[i * 128 + d] = Lc[15];
    HG_BAR();
    float rho[4]; { float s = 0.f;
#pragma unroll
        for (int j = 0; j < 4; ++j) { s += TOT[j * 128 + d]; rho[j] = s; } }
    const float rhoi = (i == 0) ? rho[0] : (i == 1) ? rho[1] : (i == 2) ? rho[2] : rho[3], ri = (i == 0) ? 0.f : (i == 1) ? rho[0] : (i == 2) ? rho[1] : rho[2], glast = rho[3];
    const float fK2 = __expf(glast - rhoi), fQ2 = __expf(rhoi);
    float fQ[4];
#pragma unroll
    for (int jj = 0; jj < 4; ++jj) fQ[jj] = (jj <= i) ? __expf(rhoi - rho[jj]) : 0.f;
    LAS bf16_t* KP = (LAS bf16_t*)(L + HA_KP); LAS bf16_t* QP = (LAS bf16_t*)(L + HA_QP);
    unsigned kt[8], vt[8];
#pragma unroll
    for (int j = 0; j < 16; j += 2) {
        float kp[2], qe[2];
#pragma unroll
        for (int q = 0; q < 2; ++q) { const float G = ri + Lc[j + q], E = __expf(G - rhoi), k = 1.f - __expf(lf[j + q]); kp[q] = k * __builtin_amdgcn_rcpf(E); qe[q] = qv[j + q] * E; }
        const int t = 16 * i + j;
        { const unsigned w = cvt_pk_bf16(kp[0], kp[1]); KP[t * 136 + d] = (bf16_t)(w & 0xffffu); KP[(t + 1) * 136 + d] = (bf16_t)(w >> 16); }
        kt[j >> 1] = cvt_pk_bf16(kp[0] * fK2, kp[1] * fK2); vt[j >> 1] = cvt_pk_bf16(vv[j], vv[j + 1]);
#pragma unroll
        for (int jj = 0; jj < 4; ++jj) if (jj <= i) { const unsigned w = cvt_pk_bf16(qe[0] * fQ[jj], qe[1] * fQ[jj]); const int rb = qp_base(jj) + t - 16 * jj; QP[rb * 136 + d] = (bf16_t)(w & 0xffffu); QP[(rb + 1) * 136 + d] = (bf16_t)(w >> 16); }
        { const unsigned w = cvt_pk_bf16(qe[0] * fQ2, qe[1] * fQ2); bf16_t* hq2 = WSP(bf16_t, WS_HQ2) + (size_t)(row0 + t) * 512 + h * 128 + d;
          if (t < nvalid) hq2[0] = (bf16_t)(w & 0xffffu); if (t + 1 < nvalid) hq2[512] = (bf16_t)(w >> 16); }
    }
    { LAS u32x4* ktp = (LAS u32x4*)(L + HA_KT + d * 144 + i * 32); ktp[0] = (u32x4){kt[0], kt[1], kt[2], kt[3]}; ktp[1] = (u32x4){kt[4], kt[5], kt[6], kt[7]};
      LAS u32x4* vtp = (LAS u32x4*)(L + HA_VT + d * 144 + i * 32); vtp[0] = (u32x4){vt[0], vt[1], vt[2], vt[3]}; vtp[1] = (u32x4){vt[4], vt[5], vt[6], vt[7]}; }
    if (i == 0) WSP(float, WS_DEC)[(size_t)id * 128 + d] = __expf(glast);
    HG_BAR();
    const int w = F.wave, fr = F.lane & 15, fq = F.lane >> 4;
    {
        LAS unsigned char* PB = L + HA_PB;
        for (int blk = w; blk < 16; blk += 8) {
            int it, js;
            if (blk < 10) { it = (blk >= 6) ? 3 : (blk >= 3) ? 2 : (blk >= 1) ? 1 : 0; js = blk - ((it * (it + 1)) >> 1); }
            else { const int q = blk - 10; it = (q < 3) ? 0 : (q < 5) ? 1 : 2; js = (q < 3) ? q + 1 : (q < 5) ? q - 1 : 3; }
            f32x4 acc = (f32x4){0.f, 0.f, 0.f, 0.f};
            if (blk < 10) {
#pragma unroll
                for (int ks = 0; ks < 4; ++ks) {
                    const bf16x8 qa = *(const LAS bf16x8*)(L + HA_QP + ((qp_base(js) + 16 * it - 16 * js + fr) * 136 + 32 * ks + 8 * fq) * 2);
                    const bf16x8 kb = *(const LAS bf16x8*)(L + HA_KP + ((16 * js + fr) * 136 + 32 * ks + 8 * fq) * 2);
                    acc = __builtin_amdgcn_mfma_f32_16x16x32_bf16(kb, qa, acc, 0, 0, 0);
                }
                if (it == js) {
#pragma unroll
                    for (int e = 0; e < 4; ++e) if (4 * fq + e > fr) acc[e] = 0.f;
                }
            }
            u32x2 pw; pw.x = pk2(acc[0], acc[1]); pw.y = pk2(acc[2], acc[3]);
            *(LAS u32x2*)(PB + (16 * it + fr) * 144 + (16 * js + 4 * fq) * 2) = pw;
        }
    }
    HG_BAR();
    {
        const int tb = w >> 1, dv0 = (w & 1) * 4;
        f32x4 acc[4];
#pragma unroll
        for (int q = 0; q < 4; ++q) acc[q] = (f32x4){0.f, 0.f, 0.f, 0.f};
#pragma unroll
        for (int ks = 0; ks < 2; ++ks) {
            const bf16x8 pa = *(const LAS bf16x8*)(L + HA_PB + (16 * tb + fr) * 144 + (32 * ks + 8 * fq) * 2);
#pragma unroll
            for (int q = 0; q < 4; ++q) { const bf16x8 vb = *(const LAS bf16x8*)(L + HA_VT + (16 * (dv0 + q) + fr) * 144 + (32 * ks + 8 * fq) * 2);
                acc[q] = __builtin_amdgcn_mfma_f32_16x16x32_bf16(vb, pa, acc[q], 0, 0, 0); }
        }
        const int t = 16 * tb + fr;
        if (t < nvalid) {
#pragma unroll
            for (int q = 0; q < 4; ++q) *(f32x4*)(WSP(float, WS_OI) + (size_t)(row0 + t) * 512 + h * 128 + 16 * (dv0 + q) + 4 * fq) = acc[q];
        }
    }
    {
        f32x4 acc[8];
#pragma unroll
        for (int q = 0; q < 8; ++q) acc[q] = (f32x4){0.f, 0.f, 0.f, 0.f};
#pragma unroll
        for (int ks = 0; ks < 2; ++ks) {
            const bf16x8 va = *(const LAS bf16x8*)(L + HA_VT + (16 * w + fr) * 144 + (32 * ks + 8 * fq) * 2);
#pragma unroll
            for (int q = 0; q < 8; ++q) { const bf16x8 kb = *(const LAS bf16x8*)(L + HA_KT + (16 * q + fr) * 144 + (32 * ks + 8 * fq) * 2);
                acc[q] = __builtin_amdgcn_mfma_f32_16x16x32_bf16(kb, va, acc[q], 0, 0, 0); }
        }
        float* DS = WSP(float, WS_DS) + (size_t)id * 16384 + (size_t)(16 * w + fr) * 128;
#pragma unroll
        for (int q = 0; q < 8; ++q) *(f32x4*)(DS + 16 * q + 4 * fq) = acc[q];
    }
    HG_BAR();
}
__device__ __forceinline__ void hgrn_scan(Frame& F) {
    const float* DS = WSP(float, WS_DS); const float* DEC = WSP(float, WS_DEC); bf16_t* ST = WSP(bf16_t, WS_ST);
    const int gt = F.vcu * 512 + F.tid, NT = F.G * 512;
    typedef float f32x2 __attribute__((ext_vector_type(2)));
    for (int idx = gt; idx < 16 * 8192; idx += NT) {
        const int bh = idx >> 13, e2 = (idx & 8191) * 2, dk = e2 & 127, h = bh & 3;
        f32x2 s = *(const GAS f32x2*)(DS + (size_t)(1024 + h) * 16384 + e2);
        for (int c0 = 0; c0 < 64; c0 += 16) {
            f32x2 dd[16], ds[16];
#pragma unroll
            for (int j = 0; j < 16; ++j) { const size_t id = (size_t)bh * 64 + c0 + j; dd[j] = *(const GAS f32x2*)(DEC + id * 128 + dk); ds[j] = *(const GAS f32x2*)(DS + id * 16384 + e2); }
#pragma unroll
            for (int j = 0; j < 16; ++j) { const size_t id = (size_t)bh * 64 + c0 + j; *(GAS unsigned*)(ST + id * 16384 + e2) = pk2(s.x, s.y); s = dd[j] * s + ds[j]; }
        }
    }
}
__device__ __forceinline__ void hgrnC_pass(Frame& F, const float* og) {
    const bf16_t* HQ = WSP(bf16_t, WS_HQ2); const bf16_t* HG = WSP(bf16_t, WS_HG); const float* OI = WSP(float, WS_OI); const bf16_t* ST = WSP(bf16_t, WS_ST); bf16_t* U = WSP(bf16_t, WS_U);
    const int gw = F.vcu * NWAVES + F.wave, NGW = F.G * NWAVES, fr = F.lane & 15, fq = F.lane >> 4;
    for (int task = gw; task < 1024 * 4 + 4; task += NGW) {
        const bool meta = task >= 4096; const int id = meta ? 0 : task >> 2, tb = meta ? 0 : task & 3, bh = id >> 6, c = id & 63, h = meta ? task - 4096 : bh & 3, b = bh >> 2;
        const int row = (meta ? MR : b * SEQ + c * 64 + 16 * tb) + fr;
        f32x4 acc[8];
#pragma unroll
        for (int q = 0; q < 8; ++q) acc[q] = *(const f32x4*)(OI + (size_t)row * 512 + h * 128 + 16 * q + 4 * fq);
        if (!meta) {
            const bf16_t* Sb = ST + (size_t)id * 16384;
#pragma unroll
            for (int ks = 0; ks < 4; ++ks) {
                const bf16x8 qa = *(const bf16x8*)(HQ + (size_t)row * 512 + h * 128 + 32 * ks + 8 * fq);
#pragma unroll
                for (int q = 0; q < 8; ++q) { const bf16x8 sb = *(const bf16x8*)(Sb + (size_t)(16 * q + fr) * 128 + 32 * ks + 8 * fq);
                    acc[q] = __builtin_amdgcn_mfma_f32_16x16x32_bf16(sb, qa, acc[q], 0, 0, 0); }
            }
        }
        float ss = 0.f;
#pragma unroll
        for (int q = 0; q < 8; ++q) ss += (acc[q][0] * acc[q][0] + acc[q][1] * acc[q][1]) + (acc[q][2] * acc[q][2] + acc[q][3] * acc[q][3]);
        ss = xadd<16>(ss); ss = xadd<32>(ss);
        const float sc = rsqrtf(ss * (1.f / 128.f) + EPS);
#pragma unroll
        for (int q = 0; q < 8; ++q) { const int dv = 16 * q + 4 * fq; const f32x4 g = *(const f32x4*)(og + dv); const u32x2 gg = *(const u32x2*)(HG + (size_t)row * 512 + h * 128 + dv);
            u32x2 o; o.x = pk2(acc[q][0] * sc * g[0] * bflo(gg.x), acc[q][1] * sc * g[1] * bfhi(gg.x)); o.y = pk2(acc[q][2] * sc * g[2] * bflo(gg.y), acc[q][3] * sc * g[3] * bfhi(gg.y));
            *(u32x2*)(U + (size_t)row * 1536 + 1024 + h * 128 + dv) = o; }
    }
}
struct TokInfo { int e1, s1, e2, s2; float w1, w2; int pad0, pad1; };
__device__ __forceinline__ void convert_moe_gu(Frame& F, int early = -1, int widx = 0, int nw = 1, int skip = -1) {
    LAS float* scr = early >= 0 ? (LAS float*)(F.lds + RING_OFF + F.wave * 16384) : (LAS float*)(F.lds + RING_OFF + 32768 + F.wave * 8704);
    const int gw = early >= 0 ? widx : F.vcu * NWAVES + F.wave, NGW = early >= 0 ? nw : F.G * NWAVES;
    constexpr int I_GU = 16 * 224;
    const int ne = early >= 0 ? 1 : (skip >= 0 ? NE - 1 : NE);
    const auto dec = [&](int it) -> CvtItem { int e = it / I_GU; const int r = it - e * I_GU, kb = r / 224, db = r % 224, tile = db >> 3, l32 = db & 7;
        e = early >= 0 ? early : (skip >= 0 && e >= skip ? e + 1 : e);
        const float* src = ((l32 < 4) ? F.in[19] : F.in[20]) + (size_t)e * D * FFE;
        return CvtItem{src, FFE, kb * 64, tile * 128 + (l32 & 3) * 32, F.ws + WS_MGU + (size_t)e * 7168 * D, D, db * 32}; };
    cvt_run<true>(gw, NGW, ne * I_GU, dec, scr, F.lane, W8_SCALE);
}
__device__ __forceinline__ void convert_moe_down(Frame& F, int widx, int nw) {
    LAS float* scr = (LAS float*)(F.lds + RING_OFF + F.wave * 16384);
    constexpr int I_DN = 56 * 32;
    const auto dec = [&](int it) -> CvtItem { const int e = it / I_DN, r = it - e * I_DN, kb = r >> 5, db = r & 31;
        return CvtItem{F.in[21] + (size_t)e * FFE * D, D, kb * 64, db * 32, F.ws + WS_MD + (size_t)e * D * FFE, FFE, db * 32}; };
    cvt_run<true>(widx, nw, NE * I_DN, dec, scr, F.lane, WD8_SCALE);
}
__device__ __forceinline__ void norm_route_pass(Frame& F, const float* gain) {
    LAS float* rwl = (LAS float*)(F.lds + RING_OFF);
    for (int i = F.tid; i < D * NE / 4; i += 512) ((LAS f32x4*)rwl)[i] = ((const f32x4*)F.in[18])[i];
    __syncthreads();
    const int gw = F.vcu * NWAVES + F.wave, NGW = F.G * NWAVES;
    f32x4 gv[4];
#pragma unroll
    for (int j = 0; j < 4; ++j) gv[j] = ((const f32x4*)gain)[F.lane + 64 * j];
    unsigned* cnt = (unsigned*)(F.ws + WS_CTL) + CW_CNT; int* lists = (int*)(F.ws + WS_SMALL + SMB_LIST); TokInfo* ti = (TokInfo*)(F.ws + WS_SMALL + SMB_TOK);
    for (int r = gw; r < MR; r += NGW) {
        const GAS f32x4* xr = (const GAS f32x4*)(F.out + (size_t)r * D) + F.lane;
        f32x4 v[4]; float s = 0.f;
#pragma unroll
        for (int j = 0; j < 4; ++j) { v[j] = xr[64 * j]; s += (v[j].x * v[j].x + v[j].y * v[j].y) + (v[j].z * v[j].z + v[j].w * v[j].w); }
        const float sc = rsqrtf(wave_sum(s) * (1.f / D) + EPS);
        GAS unsigned* o = (GAS unsigned*)(F.ws + WS_HN + (size_t)r * D) + F.lane;
        float lg[8];
#pragma unroll
        for (int e = 0; e < 8; ++e) lg[e] = 0.f;
#pragma unroll
        for (int j = 0; j < 4; ++j) {
            v[j] = v[j] * sc * gv[j];
            o[64 * j] = pk4_fp8(v[j].x, v[j].y, v[j].z, v[j].w);
#pragma unroll
            for (int q = 0; q < 4; ++q) { const int d = (F.lane + 64 * j) * 4 + q; const f32x4 r0 = *(const LAS f32x4*)(rwl + d * 8), r1 = *(const LAS f32x4*)(rwl + d * 8 + 4); const float x = v[j][q];
                lg[0] += x * r0[0]; lg[1] += x * r0[1]; lg[2] += x * r0[2]; lg[3] += x * r0[3]; lg[4] += x * r1[0]; lg[5] += x * r1[1]; lg[6] += x * r1[2]; lg[7] += x * r1[3]; }
        }
#pragma unroll
        for (int e = 0; e < 8; ++e) lg[e] = wave_sum(lg[e]);
        int i1 = 0; float m1 = lg[0];
#pragma unroll
        for (int e = 1; e < 8; ++e) if (lg[e] > m1) { m1 = lg[e]; i1 = e; }
        int i2 = -1; float m2 = -INFINITY;
#pragma unroll
        for (int e = 0; e < 8; ++e) if (e != i1 && lg[e] > m2) { m2 = lg[e]; i2 = e; }
        if (F.lane == 0) {
            const float w1 = 1.f / (1.f + expf(m2 - m1));
            const unsigned s1 = __hip_atomic_fetch_add(cnt + 64 * i1, 1u, RLX_AGENT), s2 = __hip_atomic_fetch_add(cnt + 64 * i2, 1u, RLX_AGENT);
            lists[i1 * LISTCAP + s1] = r; lists[i2 * LISTCAP + s2] = r;
            TokInfo t; t.e1 = i1; t.s1 = (int)s1; t.e2 = i2; t.s2 = (int)s2; t.w1 = w1; t.w2 = 1.f - w1; t.pad0 = 0; t.pad1 = 0; ti[r] = t;
        }
    }
}
struct MoeTiles { int ts[9]; };
__device__ __forceinline__ MoeTiles moe_tiles(Frame& F) {
    MoeTiles m; const unsigned* cnt = (const unsigned*)(F.ws + WS_CTL) + CW_CNT; int a = 0;
#pragma unroll
    for (int e = 0; e < 8; ++e) { m.ts[e] = a; const unsigned c = (unsigned)__builtin_amdgcn_readfirstlane((int)__hip_atomic_load(cnt + 64 * e, RLX_AGENT)); a += (int)((c + 255u) >> 8); }
    m.ts[8] = a; return m;
}
__device__ __forceinline__ int moe_expert_of(const MoeTiles& m, int rt) { int e = 0;
#pragma unroll
    for (int k = 1; k < 8; ++k) e += (rt >= m.ts[k]) ? 1 : 0;
    return e; }
struct MoeGuOrder {
    MoeTiles m; int G, c; const int* lists;
    __device__ __forceinline__ bool next(int i, Unit& u) const {
        const int L = i * G + c; if (L >= m.ts[8] * 28) return false;
        const int rt = L / 28, pn = L - rt * 28, e = moe_expert_of(m, rt);
        int tsb = 0;
#pragma unroll
        for (int k = 0; k < 8; ++k) tsb = (k == e) ? m.ts[k] : tsb;
        u.pm = rt; u.pn = pn; u.z = e; u.a_off = 0u; u.b_off = (unsigned)(((long)e * 7168 + pn * 256) * D); u.gidx = lists + e * LISTCAP + (rt - tsb) * 256; return true;
    }
};
struct MoeDownOrder {
    MoeTiles m; int G, c;
    __device__ __forceinline__ bool next(int i, Unit& u) const {
        const int nt = m.ts[8] < 128 ? m.ts[8] : 128; const int L = i * G + c; if (L >= nt * 4) return false;
        const int rt = L >> 2, pn = L & 3, e = moe_expert_of(m, rt);
        u.pm = rt; u.pn = pn; u.z = e; u.a_off = (unsigned)((long)rt * 256 * FFE); u.b_off = (unsigned)(((long)e * D + pn * 256) * FFE); u.gidx = nullptr; return true;
    }
};
struct MoeSlabOrder {
    MoeTiles m; int G, c, S, Kp;
    __device__ __forceinline__ bool next(int i, Unit& u) const {
        const int nleft = (m.ts[8] - 128) * 4; const int q = i * G + c; if (q >= nleft * S) return false;
        const int up = q / S, sl = q - up * S, rt = 128 + (up >> 2), pn = up & 3, e = moe_expert_of(m, rt);
        u.pm = rt; u.pn = pn; u.z = q; u.a_off = (unsigned)((long)rt * 256 * FFE + (long)sl * Kp * 2); u.b_off = (unsigned)(((long)e * D + pn * 256) * FFE + (long)sl * Kp * 2); u.gidx = nullptr; return true;
    }
};
struct EpiSlab {
    static constexpr bool PERM = false, MID = false;
    float* SL; float sc;
    __device__ __forceinline__ void row(const Unit& u, int r, int slot, int wc, int fq, const f32x4 (&v)[2][2]) const {
        float* p = SL + (size_t)u.z * 65536 + (size_t)(r & 255) * 256 + 32 * wc + 4 * fq;
#pragma unroll
        for (int bj = 0; bj < 2; ++bj)
#pragma unroll
            for (int n = 0; n < 2; ++n) *(f32x4*)(p + 128 * bj + 16 * n) = v[bj][n] * sc;
    }
};
__device__ __forceinline__ void moe_slab_split(int tiles, int G, int& S, int& Kp) { S = 7; Kp = 256; }
struct EpiY {
    static constexpr bool PERM = true, MID = false;
    bf16_t* Y; float sc;
    __device__ __forceinline__ void row(const Unit& u, int r, int slot, int wc, int fq, const f32x4 (&v)[2][2]) const {
#pragma unroll
        for (int bj = 0; bj < 2; ++bj) *(u32x4*)(Y + (size_t)r * D + u.pn * 256 + 128 * bj + 32 * wc + 8 * fq) = pack8(v[bj][0] * sc, v[bj][1] * sc);
    }
};
__device__ __forceinline__ f32x4 moe_y4(const bf16_t* Y, const float* SL, int S, size_t R, int j, int lane) {
    if (R < 32768) { const u32x2 y = *((const GAS u32x2*)(Y + R * D) + lane + 64 * j); return (f32x4){bflo(y.x), bfhi(y.x), bflo(y.y), bfhi(y.y)}; }
    const float* p = SL + ((size_t)(((R >> 8) - 128) * 4 + j) * S) * 65536 + (R & 255) * 256 + 4 * lane; f32x4 a = (f32x4){0.f, 0.f, 0.f, 0.f};
    for (int s0 = 0; s0 < S; s0 += 7) {
        f32x4 q[7];
#pragma unroll
        for (int sl = 0; sl < 7; ++sl) q[sl] = *(const f32x4*)(p + (size_t)(s0 + sl) * 65536);
#pragma unroll
        for (int sl = 0; sl < 7; ++sl) a += q[sl];
    }
    return a;
}
__device__ __forceinline__ void moe_combine_pass(Frame& F) {
    const MoeTiles m = moe_tiles(F); const TokInfo* ti = (const TokInfo*)(F.ws + WS_SMALL + SMB_TOK); const bf16_t* Y = WSP(bf16_t, WS_MY); const float* SL = WSP(float, WS_SLAB);
    int S, Kp; moe_slab_split(m.ts[8], F.G, S, Kp);
    const int gw = F.vcu * NWAVES + F.wave, NGW = F.G * NWAVES;
    TokInfo tn = ti[gw < MR ? gw : 0];
    for (int r = gw; r < MR; r += NGW) {
        const TokInfo t = tn; { const int rn = r + NGW; tn = ti[rn < MR ? rn : r]; }
        int b1 = 0, b2 = 0;
#pragma unroll
        for (int k = 0; k < 8; ++k) { b1 = (k == t.e1) ? m.ts[k] : b1; b2 = (k == t.e2) ? m.ts[k] : b2; }
        const size_t r1 = (size_t)b1 * 256 + t.s1, r2 = (size_t)b2 * 256 + t.s2;
        GAS f32x4* o = (GAS f32x4*)(F.out + (size_t)r * D) + F.lane;
        if (r1 < 32768 && r2 < 32768) {
            u32x2 y1[4], y2[4]; f32x4 x[4];
#pragma unroll
            for (int j = 0; j < 4; ++j) { y1[j] = *((const GAS u32x2*)(Y + r1 * D) + F.lane + 64 * j); y2[j] = *((const GAS u32x2*)(Y + r2 * D) + F.lane + 64 * j); x[j] = o[64 * j]; }
#pragma unroll
            for (int j = 0; j < 4; ++j) { x[j][0] += t.w1 * bflo(y1[j].x) + t.w2 * bflo(y2[j].x); x[j][1] += t.w1 * bfhi(y1[j].x) + t.w2 * bfhi(y2[j].x); x[j][2] += t.w1 * bflo(y1[j].y) + t.w2 * bflo(y2[j].y); x[j][3] += t.w1 * bfhi(y1[j].y) + t.w2 * bfhi(y2[j].y); o[64 * j] = x[j]; }
        } else {
#pragma unroll
            for (int j = 0; j < 4; ++j) { const f32x4 y1 = moe_y4(Y, SL, S, r1, j, F.lane), y2 = moe_y4(Y, SL, S, r2, j, F.lane); o[64 * j] = o[64 * j] + y1 * t.w1 + y2 * t.w2; }
        }
    }
}
}
namespace mk {
enum { P_CVT = 0, P_NORM1, P_PROJ, P_MIX, P_SCAN, P_FIN, P_GATES, P_MERGE, P_WOUT, P_NORM2, P_GU, P_DOWN, P_COMB, P_NPH };
struct Args { const float* in[22]; float* out; unsigned char* ws; unsigned pmask; int l0, l1; unsigned dup; };

#define PH(k) ((a.pmask >> (k)) & 1u)
#define PHASE_FRAME() Frame F = F0; { const int t_ = pg8::make_tid(F0.wave); F.tid = t_; F.lane = t_ & 63; F.wave = F0.wave; unsigned char* w_ = F0.ws; asm volatile("" : "+s"(w_)); F.ws = w_; int g_ = F0.G, v_ = F0.vcu; asm volatile("" : "+s"(g_), "+s"(v_)); F.G = g_; F.vcu = v_; } float* sm = SMALLF; (void)sm
#define GRID_BAR() xcd_barrier(bar, F.tid)
template <int l> __device__ __forceinline__ void layer_body(const Args& a, const Frame& F0, const XcdBarrier& bar, unsigned char* lds) {
    constexpr bool first = (l == 0);
#ifndef NO_P_CVT
        if (PH(P_CVT) && l == 0) for (int rep_ = 0; rep_ <= (int)((a.dup >> (16 + l)) & (a.dup >> P_CVT) & 1u); ++rep_) { PHASE_FRAME(); setup_small(F); convert_layer_weights(F, 0, -1, 0, F.G == 256 ? 1 : 0); }
#endif
#ifndef NO_P_NORM1
        if (PH(P_NORM1)) for (int rep_ = 0; rep_ <= (int)((a.dup >> (16 + l)) & (a.dup >> P_NORM1) & 1u); ++rep_) { PHASE_FRAME(); norm_pass(F, F.in[2] + l * D, first, true); GRID_BAR(); }
#endif
#ifndef NO_P_PROJ
        if (PH(P_PROJ)) for (int rep_ = 0; rep_ <= (int)((a.dup >> (16 + l)) & (a.dup >> P_PROJ) & 1u); ++rep_) { PHASE_FRAME();
            Gemm g{WSP(bf16_t, WS_HN), WSP(bf16_t, WS_WIN), D, D, D}; TileOrder S; S.init(64, 20, 0, F.G, (int)blockIdx.x, D, D);
            EpiProj E{F.ws, F.in[5] + l * 64, F.in[6] + l * 64, l, 1.f};
            pg8::gemm_phase<EpiProj, TileOrder>(F.lds + RING_OFF, g, S, E, F.wave);
            meta_gemm(F, WSP(bf16_t, WS_HN) + (size_t)MR * D, D, WSP(bf16_t, WS_WIN), D, D, 0, 20, E);
            GRID_BAR();
        }
#endif
#ifndef NO_P_MIX
        if (PH(P_MIX)) for (int rep_ = 0; rep_ <= (int)((a.dup >> (16 + l)) & (a.dup >> P_MIX) & 1u); ++rep_) { PHASE_FRAME();
            if (!(a.dup & 0x8000u) || rep_ == 0) {
                if (F.G == 256) {
                    const bool hm = (F.vcu & 7) == 0 && F.vcu < 32; const int idm = 1024 + (F.vcu >> 3);
                    HgIn A, B; hgrnA_load(F, F.vcu, A); hgrnA_load(F, F.vcu + 256, B); hgrnA_compute(F, F.vcu, A);
                    hgrnA_load(F, F.vcu + 512, A); hgrnA_compute(F, F.vcu + 256, B); hgrnA_load(F, F.vcu + 768, B); hgrnA_compute(F, F.vcu + 512, A);
                    if (hm) hgrnA_load(F, idm, A);
                    hgrnA_compute(F, F.vcu + 768, B); if (hm) hgrnA_compute(F, idm, A); }
                else for (int id = F.vcu; id < 1028; id += F.G) { HgIn A; hgrnA_load(F, id, A); hgrnA_compute(F, id, A); }
            }
            if (rep_ == 1 && !(a.dup & 0x8000u)) { GRID_BAR(); continue; }
            conv_pass(F, F.in[10] + l * 1536);
            { LAS float* tabl = (LAS float*)(F.lds + RING_OFF + attn_body::LDS_TAB); tabl[F.tid] = sm[SM_TAB + F.tid]; }
            __syncthreads();
            { int b, vh, qb;
              for (int i = 0; attn_body::attn_next(F.G, F.vcu, i, b, vh, qb); ++i)
                  attn_body::attn_unit<8>(b, vh, qb, (const attn_body::bf16*)WSP(bf16_t, WS_QK), (const attn_body::bf16*)WSP(bf16_t, WS_V), (attn_body::bf16*)WSP(bf16_t, WS_O), (char*)lds + RING_OFF, F.wave); }
            if (l == 0 && F.G == 256) {
                const int g = F.vcu & 7, bv = F.vcu >> 3;
                if (g != 7 && !(g == 0 && bv < 4)) { const int idx = bv < 4 ? bv * 6 + (g - 1) : 24 + (bv - 4) * 7 + g; convert_layer_weights(F, 0, idx * NWAVES + F.wave, 220 * NWAVES, 2); } }
            if (l == 1 && F.G == 256) {
                const int g = F.vcu & 7, bv = F.vcu >> 3;
                if (g != 7 && !(g == 0 && bv < 4)) { const int idx = bv < 4 ? bv * 6 + (g - 1) : 24 + (bv - 4) * 7 + g; convert_moe_gu(F, 3, idx * NWAVES + F.wave, 220 * NWAVES); } }
            GRID_BAR();
        }
#endif
#ifndef NO_P_SCAN
        if (PH(P_SCAN)) for (int rep_ = 0; rep_ <= (int)((a.dup >> (16 + l)) & (a.dup >> P_SCAN) & 1u); ++rep_) { PHASE_FRAME(); hgrn_scan(F); GRID_BAR(); }
#endif
#ifndef NO_P_FIN
        if (PH(P_FIN)) for (int rep_ = 0; rep_ <= (int)((a.dup >> (16 + l)) & (a.dup >> P_FIN) & 1u); ++rep_) { PHASE_FRAME(); hgrnC_pass(F, F.in[12] + l * 128); attcomb_pass(F, F.in[8] + l * 128, l); }
#endif
#ifndef NO_P_GATES
        if (PH(P_GATES)) for (int rep_ = 0; rep_ <= (int)((a.dup >> (16 + l)) & (a.dup >> P_GATES) & 1u); ++rep_) { PHASE_FRAME();
            Gemm g{(const bf16_t*)(F.ws + WS_HN8), (const bf16_t*)(F.ws + WS_WIN8 - (size_t)20 * 256 * D), D / 2, D / 2, D / 2}; TileOrder S; S.init(64, 12, 20, F.G, (int)blockIdx.x, D / 2, D / 2);
            EpiProj E{F.ws, F.in[5] + l * 64, F.in[6] + l * 64, l, 1.f / W8_SCALE};
            pg8::gemm_phase<EpiProj, TileOrder, false, true>(F.lds + RING_OFF, g, S, E, F.wave);
            if (l == 0) { EpiProj Em{F.ws, F.in[5] + l * 64, F.in[6] + l * 64, l, 1.f}; meta_gemm(F, WSP(bf16_t, WS_HN) + (size_t)MR * D, D, WSP(bf16_t, WS_WIN), D, D, 20, 32, Em); }
            GRID_BAR();
        }
#endif
#ifndef NO_P_MERGE
        if (PH(P_MERGE)) for (int rep_ = 0; rep_ <= (int)((a.dup >> (16 + l)) & (a.dup >> P_MERGE) & 1u); ++rep_) { PHASE_FRAME();
            Gemm g{WSP(bf16_t, WS_U), WSP(bf16_t, WS_WBR), 1536, 1536, 1536}; TileOrder S; S.init(64, 4, 0, F.G, (int)blockIdx.x, 1536, 1536);
            EpiMerge E{WSP(bf16_t, WS_GATES), WSP(bf16_t, WS_MIXED)};
            pg8::gemm_phase<EpiMerge, TileOrder>(F.lds + RING_OFF, g, S, E, F.wave);
            if (l == 0) meta_merge(F, WSP(bf16_t, WS_U) + (size_t)MR * 1536, WSP(bf16_t, WS_WBR), WSP(bf16_t, WS_GATES), WSP(bf16_t, WS_MIXED));
            GRID_BAR();
        }
#endif
#ifndef NO_P_WOUT
        if (PH(P_WOUT)) for (int rep_ = 0; rep_ <= (int)((a.dup >> (16 + l)) & (a.dup >> P_WOUT) & 1u); ++rep_) { PHASE_FRAME();
            Gemm g{WSP(bf16_t, WS_MIXED), WSP(bf16_t, WS_WO), D, D, D}; TileOrder S; S.init(64, 4, 0, F.G, (int)blockIdx.x, D, D);
            EpiRes E{first ? F.in[0] : (const float*)F.out, F.out, first ? F.in[1] : (const float*)(sm + SM_METAHS), sm + SM_METAHS};
            pg8::gemm_phase<EpiRes, TileOrder>(F.lds + RING_OFF, g, S, E, F.wave);
            if (l == 0) meta_gemm(F, WSP(bf16_t, WS_MIXED) + (size_t)MR * D, D, WSP(bf16_t, WS_WO), D, D, 0, 4, E);
            GRID_BAR();
        }
#endif
#ifndef NO_P_NORM2
        if (PH(P_NORM2) && l == 0) for (int rep_ = 0; rep_ <= (int)((a.dup >> (16 + l)) & (a.dup >> P_NORM2) & 1u); ++rep_) { PHASE_FRAME(); norm_pass(F, F.in[3] + l * D, false, false); if (PH(P_CVT)) setup_small(F); GRID_BAR(); }
        if (PH(P_NORM2) && l == 1) for (int rep_ = 0; rep_ <= (int)((a.dup >> (16 + l)) & (a.dup >> P_NORM2) & 1u); ++rep_) { PHASE_FRAME(); norm_route_pass(F, F.in[3] + l * D); convert_moe_gu(F, -1, 0, 1, F.G == 256 ? 3 : -1); GRID_BAR(); }
#endif
#ifndef NO_P_GU
        if (PH(P_GU) && l == 0) for (int rep_ = 0; rep_ <= (int)((a.dup >> (16 + l)) & (a.dup >> P_GU) & 1u); ++rep_) { PHASE_FRAME();
            Gemm g{WSP(bf16_t, WS_HN), WSP(bf16_t, WS_WGU0), D, D, D}; TileOrder S; S.init(64, 22, 0, F.G, (int)blockIdx.x, D, D);
            EpiGU E{WSP(bf16_t, WS_H0), FFD, 1.f};
            pg8::gemm_phase<EpiGU, TileOrder>(F.lds + RING_OFF, g, S, E, F.wave);
            meta_gemm(F, WSP(bf16_t, WS_HN) + (size_t)MR * D, D, WSP(bf16_t, WS_WGU0), D, D, 0, 22, E);
            if (PH(P_CVT) && rep_ == 0) { const int total = 64 * 22, rem = total % F.G, bx = (int)blockIdx.x;
              if (rem == 0) convert_layer_weights(F, 1, bx * NWAVES + F.wave, F.G * NWAVES); else if (bx >= rem) convert_layer_weights(F, 1, (bx - rem) * NWAVES + F.wave, (F.G - rem) * NWAVES); }
            GRID_BAR();
        }
#endif
#ifndef NO_P_DOWN
        if (PH(P_DOWN) && l == 0) for (int rep_ = 0; rep_ <= (int)((a.dup >> (16 + l)) & (a.dup >> P_DOWN) & 1u); ++rep_) { PHASE_FRAME();
            Gemm g{WSP(bf16_t, WS_H0), WSP(bf16_t, WS_WD0), FFD, FFD, FFD}; TileOrder S; S.init(64, 4, 0, F.G, (int)blockIdx.x, FFD, FFD);
            EpiRes E{(const float*)F.out, F.out, (const float*)(sm + SM_METAHS), sm + SM_METAHS};
            pg8::gemm_phase<EpiRes, TileOrder>(F.lds + RING_OFF, g, S, E, F.wave);
            meta_gemm(F, WSP(bf16_t, WS_H0) + (size_t)MR * FFD, FFD, WSP(bf16_t, WS_WD0), FFD, FFD, 0, 4, E);
            GRID_BAR();
        }
#endif
#ifndef NO_P_MOE
        if (PH(P_GU) && l == 1) for (int rep_ = 0; rep_ <= (int)((a.dup >> (16 + l)) & (a.dup >> P_GU) & 1u); ++rep_) { PHASE_FRAME();
            Gemm g{WSP(bf16_t, WS_HN), WSP(bf16_t, WS_MGU), D / 2, D / 2, D / 2};   MoeGuOrder S{moe_tiles(F), F.G, (int)blockIdx.x, (const int*)(F.ws + WS_SMALL + SMB_LIST)};
            EpiGU8 E{F.ws + WS_MH, FFE, 1.f / W8_SCALE};
            pg8::gemm_phase<EpiGU8, MoeGuOrder, true, true>(F.lds + RING_OFF, g, S, E, F.wave);
            { const int total = S.m.ts[8] * 28, rem = total % F.G, bx = (int)blockIdx.x;
              if (rem == 0) convert_moe_down(F, bx * NWAVES + F.wave, F.G * NWAVES); else if (bx >= rem) convert_moe_down(F, (bx - rem) * NWAVES + F.wave, (F.G - rem) * NWAVES); }
            GRID_BAR();
        }
        if (PH(P_DOWN) && l == 1) for (int rep_ = 0; rep_ <= (int)((a.dup >> (16 + l)) & (a.dup >> P_DOWN) & 1u); ++rep_) { PHASE_FRAME();
            Gemm g{WSP(bf16_t, WS_MH), WSP(bf16_t, WS_MD), FFE / 2, FFE / 2, FFE / 2};   MoeDownOrder S{moe_tiles(F), F.G, (int)blockIdx.x};
            EpiY E{WSP(bf16_t, WS_MY), 1.f / (H8_SCALE * WD8_SCALE)};
            pg8::gemm_phase<EpiY, MoeDownOrder, false, true>(F.lds + RING_OFF, g, S, E, F.wave);
            { int SS, Kp; moe_slab_split(S.m.ts[8], F.G, SS, Kp);
              Gemm g2{WSP(bf16_t, WS_MH), WSP(bf16_t, WS_MD), FFE / 2, FFE / 2, Kp}; MoeSlabOrder S2{S.m, F.G, (int)blockIdx.x, SS, Kp}; EpiSlab E2{WSP(float, WS_SLAB), 1.f / (H8_SCALE * WD8_SCALE)};
              pg8::gemm_phase<EpiSlab, MoeSlabOrder, false, true>(F.lds + RING_OFF, g2, S2, E2, F.wave); }
            GRID_BAR();
        }
        if (PH(P_COMB) && l == 1) for (int rep_ = 0; rep_ <= (int)((a.dup >> (16 + l)) & (a.dup >> P_COMB) & 1u); ++rep_) { PHASE_FRAME(); moe_combine_pass(F); if (rep_ < (int)((a.dup >> (16 + l)) & (a.dup >> P_COMB) & 1u)) GRID_BAR(); }
#endif
}
__global__ void __launch_bounds__(NWAVES * 64, 2) mega(Args a) {
    extern __shared__ __attribute__((aligned(16))) unsigned char lds[];
    Frame F0; Frame& F = F0;
    F.lds = (LAS unsigned char*)lds; F.lds_gen = lds;
    F.wave = __builtin_amdgcn_readfirstlane((int)threadIdx.x >> 6); F.tid = pg8::make_tid(F.wave); F.lane = F.tid & 63;
    F.G = gridDim.x; { const int bx = blockIdx.x; F.vcu = (F.G % 8 == 0) ? (bx % 8) * (F.G / 8) + bx / 8 : bx; }
    F.in = a.in; F.out = a.out; F.ws = a.ws;
    for (int u = F.tid; u < (LDS_BYTES - LDSCTL_OFF) / 4; u += NWAVES * 64) ((LAS unsigned*)(F.lds + LDSCTL_OFF))[u] = 0u;
    __syncthreads();
    volatile LAS unsigned* MISC = (volatile LAS unsigned*)(F.lds + MISC_OFF);
    XcdBarrier bar = xcd_barrier_post((unsigned*)(F.ws + WS_CTL) + 4096, MISC + 8, F.tid);
    if (a.l0 <= 0 && 0 < a.l1) layer_body<0>(a, F0, bar, lds);
    if (a.l0 <= 1 && 1 < a.l1) layer_body<1>(a, F0, bar, lds);
}
#undef PH
#undef GRID_BAR


#ifndef MK_DUP
#define MK_DUP 0u
#endif
static int g_grid = 0;
static bool mega_init() {
    if (g_grid) return g_grid > 0;
    int dev = 0, cus = 0, per_cu = 0;
    if (hipGetDevice(&dev) != hipSuccess || hipDeviceGetAttribute(&cus, hipDeviceAttributeMultiprocessorCount, dev) != hipSuccess) { g_grid = -1; return false; }
    if (hipFuncSetAttribute((const void*)mega, hipFuncAttributeMaxDynamicSharedMemorySize, LDS_BYTES) != hipSuccess) { g_grid = -1; return false; }
    if (hipOccupancyMaxActiveBlocksPerMultiprocessor(&per_cu, (const void*)mega, NWAVES * 64, LDS_BYTES) != hipSuccess || per_cu < 1) { fprintf(stderr, "mega: occupancy query says %d\n", per_cu); }
    (void)hipGetLastError();
    g_grid = cus;
    return true;
}
static void mega_launch(void* const* d_in, float* out, unsigned char* ws, unsigned pmask, int l0, int l1, hipStream_t st) {
    if (!mega_init()) return;
    (void)hipMemsetAsync(ws + WS_CTL, 0, CTL_ZERO_BYTES, st);
    Args a{};
    for (int i = 0; i < 22; ++i) a.in[i] = (const float*)d_in[i];
    a.out = out; a.ws = ws; a.pmask = pmask; a.l0 = l0; a.l1 = l1; a.dup = MK_DUP;
    hipLaunchKernelGGL(mega, dim3(g_grid), dim3(NWAVES * 64), LDS_BYTES, st, a);
}
}
extern "C" void kernel_launch(void* const* d_in, const int* in_sizes, int n_in, void* d_out, int out_size, void* d_ws, size_t ws_size, hipStream_t stream) {
    (void)in_sizes; (void)n_in; (void)out_size;
    if (ws_size < (size_t)512 * (1u << 20)) { fprintf(stderr, "kernel_launch: workspace too small (%zu)\n", ws_size); return; }
    mk::mega_launch(d_in, (float*)d_out, (unsigned char*)d_ws, (1u << mk::P_NPH) - 1u, 0, 2, stream);
}
```

```cpp
#include <hip/hip_runtime.h>
#include <cstdio>
#include <cstdint>
#include <cmath>
#include <hip/hip_bf16.h>
namespace pg8 {
#define PG8_LAS __attribute__((address_space(3)))
typedef unsigned short bf16_t;
typedef short bf16x8 __attribute__((ext_vector_type(8)));
typedef float f32x4 __attribute__((ext_vector_type(4)));
typedef unsigned u32x4 __attribute__((ext_vector_type(4)));
typedef unsigned u32x2 __attribute__((ext_vector_type(2)));
typedef int v4i_t __attribute__((ext_vector_type(4)));
typedef int v8i_t __attribute__((ext_vector_type(8)));
constexpr int BM = 256, BK = 64, HALF = 128, HTB = HALF * BK * 2, STAGE_BYTES = 8 * HTB;

__host__ __device__ __forceinline__ int lds_byte(int r, int c) { const int st = (r >> 4) * 2 + (c >> 5), rr = r & 15, cc = c & 31, ob = rr * 64 + cc * 2; return st * 1024 + (ob ^ (((ob >> 9) & 1) << 5)); }
__host__ __device__ __forceinline__ void stage_rc(int b, int& R, int& C) { const int st = b / 1024, sb = b % 1024, swz = sb ^ (((sb >> 9) & 1) << 5); R = (st >> 1) * 16 + swz / 64; C = (st & 1) * 32 + (swz % 64) / 2; }
__host__ __device__ __forceinline__ int perm32(int rho) { const int n = rho >> 4, i = rho & 15; return 8 * (i >> 2) + 4 * n + (i & 3); }

struct Unit { int pm, pn, z; unsigned a_off, b_off; const int* gidx; };
struct Gemm { const bf16_t* A; const bf16_t* Bt; int lda, ldb, K; };

__device__ __forceinline__ int lane_id() { unsigned m = ~0u; asm volatile("" : "+s"(m)); return (int)__builtin_amdgcn_mbcnt_hi(m, __builtin_amdgcn_mbcnt_lo(m, 0u)); }
__device__ __forceinline__ int make_tid(int wave) { int t = (wave << 6) | lane_id(); asm volatile("" : "+v"(t)); return t; }
typedef float f32x2_cv __attribute__((ext_vector_type(2))); typedef __bf16 bf16x2_cv __attribute__((ext_vector_type(2)));
__device__ __forceinline__ unsigned cvt_pk_bf16(float lo, float hi) { const f32x2_cv v = {lo, hi}; const bf16x2_cv b = __builtin_convertvector(v, bf16x2_cv); return __builtin_bit_cast(unsigned, b); }

template <class Epi, class Sched, bool GATHER = false, bool FP8 = false>
__device__ __forceinline__ void gemm_phase(PG8_LAS unsigned char* lds, const Gemm g, const Sched& S, const Epi& E, int wave0) {
    const int tid = make_tid(wave0),
              wid = __builtin_amdgcn_readfirstlane(tid >> 6), lane = tid & 63, wr = wid >> 2, wc = wid & 3, fr = lane & 15, fq = lane >> 4;
    const int K = g.K, nt = K / BK;
    unsigned voffA[2], voffB[2];
#pragma unroll
    for (int i = 0; i < 2; ++i) { int R, C; stage_rc(tid * 16 + i * 8192, R, C); const int Rb = Epi::PERM ? ((R & ~31) + perm32(R & 31)) : R;
        voffA[i] = (unsigned)(R * g.lda + C) * 2u; voffB[i] = (unsigned)(Rb * g.ldb + C) * 2u; }
    const size_t kstep = (size_t)(BK * 2);
    const size_t hstepA = GATHER ? 0 : (size_t)HALF * g.lda * 2, hstepB = (size_t)HALF * g.ldb * 2;
    const unsigned ldsw = (unsigned)wid * 1024u;
    const int aoff = lds_byte(wr * 64 + fr, fq * 8), boff = lds_byte(wc * 32 + fr, fq * 8);
    unsigned gvc[2][2], gvn[2][2];
#define PG8_SA(b, h) (((b) * 2 + (h)) * HTB)
#define PG8_SB(b, h) ((4 + (b) * 2 + (h)) * HTB)
#define PG8_STAGE(bufoff, gbase, voff) do { _Pragma("unroll") for (int _i = 0; _i < 2; ++_i) \
        __builtin_amdgcn_global_load_lds((const unsigned*)((const char*)(gbase) + (voff)[_i]), (PG8_LAS unsigned*)(lds + (bufoff) + ldsw + _i * 8192), 16, 0, 0); } while (0)
#define PG8_STAGE_A(bufoff, base, h, nx) do { if constexpr (GATHER) { if (nx) PG8_STAGE(bufoff, base, gvn[h]); else PG8_STAGE(bufoff, base, gvc[h]); } else { PG8_STAGE(bufoff, (base) + (h) * hstepA, voffA); } } while (0)
#define PG8_LD8(a_) __builtin_shufflevector(*(const PG8_LAS v4i_t*)(a_), *(const PG8_LAS v4i_t*)((a_) + 1024), 0, 1, 2, 3, 4, 5, 6, 7)
#define PG8_LDA(dst, b, h) do { if constexpr (FP8) { _Pragma("unroll") for (int m = 0; m < 4; ++m) dst##8[m] = PG8_LD8(lds + PG8_SA(b, h) + aoff + m * 2048); } else { \
        _Pragma("unroll") for (int m = 0; m < 4; ++m) _Pragma("unroll") for (int k = 0; k < 2; ++k) dst[m][k] = *(const PG8_LAS bf16x8*)(lds + PG8_SA(b, h) + aoff + m * 2048 + k * 1024); } } while (0)
#define PG8_LDB(dst, b, h) do { if constexpr (FP8) { _Pragma("unroll") for (int n = 0; n < 2; ++n) dst##8[n] = PG8_LD8(lds + PG8_SB(b, h) + boff + n * 2048); } else { \
        _Pragma("unroll") for (int n = 0; n < 2; ++n) _Pragma("unroll") for (int k = 0; k < 2; ++k) dst[n][k] = *(const PG8_LAS bf16x8*)(lds + PG8_SB(b, h) + boff + n * 2048 + k * 1024); } } while (0)
#define PG8_MMA(ai, bj, At, Bt) do { __builtin_amdgcn_s_setprio(1); if constexpr (FP8) { _Pragma("unroll") for (int m = 0; m < 4; ++m) _Pragma("unroll") for (int n = 0; n < 2; ++n) \
        asm volatile("v_mfma_scale_f32_16x16x128_f8f6f4 %0, %1, %2, %0, %3, %3 op_sel_hi:[0,0,0]" : "+v"(acc[ai][bj][m][n]) : "v"(Bt##8[n]), "v"(At##8[m]), "v"(one8)); } else { \
        _Pragma("unroll") for (int m = 0; m < 4; ++m) _Pragma("unroll") for (int n = 0; n < 2; ++n) _Pragma("unroll") for (int k = 0; k < 2; ++k) \
        acc[ai][bj][m][n] = __builtin_amdgcn_mfma_f32_16x16x32_bf16(Bt[n][k], At[m][k], acc[ai][bj][m][n], 0, 0, 0); } __builtin_amdgcn_s_setprio(0); } while (0)
#define PG8_WAIT_V(n) asm volatile("s_waitcnt vmcnt(" #n ")" ::: "memory")
#define PG8_WAIT_L(n) asm volatile("s_waitcnt lgkmcnt(" #n ")" ::: "memory")
#define PG8_BAR __builtin_amdgcn_s_barrier()
#define PG8_SCHED __builtin_amdgcn_sched_barrier(0)
#define PG8_GLOAD(dst, u) do { if constexpr (GATHER) { const int t2_ = make_tid(wave0); _Pragma("unroll") for (int _i = 0; _i < 2; ++_i) { int R_, C_; stage_rc(t2_ * 16 + _i * 8192, R_, C_); \
        _Pragma("unroll") for (int _h = 0; _h < 2; ++_h) dst[_h][_i] = (unsigned)((u).gidx[_h * HALF + R_] * g.lda + C_) * 2u; } } } while (0)
    Unit cur, nxt; int ui = 0;
    if (!S.next(0, cur)) return;
    f32x4 acc[2][2][4][2];
#pragma unroll
    for (int a = 0; a < 2; ++a)
#pragma unroll
        for (int b = 0; b < 2; ++b)
#pragma unroll
            for (int m = 0; m < 4; ++m)
#pragma unroll
                for (int n = 0; n < 2; ++n) acc[a][b][m][n] = (f32x4){0.f, 0.f, 0.f, 0.f};
    bf16x8 At[4][2], B0[2][2], B1[2][2]; v8i_t At8[4], B08[2], B18[2];
    int one8 = 0x7f7f7f7f; asm volatile("" : "+v"(one8));
    const char* cA = (const char*)g.A + cur.a_off; const char* cB = (const char*)g.Bt + cur.b_off;
    PG8_GLOAD(gvc, cur);
#pragma unroll
    for (int _h = 0; _h < 2; ++_h)
#pragma unroll
        for (int _i = 0; _i < 2; ++_i) gvn[_h][_i] = 0u;
    PG8_STAGE(PG8_SB(0, 0), cB, voffB); PG8_STAGE(PG8_SB(0, 1), cB + hstepB, voffB); PG8_STAGE_A(PG8_SA(0, 0), cA, 0, false); PG8_STAGE_A(PG8_SA(0, 1), cA, 1, false);
    if (wr == 1) PG8_BAR;
    PG8_WAIT_V(2); PG8_BAR;
    PG8_STAGE(PG8_SB(1, 0), cB + kstep, voffB); PG8_STAGE_A(PG8_SA(1, 0), cA + kstep, 0, false); PG8_STAGE(PG8_SB(1, 1), cB + hstepB + kstep, voffB);
    PG8_WAIT_V(6); PG8_BAR;
    for (;;) {
        const bool has_next = S.next(ui + 1, nxt);
        const char* nA = has_next ? (const char*)g.A + nxt.a_off : cA; const char* nB = has_next ? (const char*)g.Bt + nxt.b_off : cB;
        if constexpr (GATHER) { if (has_next) { PG8_GLOAD(gvn, nxt); } else {
#pragma unroll
            for (int _h = 0; _h < 2; ++_h)
#pragma unroll
                for (int _i = 0; _i < 2; ++_i) gvn[_h][_i] = gvc[_h][_i]; } }
        for (int t = 0; t < nt; t += 2) {
            const bool last = (t == nt - 2);
            const char* a1 = cA + (size_t)(t + 1) * kstep;
            const char* a2 = last ? nA : cA + (size_t)(t + 2) * kstep; const char* b2 = last ? nB : cB + (size_t)(t + 2) * kstep;
            const char* a3 = a2 + kstep; const char* b3 = b2 + kstep;
            if constexpr (Epi::MID) { if (t == Epi::MID_T0 || t == Epi::MID_T1) {
                if (wr == 0) PG8_BAR;
#define PG8_MIDROW(ai, m) do { f32x4 v_[2][2] = {{acc[ai][0][m][0], acc[ai][0][m][1]}, {acc[ai][1][m][0], acc[ai][1][m][1]}}; \
                int r_ = cur.pm * BM + (ai) * HALF + wr * 64 + (m) * 16 + fr; asm volatile("" : "+v"(r_)); E.mid_row(cur, r_, t, wc, fq, v_); \
                acc[ai][0][m][0] = v_[0][0]; acc[ai][0][m][1] = v_[0][1]; acc[ai][1][m][0] = v_[1][0]; acc[ai][1][m][1] = v_[1][1]; asm volatile("" ::: "memory"); } while (0)
                PG8_MIDROW(0, 0); PG8_MIDROW(0, 1); PG8_MIDROW(0, 2); PG8_MIDROW(0, 3); PG8_MIDROW(1, 0); PG8_MIDROW(1, 1); PG8_MIDROW(1, 2); PG8_MIDROW(1, 3);
#undef PG8_MIDROW
                if (wr == 1) PG8_BAR;
            } }
            PG8_LDB(B0, 0, 0); PG8_LDB(B1, 0, 1); PG8_SCHED; PG8_LDA(At, 0, 0); PG8_STAGE_A(PG8_SA(1, 1), a1, 1, false);
            PG8_WAIT_V(8); PG8_WAIT_L(0); PG8_BAR; PG8_MMA(0, 0, At, B0); PG8_MMA(0, 1, At, B1); PG8_BAR; PG8_SCHED;
            PG8_LDA(At, 0, 1); PG8_STAGE(PG8_SB(0, 0), b2, voffB); PG8_STAGE(PG8_SB(0, 1), b2 + hstepB, voffB); PG8_STAGE_A(PG8_SA(0, 0), a2, 0, last);
            PG8_WAIT_V(8); PG8_WAIT_L(0); PG8_BAR; PG8_MMA(1, 0, At, B0); PG8_MMA(1, 1, At, B1); PG8_BAR; PG8_SCHED;
            PG8_LDB(B0, 1, 0); PG8_LDB(B1, 1, 1); PG8_SCHED; PG8_LDA(At, 1, 0); PG8_STAGE_A(PG8_SA(0, 1), a2, 1, last);
            PG8_WAIT_V(8); PG8_WAIT_L(0); PG8_BAR; PG8_MMA(0, 0, At, B0); PG8_MMA(0, 1, At, B1); PG8_BAR; PG8_SCHED;
            PG8_LDA(At, 1, 1); PG8_STAGE(PG8_SB(1, 0), b3, voffB); PG8_STAGE(PG8_SB(1, 1), b3 + hstepB, voffB); PG8_STAGE_A(PG8_SA(1, 0), a3, 0, last);
            PG8_WAIT_V(8); PG8_WAIT_L(0); PG8_BAR; PG8_MMA(1, 0, At, B0); PG8_MMA(1, 1, At, B1); PG8_BAR; PG8_SCHED;
        }
        if constexpr (FP8) asm volatile("s_nop 15\n\ts_nop 15" ::: "memory");
        if (wr == 0) PG8_BAR;
        {
#define PG8_ROW(ai, m) do { const f32x4 v_[2][2] = {{acc[ai][0][m][0], acc[ai][0][m][1]}, {acc[ai][1][m][0], acc[ai][1][m][1]}}; \
            int r_ = cur.pm * BM + (ai) * HALF + wr * 64 + (m) * 16 + fr; asm volatile("" : "+v"(r_)); E.row(cur, r_, (ai) * 4 + (m), wc, fq, v_); asm volatile("" ::: "memory"); } while (0)
            PG8_ROW(0, 0); PG8_ROW(0, 1); PG8_ROW(0, 2); PG8_ROW(0, 3); PG8_ROW(1, 0); PG8_ROW(1, 1); PG8_ROW(1, 2); PG8_ROW(1, 3);
#undef PG8_ROW
        }
        if (!has_next) break;
#pragma unroll
        for (int a = 0; a < 2; ++a)
#pragma unroll
            for (int b = 0; b < 2; ++b)
#pragma unroll
                for (int m = 0; m < 4; ++m)
#pragma unroll
                    for (int n = 0; n < 2; ++n) acc[a][b][m][n] = (f32x4){0.f, 0.f, 0.f, 0.f};
        cur = nxt; cA = nA; cB = nB; ++ui;
        if constexpr (GATHER) {
#pragma unroll
            for (int _h = 0; _h < 2; ++_h)
#pragma unroll
                for (int _i = 0; _i < 2; ++_i) gvc[_h][_i] = gvn[_h][_i]; }
        if (wr == 1) PG8_BAR;
    }
    PG8_WAIT_V(0);
    PG8_BAR;
#undef PG8_SA
#undef PG8_SB
#undef PG8_STAGE
#undef PG8_STAGE_A
#undef PG8_LDA
#undef PG8_LD8
#undef PG8_LDB
#undef PG8_MMA
#undef PG8_WAIT_V
#undef PG8_WAIT_L
#undef PG8_BAR
#undef PG8_SCHED
#undef PG8_GLOAD
}

template <bool PERM>
__device__ __forceinline__ void small_tile(PG8_LAS unsigned char* lds, const bf16_t* A16, int lda, const bf16_t* Bt, int ldb, int K, int pn, int wc, f32x4 (&v)[2][2], int wave0) {
    const int tid = make_tid(wave0), wid = __builtin_amdgcn_readfirstlane(tid >> 6), lane = tid & 63, fr = lane & 15, fq = lane >> 4;
    const int kper = K >> 3, k0 = wid * kper;
    f32x4 acc[2][2];
#pragma unroll
    for (int bj = 0; bj < 2; ++bj)
#pragma unroll
        for (int n = 0; n < 2; ++n) acc[bj][n] = (f32x4){0.f, 0.f, 0.f, 0.f};
    const bf16_t* ap = A16 + (size_t)fr * lda + k0 + 8 * fq;
    const bf16_t* bp[2][2];
#pragma unroll
    for (int bj = 0; bj < 2; ++bj)
#pragma unroll
        for (int n = 0; n < 2; ++n) { const int rr = PERM ? perm32(16 * n + fr) : 16 * n + fr; bp[bj][n] = Bt + (size_t)(pn * 256 + bj * 128 + wc * 32 + rr) * ldb + k0 + 8 * fq; }
    for (int k = 0; k < kper; k += 32) {
        const bf16x8 a = *(const bf16x8*)(ap + k);
#pragma unroll
        for (int bj = 0; bj < 2; ++bj)
#pragma unroll
            for (int n = 0; n < 2; ++n) { const bf16x8 b = *(const bf16x8*)(bp[bj][n] + k); acc[bj][n] = __builtin_amdgcn_mfma_f32_16x16x32_bf16(b, a, acc[bj][n], 0, 0, 0); }
    }
    PG8_LAS f32x4* red = (PG8_LAS f32x4*)lds;
#pragma unroll
    for (int bj = 0; bj < 2; ++bj)
#pragma unroll
        for (int n = 0; n < 2; ++n) red[(wid * 4 + bj * 2 + n) * 64 + lane] = acc[bj][n];
    __syncthreads();
    if (wid == 0) {
#pragma unroll
        for (int bj = 0; bj < 2; ++bj)
#pragma unroll
            for (int n = 0; n < 2; ++n) { f32x4 s = red[(bj * 2 + n) * 64 + lane];
#pragma unroll
                for (int w = 1; w < 8; ++w) s += red[(w * 4 + bj * 2 + n) * 64 + lane];
                v[bj][n] = s; }
    }
    __syncthreads();
}
}
namespace attn_body {
using bf16=__hip_bfloat16;
using bf16x8=__attribute__((ext_vector_type(8)))short;
using s16x4=__attribute__((ext_vector_type(4)))short;
using f32x16=__attribute__((ext_vector_type(16)))float;
using u32x4=__attribute__((ext_vector_type(4)))unsigned;
constexpr int BATCH=4,SEQ=4352,D=64,QKP=1024,VP=512,OP=1024;
constexpr int NW=8,QBLK=32,QB=QBLK*NW,KVBLK=64,NQB=SEQ/QB;
constexpr int ATTN_UNIT_ROWS=QB;
__device__ __forceinline__ int crow(int r,int hi){return (r&3)+8*(r>>2)+4*hi;}
#define SBAR() __builtin_amdgcn_sched_barrier(0)
__device__ __forceinline__ void cmask(f32x16&p0,f32x16&p1,int jb,int qrel,int hi){
  const float NEG=-INFINITY; int kb=64*jb+4*hi;
  #pragma unroll
  for(int r=0;r<16;++r){int kv=kb+(r&3)+8*(r>>2); if(kv>qrel)p0[r]=NEG; if(kv+32>qrel)p1[r]=NEG;}
}

__device__ __forceinline__ void biasmask(f32x16&p0,f32x16&p1,int jb,int qrel,int hi,const __attribute__((address_space(3))) float*tab){
  const float NEG=-INFINITY; const int kb=64*jb+4*hi;
  #pragma unroll
  for(int r=0;r<16;++r){const int n0=qrel-(kb+(r&3)+8*(r>>2)),n1=n0-32;
    const float b0=tab[n0<0?0:(n0>127?127:n0)],b1=tab[n1<0?0:(n1>127?127:n1)];
    p0[r]=n0<0?NEG:p0[r]+b0; p1[r]=n1<0?NEG:p1[r]+b1;}
}
constexpr int NSLOT=3, SLOTB=8192;
constexpr int VSLOTB=2*SLOTB;
constexpr int LDS_K=0, LDS_V=NSLOT*SLOTB, LDS_WS=LDS_V+NSLOT*VSLOTB, LDS_TAB=LDS_WS+NW*64*4, LDS_OST=0  , LDS_BYTES=LDS_TAB+2048;
constexpr float C2=0.125f*1.4426950408889634f;
__device__ __forceinline__ void glds16(const void*gsrc,unsigned lds_dst){unsigned keep;
  asm volatile("s_mov_b32 %0, m0\n\ts_mov_b32 m0, %2\n\ts_nop 0\n\tglobal_load_lds_dwordx4 %1, off\n\ts_mov_b32 m0, %0":"=&s"(keep):"v"(gsrc),"s"(lds_dst):"memory");}
__device__ __forceinline__ float max3f(float a,float b,float c){float r;asm("v_max3_f32 %0, %1, %2, %3":"=v"(r):"v"(a),"v"(b),"v"(c));return r;}
__device__ __forceinline__ float max2f(float a,float b){float r;asm("v_max_f32_e32 %0, %1, %2":"=v"(r):"v"(a),"v"(b));return r;}
__device__ __forceinline__ float fadd_s(float a,float b){float r;asm("v_add_f32_e32 %0, %1, %2":"=v"(r):"v"(a),"v"(b));return r;}
__device__ __forceinline__ float fsub_s(float a,float b){float r;asm("v_sub_f32_e32 %0, %1, %2":"=v"(r):"v"(a),"v"(b));return r;}
typedef float f32x2_t __attribute__((ext_vector_type(2))); typedef __bf16 bf16x2_t __attribute__((ext_vector_type(2)));
__device__ __forceinline__ unsigned cvtpk_s(float lo,float hi){f32x2_t v={lo,hi};bf16x2_t b=__builtin_convertvector(v,bf16x2_t);return __builtin_bit_cast(unsigned,b);}
#define WAIT_BAR(N) asm volatile("s_waitcnt vmcnt(" #N ") lgkmcnt(0)\n\ts_barrier":::"memory")

__device__ __forceinline__ void qkt(f32x16&p0,f32x16&p1,const char*Kslot,const bf16x8*qr,const f32x16&negm,int r32,int hi){
  const char*kb=Kslot+hi*1024+r32*16;
  #pragma unroll
  for(int d0=0;d0<4;++d0){
    const bf16x8 b0=*reinterpret_cast<const bf16x8*>(kb+d0*2048);
    const bf16x8 b1=*reinterpret_cast<const bf16x8*>(kb+d0*2048+512);
    if(d0==0){p0=__builtin_amdgcn_mfma_f32_32x32x16_bf16(b0,qr[0],negm,0,0,0);p1=__builtin_amdgcn_mfma_f32_32x32x16_bf16(b1,qr[0],negm,0,0,0);}
    else{p0=__builtin_amdgcn_mfma_f32_32x32x16_bf16(b0,qr[d0],p0,0,0,0);p1=__builtin_amdgcn_mfma_f32_32x32x16_bf16(b1,qr[d0],p1,0,0,0);}}
}
typedef __attribute__((address_space(3))) const char* lds_cptr;
typedef short v4i16_t __attribute__((ext_vector_type(4)));
__device__ __forceinline__ void kload8(bf16x8*kf,lds_cptr kp){
  kf[0]=*(const __attribute__((address_space(3))) bf16x8*)(kp);      kf[1]=*(const __attribute__((address_space(3))) bf16x8*)(kp+512);
  kf[2]=*(const __attribute__((address_space(3))) bf16x8*)(kp+2048); kf[3]=*(const __attribute__((address_space(3))) bf16x8*)(kp+2560);
  kf[4]=*(const __attribute__((address_space(3))) bf16x8*)(kp+4096); kf[5]=*(const __attribute__((address_space(3))) bf16x8*)(kp+4608);
  kf[6]=*(const __attribute__((address_space(3))) bf16x8*)(kp+6144); kf[7]=*(const __attribute__((address_space(3))) bf16x8*)(kp+6656);
}
__device__ __forceinline__ void kload2(bf16x8*kf,lds_cptr kp,int j){ kf[2*j]=*(const __attribute__((address_space(3))) bf16x8*)(kp+j*2048); kf[2*j+1]=*(const __attribute__((address_space(3))) bf16x8*)(kp+j*2048+512); }
__device__ __forceinline__ s16x4 vtr(lds_cptr p){ return __builtin_bit_cast(s16x4,__builtin_amdgcn_ds_read_tr16_b64_v4i16((__attribute__((address_space(3))) v4i16_t*)p)); }
__device__ __forceinline__ float rowmax(const f32x16&p0,const f32x16&p1){
  float a=max3f(p0[0],p0[1],p1[0]),b=max3f(p0[2],p0[3],p1[1]);a=max3f(a,p1[2],p1[3]);
  #pragma unroll
  for(int r=4;r<16;r+=4){a=max3f(a,p0[r],p0[r+1]);b=max3f(b,p0[r+2],p0[r+3]);a=max3f(a,p1[r],p1[r+1]);b=max3f(b,p1[r+2],p1[r+3]);}
  const float m=max2f(a,b);
  auto rr=__builtin_amdgcn_permlane32_swap(__float_as_uint(m),__float_as_uint(m),false,false);
  return max2f(__uint_as_float(rr[0]),__uint_as_float(rr[1]));
}
__device__ __forceinline__ void pv(f32x16*o,int vb,bf16x8 pa0,bf16x8 pa1,bf16x8 pa2,bf16x8 pa3){
  #pragma unroll
  for(int d0=0;d0<4;++d0){s16x4 lo[4],hi[4];
    #pragma unroll
    for(int ks=0;ks<4;++ks){
      asm volatile("ds_read_b64_tr_b16 %0,%1 offset:%c2":"=&v"(lo[ks]):"v"(vb),"i"(d0*4096+ks*1024):"memory");
      asm volatile("ds_read_b64_tr_b16 %0,%1 offset:%c2":"=&v"(hi[ks]):"v"(vb),"i"(d0*4096+ks*1024+512):"memory");}
    asm volatile("s_waitcnt lgkmcnt(0)":::"memory");SBAR();
    #define PK(k) (bf16x8){lo[k][0],lo[k][1],lo[k][2],lo[k][3],hi[k][0],hi[k][1],hi[k][2],hi[k][3]}
    o[d0]=__builtin_amdgcn_mfma_f32_32x32x16_bf16(pa0,PK(0),o[d0],0,0,0);
    o[d0]=__builtin_amdgcn_mfma_f32_32x32x16_bf16(pa1,PK(1),o[d0],0,0,0);
    o[d0]=__builtin_amdgcn_mfma_f32_32x32x16_bf16(pa2,PK(2),o[d0],0,0,0);
    o[d0]=__builtin_amdgcn_mfma_f32_32x32x16_bf16(pa3,PK(3),o[d0],0,0,0);
    #undef PK
  }
}

#ifndef ATTN_STORE16
#define ATTN_STORE16(p,v) (*(u32x4*)(p)=(v))
#endif
template<int THRL> __device__ __forceinline__ void attn_unit(int b,int vh,int qb,const bf16*__restrict__ QK,const bf16*__restrict__ V,bf16*O,char*shm,int wave0){
  const int mp=vh>>2,hh=vh&3; const int qcol=(mp*4+hh)*64,kcol=512+(mp*4+hh)*64,vcol=hh*128,ocol=mp*512+hh*128;
  const int tid=pg8::make_tid(wave0),lane=tid&63,r32=lane&31,hi=lane>>5; const int wid=__builtin_amdgcn_readfirstlane(tid>>6);
  const long rowbase=(long)b*SEQ; const int q0=qb*QB;
  const bf16*Qw=QK+(rowbase+q0+wid*QBLK)*QKP+qcol;
  const bf16*Kh=QK+rowbase*QKP+kcol,*Vh=V+rowbase*VP+vcol;
  const __attribute__((address_space(3))) float*tab=(const __attribute__((address_space(3))) float*)((__attribute__((address_space(3))) char*)shm+LDS_TAB)+hh*128;
  const unsigned lds0=(unsigned)(uintptr_t)shm;
  float*wsf=(float*)(shm+LDS_WS)+wid*64;
  const bf16*ksrc=Kh+(long)lane*QKP+wid*8;
  const bf16*vsrc=Vh+(long)(16*(wid&3)+(lane>>2))*VP+(wid>>2)*32+(lane&3)*8;
  const unsigned kdst=lds0+LDS_K+wid*1024, vdst=lds0+LDS_V+wid*1024;
  #define DMA_K(t,slot) glds16(ksrc+(long)(t)*KVBLK*QKP,(unsigned)__builtin_amdgcn_readfirstlane(kdst+(slot)))
  #define DMA_V(t,slot) do{ glds16(vsrc+(long)(t)*KVBLK*VP,(unsigned)__builtin_amdgcn_readfirstlane(vdst+2*(slot))); glds16(vsrc+64+(long)(t)*KVBLK*VP,(unsigned)__builtin_amdgcn_readfirstlane(vdst+2*(slot)+8192)); }while(0)
  const int vb0=(int)(lds0+LDS_V)+((lane>>4)&1)*32+(lane&3)*8+(4*hi+((lane&15)>>2))*64;
  const char*Kbase=shm+LDS_K; bf16x8 kf[8];
  const lds_cptr shm3=(lds_cptr)shm; const lds_cptr kp0=shm3+LDS_K+hi*1024+r32*16; const lds_cptr vp0=shm3+LDS_V+((lane>>4)&1)*32+(lane&3)*8+(4*hi+((lane&15)>>2))*64;
  const int NT=(q0+QB)/KVBLK;
  DMA_K(0,0);DMA_V(0,0);DMA_K(1,SLOTB);
  bf16x8 qr[4];
  #pragma unroll
  for(int d0=0;d0<4;++d0)qr[d0]=*reinterpret_cast<const bf16x8*>(&Qw[(long)r32*QKP+d0*16+hi*8]);
  float mhat=0.f,l_reg=0.f;f32x16 o[4];o[0]=f32x16{};o[1]=f32x16{};o[2]=f32x16{};o[3]=f32x16{};f32x16 negm=f32x16{};asm volatile("":"+v"(negm));
  const int qrel=wid*QBLK+r32;
  #define CMASK(P0,P1,t) do{int jb_=(t)-(NT-4); if(jb_>=-2)biasmask(P0,P1,jb_,qrel,hi,tab);}while(0)
  bool resc=false;
  #define START(P0,P1) do{ const float rm=rowmax(P0,P1); resc=false; \
    { const float dl=rm; mhat=fadd_s(mhat,dl); \
      _Pragma("unroll") for(int r=0;r<16;++r){P0[r]=fsub_s(P0[r],dl);P1[r]=fsub_s(P1[r],dl);} \
      _Pragma("unroll") for(int r=0;r<16;++r)negm[r]=-mhat; asm volatile("":"+v"(negm)); } \
    _Pragma("unroll") for(int r=0;r<16;++r)P0[r]=__builtin_amdgcn_exp2f(P0[r]); }while(0)
  #define RESC() do{ if(resc){ asm volatile("s_waitcnt lgkmcnt(0)":::"memory"); \
      _Pragma("unroll") for(int d_=0;d_<4;++d_) _Pragma("unroll") for(int r=0;r<16;++r)o[d_][r]*=wsf[crow(r,hi)]; } }while(0)
  f32x16 pA0,pA1,pB0,pB1;
  int sl_prev=0,sl_cur=0,sl_next=SLOTB;
  #define ROT() do{sl_prev=sl_cur;sl_cur=sl_next;sl_next=(sl_next==(NSLOT-1)*SLOTB)?0:sl_next+SLOTB;}while(0)
  DMA_K(2,2*SLOTB);
  WAIT_BAR(4);
  qkt(pA0,pA1,Kbase,qr,negm,r32,hi);asm volatile("s_nop 15\n\ts_nop 7":"+v"(pA0),"+v"(pA1));CMASK(pA0,pA1,0);
  START(pA0,pA1);
  _Pragma("unroll") for(int r=0;r<16;++r)pA1[r]=__builtin_amdgcn_exp2f(pA1[r]);
  WAIT_BAR(0);
  DMA_K(3,0);DMA_V(1,SLOTB);
  ROT();
  kload8(kf,kp0+sl_cur);
  WAIT_BAR(3);
  s16x4 vlo[4],vhi[4]; u32x4 pw0,pw1,pw2,pw3;
  #define PKW(P,B) cvtpk_s(P[B],P[B+1])
  #define PAF(k) __builtin_bit_cast(bf16x8,pw##k)
  #define VFR(i) (bf16x8){vlo[i][0],vlo[i][1],vlo[i][2],vlo[i][3],vhi[i][0],vhi[i][1],vhi[i][2],vhi[i][3]}
  #define PIN(x) asm volatile("":"+v"(x))
  #define MX3(a,b,c) __builtin_fmaxf(__builtin_fmaxf((a),(b)),(c))
  #define GAPA(MF,A0,A1,A2,A3,W0,W1,PW) do{ MF; sacc+=A0; sacc+=A1; sacc+=A2; sacc+=A3; PIN(sacc); W0; W1; PIN(PW); SBAR(); }while(0)
  #define EX(v) __builtin_amdgcn_exp2f(v)
  #define GAPB(MF,VR,X,B) do{ MF; VR; X[B]=EX(X[B]); X[B+1]=EX(X[B+1]); PIN(X); SBAR(); }while(0)
  #define VRJ(kg,d0) do{ vlo[d0]=vtr(vp_+((d0)*4096+(kg)*1024)); vhi[d0]=vtr(vp_+((d0)*4096+(kg)*1024+512)); }while(0)
  #define KRD(G,j) do{ if(G){ kload2(kf,kp0+sl_next,j); SBAR(); } }while(0)
  #define STEP(C0,C1,P0,P1,t,GK,GV,GL) do{ SBAR(); \
    const lds_cptr vp_=vp0+2*sl_prev; \
    float sacc=(P0[0]+P0[1]); \
    GAPA(C0=__builtin_amdgcn_mfma_f32_32x32x16_bf16(kf[0],qr[0],negm,0,0,0), P0[2],P0[3],P0[4],P0[5],     pw0[0]=PKW(P0,0), pw0[1]=PKW(P0,2), pw0); \
    GAPA(C1=__builtin_amdgcn_mfma_f32_32x32x16_bf16(kf[1],qr[0],negm,0,0,0), P0[6],P0[7],P0[8],P0[9],     pw0[2]=PKW(P0,4), pw0[3]=PKW(P0,6), pw0); \
    GAPA(C0=__builtin_amdgcn_mfma_f32_32x32x16_bf16(kf[2],qr[1],C0,0,0,0),   P0[10],P0[11],P0[12],P0[13], pw1[0]=PKW(P0,8), pw1[1]=PKW(P0,10), pw1); \
    GAPA(C1=__builtin_amdgcn_mfma_f32_32x32x16_bf16(kf[3],qr[1],C1,0,0,0),   P0[14],P0[15],P1[0],P1[1],   pw1[2]=PKW(P0,12),pw1[3]=PKW(P0,14), pw1); \
    GAPA(C0=__builtin_amdgcn_mfma_f32_32x32x16_bf16(kf[4],qr[2],C0,0,0,0),   P1[2],P1[3],P1[4],P1[5],     pw2[0]=PKW(P1,0), pw2[1]=PKW(P1,2), pw2); \
    GAPA(C1=__builtin_amdgcn_mfma_f32_32x32x16_bf16(kf[5],qr[2],C1,0,0,0),   P1[6],P1[7],P1[8],P1[9],     pw2[2]=PKW(P1,4), pw2[3]=PKW(P1,6), pw2); \
    GAPA(C0=__builtin_amdgcn_mfma_f32_32x32x16_bf16(kf[6],qr[3],C0,0,0,0),   P1[10],P1[11],P1[12],P1[13], pw3[0]=PKW(P1,8), pw3[1]=PKW(P1,10), pw3); \
    GAPA(C1=__builtin_amdgcn_mfma_f32_32x32x16_bf16(kf[7],qr[3],C1,0,0,0),   P1[14],P1[15],0.f,0.f,       pw3[2]=PKW(P1,12),pw3[3]=PKW(P1,14), pw3); \
    l_reg+=sacc; \
    if(GK){DMA_K((t)+3,sl_cur);} if(GV){DMA_V((t)+1,sl_next);} \
    VRJ(0,0); VRJ(0,1); VRJ(0,2); VRJ(0,3); SBAR(); \
    CMASK(C0,C1,t); \
    { float a=MX3(C0[0],C0[1],C1[0]),b=MX3(C0[2],C0[3],C1[1]); a=MX3(a,C1[2],C1[3]); \
      _Pragma("unroll") for(int r=4;r<16;r+=4){a=MX3(a,C0[r],C0[r+1]);b=MX3(b,C0[r+2],C0[r+3]);a=MX3(a,C1[r],C1[r+1]);b=MX3(b,C1[r+2],C1[r+3]);} \
      float rm=__builtin_fmaxf(a,b); { auto rr=__builtin_amdgcn_permlane32_swap(__float_as_uint(rm),__float_as_uint(rm),false,false); rm=__builtin_fmaxf(__uint_as_float(rr[0]),__uint_as_float(rr[1])); } \
      resc=false; \
      if(__builtin_expect(__any(rm>(float)THRL),0)){ const float dl=__builtin_fmaxf(rm,0.f); mhat+=dl; \
        _Pragma("unroll") for(int r=0;r<16;++r){C0[r]-=dl;C1[r]-=dl;} \
        _Pragma("unroll") for(int r=0;r<16;++r)negm[r]=-mhat; asm volatile("":"+v"(negm)); \
        const float f=__builtin_amdgcn_exp2f(-dl); l_reg*=f; if(hi==0)wsf[r32]=f; resc=true; } } \
    SBAR(); \
    GAPB(o[0]=__builtin_amdgcn_mfma_f32_32x32x16_bf16(PAF(0),VFR(0),o[0],0,0,0), VRJ(1,0), C0,0); \
    GAPB(o[1]=__builtin_amdgcn_mfma_f32_32x32x16_bf16(PAF(0),VFR(1),o[1],0,0,0), VRJ(1,1), C0,2); \
    GAPB(o[2]=__builtin_amdgcn_mfma_f32_32x32x16_bf16(PAF(0),VFR(2),o[2],0,0,0), VRJ(1,2), C0,4); \
    GAPB(o[3]=__builtin_amdgcn_mfma_f32_32x32x16_bf16(PAF(0),VFR(3),o[3],0,0,0), VRJ(1,3), C0,6); \
    GAPB(o[0]=__builtin_amdgcn_mfma_f32_32x32x16_bf16(PAF(1),VFR(0),o[0],0,0,0), VRJ(2,0), C0,8); \
    KRD(GL,0); GAPB(o[1]=__builtin_amdgcn_mfma_f32_32x32x16_bf16(PAF(1),VFR(1),o[1],0,0,0), VRJ(2,1), C0,10); \
    GAPB(o[2]=__builtin_amdgcn_mfma_f32_32x32x16_bf16(PAF(1),VFR(2),o[2],0,0,0), VRJ(2,2), C0,12); \
    KRD(GL,1); GAPB(o[3]=__builtin_amdgcn_mfma_f32_32x32x16_bf16(PAF(1),VFR(3),o[3],0,0,0), VRJ(2,3), C0,14); \
    GAPB(o[0]=__builtin_amdgcn_mfma_f32_32x32x16_bf16(PAF(2),VFR(0),o[0],0,0,0), VRJ(3,0), C1,0); \
    KRD(GL,2); GAPB(o[1]=__builtin_amdgcn_mfma_f32_32x32x16_bf16(PAF(2),VFR(1),o[1],0,0,0), VRJ(3,1), C1,2); \
    GAPB(o[2]=__builtin_amdgcn_mfma_f32_32x32x16_bf16(PAF(2),VFR(2),o[2],0,0,0), VRJ(3,2), C1,4); \
    KRD(GL,3); GAPB(o[3]=__builtin_amdgcn_mfma_f32_32x32x16_bf16(PAF(2),VFR(3),o[3],0,0,0), VRJ(3,3), C1,6); \
    GAPB(o[0]=__builtin_amdgcn_mfma_f32_32x32x16_bf16(PAF(3),VFR(0),o[0],0,0,0), (void)0, C1,8); \
    GAPB(o[1]=__builtin_amdgcn_mfma_f32_32x32x16_bf16(PAF(3),VFR(1),o[1],0,0,0), (void)0, C1,10); \
    GAPB(o[2]=__builtin_amdgcn_mfma_f32_32x32x16_bf16(PAF(3),VFR(2),o[2],0,0,0), (void)0, C1,12); \
    GAPB(o[3]=__builtin_amdgcn_mfma_f32_32x32x16_bf16(PAF(3),VFR(3),o[3],0,0,0), (void)0, C1,14); \
    }while(0)
  int t=1;
  #undef CMASK
  #define CMASK(P0,P1,t) do{}while(0)
  for(;t+7<NT;t+=2){
    STEP(pB0,pB1,pA0,pA1,t,true,true,true);     WAIT_BAR(3); RESC(); ROT();
    STEP(pA0,pA1,pB0,pB1,t+1,true,true,true);   WAIT_BAR(3); RESC(); ROT();
  }
  #undef CMASK
  #define CMASK(P0,P1,t) do{int jb_=(t)-(NT-4); if(jb_>=-2)biasmask(P0,P1,jb_,qrel,hi,tab);}while(0)
  #define ENDW(tt) do{ if((tt)+3<NT){WAIT_BAR(3);} else if((tt)+2<NT){WAIT_BAR(2);} else {WAIT_BAR(0);} }while(0)
  for(;t+1<NT;t+=2){
    STEP(pB0,pB1,pA0,pA1,t,(t+3<NT),(t+1<NT),(t+1<NT));       ENDW(t);   RESC(); ROT();
    STEP(pA0,pA1,pB0,pB1,t+1,(t+4<NT),(t+2<NT),(t+2<NT));     ENDW(t+1); RESC(); ROT();
  }
  STEP(pB0,pB1,pA0,pA1,NT-1,false,false,false); RESC();
  { float sacc=pB0[0]+pB0[1]; _Pragma("unroll") for(int r=2;r<16;++r)sacc+=pB0[r]; _Pragma("unroll") for(int r=0;r<16;++r)sacc+=pB1[r]; l_reg+=sacc;
    pw0=(u32x4){PKW(pB0,0),PKW(pB0,2),PKW(pB0,4),PKW(pB0,6)};pw1=(u32x4){PKW(pB0,8),PKW(pB0,10),PKW(pB0,12),PKW(pB0,14)};pw2=(u32x4){PKW(pB1,0),PKW(pB1,2),PKW(pB1,4),PKW(pB1,6)};pw3=(u32x4){PKW(pB1,8),PKW(pB1,10),PKW(pB1,12),PKW(pB1,14)};
    SBAR(); pv(o,vb0+2*sl_cur,PAF(0),PAF(1),PAF(2),PAF(3)); }
  #undef PKW
  #undef PAF
  #undef VFR
  #undef PIN
  #undef MX3
  #undef GAPA
  #undef GAPB
  #undef EX
  #undef VRJ
  #undef KRD
  #undef STEP
  #undef ENDW
  {auto rr=__builtin_amdgcn_permlane32_swap(__float_as_uint(l_reg),__float_as_uint(l_reg),false,false);l_reg=__uint_as_float(rr[0])+__uint_as_float(rr[1]);}
  if(hi==0)wsf[32+r32]=l_reg;asm volatile("s_waitcnt lgkmcnt(0)":::"memory");
  float rli[16];
  #pragma unroll
  for(int r=0;r<16;++r)rli[r]=__builtin_amdgcn_rcpf(wsf[32+crow(r,hi)]);
  bf16*Ow=O+(rowbase+q0+wid*QBLK)*OP+ocol;
  asm volatile("s_waitcnt lgkmcnt(0)\n\ts_barrier":::"memory");
  { bf16*stg=(bf16*)(shm+LDS_OST)+wid*4096;
    #pragma unroll
    for(int r=0;r<16;++r){const int orow=crow(r,hi);
      #pragma unroll
      for(int d0=0;d0<4;++d0)stg[orow*128+d0*32+r32]=__float2bfloat16(o[d0][r]*rli[r]);}
    asm volatile("s_waitcnt lgkmcnt(0)":::"memory");
    #pragma unroll
    for(int i=0;i<8;++i){const int row=i*4+(lane>>4),ch=lane&15; const u32x4 v=*(const u32x4*)(stg+row*128+ch*8); ATTN_STORE16(Ow+(long)row*OP+ch*8,v);} }
  asm volatile("s_waitcnt lgkmcnt(0)\n\ts_barrier":::"memory");
  #undef DMA_K
  #undef DMA_V
  #undef CMASK
  #undef START
  #undef RESC
  #undef ROT
}
constexpr int ATTN_LDS_BYTES=LDS_BYTES;
__device__ __forceinline__ bool attn_next(int G,int vcu,int i,int&b,int&vh,int&qb){
  if(G==256){ const int g=vcu&7, bv=vcu>>3; int q=-1;
    if(g<7){ q=(i==0)?16-g:(i==1)?1+g:-1; } else { q=(i==0)?9:(i==1)?8:(i==2)?0:-1; }
    if(q<0)return false; b=bv>>3; vh=bv&7; qb=q; return true; }
  const int u=vcu+i*G; if(u>=BATCH*8*17)return false; b=u/(8*17); vh=(u/17)&7; qb=u%17; return true;
}
#undef SBAR
#undef WAIT_BAR
}
namespace mk {
using pg8::bf16_t; using pg8::bf16x8; using pg8::f32x4; using pg8::u32x4; using pg8::u32x2; using pg8::Unit; using pg8::Gemm; using pg8::cvt_pk_bf16;
constexpr int NWAVES = 8;
constexpr int D = 1024, NB = 4, SEQ = 4096, NM = 16, MR = NB * SEQ  , MROWS = MR + NM  , MPAD = 16640;
constexpr int TP = 4352, MATT = NB * TP;
constexpr int INC = 8192, FFD = 2816, FFE = 3584, NE = 8;
constexpr float EPS = 1e-6f, LOG2E = 1.4426950408889634f, C2 = 0.125f * LOG2E;
constexpr size_t MiB = 1u << 20;
constexpr size_t WS_CTL = 0, CTL_ZERO_BYTES = 1 * MiB;
constexpr size_t WS_SMALL = 1 * MiB;
constexpr size_t WS_HN = 3 * MiB;
constexpr size_t WS_WIN = 36 * MiB, WS_WBR = 52 * MiB, WS_WO = 55 * MiB, WS_WGU0 = 57 * MiB, WS_WD0 = 68 * MiB;
constexpr size_t WS_U = 74 * MiB;
constexpr size_t WS_O = 123 * MiB, WS_ST = 157 * MiB, WS_HQ = 190 * MiB, WS_LOGF = 207 * MiB, WS_HG = 240 * MiB;
constexpr size_t WS_QK = 257 * MiB, WS_V = 291 * MiB, WS_CONV = 308 * MiB, WS_HV = 357 * MiB, WS_DS = 374 * MiB;
constexpr size_t WS_GATES = 257 * MiB, WS_MIXED = 355 * MiB, WS_MSCR = 388 * MiB;
constexpr size_t WS_H0 = 123 * MiB;
constexpr size_t WS_DEC = 440 * MiB;
constexpr size_t WS_HQ2 = 441 * MiB, WS_OI = 458 * MiB;
constexpr size_t WS_MGU = 36 * MiB, WS_MD = 148 * MiB, WS_MH = 204 * MiB, WS_MY = 442 * MiB;
constexpr size_t WS_HN8 = 491 * MiB, WS_WIN8 = 508 * MiB;
constexpr size_t WS_SLAB = 36 * MiB;
constexpr int LISTCAP = 16640;
constexpr size_t SMB_LIST = 128 * 1024, SMB_TOK = 704 * 1024;
constexpr int CW_CNT = 8192;
constexpr int SM_SCAL = 0;
constexpr int SM_LOGLB = 64, SM_LOG1M = 64 + 1024;
constexpr int SM_TAB = 64 + 2048;
constexpr int SM_METAHS = 4096;
constexpr int RING_OFF = 0, RING_BYTES = 131072, LDSCTL_OFF = RING_BYTES, MISC_OFF = LDSCTL_OFF + 320, LDS_BYTES = 147456;

#define GAS __attribute__((address_space(1)))
#define LAS __attribute__((address_space(3)))
typedef GAS unsigned gu32;
#define RLX_AGENT __ATOMIC_RELAXED, __HIP_MEMORY_SCOPE_AGENT
#define LDS_WAIT() asm volatile("s_waitcnt lgkmcnt(0)" ::: "memory")
__device__ __forceinline__ unsigned f2bf(float f) { unsigned u = __builtin_bit_cast(unsigned, f); return (u + 0x7fffu + ((u >> 16) & 1u)) >> 16; }
__device__ __forceinline__ unsigned pk2(float lo, float hi) { return cvt_pk_bf16(lo, hi); }
__device__ __forceinline__ unsigned f2bf_hw(float f) { return cvt_pk_bf16(f, 0.f) & 0xffffu; }
__device__ __forceinline__ float bf2f(unsigned short b) { return __builtin_bit_cast(float, (unsigned)b << 16); }
__device__ __forceinline__ float bflo(unsigned w) { return __builtin_bit_cast(float, w << 16); }
__device__ __forceinline__ float bfhi(unsigned w) { return __builtin_bit_cast(float, w & 0xffff0000u); }
#ifdef SLOWMATH
__device__ __forceinline__ float sigm(float x) { return 1.f / (1.f + __expf(-x)); }
__device__ __forceinline__ float silu(float x) { return x / (1.f + __expf(-x)); }
#else
__device__ __forceinline__ float sigm(float x) { return __builtin_amdgcn_rcpf(1.f + __expf(-x)); }
__device__ __forceinline__ float silu(float x) { return x * __builtin_amdgcn_rcpf(1.f + __expf(-x)); }
#endif
#ifdef SLOWMATH
__device__ __forceinline__ float logf_gate(float z, float la, float lm) { const float ls = fminf(z, 0.f) - log1pf(expf(-fabsf(z))), bb = lm + ls; return (la == -INFINITY) ? bb : fmaxf(la, bb) + log1pf(expf(-fabsf(la - bb))); }
#else
__device__ __forceinline__ float logf_gate(float z, float la, float lm) { const float ls = fminf(z, 0.f) - __logf(1.f + __expf(-fabsf(z))), bb = lm + ls; return (la == -INFINITY) ? bb : fmaxf(la, bb) + __logf(1.f + __expf(-fabsf(la - bb))); }
#endif
template <int O> __device__ __forceinline__ float xadd(float v) {
    if constexpr (O < 32) return v + __builtin_bit_cast(float, __builtin_amdgcn_ds_swizzle(__builtin_bit_cast(int, v), (O << 10) | 0x1f));
    else { const int l = pg8::lane_id(); return v + __builtin_bit_cast(float, __builtin_amdgcn_ds_bpermute((l ^ 32) << 2, __builtin_bit_cast(int, v))); }
}
__device__ __forceinline__ float wave_sum(float v) { v = xadd<1>(v); v = xadd<2>(v); v = xadd<4>(v); v = xadd<8>(v); v = xadd<16>(v); return xadd<32>(v); }

#define XB_TMO      128
#define XB_XCNT(j)  (256  + 64 * (j))
#define XB_XSUB(j)  (1280 + 64 * (j))
#define XB_XGEN(j)  (2304 + 64 * (j))
#define XB_TOP      3328
#define XB_TOPGEN   3392
#define XCD_BAR_WORDS 3456
#define XB_SPIN_CAP (1u << 18)
__device__ __forceinline__ unsigned xb_ld(unsigned* p)              { return __hip_atomic_load(p, __ATOMIC_RELAXED, __HIP_MEMORY_SCOPE_AGENT); }
__device__ __forceinline__ unsigned xb_add(unsigned* p, unsigned v) { return __hip_atomic_fetch_add(p, v, __ATOMIC_RELAXED, __HIP_MEMORY_SCOPE_AGENT); }
__device__ __forceinline__ unsigned xb_xcc_id() { return (unsigned)__builtin_amdgcn_s_getreg((3 << 11) | 20) & 0xFu; }
#define XB_SPIN(cond, bar) do { unsigned _sp = 0; while (cond) { __builtin_amdgcn_s_sleep(1); \
    if ((++_sp & 255u) == 0u) { if (xb_ld(&(bar)[XB_TMO])) break; if (_sp > XB_SPIN_CAP) { atomicAdd(&(bar)[XB_TMO], 1u); break; } } } } while (0)
struct XcdBarrier { unsigned* bar; unsigned x; volatile LAS unsigned* st; };
__device__ __forceinline__ XcdBarrier xcd_barrier_post(unsigned* bar, volatile LAS unsigned* st, int tid) {
    XcdBarrier b; b.bar = bar; b.x = xb_xcc_id(); b.st = st;
    if (tid == 0) (void)xb_add(&bar[XB_XCNT(b.x)], 1u);
    return b;
}
__device__ __forceinline__ void xcd_barrier_complete(unsigned* bar, unsigned x, unsigned& nloc, unsigned& nx) {
    const unsigned G = gridDim.x * gridDim.y * gridDim.z;
    unsigned sum, cnt, mine, sp = 0u;
    for (;;) {
        sum = 0u; cnt = 0u; mine = 0u;
#pragma unroll
        for (unsigned j = 0; j < 16; ++j) { const unsigned c = xb_ld(&bar[XB_XCNT(j)]); sum += c; cnt += (c > 0u) ? 1u : 0u; mine = (j == x) ? c : mine; }
        if (sum == G) break;
        __builtin_amdgcn_s_sleep(1);
        if ((++sp & 255u) == 0u) { if (xb_ld(&bar[XB_TMO])) break; if (sp > XB_SPIN_CAP) { atomicAdd(&bar[XB_TMO], 1u); break; } }
    }
    nloc = mine > 0u ? mine : 1u; nx = cnt > 0u ? cnt : 1u;
}
__device__ __forceinline__ void xcd_barrier(const XcdBarrier& b, int tid) {
    asm volatile("s_waitcnt vmcnt(0)" ::: "memory");
    __syncthreads();
    if (tid == 0) {
        unsigned* bar = b.bar;
        __builtin_amdgcn_s_waitcnt(0);
        unsigned nloc = b.st[0], nx = b.st[1];
        if (nloc == 0u) { xcd_barrier_complete(bar, b.x, nloc, nx); b.st[0] = nloc; b.st[1] = nx; }
        const unsigned old = xb_add(&bar[XB_XSUB(b.x)], 1u);
        const unsigned gen = old / nloc, tgt = (gen + 1u) * nx;
        if (old + 1u == (gen + 1u) * nloc) {
            __builtin_amdgcn_fence(__ATOMIC_RELEASE, "agent");
            asm volatile("s_waitcnt vmcnt(0)" ::: "memory");
            (void)xb_add(&bar[XB_TOP], 1u);
        }
        XB_SPIN(xb_ld(&bar[XB_TOP]) < tgt, bar);
        __builtin_amdgcn_fence(__ATOMIC_ACQUIRE, "agent");
        asm volatile("s_waitcnt vmcnt(0)" ::: "memory");
    }
    __syncthreads();
}

struct Frame {
    LAS unsigned char* lds; unsigned char* lds_gen;
    int tid, lane, wave, vcu, G;
    const float* const* in; float* out; unsigned char* ws;
};
#define WSP(T, off) ((T*)(F.ws + (off)))
#define SMALLF (WSP(float, WS_SMALL))

__device__ __forceinline__ void cvt_block(const float* W, int ldw, int k0, int c0, bf16_t* WT, int ldt, int r0, LAS float* scr, int lane) {
    float wv[32];
    const float* wp = W + (size_t)(k0 + (lane >> 5)) * ldw + c0 + (lane & 31);
#pragma unroll
    for (int i = 0; i < 32; ++i) wv[i] = __builtin_nontemporal_load(wp + (size_t)(2 * i) * ldw);
#pragma unroll
    for (int i = 0; i < 32; ++i) scr[(2 * i + (lane >> 5)) * 33 + (lane & 31)] = wv[i];
    LDS_WAIT(); asm volatile("" ::: "memory");
    const int c = lane & 7;
#pragma unroll
    for (int j = 0; j < 4; ++j) { const int n = (lane >> 3) + 8 * j; const LAS float* s = scr + (8 * c) * 33 + n;
        u32x4 o; o.x = pk2(s[0 * 33], s[1 * 33]); o.y = pk2(s[2 * 33], s[3 * 33]); o.z = pk2(s[4 * 33], s[5 * 33]); o.w = pk2(s[6 * 33], s[7 * 33]);
        *(GAS u32x4*)(WT + (size_t)(r0 + n) * ldt + k0 + 8 * c) = o; }
    LDS_WAIT(); asm volatile("" ::: "memory");
}
constexpr float W8_SCALE = 32.f, H8_SCALE = 4.f, WD8_SCALE = 64.f;
__device__ __forceinline__ unsigned pk4_fp8(float a, float b, float c, float d) { int r = __builtin_amdgcn_cvt_pk_fp8_f32(a, b, 0, false); r = __builtin_amdgcn_cvt_pk_fp8_f32(c, d, r, true); return (unsigned)r; }
__device__ __forceinline__ void cvt_block_fp8(const float* W, int ldw, int k0, int c0, unsigned char* WT, int ldt, int r0, LAS float* scr, int lane, float wscale) {
    float wv[32];
    const float* wp = W + (size_t)(k0 + (lane >> 5)) * ldw + c0 + (lane & 31);
#pragma unroll
    for (int i = 0; i < 32; ++i) wv[i] = __builtin_nontemporal_load(wp + (size_t)(2 * i) * ldw);
#pragma unroll
    for (int i = 0; i < 32; ++i) scr[(2 * i + (lane >> 5)) * 33 + (lane & 31)] = wv[i] * wscale;
    LDS_WAIT(); asm volatile("" ::: "memory");
    const int c = lane & 7;
#pragma unroll
    for (int j = 0; j < 4; ++j) { const int n = (lane >> 3) + 8 * j; const LAS float* s = scr + (8 * c) * 33 + n;
        u32x2 o; o.x = pk4_fp8(s[0 * 33], s[1 * 33], s[2 * 33], s[3 * 33]); o.y = pk4_fp8(s[4 * 33], s[5 * 33], s[6 * 33], s[7 * 33]);
        *(GAS u32x2*)(WT + (size_t)(r0 + n) * ldt + k0 + 8 * c) = o; }
    LDS_WAIT(); asm volatile("" ::: "memory");
}
struct CvtItem { const float* W; int ldw, k0, c0; void* WT; int ldt, r0; };
__device__ __forceinline__ void cvt_load(float (&wv)[32], const CvtItem& c, int lane) {
    const float* wp = c.W + (size_t)(c.k0 + (lane >> 5)) * c.ldw + c.c0 + (lane & 31);
#pragma unroll
    for (int i = 0; i < 32; ++i) wv[i] = __builtin_nontemporal_load(wp + (size_t)(2 * i) * c.ldw);
}
template <bool FP8> __device__ __forceinline__ void cvt_store(const float (&wv)[32], const CvtItem& c, LAS float* scr, int lane, float wscale) {
#pragma unroll
    for (int i = 0; i < 32; ++i) scr[(2 * i + (lane >> 5)) * 33 + (lane & 31)] = FP8 ? wv[i] * wscale : wv[i];
    LDS_WAIT(); asm volatile("" ::: "memory");
    const int cc = lane & 7;
#pragma unroll
    for (int j = 0; j < 4; ++j) { const int n = (lane >> 3) + 8 * j; const LAS float* q = scr + (8 * cc) * 33 + n;
        if constexpr (FP8) { u32x2 o; o.x = pk4_fp8(q[0 * 33], q[1 * 33], q[2 * 33], q[3 * 33]); o.y = pk4_fp8(q[4 * 33], q[5 * 33], q[6 * 33], q[7 * 33]);
            *(GAS u32x2*)((unsigned char*)c.WT + (size_t)(c.r0 + n) * c.ldt + c.k0 + 8 * cc) = o; }
        else { u32x4 o; o.x = pk2(q[0 * 33], q[1 * 33]); o.y = pk2(q[2 * 33], q[3 * 33]); o.z = pk2(q[4 * 33], q[5 * 33]); o.w = pk2(q[6 * 33], q[7 * 33]);
            *(GAS u32x4*)((bf16_t*)c.WT + (size_t)(c.r0 + n) * c.ldt + c.k0 + 8 * cc) = o; } }
    LDS_WAIT(); asm volatile("" ::: "memory");
}
template <bool FP8, class Dec> __device__ __forceinline__ void cvt_run(int it0, int stride, int n, const Dec& dec, LAS float* scr, int lane, float wscale) {
    for (int it = it0; it < n; it += 2 * stride) {
        float a[32], b[32]; const CvtItem ca = dec(it); cvt_load(a, ca, lane);
        const int it2 = it + stride; const bool hb = it2 < n; CvtItem cb = ca; if (hb) { cb = dec(it2); cvt_load(b, cb, lane); }
        cvt_store<FP8>(a, ca, scr, lane, wscale); if (hb) cvt_store<FP8>(b, cb, scr, lane, wscale);
    }
}
__device__ __forceinline__ int win_src_col(int db) { const int r0 = db * 32, tile = r0 >> 8, loc = r0 & 255; if (tile >= 4) return r0; const int bj = loc >> 7, wc = (loc & 127) >> 5; return tile * 256 + 64 * wc + 32 * bj; }

__device__ __forceinline__ void convert_layer_weights(Frame& F, int l, int widx = -1, int nw = 0, int part = 0) {
    LAS float* scr = (LAS float*)(F.lds + RING_OFF + F.wave * 16384);
    const int gw = widx >= 0 ? widx : F.vcu * NWAVES + F.wave, NGW = widx >= 0 ? nw : F.G * NWAVES;
    const float* w_in = F.in[4] + (size_t)l * D * INC; const float* w_br = F.in[13] + (size_t)l * 3 * 512 * D; const float* w_o = F.in[14] + (size_t)l * D * D;
    constexpr int I_IN = 16 * 256, I_BR = 3 * 8 * 32, I_O = 16 * 32, I_GU = 16 * 176, I_DN = 44 * 32;
    const int nitems = I_IN + I_BR + I_O + (l == 0 ? I_GU + I_DN : 0);
    const auto dec = [&](int it) -> CvtItem { int r = it;
        if (r < I_IN) { const int kb = r >> 8, db = r & 255; return CvtItem{w_in, INC, kb * 64, win_src_col(db), WSP(bf16_t, WS_WIN), D, db * 32}; } r -= I_IN;
        if (r < I_BR) { const int br = r / 256, q = r % 256, kb = q >> 5, db = q & 31; return CvtItem{w_br + (size_t)br * 512 * D, D, kb * 64, db * 32, WSP(bf16_t, WS_WBR) + 512 * br, 1536, db * 32}; }   r -= I_BR;
        if (r < I_O) { const int kb = r >> 5, db = r & 31; return CvtItem{w_o, D, kb * 64, db * 32, WSP(bf16_t, WS_WO), D, db * 32}; } r -= I_O;
        if (r < I_GU) { const int kb = r / 176, db = r % 176, tile = db >> 3, l32 = db & 7; const float* src = (l32 < 4) ? F.in[15] : F.in[16];
            return CvtItem{src, FFD, kb * 64, tile * 128 + (l32 & 3) * 32, WSP(bf16_t, WS_WGU0), D, db * 32}; } r -= I_GU;
        const int kb = r >> 5, db = r & 31; return CvtItem{F.in[17], D, kb * 64, db * 32, WSP(bf16_t, WS_WD0), FFD, db * 32}; };
    const int it_lo = part == 2 ? I_IN + I_BR + I_O : 0, it_hi = part == 1 ? I_IN + I_BR + I_O : nitems;
    cvt_run<false>(it_lo + gw, NGW, it_hi, dec, scr, F.lane, 1.f);
    if (part == 2) return;
    const auto dec8 = [&](int it) -> CvtItem { const int kb = it / 96, db = it % 96; return CvtItem{w_in, INC, kb * 64, (160 + db) * 32, F.ws + WS_WIN8, D, db * 32}; };
    cvt_run<true>(gw, NGW, 16 * 96, dec8, scr, F.lane, W8_SCALE);
}
__device__ __forceinline__ void setup_small(Frame& F) {
    float* sm = SMALLF;
    if (blockIdx.x == 0) {
        if (F.tid < 2) { const int l = F.tid; const float* lp = F.in[7] + l * 256; float s1 = 0.f, s2 = 0.f;
            for (int i = 0; i < 64; ++i) { s1 += lp[i] * lp[64 + i]; s2 += lp[128 + i] * lp[192 + i]; }
            const float li = 0.8f - 0.6f * expf(-0.3f * (float)l); sm[SM_SCAL + l * 4] = expf(s1) - expf(s2) + li; sm[SM_SCAL + l * 4 + 1] = 1.f - li; }
        { const int c = F.tid; const float a = F.in[11][c], b = F.in[11][512 + c], mx = fmaxf(a, b), e0 = expf(a - mx), e1 = expf(b - mx), lb1 = e1 / (e0 + e1);
            sm[SM_LOGLB + c] = -INFINITY; sm[SM_LOG1M + c] = 0.f; sm[SM_LOGLB + 512 + c] = logf(lb1); sm[SM_LOG1M + 512 + c] = log1pf(-lb1); }
        { const int h = F.tid >> 7, n = F.tid & 127; int bk = n; if (n >= 16) { bk = 16 + (int)(logf((float)n / 16.f) / 2.0794415416798357f * 16.f); bk = bk < 31 ? bk : 31; }
            sm[SM_TAB + h * 128 + n] = (F.in[9][bk * 4 + h] - F.in[9][31 * 4 + h]) * LOG2E; }
    }
    const int gt = F.vcu * 512 + F.tid, NT = F.G * 512;
    for (int i = gt; i < NE * LISTCAP; i += NT) ((int*)(F.ws + WS_SMALL + SMB_LIST))[i] = 0;
    for (int i = gt; i < NB * 240 * (1024 / 8); i += NT) { const int row = i / 128, c = i % 128, b = row / 240, p = 4112 + row % 240; *(GAS u32x4*)(WSP(bf16_t, WS_QK) + ((size_t)(b * TP + p)) * 1024 + c * 8) = (u32x4){0u, 0u, 0u, 0u}; }
    for (int i = gt; i < NB * 240 * (512 / 8); i += NT) { const int row = i / 64, c = i % 64, b = row / 240, p = 4112 + row % 240; *(GAS u32x4*)(WSP(bf16_t, WS_V) + ((size_t)(b * TP + p)) * 512 + c * 8) = (u32x4){0u, 0u, 0u, 0u}; }
}
__device__ __forceinline__ const float* res_row(Frame& F, int r, bool first) {
    if (r < MR) return (first ? F.in[0] : (const float*)F.out) + (size_t)r * D;
    return (first ? F.in[1] : (const float*)(SMALLF + SM_METAHS)) + (size_t)(r - MR) * D;
}
__device__ __forceinline__ float* res_row_w(Frame& F, int r) { return (r < MR) ? F.out + (size_t)r * D : SMALLF + SM_METAHS + (size_t)(r - MR) * D; }
__device__ __forceinline__ void norm_pass(Frame& F, const float* gain, bool first, bool copy8) {
    const int gw = F.vcu * NWAVES + F.wave, NGW = F.G * NWAVES;
    f32x4 gv[4];
#pragma unroll
    for (int j = 0; j < 4; ++j) gv[j] = ((const f32x4*)gain)[F.lane + 64 * j];
    for (int r = gw; r < MROWS; r += NGW) {
        const GAS f32x4* xr = (const GAS f32x4*)res_row(F, r, first) + F.lane;
        f32x4 v[4]; float s = 0.f;
#pragma unroll
        for (int j = 0; j < 4; ++j) { v[j] = xr[64 * j]; s += (v[j].x * v[j].x + v[j].y * v[j].y) + (v[j].z * v[j].z + v[j].w * v[j].w); }
        const float sc = rsqrtf(wave_sum(s) * (1.f / D) + EPS);
        GAS u32x2* o = (GAS u32x2*)(WSP(bf16_t, WS_HN) + (size_t)r * D) + F.lane;
#pragma unroll
        for (int j = 0; j < 4; ++j) { u32x2 w; w.x = pk2(v[j].x * sc * gv[j].x, v[j].y * sc * gv[j].y); w.y = pk2(v[j].z * sc * gv[j].z, v[j].w * sc * gv[j].w); o[64 * j] = w; }
        if (copy8 && r < MR) { GAS unsigned* o8 = (GAS unsigned*)(F.ws + WS_HN8 + (size_t)r * D) + F.lane;
#pragma unroll
            for (int j = 0; j < 4; ++j) o8[64 * j] = pk4_fp8(v[j].x * sc * gv[j].x, v[j].y * sc * gv[j].y, v[j].z * sc * gv[j].z, v[j].w * sc * gv[j].w); }
    }
}

struct TileOrder {
    int nM, nN, nwg, G, c, pn0; long lda2, ldb2;
    __device__ void init(int nM_, int nN_, int pn0_, int G_, int c_, int lda, int ldb) { nM = nM_; nN = nN_; nwg = nM * nN; G = G_; c = c_; pn0 = pn0_; lda2 = 2L * lda; ldb2 = 2L * ldb; }
    __device__ __forceinline__ bool next(int i, Unit& u) const {
        const long L = (long)i * G + c; if (L >= nwg) return false;
        int wgid = (int)L; { const int q = nwg / 8, r = nwg % 8, xcd = wgid % 8, off = wgid / 8; wgid = (xcd < r ? xcd * (q + 1) : r * (q + 1) + (xcd - r) * q) + off; }
        const int nig = 8 * nN, gid = wgid / nig, fm = gid * 8, gsz = (nM - fm) < 8 ? (nM - fm) : 8;
        u.pm = fm + ((wgid % nig) % gsz); u.pn = pn0 + (wgid % nig) / gsz; u.z = 0; u.a_off = (unsigned)((long)u.pm * 256 * lda2); u.b_off = (unsigned)((long)u.pn * 256 * ldb2); u.gidx = nullptr; return true;
    }
};
__device__ __forceinline__ u32x4 pack8(const f32x4 a, const f32x4 b) { u32x4 w; w.x = cvt_pk_bf16(a[0], a[1]); w.y = cvt_pk_bf16(a[2], a[3]); w.z = cvt_pk_bf16(b[0], b[1]); w.w = cvt_pk_bf16(b[2], b[3]); return w; }
__device__ __forceinline__ void store_att(bf16_t* buf, int pitch, int r, int col, u32x4 w) {
    if (r < MR) { const int ar = (r >> 12) * TP + NM + (r & 4095); *(u32x4*)(buf + (size_t)ar * pitch + col) = w; }
    else { const int j = r - MR;
#pragma unroll
        for (int b = 0; b < NB; ++b) *(u32x4*)(buf + (size_t)(b * TP + j) * pitch + col) = w; }
}
struct EpiProj {
    static constexpr bool PERM = true, MID = false;
    unsigned char* ws; const float *qg, *kg; int l; float gsc;
    __device__ __forceinline__ void row(const Unit& u, int r, int slot, int wc, int fq, const f32x4 (&v)[2][2]) const {
        const int pn = u.pn;
        bf16_t* QK = (bf16_t*)(ws + WS_QK); bf16_t* V = (bf16_t*)(ws + WS_V); bf16_t* CONV = (bf16_t*)(ws + WS_CONV); bf16_t* HQ = (bf16_t*)(ws + WS_HQ); bf16_t* HV = (bf16_t*)(ws + WS_HV); bf16_t* HG = (bf16_t*)(ws + WS_HG);
        bf16_t* GATES = (bf16_t*)(ws + WS_GATES); float* LOGF = (float*)(ws + WS_LOGF); const float* loglb = (const float*)(ws + WS_SMALL) + SM_LOGLB + l * 512; const float* log1m = (const float*)(ws + WS_SMALL) + SM_LOG1M + l * 512;
        if (pn < 4) {
            float ss = 0.f;
#pragma unroll
            for (int bj = 0; bj < 2; ++bj)
#pragma unroll
                for (int n = 0; n < 2; ++n) ss += (v[bj][n][0] * v[bj][n][0] + v[bj][n][1] * v[bj][n][1]) + (v[bj][n][2] * v[bj][n][2] + v[bj][n][3] * v[bj][n][3]);
            ss = xadd<16>(ss); ss = xadd<32>(ss);
            const float sc = rsqrtf(ss * (1.f / 64.f) + EPS) * (pn < 2 ? C2 : 1.f); const float* gv = pn < 2 ? qg : kg;
#pragma unroll
            for (int bj = 0; bj < 2; ++bj) { const int d0 = 32 * bj + 8 * fq; const f32x4 g0 = *(const f32x4*)(gv + d0), g1 = *(const f32x4*)(gv + d0 + 4);
                store_att(QK, 1024, r, pn * 256 + 64 * wc + d0, pack8(v[bj][0] * g0 * sc, v[bj][1] * g1 * sc)); }
            return;
        }
#pragma unroll
        for (int bj = 0; bj < 2; ++bj) {
            const int cl = 128 * bj + 32 * wc + 8 * fq; f32x4 a = v[bj][0], b = v[bj][1];
            if (pn < 6) { store_att(V, 512, r, (pn - 4) * 256 + cl, pack8(a, b)); }
            else if (pn < 12) { *(u32x4*)(CONV + (size_t)r * 1536 + (pn - 6) * 256 + cl) = pack8(a, b); }
            else if (pn < 14 || (pn >= 18 && pn < 20)) {
#pragma unroll
                for (int e = 0; e < 4; ++e) { a[e] = silu(a[e]); b[e] = silu(b[e]); }
                bf16_t* dst = (pn < 14) ? HQ + (size_t)r * 512 + (pn - 12) * 256 + cl : HG + (size_t)r * 512 + (pn - 18) * 256 + cl; *(u32x4*)dst = pack8(a, b); }
            else if (pn < 16) {
                const int c = (pn - 14) * 256 + cl; const f32x4 la0 = *(const f32x4*)(loglb + c), la1 = *(const f32x4*)(loglb + c + 4), lm0 = *(const f32x4*)(log1m + c), lm1 = *(const f32x4*)(log1m + c + 4);
                f32x4 o0, o1;
#pragma unroll
                for (int e = 0; e < 4; ++e) {
                    o0[e] = logf_gate(a[e], la0[e], lm0[e]); o1[e] = logf_gate(b[e], la1[e], lm1[e]);
                }
                float* dst = LOGF + (size_t)r * 512 + c; *(f32x4*)dst = o0; *(f32x4*)(dst + 4) = o1; }
            else if (pn < 18) { *(u32x4*)(HV + (size_t)r * 512 + (pn - 16) * 256 + cl) = pack8(a, b); }
            else {
#pragma unroll
                for (int e = 0; e < 4; ++e) { a[e] = sigm(a[e] * gsc); b[e] = sigm(b[e] * gsc); }
                *(u32x4*)(GATES + (size_t)r * 3072 + (pn - 20) * 256 + cl) = pack8(a, b); }
        }
    }
};
struct EpiMerge {
    static constexpr bool PERM = true, MID = true; static constexpr int MID_T0 = 8, MID_T1 = 16;
    const bf16_t* GATES; bf16_t* MIXED;
    __device__ __forceinline__ void mid_row(const Unit& u, int r, int t, int wc, int fq, f32x4 (&v)[2][2]) const {
        const int b = (t >> 3) - 1;
#pragma unroll
        for (int bj = 0; bj < 2; ++bj) {
            const bf16_t* gp = GATES + (size_t)r * 3072 + b * 1024 + u.pn * 256 + 128 * bj + 32 * wc + 8 * fq; const u32x4 ga = *(const u32x4*)gp, gb = *(const u32x4*)(gp + 1024);
#define MK_RT(x, y) ((x) * __builtin_amdgcn_rcpf(fmaxf((y), 1e-20f)))
            v[bj][0][0] *= MK_RT(bflo(ga.x), bflo(gb.x)); v[bj][0][1] *= MK_RT(bfhi(ga.x), bfhi(gb.x)); v[bj][0][2] *= MK_RT(bflo(ga.y), bflo(gb.y)); v[bj][0][3] *= MK_RT(bfhi(ga.y), bfhi(gb.y));
            v[bj][1][0] *= MK_RT(bflo(ga.z), bflo(gb.z)); v[bj][1][1] *= MK_RT(bfhi(ga.z), bfhi(gb.z)); v[bj][1][2] *= MK_RT(bflo(ga.w), bflo(gb.w)); v[bj][1][3] *= MK_RT(bfhi(ga.w), bfhi(gb.w));
#undef MK_RT
        }
    }
    __device__ __forceinline__ void row(const Unit& u, int r, int slot, int wc, int fq, const f32x4 (&v)[2][2]) const {
#pragma unroll
        for (int bj = 0; bj < 2; ++bj) {
            const int cl = 128 * bj + 32 * wc + 8 * fq; const u32x4 gw = *(const u32x4*)(GATES + (size_t)r * 3072 + 2048 + u.pn * 256 + cl);
            f32x4 a = v[bj][0], b = v[bj][1];
            a[0] *= bflo(gw.x); a[1] *= bfhi(gw.x); a[2] *= bflo(gw.y); a[3] *= bfhi(gw.y); b[0] *= bflo(gw.z); b[1] *= bfhi(gw.z); b[2] *= bflo(gw.w); b[3] *= bfhi(gw.w);
            *(u32x4*)(MIXED + (size_t)r * D + u.pn * 256 + cl) = pack8(a, b);
        }
    }
};
struct EpiRes {
    static constexpr bool PERM = false, MID = false;
    const float* base; float* out; const float* mbase; float* mout;
    __device__ __forceinline__ void row(const Unit& u, int r, int slot, int wc, int fq, const f32x4 (&v)[2][2]) const {
        const float* bp = (r < MR) ? base + (size_t)r * D : mbase + (size_t)(r - MR) * D; float* op = (r < MR) ? out + (size_t)r * D : mout + (size_t)(r - MR) * D;
#pragma unroll
        for (int bj = 0; bj < 2; ++bj)
#pragma unroll
            for (int n = 0; n < 2; ++n) { const int col = u.pn * 256 + 128 * bj + 32 * wc + 16 * n + 4 * fq; *(f32x4*)(op + col) = *(const f32x4*)(bp + col) + v[bj][n]; }
    }
};
struct EpiGU {
    static constexpr bool PERM = true, MID = false;
    bf16_t* H; int ldh; float sc;
    __device__ __forceinline__ void row(const Unit& u, int r, int slot, int wc, int fq, const f32x4 (&v)[2][2]) const {
        f32x4 a, b;
#pragma unroll
        for (int e = 0; e < 4; ++e) { a[e] = silu(v[0][0][e] * sc) * (v[1][0][e] * sc); b[e] = silu(v[0][1][e] * sc) * (v[1][1][e] * sc); }
        *(u32x4*)(H + (size_t)r * ldh + u.pn * 128 + 32 * wc + 8 * fq) = pack8(a, b);
    }
};

struct EpiGU8 {
    static constexpr bool PERM = true, MID = false;
    unsigned char* H; int ldh; float sc;
    __device__ __forceinline__ void row(const Unit& u, int r, int slot, int wc, int fq, const f32x4 (&v)[2][2]) const {
        f32x4 a, b;
#pragma unroll
        for (int e = 0; e < 4; ++e) { a[e] = silu(v[0][0][e] * sc) * (v[1][0][e] * (sc * H8_SCALE)); b[e] = silu(v[0][1][e] * sc) * (v[1][1][e] * (sc * H8_SCALE)); }
#pragma unroll
        for (int e = 0; e < 4; ++e) { a[e] = __builtin_amdgcn_fmed3f(a[e], -448.f, 448.f); b[e] = __builtin_amdgcn_fmed3f(b[e], -448.f, 448.f); }
        u32x2 o; o.x = pk4_fp8(a[0], a[1], a[2], a[3]); o.y = pk4_fp8(b[0], b[1], b[2], b[3]);
        *(u32x2*)(H + (size_t)r * ldh + u.pn * 128 + 32 * wc + 8 * fq) = o;
    }
};
template <class Epi>
__device__ __forceinline__ void meta_gemm(Frame& F, const bf16_t* A16, int lda, const bf16_t* Bt, int ldb, int K, int pn_lo, int pn_hi, const Epi& E) {
    const int fr = F.lane & 15, fq = F.lane >> 4;
    for (int task = pn_lo * 4 + F.vcu; task < pn_hi * 4; task += F.G) {
        const int pn = task >> 2, wc = task & 3; f32x4 v[2][2];
        pg8::small_tile<Epi::PERM>(F.lds + RING_OFF, A16, lda, Bt, ldb, K, pn, wc, v, F.wave);
        if (F.wave == 0) { Unit u; u.pm = 64; u.pn = pn; u.z = 0; u.a_off = 0; u.b_off = 0; u.gidx = nullptr; E.row(u, MR + fr, 0, wc, fq, v); }
    }
}
__device__ __forceinline__ void meta_merge(Frame& F, const bf16_t* U16, const bf16_t* Wbr, const bf16_t* GATES, bf16_t* MIXED) {
    const int fr = F.lane & 15, fq = F.lane >> 4;
    for (int task = F.vcu; task < 16; task += F.G) {
        const int pn = task >> 2, wc = task & 3; f32x4 tot[2][2];
#pragma unroll
        for (int bj = 0; bj < 2; ++bj)
#pragma unroll
            for (int n = 0; n < 2; ++n) tot[bj][n] = (f32x4){0.f, 0.f, 0.f, 0.f};
        for (int z = 0; z < 3; ++z) {
            f32x4 v[2][2];
            pg8::small_tile<true>(F.lds + RING_OFF, U16 + 512 * z, 1536, Wbr + 512 * z, 1536, 512, pn, wc, v, F.wave);
            if (F.wave == 0) {
#pragma unroll
                for (int bj = 0; bj < 2; ++bj) { const int cl = 128 * bj + 32 * wc + 8 * fq; const u32x4 gw = *(const u32x4*)(GATES + (size_t)(MR + fr) * 3072 + z * 1024 + pn * 256 + cl);
                    f32x4 a = v[bj][0], b = v[bj][1];
                    a[0] *= bflo(gw.x); a[1] *= bfhi(gw.x); a[2] *= bflo(gw.y); a[3] *= bfhi(gw.y); b[0] *= bflo(gw.z); b[1] *= bfhi(gw.z); b[2] *= bflo(gw.w); b[3] *= bfhi(gw.w);
                    tot[bj][0] += a; tot[bj][1] += b; }
            }
        }
        if (F.wave == 0) {
#pragma unroll
            for (int bj = 0; bj < 2; ++bj) { const int cl = 128 * bj + 32 * wc + 8 * fq; *(u32x4*)(MIXED + (size_t)(MR + fr) * D + pn * 256 + cl) = pack8(tot[bj][0], tot[bj][1]); }
        }
    }
}

__device__ __forceinline__ int prev_row(int r, int d) {
    if (r >= MR) { const int j = r - MR - d; return j >= 0 ? MR + j : -1; }
    const int s = r & 4095; if (s >= d) return r - d; return MR + NM + s - d;
}
__device__ __forceinline__ void conv_pass(Frame& F, const float* cw) {
    const bf16_t* CONV = WSP(bf16_t, WS_CONV); bf16_t* U = WSP(bf16_t, WS_U);
    const int gt = F.vcu * 512 + F.tid, NT = F.G * 512, c8 = (gt & 63) * 8;
    f32x4 w0[3], w1[3];
#pragma unroll
    for (int k = 0; k < 3; ++k) { w0[k] = *(const GAS f32x4*)(cw + k * 512 + c8); w1[k] = *(const GAS f32x4*)(cw + k * 512 + c8 + 4); }
    for (int i = gt; i < MROWS * 64; i += 2 * NT) {
        u32x4 cv[2][3], hv[2][3], bv[2]; float mk[2][3];
#pragma unroll
        for (int q = 0; q < 2; ++q) { const int iq = i + q * NT; const int r = (iq < MROWS * 64 ? iq : i) >> 6;
#pragma unroll
            for (int k = 0; k < 3; ++k) { const int rr = (k == 2) ? r : prev_row(r, 2 - k); mk[q][k] = rr < 0 ? 0.f : 1.f; const int rc = rr < 0 ? r : rr;
                cv[q][k] = *(const GAS u32x4*)(CONV + (size_t)rc * 1536 + 512 + c8); hv[q][k] = *(const GAS u32x4*)(CONV + (size_t)rc * 1536 + 1024 + c8); }
            bv[q] = *(const GAS u32x4*)(CONV + (size_t)r * 1536 + c8); }
#pragma unroll
        for (int q = 0; q < 2; ++q) { const int iq = i + q * NT; if (iq >= MROWS * 64) continue; const int r = iq >> 6; float y[8];
#pragma unroll
            for (int e = 0; e < 8; ++e) y[e] = 0.f;
#pragma unroll
            for (int k = 0; k < 3; ++k) { const u32x4 c = cv[q][k], hh = hv[q][k]; const f32x4 a0 = w0[k] * mk[q][k], a1 = w1[k] * mk[q][k];
                y[0] += a0[0] * bflo(c.x) * bflo(hh.x); y[1] += a0[1] * bfhi(c.x) * bfhi(hh.x); y[2] += a0[2] * bflo(c.y) * bflo(hh.y); y[3] += a0[3] * bfhi(c.y) * bfhi(hh.y);
                y[4] += a1[0] * bflo(c.z) * bflo(hh.z); y[5] += a1[1] * bfhi(c.z) * bfhi(hh.z); y[6] += a1[2] * bflo(c.w) * bflo(hh.w); y[7] += a1[3] * bfhi(c.w) * bfhi(hh.w); }
            const u32x4 bq = bv[q];
            u32x4 o; o.x = pk2(bflo(bq.x) * y[0], bfhi(bq.x) * y[1]); o.y = pk2(bflo(bq.y) * y[2], bfhi(bq.y) * y[3]); o.z = pk2(bflo(bq.z) * y[4], bfhi(bq.z) * y[5]); o.w = pk2(bflo(bq.w) * y[6], bfhi(bq.w) * y[7]);
            *(GAS u32x4*)(U + (size_t)r * 1536 + 512 + c8) = o; }
    }
}
__device__ __forceinline__ void attcomb_pass(Frame& F, const float* sg, int l) {
    const bf16_t* O = WSP(bf16_t, WS_O); bf16_t* U = WSP(bf16_t, WS_U);
    const int gw = F.vcu * NWAVES + F.wave, NGW = F.G * NWAVES;
    const float lam = SMALLF[SM_SCAL + l * 4], oml = SMALLF[SM_SCAL + l * 4 + 1];
    const int c8 = F.lane * 8; const f32x4 g0 = *(const f32x4*)(sg + (c8 & 127)), g1 = *(const f32x4*)(sg + (c8 & 127) + 4);
    for (int r = gw; r < MROWS; r += NGW) {
        const int ar = (r < MR) ? (r >> 12) * TP + NM + (r & 4095) : (r - MR);
        const u32x4 a = *(const u32x4*)(O + (size_t)ar * 1024 + c8), b = *(const u32x4*)(O + (size_t)ar * 1024 + 512 + c8);
        float d[8]; d[0] = bflo(a.x) - lam * bflo(b.x); d[1] = bfhi(a.x) - lam * bfhi(b.x); d[2] = bflo(a.y) - lam * bflo(b.y); d[3] = bfhi(a.y) - lam * bfhi(b.y);
        d[4] = bflo(a.z) - lam * bflo(b.z); d[5] = bfhi(a.z) - lam * bfhi(b.z); d[6] = bflo(a.w) - lam * bflo(b.w); d[7] = bfhi(a.w) - lam * bfhi(b.w);
        float ss = 0.f;
#pragma unroll
        for (int e = 0; e < 8; ++e) ss += d[e] * d[e];
        ss = xadd<1>(ss); ss = xadd<2>(ss); ss = xadd<4>(ss); ss = xadd<8>(ss);
        const float sc = rsqrtf(ss * (1.f / 128.f) + EPS) * oml;
        u32x4 o; o.x = pk2(d[0] * sc * g0[0], d[1] * sc * g0[1]); o.y = pk2(d[2] * sc * g0[2], d[3] * sc * g0[3]); o.z = pk2(d[4] * sc * g1[0], d[5] * sc * g1[1]); o.w = pk2(d[6] * sc * g1[2], d[7] * sc * g1[3]);
        *(u32x4*)(U + (size_t)r * 1536 + c8) = o;
    }
}

constexpr int HA_QP = 0, HA_KP = 43520, HA_KT = HA_KP + 17408, HA_VT = HA_KT + 18432, HA_PB = HA_VT + 18432, HA_TOT = HA_PB + 9216;
__device__ __forceinline__ int qp_base(int j) { return j == 0 ? 0 : (j == 1 ? 64 : (j == 2 ? 112 : 144)); }
struct HgIn { float lf[16], qv[16], vv[16]; };
__device__ __forceinline__ void hgrnA_load(Frame& F, int id, HgIn& in) {
    const bool meta = id >= 1024; const int bh = meta ? 0 : id >> 6, c = id & 63, h = meta ? id - 1024 : bh & 3, b = bh >> 2;
    const int row0 = meta ? MR : b * SEQ + c * 64, nvalid = meta ? NM : 64;
    const int d = F.tid & 127, i = F.tid >> 7;
    const bf16_t* HQ = WSP(bf16_t, WS_HQ); const bf16_t* HV = WSP(bf16_t, WS_HV); const float* LOGF = WSP(float, WS_LOGF);
#pragma unroll
    for (int j = 0; j < 16; ++j) { const int t = 16 * i + j; const bool ok = t < nvalid; const size_t off = (size_t)(row0 + (ok ? t : 0)) * 512 + h * 128 + d;
        const float a = LOGF[off]; const unsigned short q = HQ[off], v = HV[off]; in.lf[j] = ok ? a : 0.f; in.qv[j] = ok ? bf2f(q) : 0.f; in.vv[j] = ok ? bf2f(v) : 0.f; }
}
#ifndef HG_NORAW
#define HG_BAR() do { asm volatile("s_waitcnt lgkmcnt(0)" ::: "memory"); __builtin_amdgcn_s_barrier(); asm volatile("" ::: "memory"); } while (0)
#else
#define HG_BAR() __syncthreads()
#endif
#define HG_BAR_UNUSED()
__device__ __forceinline__ void hgrnA_compute(Frame& F, int id, const HgIn& in) {
    const bool meta = id >= 1024; const int bh = meta ? 0 : id >> 6, c = id & 63, h = meta ? id - 1024 : bh & 3, b = bh >> 2;
    const int row0 = meta ? MR : b * SEQ + c * 64, nvalid = meta ? NM : 64;
    const int d = F.tid & 127, i = F.tid >> 7;
    LAS unsigned char* L = F.lds + RING_OFF;
    const float (&lf)[16] = in.lf; const float (&qv)[16] = in.qv; const float (&vv)[16] = in.vv;
    float Lc[16]; { float s = 0.f;
#pragma unroll
        for (int j = 0; j < 16; ++j) { s += lf[j]; Lc[j] = s; } }
    LAS float* TOT = (LAS float*)(L + HA_TOT);
    TOT[i * 128 + d] = Lc[15];
    HG_BAR();
    float rho[4]; { float s = 0.f;
#pragma unroll
        for (int j = 0; j < 4; ++j) { s += TOT[j * 128 + d]; rho[j] = s; } }
    const float rhoi = (i == 0) ? rho[0] : (i == 1) ? rho[1] : (i == 2) ? rho[2] : rho[3], ri = (i == 0) ? 0.f : (i == 1) ? rho[0] : (i == 2) ? rho[1] : rho[2], glast = rho[3];
    const float fK2 = __expf(glast - rhoi), fQ2 = __expf(rhoi);
    float fQ[4];
#pragma unroll
    for (int jj = 0; jj < 4; ++jj) fQ[jj] = (jj <= i) ? __expf(rhoi - rho[jj]) : 0.f;
    LAS bf16_t* KP = (LAS bf16_t*)(L + HA_KP); LAS bf16_t* QP = (LAS bf16_t*)(L + HA_QP);
    unsigned kt[8], vt[8];
#pragma unroll
    for (int j = 0; j < 16; j += 2) {
        float kp[2], qe[2];
#pragma unroll
        for (int q = 0; q < 2; ++q) { const float G = ri + Lc[j + q], E = __expf(G - rhoi), k = 1.f - __expf(lf[j + q]); kp[q] = k * __builtin_amdgcn_rcpf(E); qe[q] = qv[j + q] * E; }
        const int t = 16 * i + j;
        { const unsigned w = cvt_pk_bf16(kp[0], kp[1]); KP[t * 136 + d] = (bf16_t)(w & 0xffffu); KP[(t + 1) * 136 + d] = (bf16_t)(w >> 16); }
        kt[j >> 1] = cvt_pk_bf16(kp[0] * fK2, kp[1] * fK2); vt[j >> 1] = cvt_pk_bf16(vv[j], vv[j + 1]);
#pragma unroll
        for (int jj = 0; jj < 4; ++jj) if (jj <= i) { const unsigned w = cvt_pk_bf16(qe[0] * fQ[jj], qe[1] * fQ[jj]); const int rb = qp_base(jj) + t - 16 * jj; QP[rb * 136 + d] = (bf16_t)(w & 0xffffu); QP[(rb + 1) * 136 + d] = (bf16_t)(w >> 16); }
        { const unsigned w = cvt_pk_bf16(qe[0] * fQ2, qe[1] * fQ2); bf16_t* hq2 = WSP(bf16_t, WS_HQ2) + (size_t)(row0 + t) * 512 + h * 128 + d;
          if (t < nvalid) hq2[0] = (bf16_t)(w & 0xffffu); if (t + 1 < nvalid) hq2[512] = (bf16_t)(w >> 16); }
    }
    { LAS u32x4* ktp = (LAS u32x4*)(L + HA_KT + d * 144 + i * 32); ktp[0] = (u32x4){kt[0], kt[1], kt[2], kt[3]}; ktp[1] = (u32x4){kt[4], kt[5], kt[6], kt[7]};
      LAS u32x4* vtp = (LAS u32x4*)(L + HA_VT + d * 144 + i * 32); vtp[0] = (u32x4){vt[0], vt[1], vt[2], vt[3]}; vtp[1] = (u32x4){vt[4], vt[5], vt[6], vt[7]}; }
    if (i == 0) WSP(float, WS_DEC)[(size_t)id * 128 + d] = __expf(glast);
    HG_BAR();
    const int w = F.wave, fr = F.lane & 15, fq = F.lane >> 4;
    {
        LAS unsigned char* PB = L + HA_PB;
        for (int blk = w; blk < 16; blk += 8) {
            int it, js;
            if (blk < 10) { it = (blk >= 6) ? 3 : (blk >= 3) ? 2 : (blk >= 1) ? 1 : 0; js = blk - ((it * (it + 1)) >> 1); }
            else { const int q = blk - 10; it = (q < 3) ? 0 : (q < 5) ? 1 : 2; js = (q < 3) ? q + 1 : (q < 5) ? q - 1 : 3; }
            f32x4 acc = (f32x4){0.f, 0.f, 0.f, 0.f};
            if (blk < 10) {
#pragma unroll
                for (int ks = 0; ks < 4; ++ks) {
                    const bf16x8 qa = *(const LAS bf16x8*)(L + HA_QP + ((qp_base(js) + 16 * it - 16 * js + fr) * 136 + 32 * ks + 8 * fq) * 2);
                    const bf16x8 kb = *(const LAS bf16x8*)(L + HA_KP + ((16 * js + fr) * 136 + 32 * ks + 8 * fq) * 2);
                    acc = __builtin_amdgcn_mfma_f32_16x16x32_bf16(kb, qa, acc, 0, 0, 0);
                }
                if (it == js) {
#pragma unroll
                    for (int e = 0; e < 4; ++e) if (4 * fq + e > fr) acc[e] = 0.f;
                }
            }
            u32x2 pw; pw.x = pk2(acc[0], acc[1]); pw.y = pk2(acc[2], acc[3]);
            *(LAS u32x2*)(PB + (16 * it + fr) * 144 + (16 * js + 4 * fq) * 2) = pw;
        }
    }
    HG_BAR();
    {
        const int tb = w >> 1, dv0 = (w & 1) * 4;
        f32x4 acc[4];
#pragma unroll
        for (int q = 0; q < 4; ++q) acc[q] = (f32x4){0.f, 0.f, 0.f, 0.f};
#pragma unroll
        for (int ks = 0; ks < 2; ++ks) {
            const bf16x8 pa = *(const LAS bf16x8*)(L + HA_PB + (16 * tb + fr) * 144 + (32 * ks + 8 * fq) * 2);
#pragma unroll
            for (int q = 0; q < 4; ++q) { const bf16x8 vb = *(const LAS bf16x8*)(L + HA_VT + (16 * (dv0 + q) + fr) * 144 + (32 * ks + 8 * fq) * 2);
                acc[q] = __builtin_amdgcn_mfma_f32_16x16x32_bf16(vb, pa, acc[q], 0, 0, 0); }
        }
        const int t = 16 * tb + fr;
        if (t < nvalid) {
#pragma unroll
            for (int q = 0; q < 4; ++q) *(f32x4*)(WSP(float, WS_OI) + (size_t)(row0 + t) * 512 + h * 128 + 16 * (dv0 + q) + 4 * fq) = acc[q];
        }
    }
    {
        f32x4 acc[8];
#pragma unroll
        for (int q = 0; q < 8; ++q) acc[q] = (f32x4){0.f, 0.f, 0.f, 0.f};
#pragma unroll
        for (int ks = 0; ks < 2; ++ks) {
            const bf16x8 va = *(const LAS bf16x8*)(L + HA_VT + (16 * w + fr) * 144 + (32 * ks + 8 * fq) * 2);
#pragma unroll
            for (int q = 0; q < 8; ++q) { const bf16x8 kb = *(const LAS bf16x8*)(L + HA_KT + (16 * q + fr) * 144 + (32 * ks + 8 * fq) * 2);
                acc[q] = __builtin_amdgcn_mfma_f32_16x16x32_bf16(kb, va, acc[q], 0, 0, 0); }
        }
        float* DS = WSP(float, WS_DS) + (size_t)id * 16384 + (size_t)(16 * w + fr) * 128;
#pragma unroll
        for (int q = 0; q < 8; ++q) *(f32x4*)(DS + 16 * q + 4 * fq) = acc[q];
    }
    HG_BAR();
}
__device__ __forceinline__ void hgrn_scan(Frame& F) {
    const float* DS = WSP(float, WS_DS); const float* DEC = WSP(float, WS_DEC); bf16_t* ST = WSP(bf16_t, WS_ST);
    const int gt = F.vcu * 512 + F.tid, NT = F.G * 512;
    typedef float f32x2 __attribute__((ext_vector_type(2)));
    for (int idx = gt; idx < 16 * 8192; idx += NT) {
        const int bh = idx >> 13, e2 = (idx & 8191) * 2, dk = e2 & 127, h = bh & 3;
        f32x2 s = *(const GAS f32x2*)(DS + (size_t)(1024 + h) * 16384 + e2);
        for (int c0 = 0; c0 < 64; c0 += 16) {
            f32x2 dd[16], ds[16];
#pragma unroll
            for (int j = 0; j < 16; ++j) { const size_t id = (size_t)bh * 64 + c0 + j; dd[j] = *(const GAS f32x2*)(DEC + id * 128 + dk); ds[j] = *(const GAS f32x2*)(DS + id * 16384 + e2); }
#pragma unroll
            for (int j = 0; j < 16; ++j) { const size_t id = (size_t)bh * 64 + c0 + j; *(GAS unsigned*)(ST + id * 16384 + e2) = pk2(s.x, s.y); s = dd[j] * s + ds[j]; }
        }
    }
}
__device__ __forceinline__ void hgrnC_pass(Frame& F, const float* og) {
    const bf16_t* HQ = WSP(bf16_t, WS_HQ2); const bf16_t* HG = WSP(bf16_t, WS_HG); const float* OI = WSP(float, WS_OI); const bf16_t* ST = WSP(bf16_t, WS_ST); bf16_t* U = WSP(bf16_t, WS_U);
    const int gw = F.vcu * NWAVES + F.wave, NGW = F.G * NWAVES, fr = F.lane & 15, fq = F.lane >> 4;
    for (int task = gw; task < 1024 * 4 + 4; task += NGW) {
        const bool meta = task >= 4096; const int id = meta ? 0 : task >> 2, tb = meta ? 0 : task & 3, bh = id >> 6, c = id & 63, h = meta ? task - 4096 : bh & 3, b = bh >> 2;
        const int row = (meta ? MR : b * SEQ + c * 64 + 16 * tb) + fr;
        f32x4 acc[8];
#pragma unroll
        for (int q = 0; q < 8; ++q) acc[q] = *(const f32x4*)(OI + (size_t)row * 512 + h * 128 + 16 * q + 4 * fq);
        if (!meta) {
            const bf16_t* Sb = ST + (size_t)id * 16384;
#pragma unroll
            for (int ks = 0; ks < 4; ++ks) {
                const bf16x8 qa = *(const bf16x8*)(HQ + (size_t)row * 512 + h * 128 + 32 * ks + 8 * fq);
#pragma unroll
                for (int q = 0; q < 8; ++q) { const bf16x8 sb = *(const bf16x8*)(Sb + (size_t)(16 * q + fr) * 128 + 32 * ks + 8 * fq);
                    acc[q] = __builtin_amdgcn_mfma_f32_16x16x32_bf16(sb, qa, acc[q], 0, 0, 0); }
            }
        }
        float ss = 0.f;
#pragma unroll
        for (int q = 0; q < 8; ++q) ss += (acc[q][0] * acc[q][0] + acc[q][1] * acc[q][1]) + (acc[q][2] * acc[q][2] + acc[q][3] * acc[q][3]);
        ss = xadd<16>(ss); ss = xadd<32>(ss);
        const float sc = rsqrtf(ss * (1.f / 128.f) + EPS);
#pragma unroll
        for (int q = 0; q < 8; ++q) { const int dv = 16 * q + 4 * fq; const f32x4 g = *(const f32x4*)(og + dv); const u32x2 gg = *(const u32x2*)(HG + (size_t)row * 512 + h * 128 + dv);
            u32x2 o; o.x = pk2(acc[q][0] * sc * g[0] * bflo(gg.x), acc[q][1] * sc * g[1] * bfhi(gg.x)); o.y = pk2(acc[q][2] * sc * g[2] * bflo(gg.y), acc[q][3] * sc * g[3] * bfhi(gg.y));
            *(u32x2*)(U + (size_t)row * 1536 + 1024 + h * 128 + dv) = o; }
    }
}
struct TokInfo { int e1, s1, e2, s2; float w1, w2; int pad0, pad1; };
__device__ __forceinline__ void convert_moe_gu(Frame& F, int early = -1, int widx = 0, int nw = 1, int skip = -1) {
    LAS float* scr = early >= 0 ? (LAS float*)(F.lds + RING_OFF + F.wave * 16384) : (LAS float*)(F.lds + RING_OFF + 32768 + F.wave * 8704);
    const int gw = early >= 0 ? widx : F.vcu * NWAVES + F.wave, NGW = early >= 0 ? nw : F.G * NWAVES;
    constexpr int I_GU = 16 * 224;
    const int ne = early >= 0 ? 1 : (skip >= 0 ? NE - 1 : NE);
    const auto dec = [&](int it) -> CvtItem { int e = it / I_GU; const int r = it - e * I_GU, kb = r / 224, db = r % 224, tile = db >> 3, l32 = db & 7;
        e = early >= 0 ? early : (skip >= 0 && e >= skip ? e + 1 : e);
        const float* src = ((l32 < 4) ? F.in[19] : F.in[20]) + (size_t)e * D * FFE;
        return CvtItem{src, FFE, kb * 64, tile * 128 + (l32 & 3) * 32, F.ws + WS_MGU + (size_t)e * 7168 * D, D, db * 32}; };
    cvt_run<true>(gw, NGW, ne * I_GU, dec, scr, F.lane, W8_SCALE);
}
__device__ __forceinline__ void convert_moe_down(Frame& F, int widx, int nw) {
    LAS float* scr = (LAS float*)(F.lds + RING_OFF + F.wave * 16384);
    constexpr int I_DN = 56 * 32;
    const auto dec = [&](int it) -> CvtItem { const int e = it / I_DN, r = it - e * I_DN, kb = r >> 5, db = r & 31;
        return CvtItem{F.in[21] + (size_t)e * FFE * D, D, kb * 64, db * 32, F.ws + WS_MD + (size_t)e * D * FFE, FFE, db * 32}; };
    cvt_run<true>(widx, nw, NE * I_DN, dec, scr, F.lane, WD8_SCALE);
}
__device__ __forceinline__ void norm_route_pass(Frame& F, const float* gain) {
    LAS float* rwl = (LAS float*)(F.lds + RING_OFF);
    for (int i = F.tid; i < D * NE / 4; i += 512) ((LAS f32x4*)rwl)[i] = ((const f32x4*)F.in[18])[i];
    __syncthreads();
    const int gw = F.vcu * NWAVES + F.wave, NGW = F.G * NWAVES;
    f32x4 gv[4];
#pragma unroll
    for (int j = 0; j < 4; ++j) gv[j] = ((const f32x4*)gain)[F.lane + 64 * j];
    unsigned* cnt = (unsigned*)(F.ws + WS_CTL) + CW_CNT; int* lists = (int*)(F.ws + WS_SMALL + SMB_LIST); TokInfo* ti = (TokInfo*)(F.ws + WS_SMALL + SMB_TOK);
    f32x4 vn[4];
    { const GAS f32x4* x0 = (const GAS f32x4*)(F.out + (size_t)(gw < MR ? gw : 0) * D) + F.lane;
#pragma unroll
      for (int j = 0; j < 4; ++j) vn[j] = x0[64 * j]; }
    for (int r = gw; r < MR; r += NGW) {
        f32x4 v[4]; float s = 0.f;
#pragma unroll
        for (int j = 0; j < 4; ++j) v[j] = vn[j];
        { const int rn = r + NGW; const GAS f32x4* xn = (const GAS f32x4*)(F.out + (size_t)(rn < MR ? rn : r) * D) + F.lane;
#pragma unroll
          for (int j = 0; j < 4; ++j) vn[j] = xn[64 * j]; }
#pragma unroll
        for (int j = 0; j < 4; ++j) s += (v[j].x * v[j].x + v[j].y * v[j].y) + (v[j].z * v[j].z + v[j].w * v[j].w);
        const float sc = rsqrtf(wave_sum(s) * (1.f / D) + EPS);
        GAS unsigned* o = (GAS unsigned*)(F.ws + WS_HN + (size_t)r * D) + F.lane;
        float lg[8];
#pragma unroll
        for (int e = 0; e < 8; ++e) lg[e] = 0.f;
#pragma unroll
        for (int j = 0; j < 4; ++j) {
            v[j] = v[j] * sc * gv[j];
            o[64 * j] = pk4_fp8(v[j].x, v[j].y, v[j].z, v[j].w);
#pragma unroll
            for (int q = 0; q < 4; ++q) { const int d = (F.lane + 64 * j) * 4 + q; const f32x4 r0 = *(const LAS f32x4*)(rwl + d * 8), r1 = *(const LAS f32x4*)(rwl + d * 8 + 4); const float x = v[j][q];
                lg[0] += x * r0[0]; lg[1] += x * r0[1]; lg[2] += x * r0[2]; lg[3] += x * r0[3]; lg[4] += x * r1[0]; lg[5] += x * r1[1]; lg[6] += x * r1[2]; lg[7] += x * r1[3]; }
        }
#pragma unroll
        for (int e = 0; e < 8; ++e) lg[e] = wave_sum(lg[e]);
        int i1 = 0; float m1 = lg[0];
#pragma unroll
        for (int e = 1; e < 8; ++e) if (lg[e] > m1) { m1 = lg[e]; i1 = e; }
        int i2 = -1; float m2 = -INFINITY;
#pragma unroll
        for (int e = 0; e < 8; ++e) if (e != i1 && lg[e] > m2) { m2 = lg[e]; i2 = e; }
        if (F.lane == 0) {
            const float w1 = 1.f / (1.f + expf(m2 - m1));
            const unsigned s1 = __hip_atomic_fetch_add(cnt + 64 * i1, 1u, RLX_AGENT), s2 = __hip_atomic_fetch_add(cnt + 64 * i2, 1u, RLX_AGENT);
            lists[i1 * LISTCAP + s1] = r; lists[i2 * LISTCAP + s2] = r;
            TokInfo t; t.e1 = i1; t.s1 = (int)s1; t.e2 = i2; t.s2 = (int)s2; t.w1 = w1; t.w2 = 1.f - w1; t.pad0 = 0; t.pad1 = 0; ti[r] = t;
        }
    }
}
struct MoeTiles { int ts[9]; };
__device__ __forceinline__ MoeTiles moe_tiles(Frame& F) {
    MoeTiles m; const unsigned* cnt = (const unsigned*)(F.ws + WS_CTL) + CW_CNT; int a = 0;
#pragma unroll
    for (int e = 0; e < 8; ++e) { m.ts[e] = a; const unsigned c = (unsigned)__builtin_amdgcn_readfirstlane((int)__hip_atomic_load(cnt + 64 * e, RLX_AGENT)); a += (int)((c + 255u) >> 8); }
    m.ts[8] = a; return m;
}
__device__ __forceinline__ int moe_expert_of(const MoeTiles& m, int rt) { int e = 0;
#pragma unroll
    for (int k = 1; k < 8; ++k) e += (rt >= m.ts[k]) ? 1 : 0;
    return e; }
struct MoeGuOrder {
    MoeTiles m; int G, c; const int* lists;
    __device__ __forceinline__ bool next(int i, Unit& u) const {
        const int L = i * G + c; if (L >= m.ts[8] * 28) return false;
        const int rt = L / 28, pn = L - rt * 28, e = moe_expert_of(m, rt);
        int tsb = 0;
#pragma unroll
        for (int k = 0; k < 8; ++k) tsb = (k == e) ? m.ts[k] : tsb;
        u.pm = rt; u.pn = pn; u.z = e; u.a_off = 0u; u.b_off = (unsigned)(((long)e * 7168 + pn * 256) * D); u.gidx = lists + e * LISTCAP + (rt - tsb) * 256; return true;
    }
};
struct MoeDownOrder {
    MoeTiles m; int G, c;
    __device__ __forceinline__ bool next(int i, Unit& u) const {
        const int nt = m.ts[8] < 128 ? m.ts[8] : 128; const int L = i * G + c; if (L >= nt * 4) return false;
        const int rt = L >> 2, pn = L & 3, e = moe_expert_of(m, rt);
        u.pm = rt; u.pn = pn; u.z = e; u.a_off = (unsigned)((long)rt * 256 * FFE); u.b_off = (unsigned)(((long)e * D + pn * 256) * FFE); u.gidx = nullptr; return true;
    }
};
struct MoeSlabOrder {
    MoeTiles m; int G, c, S, Kp;
    __device__ __forceinline__ bool next(int i, Unit& u) const {
        const int nleft = (m.ts[8] - 128) * 4; const int q = i * G + c; if (q >= nleft * S) return false;
        const int up = q / S, sl = q - up * S, rt = 128 + (up >> 2), pn = up & 3, e = moe_expert_of(m, rt);
        u.pm = rt; u.pn = pn; u.z = q; u.a_off = (unsigned)((long)rt * 256 * FFE + (long)sl * Kp * 2); u.b_off = (unsigned)(((long)e * D + pn * 256) * FFE + (long)sl * Kp * 2); u.gidx = nullptr; return true;
    }
};
struct EpiSlab {
    static constexpr bool PERM = false, MID = false;
    float* SL; float sc;
    __device__ __forceinline__ void row(const Unit& u, int r, int slot, int wc, int fq, const f32x4 (&v)[2][2]) const {
        float* p = SL + (size_t)u.z * 65536 + (size_t)(r & 255) * 256 + 32 * wc + 4 * fq;
#pragma unroll
        for (int bj = 0; bj < 2; ++bj)
#pragma unroll
            for (int n = 0; n < 2; ++n) *(f32x4*)(p + 128 * bj + 16 * n) = v[bj][n] * sc;
    }
};
__device__ __forceinline__ void moe_slab_split(int tiles, int G, int& S, int& Kp) { S = 7; Kp = 256; }
struct EpiY {
    static constexpr bool PERM = true, MID = false;
    bf16_t* Y; float sc;
    __device__ __forceinline__ void row(const Unit& u, int r, int slot, int wc, int fq, const f32x4 (&v)[2][2]) const {
#pragma unroll
        for (int bj = 0; bj < 2; ++bj) *(u32x4*)(Y + (size_t)r * D + u.pn * 256 + 128 * bj + 32 * wc + 8 * fq) = pack8(v[bj][0] * sc, v[bj][1] * sc);
    }
};
__device__ __forceinline__ f32x4 moe_y4(const bf16_t* Y, const float* SL, int S, size_t R, int j, int lane) {
    if (R < 32768) { const u32x2 y = *((const GAS u32x2*)(Y + R * D) + lane + 64 * j); return (f32x4){bflo(y.x), bfhi(y.x), bflo(y.y), bfhi(y.y)}; }
    const float* p = SL + ((size_t)(((R >> 8) - 128) * 4 + j) * S) * 65536 + (R & 255) * 256 + 4 * lane; f32x4 a = (f32x4){0.f, 0.f, 0.f, 0.f};
    for (int s0 = 0; s0 < S; s0 += 7) {
        f32x4 q[7];
#pragma unroll
        for (int sl = 0; sl < 7; ++sl) q[sl] = *(const f32x4*)(p + (size_t)(s0 + sl) * 65536);
#pragma unroll
        for (int sl = 0; sl < 7; ++sl) a += q[sl];
    }
    return a;
}
__device__ __forceinline__ void moe_combine_pass(Frame& F) {
    const MoeTiles m = moe_tiles(F); const TokInfo* ti = (const TokInfo*)(F.ws + WS_SMALL + SMB_TOK); const bf16_t* Y = WSP(bf16_t, WS_MY); const float* SL = WSP(float, WS_SLAB);
    int S, Kp; moe_slab_split(m.ts[8], F.G, S, Kp);
    const int gw = F.vcu * NWAVES + F.wave, NGW = F.G * NWAVES;
    TokInfo tn = ti[gw < MR ? gw : 0];
    for (int r = gw; r < MR; r += NGW) {
        const TokInfo t = tn; { const int rn = r + NGW; tn = ti[rn < MR ? rn : r]; }
        int b1 = 0, b2 = 0;
#pragma unroll
        for (int k = 0; k < 8; ++k) { b1 = (k == t.e1) ? m.ts[k] : b1; b2 = (k == t.e2) ? m.ts[k] : b2; }
        const size_t r1 = (size_t)b1 * 256 + t.s1, r2 = (size_t)b2 * 256 + t.s2;
        GAS f32x4* o = (GAS f32x4*)(F.out + (size_t)r * D) + F.lane;
        if (r1 < 32768 && r2 < 32768) {
            u32x2 y1[4], y2[4]; f32x4 x[4];
#pragma unroll
            for (int j = 0; j < 4; ++j) { y1[j] = *((const GAS u32x2*)(Y + r1 * D) + F.lane + 64 * j); y2[j] = *((const GAS u32x2*)(Y + r2 * D) + F.lane + 64 * j); x[j] = o[64 * j]; }
#pragma unroll
            for (int j = 0; j < 4; ++j) { x[j][0] += t.w1 * bflo(y1[j].x) + t.w2 * bflo(y2[j].x); x[j][1] += t.w1 * bfhi(y1[j].x) + t.w2 * bfhi(y2[j].x); x[j][2] += t.w1 * bflo(y1[j].y) + t.w2 * bflo(y2[j].y); x[j][3] += t.w1 * bfhi(y1[j].y) + t.w2 * bfhi(y2[j].y); o[64 * j] = x[j]; }
        } else {
#pragma unroll
            for (int j = 0; j < 4; ++j) { const f32x4 y1 = moe_y4(Y, SL, S, r1, j, F.lane), y2 = moe_y4(Y, SL, S, r2, j, F.lane); o[64 * j] = o[64 * j] + y1 * t.w1 + y2 * t.w2; }
        }
    }
}
}
namespace mk {
enum { P_CVT = 0, P_NORM1, P_PROJ, P_MIX, P_SCAN, P_FIN, P_GATES, P_MERGE, P_WOUT, P_NORM2, P_GU, P_DOWN, P_COMB, P_NPH };
struct Args { const float* in[22]; float* out; unsigned char* ws; unsigned pmask; int l0, l1; unsigned dup; };

#define PH(k) ((a.pmask >> (k)) & 1u)
#define PHASE_FRAME() Frame F = F0; { const int t_ = pg8::make_tid(F0.wave); F.tid = t_; F.lane = t_ & 63; F.wave = F0.wave; unsigned char* w_ = F0.ws; asm volatile("" : "+s"(w_)); F.ws = w_; int g_ = F0.G, v_ = F0.vcu; asm volatile("" : "+s"(g_), "+s"(v_)); F.G = g_; F.vcu = v_; } float* sm = SMALLF; (void)sm
#define GRID_BAR() xcd_barrier(bar, F.tid)
template <int l> __device__ __forceinline__ void layer_body(const Args& a, const Frame& F0, const XcdBarrier& bar, unsigned char* lds) {
    constexpr bool first = (l == 0);
#ifndef NO_P_CVT
        if (PH(P_CVT) && l == 0) for (int rep_ = 0; rep_ <= (int)((a.dup >> (16 + l)) & (a.dup >> P_CVT) & 1u); ++rep_) { PHASE_FRAME(); setup_small(F); convert_layer_weights(F, 0, -1, 0, F.G == 256 ? 1 : 0); }
#endif
#ifndef NO_P_NORM1
        if (PH(P_NORM1)) for (int rep_ = 0; rep_ <= (int)((a.dup >> (16 + l)) & (a.dup >> P_NORM1) & 1u); ++rep_) { PHASE_FRAME(); norm_pass(F, F.in[2] + l * D, first, true); GRID_BAR(); }
#endif
#ifndef NO_P_PROJ
        if (PH(P_PROJ)) for (int rep_ = 0; rep_ <= (int)((a.dup >> (16 + l)) & (a.dup >> P_PROJ) & 1u); ++rep_) { PHASE_FRAME();
            Gemm g{WSP(bf16_t, WS_HN), WSP(bf16_t, WS_WIN), D, D, D}; TileOrder S; S.init(64, 20, 0, F.G, (int)blockIdx.x, D, D);
            EpiProj E{F.ws, F.in[5] + l * 64, F.in[6] + l * 64, l, 1.f};
            pg8::gemm_phase<EpiProj, TileOrder>(F.lds + RING_OFF, g, S, E, F.wave);
            meta_gemm(F, WSP(bf16_t, WS_HN) + (size_t)MR * D, D, WSP(bf16_t, WS_WIN), D, D, 0, 20, E);
            GRID_BAR();
        }
#endif
#ifndef NO_P_MIX
        if (PH(P_MIX)) for (int rep_ = 0; rep_ <= (int)((a.dup >> (16 + l)) & (a.dup >> P_MIX) & 1u); ++rep_) { PHASE_FRAME();
            if (!(a.dup & 0x8000u) || rep_ == 0) {
                if (F.G == 256) {
                    const bool hm = (F.vcu & 7) == 0 && F.vcu < 32; const int idm = 1024 + (F.vcu >> 3);
                    HgIn A, B; hgrnA_load(F, F.vcu, A); hgrnA_load(F, F.vcu + 256, B); hgrnA_compute(F, F.vcu, A);
                    hgrnA_load(F, F.vcu + 512, A); hgrnA_compute(F, F.vcu + 256, B); hgrnA_load(F, F.vcu + 768, B); hgrnA_compute(F, F.vcu + 512, A);
                    if (hm) hgrnA_load(F, idm, A);
                    hgrnA_compute(F, F.vcu + 768, B); if (hm) hgrnA_compute(F, idm, A); }
                else for (int id = F.vcu; id < 1028; id += F.G) { HgIn A; hgrnA_load(F, id, A); hgrnA_compute(F, id, A); }
            }
            if (rep_ == 1 && !(a.dup & 0x8000u)) { GRID_BAR(); continue; }
            conv_pass(F, F.in[10] + l * 1536);
            { LAS float* tabl = (LAS float*)(F.lds + RING_OFF + attn_body::LDS_TAB); tabl[F.tid] = sm[SM_TAB + F.tid]; }
            __syncthreads();
            { int b, vh, qb;
              for (int i = 0; attn_body::attn_next(F.G, F.vcu, i, b, vh, qb); ++i)
                  attn_body::attn_unit<8>(b, vh, qb, (const attn_body::bf16*)WSP(bf16_t, WS_QK), (const attn_body::bf16*)WSP(bf16_t, WS_V), (attn_body::bf16*)WSP(bf16_t, WS_O), (char*)lds + RING_OFF, F.wave); }
            if (l == 0 && F.G == 256) {
                const int g = F.vcu & 7, bv = F.vcu >> 3;
                if (g != 7 && !(g == 0 && bv < 4)) { const int idx = bv < 4 ? bv * 6 + (g - 1) : 24 + (bv - 4) * 7 + g; convert_layer_weights(F, 0, idx * NWAVES + F.wave, 220 * NWAVES, 2); } }
            if (l == 1 && F.G == 256) {
                const int g = F.vcu & 7, bv = F.vcu >> 3;
                if (g != 7 && !(g == 0 && bv < 4)) { const int idx = bv < 4 ? bv * 6 + (g - 1) : 24 + (bv - 4) * 7 + g; convert_moe_gu(F, 3, idx * NWAVES + F.wave, 220 * NWAVES); } }
            GRID_BAR();
        }
#endif
#ifndef NO_P_SCAN
        if (PH(P_SCAN)) for (int rep_ = 0; rep_ <= (int)((a.dup >> (16 + l)) & (a.dup >> P_SCAN) & 1u); ++rep_) { PHASE_FRAME(); hgrn_scan(F); GRID_BAR(); }
#endif
#ifndef NO_P_FIN
        if (PH(P_FIN)) for (int rep_ = 0; rep_ <= (int)((a.dup >> (16 + l)) & (a.dup >> P_FIN) & 1u); ++rep_) { PHASE_FRAME(); hgrnC_pass(F, F.in[12] + l * 128); attcomb_pass(F, F.in[8] + l * 128, l); }
#endif
#ifndef NO_P_GATES
        if (PH(P_GATES)) for (int rep_ = 0; rep_ <= (int)((a.dup >> (16 + l)) & (a.dup >> P_GATES) & 1u); ++rep_) { PHASE_FRAME();
            Gemm g{(const bf16_t*)(F.ws + WS_HN8), (const bf16_t*)(F.ws + WS_WIN8 - (size_t)20 * 256 * D), D / 2, D / 2, D / 2}; TileOrder S; S.init(64, 12, 20, F.G, (int)blockIdx.x, D / 2, D / 2);
            EpiProj E{F.ws, F.in[5] + l * 64, F.in[6] + l * 64, l, 1.f / W8_SCALE};
            pg8::gemm_phase<EpiProj, TileOrder, false, true>(F.lds + RING_OFF, g, S, E, F.wave);
            if (l == 0) { EpiProj Em{F.ws, F.in[5] + l * 64, F.in[6] + l * 64, l, 1.f}; meta_gemm(F, WSP(bf16_t, WS_HN) + (size_t)MR * D, D, WSP(bf16_t, WS_WIN), D, D, 20, 32, Em); }
            GRID_BAR();
        }
#endif
#ifndef NO_P_MERGE
        if (PH(P_MERGE)) for (int rep_ = 0; rep_ <= (int)((a.dup >> (16 + l)) & (a.dup >> P_MERGE) & 1u); ++rep_) { PHASE_FRAME();
            Gemm g{WSP(bf16_t, WS_U), WSP(bf16_t, WS_WBR), 1536, 1536, 1536}; TileOrder S; S.init(64, 4, 0, F.G, (int)blockIdx.x, 1536, 1536);
            EpiMerge E{WSP(bf16_t, WS_GATES), WSP(bf16_t, WS_MIXED)};
            pg8::gemm_phase<EpiMerge, TileOrder>(F.lds + RING_OFF, g, S, E, F.wave);
            if (l == 0) meta_merge(F, WSP(bf16_t, WS_U) + (size_t)MR * 1536, WSP(bf16_t, WS_WBR), WSP(bf16_t, WS_GATES), WSP(bf16_t, WS_MIXED));
            GRID_BAR();
        }
#endif
#ifndef NO_P_WOUT
        if (PH(P_WOUT)) for (int rep_ = 0; rep_ <= (int)((a.dup >> (16 + l)) & (a.dup >> P_WOUT) & 1u); ++rep_) { PHASE_FRAME();
            Gemm g{WSP(bf16_t, WS_MIXED), WSP(bf16_t, WS_WO), D, D, D}; TileOrder S; S.init(64, 4, 0, F.G, (int)blockIdx.x, D, D);
            EpiRes E{first ? F.in[0] : (const float*)F.out, F.out, first ? F.in[1] : (const float*)(sm + SM_METAHS), sm + SM_METAHS};
            pg8::gemm_phase<EpiRes, TileOrder>(F.lds + RING_OFF, g, S, E, F.wave);
            if (l == 0) meta_gemm(F, WSP(bf16_t, WS_MIXED) + (size_t)MR * D, D, WSP(bf16_t, WS_WO), D, D, 0, 4, E);
            GRID_BAR();
        }
#endif
#ifndef NO_P_NORM2
        if (PH(P_NORM2) && l == 0) for (int rep_ = 0; rep_ <= (int)((a.dup >> (16 + l)) & (a.dup >> P_NORM2) & 1u); ++rep_) { PHASE_FRAME(); norm_pass(F, F.in[3] + l * D, false, false); if (PH(P_CVT)) setup_small(F); GRID_BAR(); }
        if (PH(P_NORM2) && l == 1) for (int rep_ = 0; rep_ <= (int)((a.dup >> (16 + l)) & (a.dup >> P_NORM2) & 1u); ++rep_) { PHASE_FRAME(); norm_route_pass(F, F.in[3] + l * D); convert_moe_gu(F, -1, 0, 1, F.G == 256 ? 3 : -1); GRID_BAR(); }
#endif
#ifndef NO_P_GU
        if (PH(P_GU) && l == 0) for (int rep_ = 0; rep_ <= (int)((a.dup >> (16 + l)) & (a.dup >> P_GU) & 1u); ++rep_) { PHASE_FRAME();
            Gemm g{WSP(bf16_t, WS_HN), WSP(bf16_t, WS_WGU0), D, D, D}; TileOrder S; S.init(64, 22, 0, F.G, (int)blockIdx.x, D, D);
            EpiGU E{WSP(bf16_t, WS_H0), FFD, 1.f};
            pg8::gemm_phase<EpiGU, TileOrder>(F.lds + RING_OFF, g, S, E, F.wave);
            meta_gemm(F, WSP(bf16_t, WS_HN) + (size_t)MR * D, D, WSP(bf16_t, WS_WGU0), D, D, 0, 22, E);
            if (PH(P_CVT) && rep_ == 0) { const int total = 64 * 22, rem = total % F.G, bx = (int)blockIdx.x;
              if (rem == 0) convert_layer_weights(F, 1, bx * NWAVES + F.wave, F.G * NWAVES); else if (bx >= rem) convert_layer_weights(F, 1, (bx - rem) * NWAVES + F.wave, (F.G - rem) * NWAVES); }
            GRID_BAR();
        }
#endif
#ifndef NO_P_DOWN
        if (PH(P_DOWN) && l == 0) for (int rep_ = 0; rep_ <= (int)((a.dup >> (16 + l)) & (a.dup >> P_DOWN) & 1u); ++rep_) { PHASE_FRAME();
            Gemm g{WSP(bf16_t, WS_H0), WSP(bf16_t, WS_WD0), FFD, FFD, FFD}; TileOrder S; S.init(64, 4, 0, F.G, (int)blockIdx.x, FFD, FFD);
            EpiRes E{(const float*)F.out, F.out, (const float*)(sm + SM_METAHS), sm + SM_METAHS};
            pg8::gemm_phase<EpiRes, TileOrder>(F.lds + RING_OFF, g, S, E, F.wave);
            meta_gemm(F, WSP(bf16_t, WS_H0) + (size_t)MR * FFD, FFD, WSP(bf16_t, WS_WD0), FFD, FFD, 0, 4, E);
            GRID_BAR();
        }
#endif
#ifndef NO_P_MOE
        if (PH(P_GU) && l == 1) for (int rep_ = 0; rep_ <= (int)((a.dup >> (16 + l)) & (a.dup >> P_GU) & 1u); ++rep_) { PHASE_FRAME();
            Gemm g{WSP(bf16_t, WS_HN), WSP(bf16_t, WS_MGU), D / 2, D / 2, D / 2};   MoeGuOrder S{moe_tiles(F), F.G, (int)blockIdx.x, (const int*)(F.ws + WS_SMALL + SMB_LIST)};
            EpiGU8 E{F.ws + WS_MH, FFE, 1.f / W8_SCALE};
            pg8::gemm_phase<EpiGU8, MoeGuOrder, true, true>(F.lds + RING_OFF, g, S, E, F.wave);
            { const int total = S.m.ts[8] * 28, rem = total % F.G, bx = (int)blockIdx.x;
              if (rem == 0) convert_moe_down(F, bx * NWAVES + F.wave, F.G * NWAVES); else if (bx >= rem) convert_moe_down(F, (bx - rem) * NWAVES + F.wave, (F.G - rem) * NWAVES); }
            GRID_BAR();
        }
        if (PH(P_DOWN) && l == 1) for (int rep_ = 0; rep_ <= (int)((a.dup >> (16 + l)) & (a.dup >> P_DOWN) & 1u); ++rep_) { PHASE_FRAME();
            Gemm g{WSP(bf16_t, WS_MH), WSP(bf16_t, WS_MD), FFE / 2, FFE / 2, FFE / 2};   MoeDownOrder S{moe_tiles(F), F.G, (int)blockIdx.x};
            EpiY E{WSP(bf16_t, WS_MY), 1.f / (H8_SCALE * WD8_SCALE)};
            pg8::gemm_phase<EpiY, MoeDownOrder, false, true>(F.lds + RING_OFF, g, S, E, F.wave);
            { int SS, Kp; moe_slab_split(S.m.ts[8], F.G, SS, Kp);
              Gemm g2{WSP(bf16_t, WS_MH), WSP(bf16_t, WS_MD), FFE / 2, FFE / 2, Kp}; MoeSlabOrder S2{S.m, F.G, (int)blockIdx.x, SS, Kp}; EpiSlab E2{WSP(float, WS_SLAB), 1.f / (H8_SCALE * WD8_SCALE)};
              pg8::gemm_phase<EpiSlab, MoeSlabOrder, false, true>(F.lds + RING_OFF, g2, S2, E2, F.wave); }
            GRID_BAR();
        }
        if (PH(P_COMB) && l == 1) for (int rep_ = 0; rep_ <= (int)((a.dup >> (16 + l)) & (a.dup >> P_COMB) & 1u); ++rep_) { PHASE_FRAME(); moe_combine_pass(F); if (rep_ < (int)((a.dup >> (16 + l)) & (a.dup >> P_COMB) & 1u)) GRID_BAR(); }
#endif
}
__global__ void __launch_bounds__(NWAVES * 64, 2) mega(Args a) {
    extern __shared__ __attribute__((aligned(16))) unsigned char lds[];
    Frame F0; Frame& F = F0;
    F.lds = (LAS unsigned char*)lds; F.lds_gen = lds;
    F.wave = __builtin_amdgcn_readfirstlane((int)threadIdx.x >> 6); F.tid = pg8::make_tid(F.wave); F.lane = F.tid & 63;
    F.G = gridDim.x; { const int bx = blockIdx.x; F.vcu = (F.G % 8 == 0) ? (bx % 8) * (F.G / 8) + bx / 8 : bx; }
    F.in = a.in; F.out = a.out; F.ws = a.ws;
    for (int u = F.tid; u < (LDS_BYTES - LDSCTL_OFF) / 4; u += NWAVES * 64) ((LAS unsigned*)(F.lds + LDSCTL_OFF))[u] = 0u;
    __syncthreads();
    volatile LAS unsigned* MISC = (volatile LAS unsigned*)(F.lds + MISC_OFF);
    XcdBarrier bar = xcd_barrier_post((unsigned*)(F.ws + WS_CTL) + 4096, MISC + 8, F.tid);
    if (a.l0 <= 0 && 0 < a.l1) layer_body<0>(a, F0, bar, lds);
    if (a.l0 <= 1 && 1 < a.l1) layer_body<1>(a, F0, bar, lds);
}
#undef PH
#undef GRID_BAR


#ifndef MK_DUP
#define MK_DUP 0u
#endif
static int g_grid = 0;
static bool mega_init() {
    if (g_grid) return g_grid > 0;
    int dev = 0, cus = 0, per_cu = 0;
    if (hipGetDevice(&dev) != hipSuccess || hipDeviceGetAttribute(&cus, hipDeviceAttributeMultiprocessorCount, dev) != hipSuccess) { g_grid = -1; return false; }
    if (hipFuncSetAttribute((const void*)mega, hipFuncAttributeMaxDynamicSharedMemorySize, LDS_BYTES) != hipSuccess) { g_grid = -1; return false; }
    if (hipOccupancyMaxActiveBlocksPerMultiprocessor(&per_cu, (const void*)mega, NWAVES * 64, LDS_BYTES) != hipSuccess || per_cu < 1) { fprintf(stderr, "mega: occupancy query says %d\n", per_cu); }
    (void)hipGetLastError();
    g_grid = cus;
    return true;
}
static void mega_launch(void* const* d_in, float* out, unsigned char* ws, unsigned pmask, int l0, int l1, hipStream_t st) {
    if (!mega_init()) return;
    (void)hipMemsetAsync(ws + WS_CTL, 0, CTL_ZERO_BYTES, st);
    Args a{};
    for (int i = 0; i < 22; ++i) a.in[i] = (const float*)d_in[i];
    a.out = out; a.ws = ws; a.pmask = pmask; a.l0 = l0; a.l1 = l1; a.dup = MK_DUP;
    hipLaunchKernelGGL(mega, dim3(g_grid), dim3(NWAVES * 64), LDS_BYTES, st, a);
}
}
extern "C" void kernel_launch(void* const* d_in, const int* in_sizes, int n_in, void* d_out, int out_size, void* d_ws, size_t ws_size, hipStream_t stream) {
    (void)in_sizes; (void)n_in; (void)out_size;
    if (ws_size < (size_t)512 * (1u << 20)) { fprintf(stderr, "kernel_launch: workspace too small (%zu)\n", ws_size); return; }
    mk::mega_launch(d_in, (float*)d_out, (unsigned char*)d_ws, (1u << mk::P_NPH) - 1u, 0, 2, stream);
}
```

```cpp
#include <hip/hip_runtime.h>
#include <cstdio>
#include <cstdint>
#include <cmath>
#include <hip/hip_bf16.h>
namespace pg8 {
#define PG8_LAS __attribute__((address_space(3)))
typedef unsigned short bf16_t;
typedef short bf16x8 __attribute__((ext_vector_type(8)));
typedef float f32x4 __attribute__((ext_vector_type(4)));
typedef unsigned u32x4 __attribute__((ext_vector_type(4)));
typedef unsigned u32x2 __attribute__((ext_vector_type(2)));
typedef int v4i_t __attribute__((ext_vector_type(4)));
typedef int v8i_t __attribute__((ext_vector_type(8)));
constexpr int BM = 256, BK = 64, HALF = 128, HTB = HALF * BK * 2, STAGE_BYTES = 8 * HTB;

__host__ __device__ __forceinline__ int lds_byte(int r, int c) { const int st = (r >> 4) * 2 + (c >> 5), rr = r & 15, cc = c & 31, ob = rr * 64 + cc * 2; return st * 1024 + (ob ^ (((ob >> 9) & 1) << 5)); }
__host__ __device__ __forceinline__ void stage_rc(int b, int& R, int& C) { const int st = b / 1024, sb = b % 1024, swz = sb ^ (((sb >> 9) & 1) << 5); R = (st >> 1) * 16 + swz / 64; C = (st & 1) * 32 + (swz % 64) / 2; }
__host__ __device__ __forceinline__ int perm32(int rho) { const int n = rho >> 4, i = rho & 15; return 8 * (i >> 2) + 4 * n + (i & 3); }

struct Unit { int pm, pn, z; unsigned a_off, b_off; const int* gidx; };
struct Gemm { const bf16_t* A; const bf16_t* Bt; int lda, ldb, K; };

__device__ __forceinline__ int lane_id() { unsigned m = ~0u; asm volatile("" : "+s"(m)); return (int)__builtin_amdgcn_mbcnt_hi(m, __builtin_amdgcn_mbcnt_lo(m, 0u)); }
__device__ __forceinline__ int make_tid(int wave) { int t = (wave << 6) | lane_id(); asm volatile("" : "+v"(t)); return t; }
typedef float f32x2_cv __attribute__((ext_vector_type(2))); typedef __bf16 bf16x2_cv __attribute__((ext_vector_type(2)));
__device__ __forceinline__ unsigned cvt_pk_bf16(float lo, float hi) { const f32x2_cv v = {lo, hi}; const bf16x2_cv b = __builtin_convertvector(v, bf16x2_cv); return __builtin_bit_cast(unsigned, b); }

template <class Epi, class Sched, bool GATHER = false, bool FP8 = false>
__device__ __forceinline__ void gemm_phase(PG8_LAS unsigned char* lds, const Gemm g, const Sched& S, const Epi& E, int wave0) {
    const int tid = make_tid(wave0),
              wid = __builtin_amdgcn_readfirstlane(tid >> 6), lane = tid & 63, wr = wid >> 2, wc = wid & 3, fr = lane & 15, fq = lane >> 4;
    const int K = g.K, nt = K / BK;
    unsigned voffA[2], voffB[2];
#pragma unroll
    for (int i = 0; i < 2; ++i) { int R, C; stage_rc(tid * 16 + i * 8192, R, C); const int Rb = Epi::PERM ? ((R & ~31) + perm32(R & 31)) : R;
        voffA[i] = (unsigned)(R * g.lda + C) * 2u; voffB[i] = (unsigned)(Rb * g.ldb + C) * 2u; }
    const size_t kstep = (size_t)(BK * 2);
    const size_t hstepA = GATHER ? 0 : (size_t)HALF * g.lda * 2, hstepB = (size_t)HALF * g.ldb * 2;
    const unsigned ldsw = (unsigned)wid * 1024u;
    const int aoff = lds_byte(wr * 64 + fr, fq * 8), boff = lds_byte(wc * 32 + fr, fq * 8);
    unsigned gvc[2][2], gvn[2][2];
#define PG8_SA(b, h) (((b) * 2 + (h)) * HTB)
#define PG8_SB(b, h) ((4 + (b) * 2 + (h)) * HTB)
#define PG8_STAGE(bufoff, gbase, voff) do { _Pragma("unroll") for (int _i = 0; _i < 2; ++_i) \
        __builtin_amdgcn_global_load_lds((const unsigned*)((const char*)(gbase) + (voff)[_i]), (PG8_LAS unsigned*)(lds + (bufoff) + ldsw + _i * 8192), 16, 0, 0); } while (0)
#define PG8_STAGE_A(bufoff, base, h, nx) do { if constexpr (GATHER) { if (nx) PG8_STAGE(bufoff, base, gvn[h]); else PG8_STAGE(bufoff, base, gvc[h]); } else { PG8_STAGE(bufoff, (base) + (h) * hstepA, voffA); } } while (0)
#define PG8_LD8(a_) __builtin_shufflevector(*(const PG8_LAS v4i_t*)(a_), *(const PG8_LAS v4i_t*)((a_) + 1024), 0, 1, 2, 3, 4, 5, 6, 7)
#define PG8_LDA(dst, b, h) do { if constexpr (FP8) { _Pragma("unroll") for (int m = 0; m < 4; ++m) dst##8[m] = PG8_LD8(lds + PG8_SA(b, h) + aoff + m * 2048); } else { \
        _Pragma("unroll") for (int m = 0; m < 4; ++m) _Pragma("unroll") for (int k = 0; k < 2; ++k) dst[m][k] = *(const PG8_LAS bf16x8*)(lds + PG8_SA(b, h) + aoff + m * 2048 + k * 1024); } } while (0)
#define PG8_LDB(dst, b, h) do { if constexpr (FP8) { _Pragma("unroll") for (int n = 0; n < 2; ++n) dst##8[n] = PG8_LD8(lds + PG8_SB(b, h) + boff + n * 2048); } else { \
        _Pragma("unroll") for (int n = 0; n < 2; ++n) _Pragma("unroll") for (int k = 0; k < 2; ++k) dst[n][k] = *(const PG8_LAS bf16x8*)(lds + PG8_SB(b, h) + boff + n * 2048 + k * 1024); } } while (0)
#define PG8_MMA(ai, bj, At, Bt) do { __builtin_amdgcn_s_setprio(1); if constexpr (FP8) { _Pragma("unroll") for (int m = 0; m < 4; ++m) _Pragma("unroll") for (int n = 0; n < 2; ++n) \
        asm volatile("v_mfma_scale_f32_16x16x128_f8f6f4 %0, %1, %2, %0, %3, %3 op_sel_hi:[0,0,0]" : "+v"(acc[ai][bj][m][n]) : "v"(Bt##8[n]), "v"(At##8[m]), "v"(one8)); } else { \
        _Pragma("unroll") for (int m = 0; m < 4; ++m) _Pragma("unroll") for (int n = 0; n < 2; ++n) _Pragma("unroll") for (int k = 0; k < 2; ++k) \
        acc[ai][bj][m][n] = __builtin_amdgcn_mfma_f32_16x16x32_bf16(Bt[n][k], At[m][k], acc[ai][bj][m][n], 0, 0, 0); } __builtin_amdgcn_s_setprio(0); } while (0)
#define PG8_WAIT_V(n) asm volatile("s_waitcnt vmcnt(" #n ")" ::: "memory")
#define PG8_WAIT_L(n) asm volatile("s_waitcnt lgkmcnt(" #n ")" ::: "memory")
#define PG8_BAR __builtin_amdgcn_s_barrier()
#define PG8_SCHED __builtin_amdgcn_sched_barrier(0)
#define PG8_GLOAD(dst, u) do { if constexpr (GATHER) { const int t2_ = make_tid(wave0); _Pragma("unroll") for (int _i = 0; _i < 2; ++_i) { int R_, C_; stage_rc(t2_ * 16 + _i * 8192, R_, C_); \
        _Pragma("unroll") for (int _h = 0; _h < 2; ++_h) dst[_h][_i] = (unsigned)((u).gidx[_h * HALF + R_] * g.lda + C_) * 2u; } } } while (0)
    Unit cur, nxt; int ui = 0;
    if (!S.next(0, cur)) return;
    f32x4 acc[2][2][4][2];
#pragma unroll
    for (int a = 0; a < 2; ++a)
#pragma unroll
        for (int b = 0; b < 2; ++b)
#pragma unroll
            for (int m = 0; m < 4; ++m)
#pragma unroll
                for (int n = 0; n < 2; ++n) acc[a][b][m][n] = (f32x4){0.f, 0.f, 0.f, 0.f};
    bf16x8 At[4][2], B0[2][2], B1[2][2]; v8i_t At8[4], B08[2], B18[2];
    int one8 = 0x7f7f7f7f; asm volatile("" : "+v"(one8));
    const char* cA = (const char*)g.A + cur.a_off; const char* cB = (const char*)g.Bt + cur.b_off;
    PG8_GLOAD(gvc, cur);
#pragma unroll
    for (int _h = 0; _h < 2; ++_h)
#pragma unroll
        for (int _i = 0; _i < 2; ++_i) gvn[_h][_i] = 0u;
    PG8_STAGE(PG8_SB(0, 0), cB, voffB); PG8_STAGE(PG8_SB(0, 1), cB + hstepB, voffB); PG8_STAGE_A(PG8_SA(0, 0), cA, 0, false); PG8_STAGE_A(PG8_SA(0, 1), cA, 1, false);
    if (wr == 1) PG8_BAR;
    PG8_WAIT_V(2); PG8_BAR;
    PG8_STAGE(PG8_SB(1, 0), cB + kstep, voffB); PG8_STAGE_A(PG8_SA(1, 0), cA + kstep, 0, false); PG8_STAGE(PG8_SB(1, 1), cB + hstepB + kstep, voffB);
    PG8_WAIT_V(6); PG8_BAR;
    for (;;) {
        const bool has_next = S.next(ui + 1, nxt);
        const char* nA = has_next ? (const char*)g.A + nxt.a_off : cA; const char* nB = has_next ? (const char*)g.Bt + nxt.b_off : cB;
        if constexpr (GATHER) { if (has_next) { PG8_GLOAD(gvn, nxt); } else {
#pragma unroll
            for (int _h = 0; _h < 2; ++_h)
#pragma unroll
                for (int _i = 0; _i < 2; ++_i) gvn[_h][_i] = gvc[_h][_i]; } }
        for (int t = 0; t < nt; t += 2) {
            const bool last = (t == nt - 2);
            const char* a1 = cA + (size_t)(t + 1) * kstep;
            const char* a2 = last ? nA : cA + (size_t)(t + 2) * kstep; const char* b2 = last ? nB : cB + (size_t)(t + 2) * kstep;
            const char* a3 = a2 + kstep; const char* b3 = b2 + kstep;
            if constexpr (Epi::MID) { if (t == Epi::MID_T0 || t == Epi::MID_T1) {
                if (wr == 0) PG8_BAR;
#define PG8_MIDROW(ai, m) do { f32x4 v_[2][2] = {{acc[ai][0][m][0], acc[ai][0][m][1]}, {acc[ai][1][m][0], acc[ai][1][m][1]}}; \
                int r_ = cur.pm * BM + (ai) * HALF + wr * 64 + (m) * 16 + fr; asm volatile("" : "+v"(r_)); E.mid_row(cur, r_, t, wc, fq, v_); \
                acc[ai][0][m][0] = v_[0][0]; acc[ai][0][m][1] = v_[0][1]; acc[ai][1][m][0] = v_[1][0]; acc[ai][1][m][1] = v_[1][1]; asm volatile("" ::: "memory"); } while (0)
                PG8_MIDROW(0, 0); PG8_MIDROW(0, 1); PG8_MIDROW(0, 2); PG8_MIDROW(0, 3); PG8_MIDROW(1, 0); PG8_MIDROW(1, 1); PG8_MIDROW(1, 2); PG8_MIDROW(1, 3);
#undef PG8_MIDROW
                if (wr == 1) PG8_BAR;
            } }
            PG8_LDB(B0, 0, 0); PG8_LDB(B1, 0, 1); PG8_SCHED; PG8_LDA(At, 0, 0); PG8_STAGE_A(PG8_SA(1, 1), a1, 1, false);
            PG8_WAIT_V(8); PG8_WAIT_L(0); PG8_BAR; PG8_MMA(0, 0, At, B0); PG8_MMA(0, 1, At, B1); PG8_BAR; PG8_SCHED;
            PG8_LDA(At, 0, 1); PG8_STAGE(PG8_SB(0, 0), b2, voffB); PG8_STAGE(PG8_SB(0, 1), b2 + hstepB, voffB); PG8_STAGE_A(PG8_SA(0, 0), a2, 0, last);
            PG8_WAIT_V(8); PG8_WAIT_L(0); PG8_BAR; PG8_MMA(1, 0, At, B0); PG8_MMA(1, 1, At, B1); PG8_BAR; PG8_SCHED;
            PG8_LDB(B0, 1, 0); PG8_LDB(B1, 1, 1); PG8_SCHED; PG8_LDA(At, 1, 0); PG8_STAGE_A(PG8_SA(0, 1), a2, 1, last);
            PG8_WAIT_V(8); PG8_WAIT_L(0); PG8_BAR; PG8_MMA(0, 0, At, B0); PG8_MMA(0, 1, At, B1); PG8_BAR; PG8_SCHED;
            PG8_LDA(At, 1, 1); PG8_STAGE(PG8_SB(1, 0), b3, voffB); PG8_STAGE(PG8_SB(1, 1), b3 + hstepB, voffB); PG8_STAGE_A(PG8_SA(1, 0), a3, 0, last);
            PG8_WAIT_V(8); PG8_WAIT_L(0); PG8_BAR; PG8_MMA(1, 0, At, B0); PG8_MMA(1, 1, At, B1); PG8_BAR; PG8_SCHED;
        }
        if constexpr (FP8) asm volatile("s_nop 15\n\ts_nop 15" ::: "memory");
        if (wr == 0) PG8_BAR;
        {
#define PG8_ROW(ai, m) do { const f32x4 v_[2][2] = {{acc[ai][0][m][0], acc[ai][0][m][1]}, {acc[ai][1][m][0], acc[ai][1][m][1]}}; \
            int r_ = cur.pm * BM + (ai) * HALF + wr * 64 + (m) * 16 + fr; asm volatile("" : "+v"(r_)); E.row(cur, r_, (ai) * 4 + (m), wc, fq, v_); asm volatile("" ::: "memory"); } while (0)
            PG8_ROW(0, 0); PG8_ROW(0, 1); PG8_ROW(0, 2); PG8_ROW(0, 3); PG8_ROW(1, 0); PG8_ROW(1, 1); PG8_ROW(1, 2); PG8_ROW(1, 3);
#undef PG8_ROW
        }
        if (!has_next) break;
#pragma unroll
        for (int a = 0; a < 2; ++a)
#pragma unroll
            for (int b = 0; b < 2; ++b)
#pragma unroll
                for (int m = 0; m < 4; ++m)
#pragma unroll
                    for (int n = 0; n < 2; ++n) acc[a][b][m][n] = (f32x4){0.f, 0.f, 0.f, 0.f};
        cur = nxt; cA = nA; cB = nB; ++ui;
        if constexpr (GATHER) {
#pragma unroll
            for (int _h = 0; _h < 2; ++_h)
#pragma unroll
                for (int _i = 0; _i < 2; ++_i) gvc[_h][_i] = gvn[_h][_i]; }
        if (wr == 1) PG8_BAR;
    }
    PG8_WAIT_V(0);
    PG8_BAR;
#undef PG8_SA
#undef PG8_SB
#undef PG8_STAGE
#undef PG8_STAGE_A
#undef PG8_LDA
#undef PG8_LD8
#undef PG8_LDB
#undef PG8_MMA
#undef PG8_WAIT_V
#undef PG8_WAIT_L
#undef PG8_BAR
#undef PG8_SCHED
#undef PG8_GLOAD
}

template <bool PERM>
__device__ __forceinline__ void small_tile(PG8_LAS unsigned char* lds, const bf16_t* A16, int lda, const bf16_t* Bt, int ldb, int K, int pn, int wc, f32x4 (&v)[2][2], int wave0) {
    const int tid = make_tid(wave0), wid = __builtin_amdgcn_readfirstlane(tid >> 6), lane = tid & 63, fr = lane & 15, fq = lane >> 4;
    const int kper = K >> 3, k0 = wid * kper;
    f32x4 acc[2][2];
#pragma unroll
    for (int bj = 0; bj < 2; ++bj)
#pragma unroll
        for (int n = 0; n < 2; ++n) acc[bj][n] = (f32x4){0.f, 0.f, 0.f, 0.f};
    const bf16_t* ap = A16 + (size_t)fr * lda + k0 + 8 * fq;
    const bf16_t* bp[2][2];
#pragma unroll
    for (int bj = 0; bj < 2; ++bj)
#pragma unroll
        for (int n = 0; n < 2; ++n) { const int rr = PERM ? perm32(16 * n + fr) : 16 * n + fr; bp[bj][n] = Bt + (size_t)(pn * 256 + bj * 128 + wc * 32 + rr) * ldb + k0 + 8 * fq; }
    for (int k = 0; k < kper; k += 32) {
        const bf16x8 a = *(const bf16x8*)(ap + k);
#pragma unroll
        for (int bj = 0; bj < 2; ++bj)
#pragma unroll
            for (int n = 0; n < 2; ++n) { const bf16x8 b = *(const bf16x8*)(bp[bj][n] + k); acc[bj][n] = __builtin_amdgcn_mfma_f32_16x16x32_bf16(b, a, acc[bj][n], 0, 0, 0); }
    }
    PG8_LAS f32x4* red = (PG8_LAS f32x4*)lds;
#pragma unroll
    for (int bj = 0; bj < 2; ++bj)
#pragma unroll
        for (int n = 0; n < 2; ++n) red[(wid * 4 + bj * 2 + n) * 64 + lane] = acc[bj][n];
    __syncthreads();
    if (wid == 0) {
#pragma unroll
        for (int bj = 0; bj < 2; ++bj)
#pragma unroll
            for (int n = 0; n < 2; ++n) { f32x4 s = red[(bj * 2 + n) * 64 + lane];
#pragma unroll
                for (int w = 1; w < 8; ++w) s += red[(w * 4 + bj * 2 + n) * 64 + lane];
                v[bj][n] = s; }
    }
    __syncthreads();
}
}
namespace attn_body {
using bf16=__hip_bfloat16;
using bf16x8=__attribute__((ext_vector_type(8)))short;
using s16x4=__attribute__((ext_vector_type(4)))short;
using f32x16=__attribute__((ext_vector_type(16)))float;
using u32x4=__attribute__((ext_vector_type(4)))unsigned;
constexpr int BATCH=4,SEQ=4352,D=64,QKP=1024,VP=512,OP=1024;
constexpr int NW=8,QBLK=32,QB=QBLK*NW,KVBLK=64,NQB=SEQ/QB;
constexpr int ATTN_UNIT_ROWS=QB;
__device__ __forceinline__ int crow(int r,int hi){return (r&3)+8*(r>>2)+4*hi;}
#define SBAR() __builtin_amdgcn_sched_barrier(0)
__device__ __forceinline__ void cmask(f32x16&p0,f32x16&p1,int jb,int qrel,int hi){
  const float NEG=-INFINITY; int kb=64*jb+4*hi;
  #pragma unroll
  for(int r=0;r<16;++r){int kv=kb+(r&3)+8*(r>>2); if(kv>qrel)p0[r]=NEG; if(kv+32>qrel)p1[r]=NEG;}
}

__device__ __forceinline__ void biasmask(f32x16&p0,f32x16&p1,int jb,int qrel,int hi,const __attribute__((address_space(3))) float*tab){
  const float NEG=-INFINITY; const int kb=64*jb+4*hi;
  #pragma unroll
  for(int r=0;r<16;++r){const int n0=qrel-(kb+(r&3)+8*(r>>2)),n1=n0-32;
    const float b0=tab[n0<0?0:(n0>127?127:n0)],b1=tab[n1<0?0:(n1>127?127:n1)];
    p0[r]=n0<0?NEG:p0[r]+b0; p1[r]=n1<0?NEG:p1[r]+b1;}
}
constexpr int NSLOT=3, SLOTB=8192;
constexpr int VSLOTB=2*SLOTB;
constexpr int LDS_K=0, LDS_V=NSLOT*SLOTB, LDS_WS=LDS_V+NSLOT*VSLOTB, LDS_TAB=LDS_WS+NW*64*4, LDS_OST=0  , LDS_BYTES=LDS_TAB+2048;
constexpr float C2=0.125f*1.4426950408889634f;
__device__ __forceinline__ void glds16(const void*gsrc,unsigned lds_dst){unsigned keep;
  asm volatile("s_mov_b32 %0, m0\n\ts_mov_b32 m0, %2\n\ts_nop 0\n\tglobal_load_lds_dwordx4 %1, off\n\ts_mov_b32 m0, %0":"=&s"(keep):"v"(gsrc),"s"(lds_dst):"memory");}
__device__ __forceinline__ float max3f(float a,float b,float c){float r;asm("v_max3_f32 %0, %1, %2, %3":"=v"(r):"v"(a),"v"(b),"v"(c));return r;}
__device__ __forceinline__ float max2f(float a,float b){float r;asm("v_max_f32_e32 %0, %1, %2":"=v"(r):"v"(a),"v"(b));return r;}
__device__ __forceinline__ float fadd_s(float a,float b){float r;asm("v_add_f32_e32 %0, %1, %2":"=v"(r):"v"(a),"v"(b));return r;}
__device__ __forceinline__ float fsub_s(float a,float b){float r;asm("v_sub_f32_e32 %0, %1, %2":"=v"(r):"v"(a),"v"(b));return r;}
typedef float f32x2_t __attribute__((ext_vector_type(2))); typedef __bf16 bf16x2_t __attribute__((ext_vector_type(2)));
__device__ __forceinline__ unsigned cvtpk_s(float lo,float hi){f32x2_t v={lo,hi};bf16x2_t b=__builtin_convertvector(v,bf16x2_t);return __builtin_bit_cast(unsigned,b);}
#define WAIT_BAR(N) asm volatile("s_waitcnt vmcnt(" #N ") lgkmcnt(0)\n\ts_barrier":::"memory")

__device__ __forceinline__ void qkt(f32x16&p0,f32x16&p1,const char*Kslot,const bf16x8*qr,const f32x16&negm,int r32,int hi){
  const char*kb=Kslot+hi*1024+r32*16;
  #pragma unroll
  for(int d0=0;d0<4;++d0){
    const bf16x8 b0=*reinterpret_cast<const bf16x8*>(kb+d0*2048);
    const bf16x8 b1=*reinterpret_cast<const bf16x8*>(kb+d0*2048+512);
    if(d0==0){p0=__builtin_amdgcn_mfma_f32_32x32x16_bf16(b0,qr[0],negm,0,0,0);p1=__builtin_amdgcn_mfma_f32_32x32x16_bf16(b1,qr[0],negm,0,0,0);}
    else{p0=__builtin_amdgcn_mfma_f32_32x32x16_bf16(b0,qr[d0],p0,0,0,0);p1=__builtin_amdgcn_mfma_f32_32x32x16_bf16(b1,qr[d0],p1,0,0,0);}}
}
typedef __attribute__((address_space(3))) const char* lds_cptr;
typedef short v4i16_t __attribute__((ext_vector_type(4)));
__device__ __forceinline__ void kload8(bf16x8*kf,lds_cptr kp){
  kf[0]=*(const __attribute__((address_space(3))) bf16x8*)(kp);      kf[1]=*(const __attribute__((address_space(3))) bf16x8*)(kp+512);
  kf[2]=*(const __attribute__((address_space(3))) bf16x8*)(kp+2048); kf[3]=*(const __attribute__((address_space(3))) bf16x8*)(kp+2560);
  kf[4]=*(const __attribute__((address_space(3))) bf16x8*)(kp+4096); kf[5]=*(const __attribute__((address_space(3))) bf16x8*)(kp+4608);
  kf[6]=*(const __attribute__((address_space(3))) bf16x8*)(kp+6144); kf[7]=*(const __attribute__((address_space(3))) bf16x8*)(kp+6656);
}
__device__ __forceinline__ void kload2(bf16x8*kf,lds_cptr kp,int j){ kf[2*j]=*(const __attribute__((address_space(3))) bf16x8*)(kp+j*2048); kf[2*j+1]=*(const __attribute__((address_space(3))) bf16x8*)(kp+j*2048+512); }
__device__ __forceinline__ s16x4 vtr(lds_cptr p){ return __builtin_bit_cast(s16x4,__builtin_amdgcn_ds_read_tr16_b64_v4i16((__attribute__((address_space(3))) v4i16_t*)p)); }
__device__ __forceinline__ float rowmax(const f32x16&p0,const f32x16&p1){
  float a=max3f(p0[0],p0[1],p1[0]),b=max3f(p0[2],p0[3],p1[1]);a=max3f(a,p1[2],p1[3]);
  #pragma unroll
  for(int r=4;r<16;r+=4){a=max3f(a,p0[r],p0[r+1]);b=max3f(b,p0[r+2],p0[r+3]);a=max3f(a,p1[r],p1[r+1]);b=max3f(b,p1[r+2],p1[r+3]);}
  const float m=max2f(a,b);
  auto rr=__builtin_amdgcn_permlane32_swap(__float_as_uint(m),__float_as_uint(m),false,false);
  return max2f(__uint_as_float(rr[0]),__uint_as_float(rr[1]));
}
__device__ __forceinline__ void pv(f32x16*o,int vb,bf16x8 pa0,bf16x8 pa1,bf16x8 pa2,bf16x8 pa3){
  #pragma unroll
  for(int d0=0;d0<4;++d0){s16x4 lo[4],hi[4];
    #pragma unroll
    for(int ks=0;ks<4;++ks){
      asm volatile("ds_read_b64_tr_b16 %0,%1 offset:%c2":"=&v"(lo[ks]):"v"(vb),"i"(d0*4096+ks*1024):"memory");
      asm volatile("ds_read_b64_tr_b16 %0,%1 offset:%c2":"=&v"(hi[ks]):"v"(vb),"i"(d0*4096+ks*1024+512):"memory");}
    asm volatile("s_waitcnt lgkmcnt(0)":::"memory");SBAR();
    #define PK(k) (bf16x8){lo[k][0],lo[k][1],lo[k][2],lo[k][3],hi[k][0],hi[k][1],hi[k][2],hi[k][3]}
    o[d0]=__builtin_amdgcn_mfma_f32_32x32x16_bf16(pa0,PK(0),o[d0],0,0,0);
    o[d0]=__builtin_amdgcn_mfma_f32_32x32x16_bf16(pa1,PK(1),o[d0],0,0,0);
    o[d0]=__builtin_amdgcn_mfma_f32_32x32x16_bf16(pa2,PK(2),o[d0],0,0,0);
    o[d0]=__builtin_amdgcn_mfma_f32_32x32x16_bf16(pa3,PK(3),o[d0],0,0,0);
    #undef PK
  }
}

#ifndef ATTN_STORE16
#define ATTN_STORE16(p,v) (*(u32x4*)(p)=(v))
#endif
template<int THRL> __device__ __forceinline__ void attn_unit(int b,int vh,int qb,const bf16*__restrict__ QK,const bf16*__restrict__ V,bf16*O,char*shm,int wave0){
  const int mp=vh>>2,hh=vh&3; const int qcol=(mp*4+hh)*64,kcol=512+(mp*4+hh)*64,vcol=hh*128,ocol=mp*512+hh*128;
  const int tid=pg8::make_tid(wave0),lane=tid&63,r32=lane&31,hi=lane>>5; const int wid=__builtin_amdgcn_readfirstlane(tid>>6);
  const long rowbase=(long)b*SEQ; const int q0=qb*QB;
  const bf16*Qw=QK+(rowbase+q0+wid*QBLK)*QKP+qcol;
  const bf16*Kh=QK+rowbase*QKP+kcol,*Vh=V+rowbase*VP+vcol;
  const __attribute__((address_space(3))) float*tab=(const __attribute__((address_space(3))) float*)((__attribute__((address_space(3))) char*)shm+LDS_TAB)+hh*128;
  const unsigned lds0=(unsigned)(uintptr_t)shm;
  float*wsf=(float*)(shm+LDS_WS)+wid*64;
  const bf16*ksrc=Kh+(long)lane*QKP+wid*8;
  const bf16*vsrc=Vh+(long)(16*(wid&3)+(lane>>2))*VP+(wid>>2)*32+(lane&3)*8;
  const unsigned kdst=lds0+LDS_K+wid*1024, vdst=lds0+LDS_V+wid*1024;
  #define DMA_K(t,slot) glds16(ksrc+(long)(t)*KVBLK*QKP,(unsigned)__builtin_amdgcn_readfirstlane(kdst+(slot)))
  #define DMA_V(t,slot) do{ glds16(vsrc+(long)(t)*KVBLK*VP,(unsigned)__builtin_amdgcn_readfirstlane(vdst+2*(slot))); glds16(vsrc+64+(long)(t)*KVBLK*VP,(unsigned)__builtin_amdgcn_readfirstlane(vdst+2*(slot)+8192)); }while(0)
  const int vb0=(int)(lds0+LDS_V)+((lane>>4)&1)*32+(lane&3)*8+(4*hi+((lane&15)>>2))*64;
  const char*Kbase=shm+LDS_K; bf16x8 kf[8];
  const lds_cptr shm3=(lds_cptr)shm; const lds_cptr kp0=shm3+LDS_K+hi*1024+r32*16; const lds_cptr vp0=shm3+LDS_V+((lane>>4)&1)*32+(lane&3)*8+(4*hi+((lane&15)>>2))*64;
  const int NT=(q0+QB)/KVBLK;
  DMA_K(0,0);DMA_V(0,0);DMA_K(1,SLOTB);
  bf16x8 qr[4];
  #pragma unroll
  for(int d0=0;d0<4;++d0)qr[d0]=*reinterpret_cast<const bf16x8*>(&Qw[(long)r32*QKP+d0*16+hi*8]);
  float mhat=0.f,l_reg=0.f;f32x16 o[4];o[0]=f32x16{};o[1]=f32x16{};o[2]=f32x16{};o[3]=f32x16{};f32x16 negm=f32x16{};asm volatile("":"+v"(negm));
  const int qrel=wid*QBLK+r32;
  #define CMASK(P0,P1,t) do{int jb_=(t)-(NT-4); if(jb_>=-2)biasmask(P0,P1,jb_,qrel,hi,tab);}while(0)
  bool resc=false;
  #define START(P0,P1) do{ const float rm=rowmax(P0,P1); resc=false; \
    { const float dl=rm; mhat=fadd_s(mhat,dl); \
      _Pragma("unroll") for(int r=0;r<16;++r){P0[r]=fsub_s(P0[r],dl);P1[r]=fsub_s(P1[r],dl);} \
      _Pragma("unroll") for(int r=0;r<16;++r)negm[r]=-mhat; asm volatile("":"+v"(negm)); } \
    _Pragma("unroll") for(int r=0;r<16;++r)P0[r]=__builtin_amdgcn_exp2f(P0[r]); }while(0)
  #define RESC() do{ if(resc){ asm volatile("s_waitcnt lgkmcnt(0)":::"memory"); \
      _Pragma("unroll") for(int d_=0;d_<4;++d_) _Pragma("unroll") for(int r=0;r<16;++r)o[d_][r]*=wsf[crow(r,hi)]; } }while(0)
  f32x16 pA0,pA1,pB0,pB1;
  int sl_prev=0,sl_cur=0,sl_next=SLOTB;
  #define ROT() do{sl_prev=sl_cur;sl_cur=sl_next;sl_next=(sl_next==(NSLOT-1)*SLOTB)?0:sl_next+SLOTB;}while(0)
  DMA_K(2,2*SLOTB);
  WAIT_BAR(4);
  qkt(pA0,pA1,Kbase,qr,negm,r32,hi);asm volatile("s_nop 15\n\ts_nop 7":"+v"(pA0),"+v"(pA1));CMASK(pA0,pA1,0);
  START(pA0,pA1);
  _Pragma("unroll") for(int r=0;r<16;++r)pA1[r]=__builtin_amdgcn_exp2f(pA1[r]);
  WAIT_BAR(0);
  DMA_K(3,0);DMA_V(1,SLOTB);
  ROT();
  kload8(kf,kp0+sl_cur);
  WAIT_BAR(3);
  s16x4 vlo[4],vhi[4]; u32x4 pw0,pw1,pw2,pw3;
  #define PKW(P,B) cvtpk_s(P[B],P[B+1])
  #define PAF(k) __builtin_bit_cast(bf16x8,pw##k)
  #define VFR(i) (bf16x8){vlo[i][0],vlo[i][1],vlo[i][2],vlo[i][3],vhi[i][0],vhi[i][1],vhi[i][2],vhi[i][3]}
  #define PIN(x) asm volatile("":"+v"(x))
  #define MX3(a,b,c) __builtin_fmaxf(__builtin_fmaxf((a),(b)),(c))
  #define GAPA(MF,A0,A1,A2,A3,W0,W1,PW) do{ MF; sacc+=A0; sacc+=A1; sacc+=A2; sacc+=A3; PIN(sacc); W0; W1; PIN(PW); SBAR(); }while(0)
  #define EX(v) __builtin_amdgcn_exp2f(v)
  #define GAPB(MF,VR,X,B) do{ MF; VR; X[B]=EX(X[B]); X[B+1]=EX(X[B+1]); PIN(X); SBAR(); }while(0)
  #define VRJ(kg,d0) do{ vlo[d0]=vtr(vp_+((d0)*4096+(kg)*1024)); vhi[d0]=vtr(vp_+((d0)*4096+(kg)*1024+512)); }while(0)
  #define KRD(G,j) do{ if(G){ kload2(kf,kp0+sl_next,j); SBAR(); } }while(0)
  #define STEP(C0,C1,P0,P1,t,GK,GV,GL) do{ SBAR(); \
    const lds_cptr vp_=vp0+2*sl_prev; \
    float sacc=(P0[0]+P0[1]); \
    GAPA(C0=__builtin_amdgcn_mfma_f32_32x32x16_bf16(kf[0],qr[0],negm,0,0,0), P0[2],P0[3],P0[4],P0[5],     pw0[0]=PKW(P0,0), pw0[1]=PKW(P0,2), pw0); \
    GAPA(C1=__builtin_amdgcn_mfma_f32_32x32x16_bf16(kf[1],qr[0],negm,0,0,0), P0[6],P0[7],P0[8],P0[9],     pw0[2]=PKW(P0,4), pw0[3]=PKW(P0,6), pw0); \
    GAPA(C0=__builtin_amdgcn_mfma_f32_32x32x16_bf16(kf[2],qr[1],C0,0,0,0),   P0[10],P0[11],P0[12],P0[13], pw1[0]=PKW(P0,8), pw1[1]=PKW(P0,10), pw1); \
    GAPA(C1=__builtin_amdgcn_mfma_f32_32x32x16_bf16(kf[3],qr[1],C1,0,0,0),   P0[14],P0[15],P1[0],P1[1],   pw1[2]=PKW(P0,12),pw1[3]=PKW(P0,14), pw1); \
    GAPA(C0=__builtin_amdgcn_mfma_f32_32x32x16_bf16(kf[4],qr[2],C0,0,0,0),   P1[2],P1[3],P1[4],P1[5],     pw2[0]=PKW(P1,0), pw2[1]=PKW(P1,2), pw2); \
    GAPA(C1=__builtin_amdgcn_mfma_f32_32x32x16_bf16(kf[5],qr[2],C1,0,0,0),   P1[6],P1[7],P1[8],P1[9],     pw2[2]=PKW(P1,4), pw2[3]=PKW(P1,6), pw2); \
    GAPA(C0=__builtin_amdgcn_mfma_f32_32x32x16_bf16(kf[6],qr[3],C0,0,0,0),   P1[10],P1[11],P1[12],P1[13], pw3[0]=PKW(P1,8), pw3[1]=PKW(P1,10), pw3); \
    GAPA(C1=__builtin_amdgcn_mfma_f32_32x32x16_bf16(kf[7],qr[3],C1,0,0,0),   P1[14],P1[15],0.f,0.f,       pw3[2]=PKW(P1,12),pw3[3]=PKW(P1,14), pw3); \
    l_reg+=sacc; \
    if(GK){DMA_K((t)+3,sl_cur);} if(GV){DMA_V((t)+1,sl_next);} \
    VRJ(0,0); VRJ(0,1); VRJ(0,2); VRJ(0,3); SBAR(); \
    CMASK(C0,C1,t); \
    { float a=MX3(C0[0],C0[1],C1[0]),b=MX3(C0[2],C0[3],C1[1]); a=MX3(a,C1[2],C1[3]); \
      _Pragma("unroll") for(int r=4;r<16;r+=4){a=MX3(a,C0[r],C0[r+1]);b=MX3(b,C0[r+2],C0[r+3]);a=MX3(a,C1[r],C1[r+1]);b=MX3(b,C1[r+2],C1[r+3]);} \
      float rm=__builtin_fmaxf(a,b); { auto rr=__builtin_amdgcn_permlane32_swap(__float_as_uint(rm),__float_as_uint(rm),false,false); rm=__builtin_fmaxf(__uint_as_float(rr[0]),__uint_as_float(rr[1])); } \
      resc=false; \
      if(__builtin_expect(__any(rm>(float)THRL),0)){ const float dl=__builtin_fmaxf(rm,0.f); mhat+=dl; \
        _Pragma("unroll") for(int r=0;r<16;++r){C0[r]-=dl;C1[r]-=dl;} \
        _Pragma("unroll") for(int r=0;r<16;++r)negm[r]=-mhat; asm volatile("":"+v"(negm)); \
        const float f=__builtin_amdgcn_exp2f(-dl); l_reg*=f; if(hi==0)wsf[r32]=f; resc=true; } } \
    SBAR(); \
    GAPB(o[0]=__builtin_amdgcn_mfma_f32_32x32x16_bf16(PAF(0),VFR(0),o[0],0,0,0), VRJ(1,0), C0,0); \
    GAPB(o[1]=__builtin_amdgcn_mfma_f32_32x32x16_bf16(PAF(0),VFR(1),o[1],0,0,0), VRJ(1,1), C0,2); \
    GAPB(o[2]=__builtin_amdgcn_mfma_f32_32x32x16_bf16(PAF(0),VFR(2),o[2],0,0,0), VRJ(1,2), C0,4); \
    GAPB(o[3]=__builtin_amdgcn_mfma_f32_32x32x16_bf16(PAF(0),VFR(3),o[3],0,0,0), VRJ(1,3), C0,6); \
    GAPB(o[0]=__builtin_amdgcn_mfma_f32_32x32x16_bf16(PAF(1),VFR(0),o[0],0,0,0), VRJ(2,0), C0,8); \
    KRD(GL,0); GAPB(o[1]=__builtin_amdgcn_mfma_f32_32x32x16_bf16(PAF(1),VFR(1),o[1],0,0,0), VRJ(2,1), C0,10); \
    GAPB(o[2]=__builtin_amdgcn_mfma_f32_32x32x16_bf16(PAF(1),VFR(2),o[2],0,0,0), VRJ(2,2), C0,12); \
    KRD(GL,1); GAPB(o[3]=__builtin_amdgcn_mfma_f32_32x32x16_bf16(PAF(1),VFR(3),o[3],0,0,0), VRJ(2,3), C0,14); \
    GAPB(o[0]=__builtin_amdgcn_mfma_f32_32x32x16_bf16(PAF(2),VFR(0),o[0],0,0,0), VRJ(3,0), C1,0); \
    KRD(GL,2); GAPB(o[1]=__builtin_amdgcn_mfma_f32_32x32x16_bf16(PAF(2),VFR(1),o[1],0,0,0), VRJ(3,1), C1,2); \
    GAPB(o[2]=__builtin_amdgcn_mfma_f32_32x32x16_bf16(PAF(2),VFR(2),o[2],0,0,0), VRJ(3,2), C1,4); \
    KRD(GL,3); GAPB(o[3]=__builtin_amdgcn_mfma_f32_32x32x16_bf16(PAF(2),VFR(3),o[3],0,0,0), VRJ(3,3), C1,6); \
    GAPB(o[0]=__builtin_amdgcn_mfma_f32_32x32x16_bf16(PAF(3),VFR(0),o[0],0,0,0), (void)0, C1,8); \
    GAPB(o[1]=__builtin_amdgcn_mfma_f32_32x32x16_bf16(PAF(3),VFR(1),o[1],0,0,0), (void)0, C1,10); \
    GAPB(o[2]=__builtin_amdgcn_mfma_f32_32x32x16_bf16(PAF(3),VFR(2),o[2],0,0,0), (void)0, C1,12); \
    GAPB(o[3]=__builtin_amdgcn_mfma_f32_32x32x16_bf16(PAF(3),VFR(3),o[3],0,0,0), (void)0, C1,14); \
    }while(0)
  int t=1;
  #undef CMASK
  #define CMASK(P0,P1,t) do{}while(0)
  for(;t+7<NT;t+=2){
    STEP(pB0,pB1,pA0,pA1,t,true,true,true);     WAIT_BAR(3); RESC(); ROT();
    STEP(pA0,pA1,pB0,pB1,t+1,true,true,true);   WAIT_BAR(3); RESC(); ROT();
  }
  #undef CMASK
  #define CMASK(P0,P1,t) do{int jb_=(t)-(NT-4); if(jb_>=-2)biasmask(P0,P1,jb_,qrel,hi,tab);}while(0)
  #define ENDW(tt) do{ if((tt)+3<NT){WAIT_BAR(3);} else if((tt)+2<NT){WAIT_BAR(2);} else {WAIT_BAR(0);} }while(0)
  for(;t+1<NT;t+=2){
    STEP(pB0,pB1,pA0,pA1,t,(t+3<NT),(t+1<NT),(t+1<NT));       ENDW(t);   RESC(); ROT();
    STEP(pA0,pA1,pB0,pB1,t+1,(t+4<NT),(t+2<NT),(t+2<NT));     ENDW(t+1); RESC(); ROT();
  }
  STEP(pB0,pB1,pA0,pA1,NT-1,false,false,false); RESC();
  { float sacc=pB0[0]+pB0[1]; _Pragma("unroll") for(int r=2;r<16;++r)sacc+=pB0[r]; _Pragma("unroll") for(int r=0;r<16;++r)sacc+=pB1[r]; l_reg+=sacc;
    pw0=(u32x4){PKW(pB0,0),PKW(pB0,2),PKW(pB0,4),PKW(pB0,6)};pw1=(u32x4){PKW(pB0,8),PKW(pB0,10),PKW(pB0,12),PKW(pB0,14)};pw2=(u32x4){PKW(pB1,0),PKW(pB1,2),PKW(pB1,4),PKW(pB1,6)};pw3=(u32x4){PKW(pB1,8),PKW(pB1,10),PKW(pB1,12),PKW(pB1,14)};
    SBAR(); pv(o,vb0+2*sl_cur,PAF(0),PAF(1),PAF(2),PAF(3)); }
  #undef PKW
  #undef PAF
  #undef VFR
  #undef PIN
  #undef MX3
  #undef GAPA
  #undef GAPB
  #undef EX
  #undef VRJ
  #undef KRD
  #undef STEP
  #undef ENDW
  {auto rr=__builtin_amdgcn_permlane32_swap(__float_as_uint(l_reg),__float_as_uint(l_reg),false,false);l_reg=__uint_as_float(rr[0])+__uint_as_float(rr[1]);}
  if(hi==0)wsf[32+r32]=l_reg;asm volatile("s_waitcnt lgkmcnt(0)":::"memory");
  float rli[16];
  #pragma unroll
  for(int r=0;r<16;++r)rli[r]=__builtin_amdgcn_rcpf(wsf[32+crow(r,hi)]);
  bf16*Ow=O+(rowbase+q0+wid*QBLK)*OP+ocol;
  asm volatile("s_waitcnt lgkmcnt(0)\n\ts_barrier":::"memory");
  { bf16*stg=(bf16*)(shm+LDS_OST)+wid*4096;
    #pragma unroll
    for(int r=0;r<16;++r){const int orow=crow(r,hi);
      #pragma unroll
      for(int d0=0;d0<4;++d0)stg[orow*128+d0*32+r32]=__float2bfloat16(o[d0][r]*rli[r]);}
    asm volatile("s_waitcnt lgkmcnt(0)":::"memory");
    #pragma unroll
    for(int i=0;i<8;++i){const int row=i*4+(lane>>4),ch=lane&15; const u32x4 v=*(const u32x4*)(stg+row*128+ch*8); ATTN_STORE16(Ow+(long)row*OP+ch*8,v);} }
  asm volatile("s_waitcnt lgkmcnt(0)\n\ts_barrier":::"memory");
  #undef DMA_K
  #undef DMA_V
  #undef CMASK
  #undef START
  #undef RESC
  #undef ROT
}
constexpr int ATTN_LDS_BYTES=LDS_BYTES;
__device__ __forceinline__ bool attn_next(int G,int vcu,int i,int&b,int&vh,int&qb){
  if(G==256){ const int g=vcu&7, bv=vcu>>3; int q=-1;
    if(g<7){ q=(i==0)?16-g:(i==1)?1+g:-1; } else { q=(i==0)?9:(i==1)?8:(i==2)?0:-1; }
    if(q<0)return false; b=bv>>3; vh=bv&7; qb=q; return true; }
  const int u=vcu+i*G; if(u>=BATCH*8*17)return false; b=u/(8*17); vh=(u/17)&7; qb=u%17; return true;
}
#undef SBAR
#undef WAIT_BAR
}
namespace mk {
using pg8::bf16_t; using pg8::bf16x8; using pg8::f32x4; using pg8::u32x4; using pg8::u32x2; using pg8::Unit; using pg8::Gemm; using pg8::cvt_pk_bf16;
constexpr int NWAVES = 8;
constexpr int D = 1024, NB = 4, SEQ = 4096, NM = 16, MR = NB * SEQ  , MROWS = MR + NM  , MPAD = 16640;
constexpr int TP = 4352, MATT = NB * TP;
constexpr int INC = 8192, FFD = 2816, FFE = 3584, NE = 8;
constexpr float EPS = 1e-6f, LOG2E = 1.4426950408889634f, C2 = 0.125f * LOG2E;
constexpr size_t MiB = 1u << 20;
constexpr size_t WS_CTL = 0, CTL_ZERO_BYTES = 1 * MiB;
constexpr size_t WS_SMALL = 1 * MiB;
constexpr size_t WS_HN = 3 * MiB;
constexpr size_t WS_WIN = 36 * MiB, WS_WBR = 52 * MiB, WS_WO = 55 * MiB, WS_WGU0 = 57 * MiB, WS_WD0 = 68 * MiB;
constexpr size_t WS_U = 74 * MiB;
constexpr size_t WS_O = 123 * MiB, WS_ST = 157 * MiB, WS_HQ = 190 * MiB, WS_LOGF = 207 * MiB, WS_HG = 240 * MiB;
constexpr size_t WS_QK = 257 * MiB, WS_V = 291 * MiB, WS_CONV = 308 * MiB, WS_HV = 357 * MiB, WS_DS = 374 * MiB;
constexpr size_t WS_GATES = 257 * MiB, WS_MIXED = 355 * MiB, WS_MSCR = 388 * MiB;
constexpr size_t WS_H0 = 123 * MiB;
constexpr size_t WS_DEC = 440 * MiB;
constexpr size_t WS_HQ2 = 441 * MiB, WS_OI = 458 * MiB;
constexpr size_t WS_MGU = 36 * MiB, WS_MD = 148 * MiB, WS_MH = 204 * MiB, WS_MY = 442 * MiB;
constexpr size_t WS_HN8 = 491 * MiB, WS_WIN8 = 508 * MiB;
constexpr size_t WS_SLAB = 36 * MiB;
constexpr int LISTCAP = 16640;
constexpr size_t SMB_LIST = 128 * 1024, SMB_TOK = 704 * 1024;
constexpr int CW_CNT = 8192;
constexpr int SM_SCAL = 0;
constexpr int SM_LOGLB = 64, SM_LOG1M = 64 + 1024;
constexpr int SM_TAB = 64 + 2048;
constexpr int SM_METAHS = 4096;
constexpr int RING_OFF = 0, RING_BYTES = 131072, LDSCTL_OFF = RING_BYTES, MISC_OFF = LDSCTL_OFF + 320, LDS_BYTES = 147456;

#define GAS __attribute__((address_space(1)))
#define LAS __attribute__((address_space(3)))
typedef GAS unsigned gu32;
#define RLX_AGENT __ATOMIC_RELAXED, __HIP_MEMORY_SCOPE_AGENT
#define LDS_WAIT() asm volatile("s_waitcnt lgkmcnt(0)" ::: "memory")
__device__ __forceinline__ unsigned f2bf(float f) { unsigned u = __builtin_bit_cast(unsigned, f); return (u + 0x7fffu + ((u >> 16) & 1u)) >> 16; }
__device__ __forceinline__ unsigned pk2(float lo, float hi) { return cvt_pk_bf16(lo, hi); }
__device__ __forceinline__ unsigned f2bf_hw(float f) { return cvt_pk_bf16(f, 0.f) & 0xffffu; }
__device__ __forceinline__ float bf2f(unsigned short b) { return __builtin_bit_cast(float, (unsigned)b << 16); }
__device__ __forceinline__ float bflo(unsigned w) { return __builtin_bit_cast(float, w << 16); }
__device__ __forceinline__ float bfhi(unsigned w) { return __builtin_bit_cast(float, w & 0xffff0000u); }
#ifdef SLOWMATH
__device__ __forceinline__ float sigm(float x) { return 1.f / (1.f + __expf(-x)); }
__device__ __forceinline__ float silu(float x) { return x / (1.f + __expf(-x)); }
#else
__device__ __forceinline__ float sigm(float x) { return __builtin_amdgcn_rcpf(1.f + __expf(-x)); }
__device__ __forceinline__ float silu(float x) { return x * __builtin_amdgcn_rcpf(1.f + __expf(-x)); }
#endif
#ifdef SLOWMATH
__device__ __forceinline__ float logf_gate(float z, float la, float lm) { const float ls = fminf(z, 0.f) - log1pf(expf(-fabsf(z))), bb = lm + ls; return (la == -INFINITY) ? bb : fmaxf(la, bb) + log1pf(expf(-fabsf(la - bb))); }
#else
__device__ __forceinline__ float logf_gate(float z, float la, float lm) { const float ls = fminf(z, 0.f) - __logf(1.f + __expf(-fabsf(z))), bb = lm + ls; return (la == -INFINITY) ? bb : fmaxf(la, bb) + __logf(1.f + __expf(-fabsf(la - bb))); }
#endif
template <int O> __device__ __forceinline__ float xadd(float v) {
    if constexpr (O < 32) return v + __builtin_bit_cast(float, __builtin_amdgcn_ds_swizzle(__builtin_bit_cast(int, v), (O << 10) | 0x1f));
    else { const int l = pg8::lane_id(); return v + __builtin_bit_cast(float, __builtin_amdgcn_ds_bpermute((l ^ 32) << 2, __builtin_bit_cast(int, v))); }
}
__device__ __forceinline__ float wave_sum(float v) { v = xadd<1>(v); v = xadd<2>(v); v = xadd<4>(v); v = xadd<8>(v); v = xadd<16>(v); return xadd<32>(v); }

#define XB_TMO      128
#define XB_XCNT(j)  (256  + 64 * (j))
#define XB_XSUB(j)  (1280 + 64 * (j))
#define XB_XGEN(j)  (2304 + 64 * (j))
#define XB_TOP      3328
#define XB_TOPGEN   3392
#define XCD_BAR_WORDS 3456
#define XB_SPIN_CAP (1u << 18)
__device__ __forceinline__ unsigned xb_ld(unsigned* p)              { return __hip_atomic_load(p, __ATOMIC_RELAXED, __HIP_MEMORY_SCOPE_AGENT); }
__device__ __forceinline__ unsigned xb_add(unsigned* p, unsigned v) { return __hip_atomic_fetch_add(p, v, __ATOMIC_RELAXED, __HIP_MEMORY_SCOPE_AGENT); }
__device__ __forceinline__ unsigned xb_xcc_id() { return (unsigned)__builtin_amdgcn_s_getreg((3 << 11) | 20) & 0xFu; }
#define XB_SPIN(cond, bar) do { unsigned _sp = 0; while (cond) { __builtin_amdgcn_s_sleep(1); \
    if ((++_sp & 255u) == 0u) { if (xb_ld(&(bar)[XB_TMO])) break; if (_sp > XB_SPIN_CAP) { atomicAdd(&(bar)[XB_TMO], 1u); break; } } } } while (0)
struct XcdBarrier { unsigned* bar; unsigned x; volatile LAS unsigned* st; };
__device__ __forceinline__ XcdBarrier xcd_barrier_post(unsigned* bar, volatile LAS unsigned* st, int tid) {
    XcdBarrier b; b.bar = bar; b.x = xb_xcc_id(); b.st = st;
    if (tid == 0) (void)xb_add(&bar[XB_XCNT(b.x)], 1u);
    return b;
}
__device__ __forceinline__ void xcd_barrier_complete(unsigned* bar, unsigned x, unsigned& nloc, unsigned& nx) {
    const unsigned G = gridDim.x * gridDim.y * gridDim.z;
    unsigned sum, cnt, mine, sp = 0u;
    for (;;) {
        sum = 0u; cnt = 0u; mine = 0u;
#pragma unroll
        for (unsigned j = 0; j < 16; ++j) { const unsigned c = xb_ld(&bar[XB_XCNT(j)]); sum += c; cnt += (c > 0u) ? 1u : 0u; mine = (j == x) ? c : mine; }
        if (sum == G) break;
        __builtin_amdgcn_s_sleep(1);
        if ((++sp & 255u) == 0u) { if (xb_ld(&bar[XB_TMO])) break; if (sp > XB_SPIN_CAP) { atomicAdd(&bar[XB_TMO], 1u); break; } }
    }
    nloc = mine > 0u ? mine : 1u; nx = cnt > 0u ? cnt : 1u;
}
__device__ __forceinline__ void xcd_barrier(const XcdBarrier& b, int tid) {
    asm volatile("s_waitcnt vmcnt(0)" ::: "memory");
    __syncthreads();
    if (tid == 0) {
        unsigned* bar = b.bar;
        __builtin_amdgcn_s_waitcnt(0);
        unsigned nloc = b.st[0], nx = b.st[1];
        if (nloc == 0u) { xcd_barrier_complete(bar, b.x, nloc, nx); b.st[0] = nloc; b.st[1] = nx; }
        const unsigned old = xb_add(&bar[XB_XSUB(b.x)], 1u);
        const unsigned gen = old / nloc, tgt = (gen + 1u) * nx;
        if (old + 1u == (gen + 1u) * nloc) {
            __builtin_amdgcn_fence(__ATOMIC_RELEASE, "agent");
            asm volatile("s_waitcnt vmcnt(0)" ::: "memory");
            (void)xb_add(&bar[XB_TOP], 1u);
        }
        XB_SPIN(xb_ld(&bar[XB_TOP]) < tgt, bar);
        __builtin_amdgcn_fence(__ATOMIC_ACQUIRE, "agent");
        asm volatile("s_waitcnt vmcnt(0)" ::: "memory");
    }
    __syncthreads();
}

struct Frame {
    LAS unsigned char* lds; unsigned char* lds_gen;
    int tid, lane, wave, vcu, G;
    const float* const* in; float* out; unsigned char* ws;
};
#define WSP(T, off) ((T*)(F.ws + (off)))
#define SMALLF (WSP(float, WS_SMALL))

__device__ __forceinline__ void cvt_block(const float* W, int ldw, int k0, int c0, bf16_t* WT, int ldt, int r0, LAS float* scr, int lane) {
    float wv[32];
    const float* wp = W + (size_t)(k0 + (lane >> 5)) * ldw + c0 + (lane & 31);
#pragma unroll
    for (int i = 0; i < 32; ++i) wv[i] = __builtin_nontemporal_load(wp + (size_t)(2 * i) * ldw);
#pragma unroll
    for (int i = 0; i < 32; ++i) scr[(2 * i + (lane >> 5)) * 33 + (lane & 31)] = wv[i];
    LDS_WAIT(); asm volatile("" ::: "memory");
    const int c = lane & 7;
#pragma unroll
    for (int j = 0; j < 4; ++j) { const int n = (lane >> 3) + 8 * j; const LAS float* s = scr + (8 * c) * 33 + n;
        u32x4 o; o.x = pk2(s[0 * 33], s[1 * 33]); o.y = pk2(s[2 * 33], s[3 * 33]); o.z = pk2(s[4 * 33], s[5 * 33]); o.w = pk2(s[6 * 33], s[7 * 33]);
        *(GAS u32x4*)(WT + (size_t)(r0 + n) * ldt + k0 + 8 * c) = o; }
    LDS_WAIT(); asm volatile("" ::: "memory");
}
constexpr float W8_SCALE = 32.f, H8_SCALE = 4.f, WD8_SCALE = 64.f;
__device__ __forceinline__ unsigned pk4_fp8(float a, float b, float c, float d) { int r = __builtin_amdgcn_cvt_pk_fp8_f32(a, b, 0, false); r = __builtin_amdgcn_cvt_pk_fp8_f32(c, d, r, true); return (unsigned)r; }
__device__ __forceinline__ void cvt_block_fp8(const float* W, int ldw, int k0, int c0, unsigned char* WT, int ldt, int r0, LAS float* scr, int lane, float wscale) {
    float wv[32];
    const float* wp = W + (size_t)(k0 + (lane >> 5)) * ldw + c0 + (lane & 31);
#pragma unroll
    for (int i = 0; i < 32; ++i) wv[i] = __builtin_nontemporal_load(wp + (size_t)(2 * i) * ldw);
#pragma unroll
    for (int i = 0; i < 32; ++i) scr[(2 * i + (lane >> 5)) * 33 + (lane & 31)] = wv[i] * wscale;
    LDS_WAIT(); asm volatile("" ::: "memory");
    const int c = lane & 7;
#pragma unroll
    for (int j = 0; j < 4; ++j) { const int n = (lane >> 3) + 8 * j; const LAS float* s = scr + (8 * c) * 33 + n;
        u32x2 o; o.x = pk4_fp8(s[0 * 33], s[1 * 33], s[2 * 33], s[3 * 33]); o.y = pk4_fp8(s[4 * 33], s[5 * 33], s[6 * 33], s[7 * 33]);
        *(GAS u32x2*)(WT + (size_t)(r0 + n) * ldt + k0 + 8 * c) = o; }
    LDS_WAIT(); asm volatile("" ::: "memory");
}
struct CvtItem { const float* W; int ldw, k0, c0; void* WT; int ldt, r0; };
__device__ __forceinline__ void cvt_load(float (&wv)[32], const CvtItem& c, int lane) {
    const float* wp = c.W + (size_t)(c.k0 + (lane >> 5)) * c.ldw + c.c0 + (lane & 31);
#pragma unroll
    for (int i = 0; i < 32; ++i) wv[i] = __builtin_nontemporal_load(wp + (size_t)(2 * i) * c.ldw);
}
template <bool FP8> __device__ __forceinline__ void cvt_store(const float (&wv)[32], const CvtItem& c, LAS float* scr, int lane, float wscale) {
#pragma unroll
    for (int i = 0; i < 32; ++i) scr[(2 * i + (lane >> 5)) * 33 + (lane & 31)] = FP8 ? wv[i] * wscale : wv[i];
    LDS_WAIT(); asm volatile("" ::: "memory");
    const int cc = lane & 7;
#pragma unroll
    for (int j = 0; j < 4; ++j) { const int n = (lane >> 3) + 8 * j; const LAS float* q = scr + (8 * cc) * 33 + n;
        if constexpr (FP8) { u32x2 o; o.x = pk4_fp8(q[0 * 33], q[1 * 33], q[2 * 33], q[3 * 33]); o.y = pk4_fp8(q[4 * 33], q[5 * 33], q[6 * 33], q[7 * 33]);
            *(GAS u32x2*)((unsigned char*)c.WT + (size_t)(c.r0 + n) * c.ldt + c.k0 + 8 * cc) = o; }
        else { u32x4 o; o.x = pk2(q[0 * 33], q[1 * 33]); o.y = pk2(q[2 * 33], q[3 * 33]); o.z = pk2(q[4 * 33], q[5 * 33]); o.w = pk2(q[6 * 33], q[7 * 33]);
            *(GAS u32x4*)((bf16_t*)c.WT + (size_t)(c.r0 + n) * c.ldt + c.k0 + 8 * cc) = o; } }
    LDS_WAIT(); asm volatile("" ::: "memory");
}
template <bool FP8, class Dec> __device__ __forceinline__ void cvt_run(int it0, int stride, int n, const Dec& dec, LAS float* scr, int lane, float wscale) {
    for (int it = it0; it < n; it += 2 * stride) {
        float a[32], b[32]; const CvtItem ca = dec(it); cvt_load(a, ca, lane);
        const int it2 = it + stride; const bool hb = it2 < n; CvtItem cb = ca; if (hb) { cb = dec(it2); cvt_load(b, cb, lane); }
        cvt_store<FP8>(a, ca, scr, lane, wscale); if (hb) cvt_store<FP8>(b, cb, scr, lane, wscale);
    }
}
__device__ __forceinline__ int win_src_col(int db) { const int r0 = db * 32, tile = r0 >> 8, loc = r0 & 255; if (tile >= 4) return r0; const int bj = loc >> 7, wc = (loc & 127) >> 5; return tile * 256 + 64 * wc + 32 * bj; }

__device__ __forceinline__ void convert_layer_weights(Frame& F, int l, int widx = -1, int nw = 0, int part = 0) {
    LAS float* scr = (LAS float*)(F.lds + RING_OFF + F.wave * 16384);
    const int gw = widx >= 0 ? widx : F.vcu * NWAVES + F.wave, NGW = widx >= 0 ? nw : F.G * NWAVES;
    const float* w_in = F.in[4] + (size_t)l * D * INC; const float* w_br = F.in[13] + (size_t)l * 3 * 512 * D; const float* w_o = F.in[14] + (size_t)l * D * D;
    constexpr int I_IN = 16 * 256, I_BR = 3 * 8 * 32, I_O = 16 * 32, I_GU = 16 * 176, I_DN = 44 * 32;
    const int nitems = I_IN + I_BR + I_O + (l == 0 ? I_GU + I_DN : 0);
    const auto dec = [&](int it) -> CvtItem { int r = it;
        if (r < I_IN) { const int kb = r >> 8, db = r & 255; return CvtItem{w_in, INC, kb * 64, win_src_col(db), WSP(bf16_t, WS_WIN), D, db * 32}; } r -= I_IN;
        if (r < I_BR) { const int br = r / 256, q = r % 256, kb = q >> 5, db = q & 31; return CvtItem{w_br + (size_t)br * 512 * D, D, kb * 64, db * 32, WSP(bf16_t, WS_WBR) + 512 * br, 1536, db * 32}; }   r -= I_BR;
        if (r < I_O) { const int kb = r >> 5, db = r & 31; return CvtItem{w_o, D, kb * 64, db * 32, WSP(bf16_t, WS_WO), D, db * 32}; } r -= I_O;
        if (r < I_GU) { const int kb = r / 176, db = r % 176, tile = db >> 3, l32 = db & 7; const float* src = (l32 < 4) ? F.in[15] : F.in[16];
            return CvtItem{src, FFD, kb * 64, tile * 128 + (l32 & 3) * 32, WSP(bf16_t, WS_WGU0), D, db * 32}; } r -= I_GU;
        const int kb = r >> 5, db = r & 31; return CvtItem{F.in[17], D, kb * 64, db * 32, WSP(bf16_t, WS_WD0), FFD, db * 32}; };
    const int it_lo = part == 2 ? I_IN + I_BR + I_O : 0, it_hi = part == 1 ? I_IN + I_BR + I_O : nitems;
    cvt_run<false>(it_lo + gw, NGW, it_hi, dec, scr, F.lane, 1.f);
    if (part == 2) return;
    const auto dec8 = [&](int it) -> CvtItem { const int kb = it / 96, db = it % 96; return CvtItem{w_in, INC, kb * 64, (160 + db) * 32, F.ws + WS_WIN8, D, db * 32}; };
    cvt_run<true>(gw, NGW, 16 * 96, dec8, scr, F.lane, W8_SCALE);
}
__device__ __forceinline__ void setup_small(Frame& F) {
    float* sm = SMALLF;
    if (blockIdx.x == 0) {
        if (F.tid < 2) { const int l = F.tid; const float* lp = F.in[7] + l * 256; float s1 = 0.f, s2 = 0.f;
            for (int i = 0; i < 64; ++i) { s1 += lp[i] * lp[64 + i]; s2 += lp[128 + i] * lp[192 + i]; }
            const float li = 0.8f - 0.6f * expf(-0.3f * (float)l); sm[SM_SCAL + l * 4] = expf(s1) - expf(s2) + li; sm[SM_SCAL + l * 4 + 1] = 1.f - li; }
        { const int c = F.tid; const float a = F.in[11][c], b = F.in[11][512 + c], mx = fmaxf(a, b), e0 = expf(a - mx), e1 = expf(b - mx), lb1 = e1 / (e0 + e1);
            sm[SM_LOGLB + c] = -INFINITY; sm[SM_LOG1M + c] = 0.f; sm[SM_LOGLB + 512 + c] = logf(lb1); sm[SM_LOG1M + 512 + c] = log1pf(-lb1); }
        { const int h = F.tid >> 7, n = F.tid & 127; int bk = n; if (n >= 16) { bk = 16 + (int)(logf((float)n / 16.f) / 2.0794415416798357f * 16.f); bk = bk < 31 ? bk : 31; }
            sm[SM_TAB + h * 128 + n] = (F.in[9][bk * 4 + h] - F.in[9][31 * 4 + h]) * LOG2E; }
    }
    const int gt = F.vcu * 512 + F.tid, NT = F.G * 512;
    for (int i = gt; i < NE * LISTCAP; i += NT) ((int*)(F.ws + WS_SMALL + SMB_LIST))[i] = 0;
    for (int i = gt; i < NB * 240 * (1024 / 8); i += NT) { const int row = i / 128, c = i % 128, b = row / 240, p = 4112 + row % 240; *(GAS u32x4*)(WSP(bf16_t, WS_QK) + ((size_t)(b * TP + p)) * 1024 + c * 8) = (u32x4){0u, 0u, 0u, 0u}; }
    for (int i = gt; i < NB * 240 * (512 / 8); i += NT) { const int row = i / 64, c = i % 64, b = row / 240, p = 4112 + row % 240; *(GAS u32x4*)(WSP(bf16_t, WS_V) + ((size_t)(b * TP + p)) * 512 + c * 8) = (u32x4){0u, 0u, 0u, 0u}; }
}
__device__ __forceinline__ const float* res_row(Frame& F, int r, bool first) {
    if (r < MR) return (first ? F.in[0] : (const float*)F.out) + (size_t)r * D;
    return (first ? F.in[1] : (const float*)(SMALLF + SM_METAHS)) + (size_t)(r - MR) * D;
}
__device__ __forceinline__ float* res_row_w(Frame& F, int r) { return (r < MR) ? F.out + (size_t)r * D : SMALLF + SM_METAHS + (size_t)(r - MR) * D; }
__device__ __forceinline__ void norm_pass(Frame& F, const float* gain, bool first, bool copy8) {
    const int gw = F.vcu * NWAVES + F.wave, NGW = F.G * NWAVES;
    f32x4 gv[4];
#pragma unroll
    for (int j = 0; j < 4; ++j) gv[j] = ((const f32x4*)gain)[F.lane + 64 * j];
    for (int r = gw; r < MROWS; r += NGW) {
        const GAS f32x4* xr = (const GAS f32x4*)res_row(F, r, first) + F.lane;
        f32x4 v[4]; float s = 0.f;
#pragma unroll
        for (int j = 0; j < 4; ++j) { v[j] = xr[64 * j]; s += (v[j].x * v[j].x + v[j].y * v[j].y) + (v[j].z * v[j].z + v[j].w * v[j].w); }
        const float sc = rsqrtf(wave_sum(s) * (1.f / D) + EPS);
        GAS u32x2* o = (GAS u32x2*)(WSP(bf16_t, WS_HN) + (size_t)r * D) + F.lane;
#pragma unroll
        for (int j = 0; j < 4; ++j) { u32x2 w; w.x = pk2(v[j].x * sc * gv[j].x, v[j].y * sc * gv[j].y); w.y = pk2(v[j].z * sc * gv[j].z, v[j].w * sc * gv[j].w); o[64 * j] = w; }
        if (copy8 && r < MR) { GAS unsigned* o8 = (GAS unsigned*)(F.ws + WS_HN8 + (size_t)r * D) + F.lane;
#pragma unroll
            for (int j = 0; j < 4; ++j) o8[64 * j] = pk4_fp8(v[j].x * sc * gv[j].x, v[j].y * sc * gv[j].y, v[j].z * sc * gv[j].z, v[j].w * sc * gv[j].w); }
    }
}

struct TileOrder {
    int nM, nN, nwg, G, c, pn0; long lda2, ldb2;
    __device__ void init(int nM_, int nN_, int pn0_, int G_, int c_, int lda, int ldb) { nM = nM_; nN = nN_; nwg = nM * nN; G = G_; c = c_; pn0 = pn0_; lda2 = 2L * lda; ldb2 = 2L * ldb; }
    __device__ __forceinline__ bool next(int i, Unit& u) const {
        const long L = (long)i * G + c; if (L >= nwg) return false;
        int wgid = (int)L; { const int q = nwg / 8, r = nwg % 8, xcd = wgid % 8, off = wgid / 8; wgid = (xcd < r ? xcd * (q + 1) : r * (q + 1) + (xcd - r) * q) + off; }
        const int nig = 8 * nN, gid = wgid / nig, fm = gid * 8, gsz = (nM - fm) < 8 ? (nM - fm) : 8;
        u.pm = fm + ((wgid % nig) % gsz); u.pn = pn0 + (wgid % nig) / gsz; u.z = 0; u.a_off = (unsigned)((long)u.pm * 256 * lda2); u.b_off = (unsigned)((long)u.pn * 256 * ldb2); u.gidx = nullptr; return true;
    }
};
__device__ __forceinline__ u32x4 pack8(const f32x4 a, const f32x4 b) { u32x4 w; w.x = cvt_pk_bf16(a[0], a[1]); w.y = cvt_pk_bf16(a[2], a[3]); w.z = cvt_pk_bf16(b[0], b[1]); w.w = cvt_pk_bf16(b[2], b[3]); return w; }
__device__ __forceinline__ void store_att(bf16_t* buf, int pitch, int r, int col, u32x4 w) {
    if (r < MR) { const int ar = (r >> 12) * TP + NM + (r & 4095); *(u32x4*)(buf + (size_t)ar * pitch + col) = w; }
    else { const int j = r - MR;
#pragma unroll
        for (int b = 0; b < NB; ++b) *(u32x4*)(buf + (size_t)(b * TP + j) * pitch + col) = w; }
}
struct EpiProj {
    static constexpr bool PERM = true, MID = false;
    unsigned char* ws; const float *qg, *kg; int l; float gsc;
    __device__ __forceinline__ void row(const Unit& u, int r, int slot, int wc, int fq, const f32x4 (&v)[2][2]) const {
        const int pn = u.pn;
        bf16_t* QK = (bf16_t*)(ws + WS_QK); bf16_t* V = (bf16_t*)(ws + WS_V); bf16_t* CONV = (bf16_t*)(ws + WS_CONV); bf16_t* HQ = (bf16_t*)(ws + WS_HQ); bf16_t* HV = (bf16_t*)(ws + WS_HV); bf16_t* HG = (bf16_t*)(ws + WS_HG);
        bf16_t* GATES = (bf16_t*)(ws + WS_GATES); float* LOGF = (float*)(ws + WS_LOGF); const float* loglb = (const float*)(ws + WS_SMALL) + SM_LOGLB + l * 512; const float* log1m = (const float*)(ws + WS_SMALL) + SM_LOG1M + l * 512;
        if (pn < 4) {
            float ss = 0.f;
#pragma unroll
            for (int bj = 0; bj < 2; ++bj)
#pragma unroll
                for (int n = 0; n < 2; ++n) ss += (v[bj][n][0] * v[bj][n][0] + v[bj][n][1] * v[bj][n][1]) + (v[bj][n][2] * v[bj][n][2] + v[bj][n][3] * v[bj][n][3]);
            ss = xadd<16>(ss); ss = xadd<32>(ss);
            const float sc = rsqrtf(ss * (1.f / 64.f) + EPS) * (pn < 2 ? C2 : 1.f); const float* gv = pn < 2 ? qg : kg;
#pragma unroll
            for (int bj = 0; bj < 2; ++bj) { const int d0 = 32 * bj + 8 * fq; const f32x4 g0 = *(const f32x4*)(gv + d0), g1 = *(const f32x4*)(gv + d0 + 4);
                store_att(QK, 1024, r, pn * 256 + 64 * wc + d0, pack8(v[bj][0] * g0 * sc, v[bj][1] * g1 * sc)); }
            return;
        }
#pragma unroll
        for (int bj = 0; bj < 2; ++bj) {
            const int cl = 128 * bj + 32 * wc + 8 * fq; f32x4 a = v[bj][0], b = v[bj][1];
            if (pn < 6) { store_att(V, 512, r, (pn - 4) * 256 + cl, pack8(a, b)); }
            else if (pn < 12) { *(u32x4*)(CONV + (size_t)r * 1536 + (pn - 6) * 256 + cl) = pack8(a, b); }
            else if (pn < 14 || (pn >= 18 && pn < 20)) {
#pragma unroll
                for (int e = 0; e < 4; ++e) { a[e] = silu(a[e]); b[e] = silu(b[e]); }
                bf16_t* dst = (pn < 14) ? HQ + (size_t)r * 512 + (pn - 12) * 256 + cl : HG + (size_t)r * 512 + (pn - 18) * 256 + cl; *(u32x4*)dst = pack8(a, b); }
            else if (pn < 16) {
                const int c = (pn - 14) * 256 + cl; const f32x4 la0 = *(const f32x4*)(loglb + c), la1 = *(const f32x4*)(loglb + c + 4), lm0 = *(const f32x4*)(log1m + c), lm1 = *(const f32x4*)(log1m + c + 4);
                f32x4 o0, o1;
#pragma unroll
                for (int e = 0; e < 4; ++e) {
                    o0[e] = logf_gate(a[e], la0[e], lm0[e]); o1[e] = logf_gate(b[e], la1[e], lm1[e]);
                }
                float* dst = LOGF + (size_t)r * 512 + c; *(f32x4*)dst = o0; *(f32x4*)(dst + 4) = o1; }
            else if (pn < 18) { *(u32x4*)(HV + (size_t)r * 512 + (pn - 16) * 256 + cl) = pack8(a, b); }
            else {
#pragma unroll
                for (int e = 0; e < 4; ++e) { a[e] = sigm(a[e] * gsc); b[e] = sigm(b[e] * gsc); }
                *(u32x4*)(GATES + (size_t)r * 3072 + (pn - 20) * 256 + cl) = pack8(a, b); }
        }
    }
};
struct EpiMerge {
    static constexpr bool PERM = true, MID = true; static constexpr int MID_T0 = 8, MID_T1 = 16;
    const bf16_t* GATES; bf16_t* MIXED;
    __device__ __forceinline__ void mid_row(const Unit& u, int r, int t, int wc, int fq, f32x4 (&v)[2][2]) const {
        const int b = (t >> 3) - 1;
#pragma unroll
        for (int bj = 0; bj < 2; ++bj) {
            const bf16_t* gp = GATES + (size_t)r * 3072 + b * 1024 + u.pn * 256 + 128 * bj + 32 * wc + 8 * fq; const u32x4 ga = *(const u32x4*)gp, gb = *(const u32x4*)(gp + 1024);
#define MK_RT(x, y) ((x) * __builtin_amdgcn_rcpf(fmaxf((y), 1e-20f)))
            v[bj][0][0] *= MK_RT(bflo(ga.x), bflo(gb.x)); v[bj][0][1] *= MK_RT(bfhi(ga.x), bfhi(gb.x)); v[bj][0][2] *= MK_RT(bflo(ga.y), bflo(gb.y)); v[bj][0][3] *= MK_RT(bfhi(ga.y), bfhi(gb.y));
            v[bj][1][0] *= MK_RT(bflo(ga.z), bflo(gb.z)); v[bj][1][1] *= MK_RT(bfhi(ga.z), bfhi(gb.z)); v[bj][1][2] *= MK_RT(bflo(ga.w), bflo(gb.w)); v[bj][1][3] *= MK_RT(bfhi(ga.w), bfhi(gb.w));
#undef MK_RT
        }
    }
    __device__ __forceinline__ void row(const Unit& u, int r, int slot, int wc, int fq, const f32x4 (&v)[2][2]) const {
#pragma unroll
        for (int bj = 0; bj < 2; ++bj) {
            const int cl = 128 * bj + 32 * wc + 8 * fq; const u32x4 gw = *(const u32x4*)(GATES + (size_t)r * 3072 + 2048 + u.pn * 256 + cl);
            f32x4 a = v[bj][0], b = v[bj][1];
            a[0] *= bflo(gw.x); a[1] *= bfhi(gw.x); a[2] *= bflo(gw.y); a[3] *= bfhi(gw.y); b[0] *= bflo(gw.z); b[1] *= bfhi(gw.z); b[2] *= bflo(gw.w); b[3] *= bfhi(gw.w);
            *(u32x4*)(MIXED + (size_t)r * D + u.pn * 256 + cl) = pack8(a, b);
        }
    }
};
struct EpiRes {
    static constexpr bool PERM = false, MID = false;
    const float* base; float* out; const float* mbase; float* mout;
    __device__ __forceinline__ void row(const Unit& u, int r, int slot, int wc, int fq, const f32x4 (&v)[2][2]) const {
        const float* bp = (r < MR) ? base + (size_t)r * D : mbase + (size_t)(r - MR) * D; float* op = (r < MR) ? out + (size_t)r * D : mout + (size_t)(r - MR) * D;
#pragma unroll
        for (int bj = 0; bj < 2; ++bj)
#pragma unroll
            for (int n = 0; n < 2; ++n) { const int col = u.pn * 256 + 128 * bj + 32 * wc + 16 * n + 4 * fq; *(f32x4*)(op + col) = *(const f32x4*)(bp + col) + v[bj][n]; }
    }
};
struct EpiGU {
    static constexpr bool PERM = true, MID = false;
    bf16_t* H; int ldh; float sc;
    __device__ __forceinline__ void row(const Unit& u, int r, int slot, int wc, int fq, const f32x4 (&v)[2][2]) const {
        f32x4 a, b;
#pragma unroll
        for (int e = 0; e < 4; ++e) { a[e] = silu(v[0][0][e] * sc) * (v[1][0][e] * sc); b[e] = silu(v[0][1][e] * sc) * (v[1][1][e] * sc); }
        *(u32x4*)(H + (size_t)r * ldh + u.pn * 128 + 32 * wc + 8 * fq) = pack8(a, b);
    }
};

struct EpiGU8 {
    static constexpr bool PERM = true, MID = false;
    unsigned char* H; int ldh; float sc;
    __device__ __forceinline__ void row(const Unit& u, int r, int slot, int wc, int fq, const f32x4 (&v)[2][2]) const {
        f32x4 a, b;
#pragma unroll
        for (int e = 0; e < 4; ++e) { a[e] = silu(v[0][0][e] * sc) * (v[1][0][e] * (sc * H8_SCALE)); b[e] = silu(v[0][1][e] * sc) * (v[1][1][e] * (sc * H8_SCALE)); }
#pragma unroll
        for (int e = 0; e < 4; ++e) { a[e] = __builtin_amdgcn_fmed3f(a[e], -448.f, 448.f); b[e] = __builtin_amdgcn_fmed3f(b[e], -448.f, 448.f); }
        u32x2 o; o.x = pk4_fp8(a[0], a[1], a[2], a[3]); o.y = pk4_fp8(b[0], b[1], b[2], b[3]);
        *(u32x2*)(H + (size_t)r * ldh + u.pn * 128 + 32 * wc + 8 * fq) = o;
    }
};
template <class Epi>
__device__ __forceinline__ void meta_gemm(Frame& F, const bf16_t* A16, int lda, const bf16_t* Bt, int ldb, int K, int pn_lo, int pn_hi, const Epi& E) {
    const int fr = F.lane & 15, fq = F.lane >> 4;
    for (int task = pn_lo * 4 + F.vcu; task < pn_hi * 4; task += F.G) {
        const int pn = task >> 2, wc = task & 3; f32x4 v[2][2];
        pg8::small_tile<Epi::PERM>(F.lds + RING_OFF, A16, lda, Bt, ldb, K, pn, wc, v, F.wave);
        if (F.wave == 0) { Unit u; u.pm = 64; u.pn = pn; u.z = 0; u.a_off = 0; u.b_off = 0; u.gidx = nullptr; E.row(u, MR + fr, 0, wc, fq, v); }
    }
}
__device__ __forceinline__ void meta_merge(Frame& F, const bf16_t* U16, const bf16_t* Wbr, const bf16_t* GATES, bf16_t* MIXED) {
    const int fr = F.lane & 15, fq = F.lane >> 4;
    for (int task = F.vcu; task < 16; task += F.G) {
        const int pn = task >> 2, wc = task & 3; f32x4 tot[2][2];
#pragma unroll
        for (int bj = 0; bj < 2; ++bj)
#pragma unroll
            for (int n = 0; n < 2; ++n) tot[bj][n] = (f32x4){0.f, 0.f, 0.f, 0.f};
        for (int z = 0; z < 3; ++z) {
            f32x4 v[2][2];
            pg8::small_tile<true>(F.lds + RING_OFF, U16 + 512 * z, 1536, Wbr + 512 * z, 1536, 512, pn, wc, v, F.wave);
            if (F.wave == 0) {
#pragma unroll
                for (int bj = 0; bj < 2; ++bj) { const int cl = 128 * bj + 32 * wc + 8 * fq; const u32x4 gw = *(const u32x4*)(GATES + (size_t)(MR + fr) * 3072 + z * 1024 + pn * 256 + cl);
                    f32x4 a = v[bj][0], b = v[bj][1];
                    a[0] *= bflo(gw.x); a[1] *= bfhi(gw.x); a[2] *= bflo(gw.y); a[3] *= bfhi(gw.y); b[0] *= bflo(gw.z); b[1] *= bfhi(gw.z); b[2] *= bflo(gw.w); b[3] *= bfhi(gw.w);
                    tot[bj][0] += a; tot[bj][1] += b; }
            }
        }
        if (F.wave == 0) {
#pragma unroll
            for (int bj = 0; bj < 2; ++bj) { const int cl = 128 * bj + 32 * wc + 8 * fq; *(u32x4*)(MIXED + (size_t)(MR + fr) * D + pn * 256 + cl) = pack8(tot[bj][0], tot[bj][1]); }
        }
    }
}

__device__ __forceinline__ int prev_row(int r, int d) {
    if (r >= MR) { const int j = r - MR - d; return j >= 0 ? MR + j : -1; }
    const int s = r & 4095; if (s >= d) return r - d; return MR + NM + s - d;
}
__device__ __forceinline__ void conv_pass(Frame& F, const float* cw) {
    const bf16_t* CONV = WSP(bf16_t, WS_CONV); bf16_t* U = WSP(bf16_t, WS_U);
    const int gt = F.vcu * 512 + F.tid, NT = F.G * 512, c8 = (gt & 63) * 8;
    f32x4 w0[3], w1[3];
#pragma unroll
    for (int k = 0; k < 3; ++k) { w0[k] = *(const GAS f32x4*)(cw + k * 512 + c8); w1[k] = *(const GAS f32x4*)(cw + k * 512 + c8 + 4); }
    for (int i = gt; i < MROWS * 64; i += 2 * NT) {
        u32x4 cv[2][3], hv[2][3], bv[2]; float mk[2][3];
#pragma unroll
        for (int q = 0; q < 2; ++q) { const int iq = i + q * NT; const int r = (iq < MROWS * 64 ? iq : i) >> 6;
#pragma unroll
            for (int k = 0; k < 3; ++k) { const int rr = (k == 2) ? r : prev_row(r, 2 - k); mk[q][k] = rr < 0 ? 0.f : 1.f; const int rc = rr < 0 ? r : rr;
                cv[q][k] = *(const GAS u32x4*)(CONV + (size_t)rc * 1536 + 512 + c8); hv[q][k] = *(const GAS u32x4*)(CONV + (size_t)rc * 1536 + 1024 + c8); }
            bv[q] = *(const GAS u32x4*)(CONV + (size_t)r * 1536 + c8); }
#pragma unroll
        for (int q = 0; q < 2; ++q) { const int iq = i + q * NT; if (iq >= MROWS * 64) continue; const int r = iq >> 6; float y[8];
#pragma unroll
            for (int e = 0; e < 8; ++e) y[e] = 0.f;
#pragma unroll
            for (int k = 0; k < 3; ++k) { const u32x4 c = cv[q][k], hh = hv[q][k]; const f32x4 a0 = w0[k] * mk[q][k], a1 = w1[k] * mk[q][k];
                y[0] += a0[0] * bflo(c.x) * bflo(hh.x); y[1] += a0[1] * bfhi(c.x) * bfhi(hh.x); y[2] += a0[2] * bflo(c.y) * bflo(hh.y); y[3] += a0[3] * bfhi(c.y) * bfhi(hh.y);
                y[4] += a1[0] * bflo(c.z) * bflo(hh.z); y[5] += a1[1] * bfhi(c.z) * bfhi(hh.z); y[6] += a1[2] * bflo(c.w) * bflo(hh.w); y[7] += a1[3] * bfhi(c.w) * bfhi(hh.w); }
            const u32x4 bq = bv[q];
            u32x4 o; o.x = pk2(bflo(bq.x) * y[0], bfhi(bq.x) * y[1]); o.y = pk2(bflo(bq.y) * y[2], bfhi(bq.y) * y[3]); o.z = pk2(bflo(bq.z) * y[4], bfhi(bq.z) * y[5]); o.w = pk2(bflo(bq.w) * y[6], bfhi(bq.w) * y[7]);
            *(GAS u32x4*)(U + (size_t)r * 1536 + 512 + c8) = o; }
    }
}
__device__ __forceinline__ void attcomb_pass(Frame& F, const float* sg, int l) {
    const bf16_t* O = WSP(bf16_t, WS_O); bf16_t* U = WSP(bf16_t, WS_U);
    const int gw = F.vcu * NWAVES + F.wave, NGW = F.G * NWAVES;
    const float lam = SMALLF[SM_SCAL + l * 4], oml = SMALLF[SM_SCAL + l * 4 + 1];
    const int c8 = F.lane * 8; const f32x4 g0 = *(const f32x4*)(sg + (c8 & 127)), g1 = *(const f32x4*)(sg + (c8 & 127) + 4);
    for (int r = gw; r < MROWS; r += NGW) {
        const int ar = (r < MR) ? (r >> 12) * TP + NM + (r & 4095) : (r - MR);
        const u32x4 a = *(const u32x4*)(O + (size_t)ar * 1024 + c8), b = *(const u32x4*)(O + (size_t)ar * 1024 + 512 + c8);
        float d[8]; d[0] = bflo(a.x) - lam * bflo(b.x); d[1] = bfhi(a.x) - lam * bfhi(b.x); d[2] = bflo(a.y) - lam * bflo(b.y); d[3] = bfhi(a.y) - lam * bfhi(b.y);
        d[4] = bflo(a.z) - lam * bflo(b.z); d[5] = bfhi(a.z) - lam * bfhi(b.z); d[6] = bflo(a.w) - lam * bflo(b.w); d[7] = bfhi(a.w) - lam * bfhi(b.w);
        float ss = 0.f;
#pragma unroll
        for (int e = 0; e < 8; ++e) ss += d[e] * d[e];
        ss = xadd<1>(ss); ss = xadd<2>(ss); ss = xadd<4>(ss); ss = xadd<8>(ss);
        const float sc = rsqrtf(ss * (1.f / 128.f) + EPS) * oml;
        u32x4 o; o.x = pk2(d[0] * sc * g0[0], d[1] * sc * g0[1]); o.y = pk2(d[2] * sc * g0[2], d[3] * sc * g0[3]); o.z = pk2(d[4] * sc * g1[0], d[5] * sc * g1[1]); o.w = pk2(d[6] * sc * g1[2], d[7] * sc * g1[3]);
        *(u32x4*)(U + (size_t)r * 1536 + c8) = o;
    }
}

constexpr int HA_QP = 0, HA_KP = 43520, HA_KT = HA_KP + 17408, HA_VT = HA_KT + 18432, HA_PB = HA_VT + 18432, HA_TOT = HA_PB + 9216;
__device__ __forceinline__ int qp_base(int j) { return j == 0 ? 0 : (j == 1 ? 64 : (j == 2 ? 112 : 144)); }
struct HgIn { float lf[16], qv[16], vv[16]; };
__device__ __forceinline__ void hgrnA_load(Frame& F, int id, HgIn& in) {
    const bool meta = id >= 1024; const int bh = meta ? 0 : id >> 6, c = id & 63, h = meta ? id - 1024 : bh & 3, b = bh >> 2;
    const int row0 = meta ? MR : b * SEQ + c * 64, nvalid = meta ? NM : 64;
    const int d = F.tid & 127, i = F.tid >> 7;
    const bf16_t* HQ = WSP(bf16_t, WS_HQ); const bf16_t* HV = WSP(bf16_t, WS_HV); const float* LOGF = WSP(float, WS_LOGF);
#pragma unroll
    for (int j = 0; j < 16; ++j) { const int t = 16 * i + j; const bool ok = t < nvalid; const size_t off = (size_t)(row0 + (ok ? t : 0)) * 512 + h * 128 + d;
        const float a = LOGF[off]; const unsigned short q = HQ[off], v = HV[off]; in.lf[j] = ok ? a : 0.f; in.qv[j] = ok ? bf2f(q) : 0.f; in.vv[j] = ok ? bf2f(v) : 0.f; }
}
#ifndef HG_NORAW
#define HG_BAR() do { asm volatile("s_waitcnt lgkmcnt(0)" ::: "memory"); __builtin_amdgcn_s_barrier(); asm volatile("" ::: "memory"); } while (0)
#else
#define HG_BAR() __syncthreads()
#endif
#define HG_BAR_UNUSED()
__device__ __forceinline__ void hgrnA_compute(Frame& F, int id, const HgIn& in) {
    const bool meta = id >= 1024; const int bh = meta ? 0 : id >> 6, c = id & 63, h = meta ? id - 1024 : bh & 3, b = bh >> 2;
    const int row0 = meta ? MR : b * SEQ + c * 64, nvalid = meta ? NM : 64;
    const int d = F.tid & 127, i = F.tid >> 7;
    LAS unsigned char* L = F.lds + RING_OFF;
    const float (&lf)[16] = in.lf; const float (&qv)[16] = in.qv; const float (&vv)[16] = in.vv;
    float Lc[16]; { float s = 0.f;
#pragma unroll
        for (int j = 0; j < 16; ++j) { s += lf[j]; Lc[j] = s; } }
    LAS float* TOT = (LAS float*)(L + HA_TOT);
    TOT[i * 128 + d] = Lc[15];
    HG_BAR();
    float rho[4]; { float s = 0.f;
#pragma unroll
        for (int j = 0; j < 4; ++j) { s += TOT[j * 128 + d]; rho[j] = s; } }
    const float rhoi = (i == 0) ? rho[0] : (i == 1) ? rho[1] : (i == 2) ? rho[2] : rho[3], ri = (i == 0) ? 0.f : (i == 1) ? rho[0] : (i == 2) ? rho[1] : rho[2], glast = rho[3];
    const float fK2 = __expf(glast - rhoi), fQ2 = __expf(rhoi);
    float fQ[4];
#pragma unroll
    for (int jj = 0; jj < 4; ++jj) fQ[jj] = (jj <= i) ? __expf(rhoi - rho[jj]) : 0.f;
    LAS bf16_t* KP = (LAS bf16_t*)(L + HA_KP); LAS bf16_t* QP = (LAS bf16_t*)(L + HA_QP);
    unsigned kt[8], vt[8];
#pragma unroll
    for (int j = 0; j < 16; j += 2) {
        float kp[2], qe[2];
#pragma unroll
        for (int q = 0; q < 2; ++q) { const float G = ri + Lc[j + q], E = __expf(G - rhoi), k = 1.f - __expf(lf[j + q]); kp[q] = k * __builtin_amdgcn_rcpf(E); qe[q] = qv[j + q] * E; }
        const int t = 16 * i + j;
        { const unsigned w = cvt_pk_bf16(kp[0], kp[1]); KP[t * 136 + d] = (bf16_t)(w & 0xffffu); KP[(t + 1) * 136 + d] = (bf16_t)(w >> 16); }
        kt[j >> 1] = cvt_pk_bf16(kp[0] * fK2, kp[1] * fK2); vt[j >> 1] = cvt_pk_bf16(vv[j], vv[j + 1]);
#pragma unroll
        for (int jj = 0; jj < 4; ++jj) if (jj <= i) { const unsigned w = cvt_pk_bf16(qe[0] * fQ[jj], qe[1] * fQ[jj]); const int rb = qp_base(jj) + t - 16 * jj; QP[rb * 136 + d] = (bf16_t)(w & 0xffffu); QP[(rb + 1) * 136 + d] = (bf16_t)(w >> 16); }
        { const unsigned w = cvt_pk_bf16(qe[0] * fQ2, qe[1] * fQ2); bf16_t* hq2 = WSP(bf16_t, WS_HQ2) + (size_t)(row0 + t) * 512 + h * 128 + d;
          if (t < nvalid) hq2[0] = (bf16_t)(w & 0xffffu); if (t + 1 < nvalid) hq2[512] = (bf16_t)(w >> 16); }
    }
    { LAS u32x4* ktp = (LAS u32x4*)(L + HA_KT + d * 144 + i * 32); ktp[0] = (u32x4){kt[0], kt[1], kt[2], kt[3]}; ktp[1] = (u32x4){kt[4], kt[5], kt[6], kt[7]};
      LAS u32x4* vtp = (LAS u32x4*)(L + HA_VT + d * 144 + i * 32); vtp[0] = (u32x4){vt[0], vt[1], vt[2], vt[3]}; vtp[1] = (u32x4){vt[4], vt[5], vt[6], vt[7]}; }
    if (i == 0) WSP(float, WS_DEC)[(size_t)id * 128 + d] = __expf(glast);
    HG_BAR();
    const int w = F.wave, fr = F.lane & 15, fq = F.lane >> 4;
    {
        LAS unsigned char* PB = L + HA_PB;
        for (int blk = w; blk < 16; blk += 8) {
            int it, js;
            if (blk < 10) { it = (blk >= 6) ? 3 : (blk >= 3) ? 2 : (blk >= 1) ? 1 : 0; js = blk - ((it * (it + 1)) >> 1); }
            else { const int q = blk - 10; it = (q < 3) ? 0 : (q < 5) ? 1 : 2; js = (q < 3) ? q + 1 : (q < 5) ? q - 1 : 3; }
            f32x4 acc = (f32x4){0.f, 0.f, 0.f, 0.f};
            if (blk < 10) {
#pragma unroll
                for (int ks = 0; ks < 4; ++ks) {
                    const bf16x8 qa = *(const LAS bf16x8*)(L + HA_QP + ((qp_base(js) + 16 * it - 16 * js + fr) * 136 + 32 * ks + 8 * fq) * 2);
                    const bf16x8 kb = *(const LAS bf16x8*)(L + HA_KP + ((16 * js + fr) * 136 + 32 * ks + 8 * fq) * 2);
                    acc = __builtin_amdgcn_mfma_f32_16x16x32_bf16(kb, qa, acc, 0, 0, 0);
                }
                if (it == js) {
#pragma unroll
                    for (int e = 0; e < 4; ++e) if (4 * fq + e > fr) acc[e] = 0.f;
                }
            }
            u32x2 pw; pw.x = pk2(acc[0], acc[1]); pw.y = pk2(acc[2], acc[3]);
            *(LAS u32x2*)(PB + (16 * it + fr) * 144 + (16 * js + 4 * fq) * 2) = pw;
        }
    }
    HG_BAR();
    {
        const int tb = w >> 1, dv0 = (w & 1) * 4;
        f32x4 acc[4];
#pragma unroll
        for (int q = 0; q < 4; ++q) acc[q] = (f32x4){0.f, 0.f, 0.f, 0.f};
#pragma unroll
        for (int ks = 0; ks < 2; ++ks) {
            const bf16x8 pa = *(const LAS bf16x8*)(L + HA_PB + (16 * tb + fr) * 144 + (32 * ks + 8 * fq) * 2);
#pragma unroll
            for (int q = 0; q < 4; ++q) { const bf16x8 vb = *(const LAS bf16x8*)(L + HA_VT + (16 * (dv0 + q) + fr) * 144 + (32 * ks + 8 * fq) * 2);
                acc[q] = __builtin_amdgcn_mfma_f32_16x16x32_bf16(vb, pa, acc[q], 0, 0, 0); }
        }
        const int t = 16 * tb + fr;
        if (t < nvalid) {
#pragma unroll
            for (int q = 0; q < 4; ++q) *(f32x4*)(WSP(float, WS_OI) + (size_t)(row0 + t) * 512 + h * 128 + 16 * (dv0 + q) + 4 * fq) = acc[q];
        }
    }
    {
        f32x4 acc[8];
#pragma unroll
        for (int q = 0; q < 8; ++q) acc[q] = (f32x4){0.f, 0.f, 0.f, 0.f};
#pragma unroll
        for (int ks = 0; ks < 2; ++ks) {
            const bf16x8 va = *(const LAS bf16x8*)(L + HA_VT + (16 * w + fr) * 144 + (32 * ks + 8 * fq) * 2);
#pragma unroll
            for (int q = 0; q < 8; ++q) { const bf16x8 kb = *(const LAS bf16x8*)(L + HA_KT + (16 * q + fr) * 144 + (32 * ks + 8 * fq) * 2);
                acc[q] = __builtin_amdgcn_mfma_f32_16x16x32_bf16(kb, va, acc[q], 0, 0, 0); }
        }
        float* DS = WSP(float, WS_DS) + (size_t)id * 16384 + (size_t)(16 * w + fr) * 128;
#pragma unroll
        for (int q = 0; q < 8; ++q) *(f32x4*)(DS + 16 * q + 4 * fq) = acc[q];
    }
    HG_BAR();
}
__device__ __forceinline__ void hgrn_scan(Frame& F) {
    const float* DS = WSP(float, WS_DS); const float* DEC = WSP(float, WS_DEC); bf16_t* ST = WSP(bf16_t, WS_ST);
    const int gt = F.vcu * 512 + F.tid, NT = F.G * 512;
    typedef float f32x2 __attribute__((ext_vector_type(2)));
    for (int idx = gt; idx < 16 * 8192; idx += NT) {
        const int bh = idx >> 13, e2 = (idx & 8191) * 2, dk = e2 & 127, h = bh & 3;
        f32x2 s = *(const GAS f32x2*)(DS + (size_t)(1024 + h) * 16384 + e2);
        for (int c0 = 0; c0 < 64; c0 += 16) {
            f32x2 dd[16], ds[16];
#pragma unroll
            for (int j = 0; j < 16; ++j) { const size_t id = (size_t)bh * 64 + c0 + j; dd[j] = *(const GAS f32x2*)(DEC + id * 128 + dk); ds[j] = *(const GAS f32x2*)(DS + id * 16384 + e2); }
#pragma unroll
            for (int j = 0; j < 16; ++j) { const size_t id = (size_t)bh * 64 + c0 + j; *(GAS unsigned*)(ST + id * 16384 + e2) = pk2(s.x, s.y); s = dd[j] * s + ds[j]; }
        }
    }
}
__device__ __forceinline__ void hgrnC_pass(Frame& F, const float* og) {
    const bf16_t* HQ = WSP(bf16_t, WS_HQ2); const bf16_t* HG = WSP(bf16_t, WS_HG); const float* OI = WSP(float, WS_OI); const bf16_t* ST = WSP(bf16_t, WS_ST); bf16_t* U = WSP(bf16_t, WS_U);
    const int gw = F.vcu * NWAVES + F.wave, NGW = F.G * NWAVES, fr = F.lane & 15, fq = F.lane >> 4;
    for (int task = gw; task < 1024 * 4 + 4; task += NGW) {
        const bool meta = task >= 4096; const int id = meta ? 0 : task >> 2, tb = meta ? 0 : task & 3, bh = id >> 6, c = id & 63, h = meta ? task - 4096 : bh & 3, b = bh >> 2;
        const int row = (meta ? MR : b * SEQ + c * 64 + 16 * tb) + fr;
        f32x4 acc[8], og4[8]; u32x2 hg2[8];
#pragma unroll
        for (int q = 0; q < 8; ++q) { acc[q] = *(const GAS f32x4*)(OI + (size_t)row * 512 + h * 128 + 16 * q + 4 * fq);
            og4[q] = *(const GAS f32x4*)(og + 16 * q + 4 * fq); hg2[q] = *(const GAS u32x2*)(HG + (size_t)row * 512 + h * 128 + 16 * q + 4 * fq); }
        if (!meta) {
            const bf16_t* Sb = ST + (size_t)id * 16384;
#pragma unroll
            for (int ks = 0; ks < 4; ++ks) {
                const bf16x8 qa = *(const bf16x8*)(HQ + (size_t)row * 512 + h * 128 + 32 * ks + 8 * fq);
#pragma unroll
                for (int q = 0; q < 8; ++q) { const bf16x8 sb = *(const bf16x8*)(Sb + (size_t)(16 * q + fr) * 128 + 32 * ks + 8 * fq);
                    acc[q] = __builtin_amdgcn_mfma_f32_16x16x32_bf16(sb, qa, acc[q], 0, 0, 0); }
            }
        }
        float ss = 0.f;
#pragma unroll
        for (int q = 0; q < 8; ++q) ss += (acc[q][0] * acc[q][0] + acc[q][1] * acc[q][1]) + (acc[q][2] * acc[q][2] + acc[q][3] * acc[q][3]);
        ss = xadd<16>(ss); ss = xadd<32>(ss);
        const float sc = rsqrtf(ss * (1.f / 128.f) + EPS);
#pragma unroll
        for (int q = 0; q < 8; ++q) { const int dv = 16 * q + 4 * fq; const f32x4 g = og4[q]; const u32x2 gg = hg2[q];
            u32x2 o; o.x = pk2(acc[q][0] * sc * g[0] * bflo(gg.x), acc[q][1] * sc * g[1] * bfhi(gg.x)); o.y = pk2(acc[q][2] * sc * g[2] * bflo(gg.y), acc[q][3] * sc * g[3] * bfhi(gg.y));
            *(GAS u32x2*)(U + (size_t)row * 1536 + 1024 + h * 128 + dv) = o; }
    }
}
struct TokInfo { int e1, s1, e2, s2; float w1, w2; int pad0, pad1; };
__device__ __forceinline__ void convert_moe_gu(Frame& F, int early = -1, int widx = 0, int nw = 1, int skip = -1) {
    LAS float* scr = early >= 0 ? (LAS float*)(F.lds + RING_OFF + F.wave * 16384) : (LAS float*)(F.lds + RING_OFF + 32768 + F.wave * 8704);
    const int gw = early >= 0 ? widx : F.vcu * NWAVES + F.wave, NGW = early >= 0 ? nw : F.G * NWAVES;
    constexpr int I_GU = 16 * 224;
    const int ne = early >= 0 ? 1 : (skip >= 0 ? NE - 1 : NE);
    const auto dec = [&](int it) -> CvtItem { int e = it / I_GU; const int r = it - e * I_GU, kb = r / 224, db = r % 224, tile = db >> 3, l32 = db & 7;
        e = early >= 0 ? early : (skip >= 0 && e >= skip ? e + 1 : e);
        const float* src = ((l32 < 4) ? F.in[19] : F.in[20]) + (size_t)e * D * FFE;
        return CvtItem{src, FFE, kb * 64, tile * 128 + (l32 & 3) * 32, F.ws + WS_MGU + (size_t)e * 7168 * D, D, db * 32}; };
    cvt_run<true>(gw, NGW, ne * I_GU, dec, scr, F.lane, W8_SCALE);
}
__device__ __forceinline__ void convert_moe_down(Frame& F, int widx, int nw) {
    LAS float* scr = (LAS float*)(F.lds + RING_OFF + F.wave * 16384);
    constexpr int I_DN = 56 * 32;
    const auto dec = [&](int it) -> CvtItem { const int e = it / I_DN, r = it - e * I_DN, kb = r >> 5, db = r & 31;
        return CvtItem{F.in[21] + (size_t)e * FFE * D, D, kb * 64, db * 32, F.ws + WS_MD + (size_t)e * D * FFE, FFE, db * 32}; };
    cvt_run<true>(widx, nw, NE * I_DN, dec, scr, F.lane, WD8_SCALE);
}
__device__ __forceinline__ void norm_route_pass(Frame& F, const float* gain) {
    LAS float* rwl = (LAS float*)(F.lds + RING_OFF);
    for (int i = F.tid; i < D * NE / 4; i += 512) ((LAS f32x4*)rwl)[i] = ((const f32x4*)F.in[18])[i];
    __syncthreads();
    const int gw = F.vcu * NWAVES + F.wave, NGW = F.G * NWAVES;
    f32x4 gv[4];
#pragma unroll
    for (int j = 0; j < 4; ++j) gv[j] = ((const f32x4*)gain)[F.lane + 64 * j];
    unsigned* cnt = (unsigned*)(F.ws + WS_CTL) + CW_CNT; int* lists = (int*)(F.ws + WS_SMALL + SMB_LIST); TokInfo* ti = (TokInfo*)(F.ws + WS_SMALL + SMB_TOK);
    f32x4 vn[4];
    { const GAS f32x4* x0 = (const GAS f32x4*)(F.out + (size_t)(gw < MR ? gw : 0) * D) + F.lane;
#pragma unroll
      for (int j = 0; j < 4; ++j) vn[j] = x0[64 * j]; }
    for (int r = gw; r < MR; r += NGW) {
        f32x4 v[4]; float s = 0.f;
#pragma unroll
        for (int j = 0; j < 4; ++j) v[j] = vn[j];
        { const int rn = r + NGW; const GAS f32x4* xn = (const GAS f32x4*)(F.out + (size_t)(rn < MR ? rn : r) * D) + F.lane;
#pragma unroll
          for (int j = 0; j < 4; ++j) vn[j] = xn[64 * j]; }
#pragma unroll
        for (int j = 0; j < 4; ++j) s += (v[j].x * v[j].x + v[j].y * v[j].y) + (v[j].z * v[j].z + v[j].w * v[j].w);
        const float sc = rsqrtf(wave_sum(s) * (1.f / D) + EPS);
        GAS unsigned* o = (GAS unsigned*)(F.ws + WS_HN + (size_t)r * D) + F.lane;
        float lg[8];
#pragma unroll
        for (int e = 0; e < 8; ++e) lg[e] = 0.f;
#pragma unroll
        for (int j = 0; j < 4; ++j) {
            v[j] = v[j] * sc * gv[j];
            o[64 * j] = pk4_fp8(v[j].x, v[j].y, v[j].z, v[j].w);
#pragma unroll
            for (int q = 0; q < 4; ++q) { const int d = (F.lane + 64 * j) * 4 + q; const f32x4 r0 = *(const LAS f32x4*)(rwl + d * 8), r1 = *(const LAS f32x4*)(rwl + d * 8 + 4); const float x = v[j][q];
                lg[0] += x * r0[0]; lg[1] += x * r0[1]; lg[2] += x * r0[2]; lg[3] += x * r0[3]; lg[4] += x * r1[0]; lg[5] += x * r1[1]; lg[6] += x * r1[2]; lg[7] += x * r1[3]; }
        }
#pragma unroll
        for (int e = 0; e < 8; ++e) lg[e] = wave_sum(lg[e]);
        int i1 = 0; float m1 = lg[0];
#pragma unroll
        for (int e = 1; e < 8; ++e) if (lg[e] > m1) { m1 = lg[e]; i1 = e; }
        int i2 = -1; float m2 = -INFINITY;
#pragma unroll
        for (int e = 0; e < 8; ++e) if (e != i1 && lg[e] > m2) { m2 = lg[e]; i2 = e; }
        if (F.lane == 0) {
            const float w1 = 1.f / (1.f + expf(m2 - m1));
            const unsigned s1 = __hip_atomic_fetch_add(cnt + 64 * i1, 1u, RLX_AGENT), s2 = __hip_atomic_fetch_add(cnt + 64 * i2, 1u, RLX_AGENT);
            lists[i1 * LISTCAP + s1] = r; lists[i2 * LISTCAP + s2] = r;
            TokInfo t; t.e1 = i1; t.s1 = (int)s1; t.e2 = i2; t.s2 = (int)s2; t.w1 = w1; t.w2 = 1.f - w1; t.pad0 = 0; t.pad1 = 0; ti[r] = t;
        }
    }
}
struct MoeTiles { int ts[9]; };
__device__ __forceinline__ MoeTiles moe_tiles(Frame& F) {
    MoeTiles m; const unsigned* cnt = (const unsigned*)(F.ws + WS_CTL) + CW_CNT; int a = 0;
#pragma unroll
    for (int e = 0; e < 8; ++e) { m.ts[e] = a; const unsigned c = (unsigned)__builtin_amdgcn_readfirstlane((int)__hip_atomic_load(cnt + 64 * e, RLX_AGENT)); a += (int)((c + 255u) >> 8); }
    m.ts[8] = a; return m;
}
__device__ __forceinline__ int moe_expert_of(const MoeTiles& m, int rt) { int e = 0;
#pragma unroll
    for (int k = 1; k < 8; ++k) e += (rt >= m.ts[k]) ? 1 : 0;
    return e; }
struct MoeGuOrder {
    MoeTiles m; int G, c; const int* lists;
    __device__ __forceinline__ bool next(int i, Unit& u) const {
        const int L = i * G + c; if (L >= m.ts[8] * 28) return false;
        const int rt = L / 28, pn = L - rt * 28, e = moe_expert_of(m, rt);
        int tsb = 0;
#pragma unroll
        for (int k = 0; k < 8; ++k) tsb = (k == e) ? m.ts[k] : tsb;
        u.pm = rt; u.pn = pn; u.z = e; u.a_off = 0u; u.b_off = (unsigned)(((long)e * 7168 + pn * 256) * D); u.gidx = lists + e * LISTCAP + (rt - tsb) * 256; return true;
    }
};
struct MoeDownOrder {
    MoeTiles m; int G, c;
    __device__ __forceinline__ bool next(int i, Unit& u) const {
        const int nt = m.ts[8] < 128 ? m.ts[8] : 128; const int L = i * G + c; if (L >= nt * 4) return false;
        const int rt = L >> 2, pn = L & 3, e = moe_expert_of(m, rt);
        u.pm = rt; u.pn = pn; u.z = e; u.a_off = (unsigned)((long)rt * 256 * FFE); u.b_off = (unsigned)(((long)e * D + pn * 256) * FFE); u.gidx = nullptr; return true;
    }
};
struct MoeSlabOrder {
    MoeTiles m; int G, c, S, Kp;
    __device__ __forceinline__ bool next(int i, Unit& u) const {
        const int nleft = (m.ts[8] - 128) * 4; const int q = i * G + c; if (q >= nleft * S) return false;
        const int up = q / S, sl = q - up * S, rt = 128 + (up >> 2), pn = up & 3, e = moe_expert_of(m, rt);
        u.pm = rt; u.pn = pn; u.z = q; u.a_off = (unsigned)((long)rt * 256 * FFE + (long)sl * Kp * 2); u.b_off = (unsigned)(((long)e * D + pn * 256) * FFE + (long)sl * Kp * 2); u.gidx = nullptr; return true;
    }
};
struct EpiSlab {
    static constexpr bool PERM = false, MID = false;
    float* SL; float sc;
    __device__ __forceinline__ void row(const Unit& u, int r, int slot, int wc, int fq, const f32x4 (&v)[2][2]) const {
        float* p = SL + (size_t)u.z * 65536 + (size_t)(r & 255) * 256 + 32 * wc + 4 * fq;
#pragma unroll
        for (int bj = 0; bj < 2; ++bj)
#pragma unroll
            for (int n = 0; n < 2; ++n) *(f32x4*)(p + 128 * bj + 16 * n) = v[bj][n] * sc;
    }
};
__device__ __forceinline__ void moe_slab_split(int tiles, int G, int& S, int& Kp) { S = 7; Kp = 256; }
struct EpiY {
    static constexpr bool PERM = true, MID = false;
    bf16_t* Y; float sc;
    __device__ __forceinline__ void row(const Unit& u, int r, int slot, int wc, int fq, const f32x4 (&v)[2][2]) const {
#pragma unroll
        for (int bj = 0; bj < 2; ++bj) *(u32x4*)(Y + (size_t)r * D + u.pn * 256 + 128 * bj + 32 * wc + 8 * fq) = pack8(v[bj][0] * sc, v[bj][1] * sc);
    }
};
__device__ __forceinline__ f32x4 moe_y4(const bf16_t* Y, const float* SL, int S, size_t R, int j, int lane) {
    if (R < 32768) { const u32x2 y = *((const GAS u32x2*)(Y + R * D) + lane + 64 * j); return (f32x4){bflo(y.x), bfhi(y.x), bflo(y.y), bfhi(y.y)}; }
    const float* p = SL + ((size_t)(((R >> 8) - 128) * 4 + j) * S) * 65536 + (R & 255) * 256 + 4 * lane; f32x4 a = (f32x4){0.f, 0.f, 0.f, 0.f};
    for (int s0 = 0; s0 < S; s0 += 7) {
        f32x4 q[7];
#pragma unroll
        for (int sl = 0; sl < 7; ++sl) q[sl] = *(const f32x4*)(p + (size_t)(s0 + sl) * 65536);
#pragma unroll
        for (int sl = 0; sl < 7; ++sl) a += q[sl];
    }
    return a;
}
__device__ __forceinline__ void moe_combine_pass(Frame& F) {
    const MoeTiles m = moe_tiles(F); const TokInfo* ti = (const TokInfo*)(F.ws + WS_SMALL + SMB_TOK); const bf16_t* Y = WSP(bf16_t, WS_MY); const float* SL = WSP(float, WS_SLAB);
    int S, Kp; moe_slab_split(m.ts[8], F.G, S, Kp);
    const int gw = F.vcu * NWAVES + F.wave, NGW = F.G * NWAVES;
    TokInfo tn = ti[gw < MR ? gw : 0];
    for (int r = gw; r < MR; r += NGW) {
        const TokInfo t = tn; { const int rn = r + NGW; tn = ti[rn < MR ? rn : r]; }
        int b1 = 0, b2 = 0;
#pragma unroll
        for (int k = 0; k < 8; ++k) { b1 = (k == t.e1) ? m.ts[k] : b1; b2 = (k == t.e2) ? m.ts[k] : b2; }
        const size_t r1 = (size_t)b1 * 256 + t.s1, r2 = (size_t)b2 * 256 + t.s2;
        GAS f32x4* o = (GAS f32x4*)(F.out + (size_t)r * D) + F.lane;
        if (r1 < 32768 && r2 < 32768) {
            u32x2 y1[4], y2[4]; f32x4 x[4];
#pragma unroll
            for (int j = 0; j < 4; ++j) { y1[j] = *((const GAS u32x2*)(Y + r1 * D) + F.lane + 64 * j); y2[j] = *((const GAS u32x2*)(Y + r2 * D) + F.lane + 64 * j); x[j] = o[64 * j]; }
#pragma unroll
            for (int j = 0; j < 4; ++j) { x[j][0] += t.w1 * bflo(y1[j].x) + t.w2 * bflo(y2[j].x); x[j][1] += t.w1 * bfhi(y1[j].x) + t.w2 * bfhi(y2[j].x); x[j][2] += t.w1 * bflo(y1[j].y) + t.w2 * bflo(y2[j].y); x[j][3] += t.w1 * bfhi(y1[j].y) + t.w2 * bfhi(y2[j].y); o[64 * j] = x[j]; }
        } else {
#pragma unroll
            for (int j = 0; j < 4; ++j) { const f32x4 y1 = moe_y4(Y, SL, S, r1, j, F.lane), y2 = moe_y4(Y, SL, S, r2, j, F.lane); o[64 * j] = o[64 * j] + y1 * t.w1 + y2 * t.w2; }
        }
    }
}
}
namespace mk {
enum { P_CVT = 0, P_NORM1, P_PROJ, P_MIX, P_SCAN, P_FIN, P_GATES, P_MERGE, P_WOUT, P_NORM2, P_GU, P_DOWN, P_COMB, P_NPH };
struct Args { const float* in[22]; float* out; unsigned char* ws; unsigned pmask; int l0, l1; unsigned dup; };

#define PH(k) ((a.pmask >> (k)) & 1u)
#define PHASE_FRAME() Frame F = F0; { const int t_ = pg8::make_tid(F0.wave); F.tid = t_; F.lane = t_ & 63; F.wave = F0.wave; unsigned char* w_ = F0.ws; asm volatile("" : "+s"(w_)); F.ws = w_; int g_ = F0.G, v_ = F0.vcu; asm volatile("" : "+s"(g_), "+s"(v_)); F.G = g_; F.vcu = v_; } float* sm = SMALLF; (void)sm
#define GRID_BAR() xcd_barrier(bar, F.tid)
template <int l> __device__ __forceinline__ void layer_body(const Args& a, const Frame& F0, const XcdBarrier& bar, unsigned char* lds) {
    constexpr bool first = (l == 0);
#ifndef NO_P_CVT
        if (PH(P_CVT) && l == 0) for (int rep_ = 0; rep_ <= (int)((a.dup >> (16 + l)) & (a.dup >> P_CVT) & 1u); ++rep_) { PHASE_FRAME(); setup_small(F); convert_layer_weights(F, 0, -1, 0, F.G == 256 ? 1 : 0); }
#endif
#ifndef NO_P_NORM1
        if (PH(P_NORM1)) for (int rep_ = 0; rep_ <= (int)((a.dup >> (16 + l)) & (a.dup >> P_NORM1) & 1u); ++rep_) { PHASE_FRAME(); norm_pass(F, F.in[2] + l * D, first, true); GRID_BAR(); }
#endif
#ifndef NO_P_PROJ
        if (PH(P_PROJ)) for (int rep_ = 0; rep_ <= (int)((a.dup >> (16 + l)) & (a.dup >> P_PROJ) & 1u); ++rep_) { PHASE_FRAME();
            Gemm g{WSP(bf16_t, WS_HN), WSP(bf16_t, WS_WIN), D, D, D}; TileOrder S; S.init(64, 20, 0, F.G, (int)blockIdx.x, D, D);
            EpiProj E{F.ws, F.in[5] + l * 64, F.in[6] + l * 64, l, 1.f};
            pg8::gemm_phase<EpiProj, TileOrder>(F.lds + RING_OFF, g, S, E, F.wave);
            meta_gemm(F, WSP(bf16_t, WS_HN) + (size_t)MR * D, D, WSP(bf16_t, WS_WIN), D, D, 0, 20, E);
            GRID_BAR();
        }
#endif
#ifndef NO_P_MIX
        if (PH(P_MIX)) for (int rep_ = 0; rep_ <= (int)((a.dup >> (16 + l)) & (a.dup >> P_MIX) & 1u); ++rep_) { PHASE_FRAME();
            if (!(a.dup & 0x8000u) || rep_ == 0) {
                if (F.G == 256) {
                    const bool hm = (F.vcu & 7) == 0 && F.vcu < 32; const int idm = 1024 + (F.vcu >> 3);
                    HgIn A, B; hgrnA_load(F, F.vcu, A); hgrnA_load(F, F.vcu + 256, B); hgrnA_compute(F, F.vcu, A);
                    hgrnA_load(F, F.vcu + 512, A); hgrnA_compute(F, F.vcu + 256, B); hgrnA_load(F, F.vcu + 768, B); hgrnA_compute(F, F.vcu + 512, A);
                    if (hm) hgrnA_load(F, idm, A);
                    hgrnA_compute(F, F.vcu + 768, B); if (hm) hgrnA_compute(F, idm, A); }
                else for (int id = F.vcu; id < 1028; id += F.G) { HgIn A; hgrnA_load(F, id, A); hgrnA_compute(F, id, A); }
            }
            if (rep_ == 1 && !(a.dup & 0x8000u)) { GRID_BAR(); continue; }
            conv_pass(F, F.in[10] + l * 1536);
            { LAS float* tabl = (LAS float*)(F.lds + RING_OFF + attn_body::LDS_TAB); tabl[F.tid] = sm[SM_TAB + F.tid]; }
            __syncthreads();
            { int b, vh, qb;
              for (int i = 0; attn_body::attn_next(F.G, F.vcu, i, b, vh, qb); ++i)
                  attn_body::attn_unit<8>(b, vh, qb, (const attn_body::bf16*)WSP(bf16_t, WS_QK), (const attn_body::bf16*)WSP(bf16_t, WS_V), (attn_body::bf16*)WSP(bf16_t, WS_O), (char*)lds + RING_OFF, F.wave); }
            if (l == 0 && F.G == 256) {
                const int g = F.vcu & 7, bv = F.vcu >> 3;
                if (g != 7 && !(g == 0 && bv < 4)) { const int idx = bv < 4 ? bv * 6 + (g - 1) : 24 + (bv - 4) * 7 + g; convert_layer_weights(F, 0, idx * NWAVES + F.wave, 220 * NWAVES, 2); } }
            if (l == 1 && F.G == 256) {
                const int g = F.vcu & 7, bv = F.vcu >> 3;
                if (g != 7 && !(g == 0 && bv < 4)) { const int idx = bv < 4 ? bv * 6 + (g - 1) : 24 + (bv - 4) * 7 + g; convert_moe_gu(F, 3, idx * NWAVES + F.wave, 220 * NWAVES); } }
            GRID_BAR();
        }
#endif
#ifndef NO_P_SCAN
        if (PH(P_SCAN)) for (int rep_ = 0; rep_ <= (int)((a.dup >> (16 + l)) & (a.dup >> P_SCAN) & 1u); ++rep_) { PHASE_FRAME(); hgrn_scan(F); GRID_BAR(); }
#endif
#ifndef NO_P_FIN
        if (PH(P_FIN)) for (int rep_ = 0; rep_ <= (int)((a.dup >> (16 + l)) & (a.dup >> P_FIN) & 1u); ++rep_) { PHASE_FRAME(); hgrnC_pass(F, F.in[12] + l * 128); attcomb_pass(F, F.in[8] + l * 128, l); }
#endif
#ifndef NO_P_GATES
        if (PH(P_GATES)) for (int rep_ = 0; rep_ <= (int)((a.dup >> (16 + l)) & (a.dup >> P_GATES) & 1u); ++rep_) { PHASE_FRAME();
            Gemm g{(const bf16_t*)(F.ws + WS_HN8), (const bf16_t*)(F.ws + WS_WIN8 - (size_t)20 * 256 * D), D / 2, D / 2, D / 2}; TileOrder S; S.init(64, 12, 20, F.G, (int)blockIdx.x, D / 2, D / 2);
            EpiProj E{F.ws, F.in[5] + l * 64, F.in[6] + l * 64, l, 1.f / W8_SCALE};
            pg8::gemm_phase<EpiProj, TileOrder, false, true>(F.lds + RING_OFF, g, S, E, F.wave);
            if (l == 0) { EpiProj Em{F.ws, F.in[5] + l * 64, F.in[6] + l * 64, l, 1.f}; meta_gemm(F, WSP(bf16_t, WS_HN) + (size_t)MR * D, D, WSP(bf16_t, WS_WIN), D, D, 20, 32, Em); }
            GRID_BAR();
        }
#endif
#ifndef NO_P_MERGE
        if (PH(P_MERGE)) for (int rep_ = 0; rep_ <= (int)((a.dup >> (16 + l)) & (a.dup >> P_MERGE) & 1u); ++rep_) { PHASE_FRAME();
            Gemm g{WSP(bf16_t, WS_U), WSP(bf16_t, WS_WBR), 1536, 1536, 1536}; TileOrder S; S.init(64, 4, 0, F.G, (int)blockIdx.x, 1536, 1536);
            EpiMerge E{WSP(bf16_t, WS_GATES), WSP(bf16_t, WS_MIXED)};
            pg8::gemm_phase<EpiMerge, TileOrder>(F.lds + RING_OFF, g, S, E, F.wave);
            if (l == 0) meta_merge(F, WSP(bf16_t, WS_U) + (size_t)MR * 1536, WSP(bf16_t, WS_WBR), WSP(bf16_t, WS_GATES), WSP(bf16_t, WS_MIXED));
            GRID_BAR();
        }
#endif
#ifndef NO_P_WOUT
        if (PH(P_WOUT)) for (int rep_ = 0; rep_ <= (int)((a.dup >> (16 + l)) & (a.dup >> P_WOUT) & 1u); ++rep_) { PHASE_FRAME();
            Gemm g{WSP(bf16_t, WS_MIXED), WSP(bf16_t, WS_WO), D, D, D}; TileOrder S; S.init(64, 4, 0, F.G, (int)blockIdx.x, D, D);
            EpiRes E{first ? F.in[0] : (const float*)F.out, F.out, first ? F.in[1] : (const float*)(sm + SM_METAHS), sm + SM_METAHS};
            pg8::gemm_phase<EpiRes, TileOrder>(F.lds + RING_OFF, g, S, E, F.wave);
            if (l == 0) meta_gemm(F, WSP(bf16_t, WS_MIXED) + (size_t)MR * D, D, WSP(bf16_t, WS_WO), D, D, 0, 4, E);
            GRID_BAR();
        }
#endif
#ifndef NO_P_NORM2
        if (PH(P_NORM2) && l == 0) for (int rep_ = 0; rep_ <= (int)((a.dup >> (16 + l)) & (a.dup >> P_NORM2) & 1u); ++rep_) { PHASE_FRAME(); norm_pass(F, F.in[3] + l * D, false, false); if (PH(P_CVT)) setup_small(F); GRID_BAR(); }
        if (PH(P_NORM2) && l == 1) for (int rep_ = 0; rep_ <= (int)((a.dup >> (16 + l)) & (a.dup >> P_NORM2) & 1u); ++rep_) { PHASE_FRAME(); norm_route_pass(F, F.in[3] + l * D); convert_moe_gu(F, -1, 0, 1, F.G == 256 ? 3 : -1); GRID_BAR(); }
#endif
#ifndef NO_P_GU
        if (PH(P_GU) && l == 0) for (int rep_ = 0; rep_ <= (int)((a.dup >> (16 + l)) & (a.dup >> P_GU) & 1u); ++rep_) { PHASE_FRAME();
            Gemm g{WSP(bf16_t, WS_HN), WSP(bf16_t, WS_WGU0), D, D, D}; TileOrder S; S.init(64, 22, 0, F.G, (int)blockIdx.x, D, D);
            EpiGU E{WSP(bf16_t, WS_H0), FFD, 1.f};
            pg8::gemm_phase<EpiGU, TileOrder>(F.lds + RING_OFF, g, S, E, F.wave);
            meta_gemm(F, WSP(bf16_t, WS_HN) + (size_t)MR * D, D, WSP(bf16_t, WS_WGU0), D, D, 0, 22, E);
            if (PH(P_CVT) && rep_ == 0) { const int total = 64 * 22, rem = total % F.G, bx = (int)blockIdx.x;
              if (rem == 0) convert_layer_weights(F, 1, bx * NWAVES + F.wave, F.G * NWAVES); else if (bx >= rem) convert_layer_weights(F, 1, (bx - rem) * NWAVES + F.wave, (F.G - rem) * NWAVES); }
            GRID_BAR();
        }
#endif
#ifndef NO_P_DOWN
        if (PH(P_DOWN) && l == 0) for (int rep_ = 0; rep_ <= (int)((a.dup >> (16 + l)) & (a.dup >> P_DOWN) & 1u); ++rep_) { PHASE_FRAME();
            Gemm g{WSP(bf16_t, WS_H0), WSP(bf16_t, WS_WD0), FFD, FFD, FFD}; TileOrder S; S.init(64, 4, 0, F.G, (int)blockIdx.x, FFD, FFD);
            EpiRes E{(const float*)F.out, F.out, (const float*)(sm + SM_METAHS), sm + SM_METAHS};
            pg8::gemm_phase<EpiRes, TileOrder>(F.lds + RING_OFF, g, S, E, F.wave);
            meta_gemm(F, WSP(bf16_t, WS_H0) + (size_t)MR * FFD, FFD, WSP(bf16_t, WS_WD0), FFD, FFD, 0, 4, E);
            GRID_BAR();
        }
#endif
#ifndef NO_P_MOE
        if (PH(P_GU) && l == 1) for (int rep_ = 0; rep_ <= (int)((a.dup >> (16 + l)) & (a.dup >> P_GU) & 1u); ++rep_) { PHASE_FRAME();
            Gemm g{WSP(bf16_t, WS_HN), WSP(bf16_t, WS_MGU), D / 2, D / 2, D / 2};   MoeGuOrder S{moe_tiles(F), F.G, (int)blockIdx.x, (const int*)(F.ws + WS_SMALL + SMB_LIST)};
            EpiGU8 E{F.ws + WS_MH, FFE, 1.f / W8_SCALE};
            pg8::gemm_phase<EpiGU8, MoeGuOrder, true, true>(F.lds + RING_OFF, g, S, E, F.wave);
            { const int total = S.m.ts[8] * 28, rem = total % F.G, bx = (int)blockIdx.x;
              if (rem == 0) convert_moe_down(F, bx * NWAVES + F.wave, F.G * NWAVES); else if (bx >= rem) convert_moe_down(F, (bx - rem) * NWAVES + F.wave, (F.G - rem) * NWAVES); }
            GRID_BAR();
        }
        if (PH(P_DOWN) && l == 1) for (int rep_ = 0; rep_ <= (int)((a.dup >> (16 + l)) & (a.dup >> P_DOWN) & 1u); ++rep_) { PHASE_FRAME();
            Gemm g{WSP(bf16_t, WS_MH), WSP(bf16_t, WS_MD), FFE / 2, FFE / 2, FFE / 2};   MoeDownOrder S{moe_tiles(F), F.G, (int)blockIdx.x};
            EpiY E{WSP(bf16_t, WS_MY), 1.f / (H8_SCALE * WD8_SCALE)};
            pg8::gemm_phase<EpiY, MoeDownOrder, false, true>(F.lds + RING_OFF, g, S, E, F.wave);
            { int SS, Kp; moe_slab_split(S.m.ts[8], F.G, SS, Kp);
              Gemm g2{WSP(bf16_t, WS_MH), WSP(bf16_t, WS_MD), FFE / 2, FFE / 2, Kp}; MoeSlabOrder S2{S.m, F.G, (int)blockIdx.x, SS, Kp}; EpiSlab E2{WSP(float, WS_SLAB), 1.f / (H8_SCALE * WD8_SCALE)};
              pg8::gemm_phase<EpiSlab, MoeSlabOrder, false, true>(F.lds + RING_OFF, g2, S2, E2, F.wave); }
            GRID_BAR();
        }
        if (PH(P_COMB) && l == 1) for (int rep_ = 0; rep_ <= (int)((a.dup >> (16 + l)) & (a.dup >> P_COMB) & 1u); ++rep_) { PHASE_FRAME(); moe_combine_pass(F); if (rep_ < (int)((a.dup >> (16 + l)) & (a.dup >> P_COMB) & 1u)) GRID_BAR(); }
#endif
}
__global__ void __launch_bounds__(NWAVES * 64, 2) mega(Args a) {
    extern __shared__ __attribute__((aligned(16))) unsigned char lds[];
    Frame F0; Frame& F = F0;
    F.lds = (LAS unsigned char*)lds; F.lds_gen = lds;
    F.wave = __builtin_amdgcn_readfirstlane((int)threadIdx.x >> 6); F.tid = pg8::make_tid(F.wave); F.lane = F.tid & 63;
    F.G = gridDim.x; { const int bx = blockIdx.x; F.vcu = (F.G % 8 == 0) ? (bx % 8) * (F.G / 8) + bx / 8 : bx; }
    F.in = a.in; F.out = a.out; F.ws = a.ws;
    for (int u = F.tid; u < (LDS_BYTES - LDSCTL_OFF) / 4; u += NWAVES * 64) ((LAS unsigned*)(F.lds + LDSCTL_OFF))[u] = 0u;
    __syncthreads();
    volatile LAS unsigned* MISC = (volatile LAS unsigned*)(F.lds + MISC_OFF);
    XcdBarrier bar = xcd_barrier_post((unsigned*)(F.ws + WS_CTL) + 4096, MISC + 8, F.tid);
    if (a.l0 <= 0 && 0 < a.l1) layer_body<0>(a, F0, bar, lds);
    if (a.l0 <= 1 && 1 < a.l1) layer_body<1>(a, F0, bar, lds);
}
#undef PH
#undef GRID_BAR


#ifndef MK_DUP
#define MK_DUP 0u
#endif
static int g_grid = 0;
static bool mega_init() {
    if (g_grid) return g_grid > 0;
    int dev = 0, cus = 0, per_cu = 0;
    if (hipGetDevice(&dev) != hipSuccess || hipDeviceGetAttribute(&cus, hipDeviceAttributeMultiprocessorCount, dev) != hipSuccess) { g_grid = -1; return false; }
    if (hipFuncSetAttribute((const void*)mega, hipFuncAttributeMaxDynamicSharedMemorySize, LDS_BYTES) != hipSuccess) { g_grid = -1; return false; }
    if (hipOccupancyMaxActiveBlocksPerMultiprocessor(&per_cu, (const void*)mega, NWAVES * 64, LDS_BYTES) != hipSuccess || per_cu < 1) { fprintf(stderr, "mega: occupancy query says %d\n", per_cu); }
    (void)hipGetLastError();
    g_grid = cus;
    return true;
}
static void mega_launch(void* const* d_in, float* out, unsigned char* ws, unsigned pmask, int l0, int l1, hipStream_t st) {
    if (!mega_init()) return;
    (void)hipMemsetAsync(ws + WS_CTL, 0, CTL_ZERO_BYTES, st);
    Args a{};
    for (int i = 0; i < 22; ++i) a.in[i] = (const float*)d_in[i];
    a.out = out; a.ws = ws; a.pmask = pmask; a.l0 = l0; a.l1 = l1; a.dup = MK_DUP;
    hipLaunchKernelGGL(mega, dim3(g_grid), dim3(NWAVES * 64), LDS_BYTES, st, a);
}
}
extern "C" void kernel_launch(void* const* d_in, const int* in_sizes, int n_in, void* d_out, int out_size, void* d_ws, size_t ws_size, hipStream_t stream) {
    (void)in_sizes; (void)n_in; (void)out_size;
    if (ws_size < (size_t)512 * (1u << 20)) { fprintf(stderr, "kernel_launch: workspace too small (%zu)\n", ws_size); return; }
    mk::mega_launch(d_in, (float*)d_out, (unsigned char*)d_ws, (1u << mk::P_NPH) - 1u, 0, 2, stream);
}
```

```cpp
#include <hip/hip_runtime.h>
#include <cstdio>
#include <cstdint>
#include <cmath>
#include <hip/hip_bf16.h>
namespace pg8 {
#define PG8_LAS __attribute__((address_space(3)))
typedef unsigned short bf16_t;
typedef short bf16x8 __attribute__((ext_vector_type(8)));
typedef float f32x4 __attribute__((ext_vector_type(4)));
typedef unsigned u32x4 __attribute__((ext_vector_type(4)));
typedef unsigned u32x2 __attribute__((ext_vector_type(2)));
typedef int v4i_t __attribute__((ext_vector_type(4)));
typedef int v8i_t __attribute__((ext_vector_type(8)));
constexpr int BM = 256, BK = 64, HALF = 128, HTB = HALF * BK * 2, STAGE_BYTES = 8 * HTB;

__host__ __device__ __forceinline__ int lds_byte(int r, int c) { const int st = (r >> 4) * 2 + (c >> 5), rr = r & 15, cc = c & 31, ob = rr * 64 + cc * 2; return st * 1024 + (ob ^ (((ob >> 9) & 1) << 5)); }
__host__ __device__ __forceinline__ void stage_rc(int b, int& R, int& C) { const int st = b / 1024, sb = b % 1024, swz = sb ^ (((sb >> 9) & 1) << 5); R = (st >> 1) * 16 + swz / 64; C = (st & 1) * 32 + (swz % 64) / 2; }
__host__ __device__ __forceinline__ int perm32(int rho) { const int n = rho >> 4, i = rho & 15; return 8 * (i >> 2) + 4 * n + (i & 3); }

struct Unit { int pm, pn, z; unsigned a_off, b_off; const int* gidx; };
struct Gemm { const bf16_t* A; const bf16_t* Bt; int lda, ldb, K; };

__device__ __forceinline__ int lane_id() { unsigned m = ~0u; asm volatile("" : "+s"(m)); return (int)__builtin_amdgcn_mbcnt_hi(m, __builtin_amdgcn_mbcnt_lo(m, 0u)); }
__device__ __forceinline__ int make_tid(int wave) { int t = (wave << 6) | lane_id(); asm volatile("" : "+v"(t)); return t; }
typedef float f32x2_cv __attribute__((ext_vector_type(2))); typedef __bf16 bf16x2_cv __attribute__((ext_vector_type(2)));
__device__ __forceinline__ unsigned cvt_pk_bf16(float lo, float hi) { const f32x2_cv v = {lo, hi}; const bf16x2_cv b = __builtin_convertvector(v, bf16x2_cv); return __builtin_bit_cast(unsigned, b); }

template <class Epi, class Sched, bool GATHER = false, bool FP8 = false>
__device__ __forceinline__ void gemm_phase(PG8_LAS unsigned char* lds, const Gemm g, const Sched& S, const Epi& E, int wave0) {
    const int tid = make_tid(wave0),
              wid = __builtin_amdgcn_readfirstlane(tid >> 6), lane = tid & 63, wr = wid >> 2, wc = wid & 3, fr = lane & 15, fq = lane >> 4;
    const int K = g.K, nt = K / BK;
    unsigned voffA[2], voffB[2];
#pragma unroll
    for (int i = 0; i < 2; ++i) { int R, C; stage_rc(tid * 16 + i * 8192, R, C); const int Rb = Epi::PERM ? ((R & ~31) + perm32(R & 31)) : R;
        voffA[i] = (unsigned)(R * g.lda + C) * 2u; voffB[i] = (unsigned)(Rb * g.ldb + C) * 2u; }
    const size_t kstep = (size_t)(BK * 2);
    const size_t hstepA = GATHER ? 0 : (size_t)HALF * g.lda * 2, hstepB = (size_t)HALF * g.ldb * 2;
    const unsigned ldsw = (unsigned)wid * 1024u;
    const int aoff = lds_byte(wr * 64 + fr, fq * 8), boff = lds_byte(wc * 32 + fr, fq * 8);
    unsigned gvc[2][2], gvn[2][2];
#define PG8_SA(b, h) (((b) * 2 + (h)) * HTB)
#define PG8_SB(b, h) ((4 + (b) * 2 + (h)) * HTB)
#define PG8_STAGE(bufoff, gbase, voff) do { _Pragma("unroll") for (int _i = 0; _i < 2; ++_i) \
        __builtin_amdgcn_global_load_lds((const unsigned*)((const char*)(gbase) + (voff)[_i]), (PG8_LAS unsigned*)(lds + (bufoff) + ldsw + _i * 8192), 16, 0, 0); } while (0)
#define PG8_STAGE_A(bufoff, base, h, nx) do { if constexpr (GATHER) { if (nx) PG8_STAGE(bufoff, base, gvn[h]); else PG8_STAGE(bufoff, base, gvc[h]); } else { PG8_STAGE(bufoff, (base) + (h) * hstepA, voffA); } } while (0)
#define PG8_LD8(a_) __builtin_shufflevector(*(const PG8_LAS v4i_t*)(a_), *(const PG8_LAS v4i_t*)((a_) + 1024), 0, 1, 2, 3, 4, 5, 6, 7)
#define PG8_LDA(dst, b, h) do { if constexpr (FP8) { _Pragma("unroll") for (int m = 0; m < 4; ++m) dst##8[m] = PG8_LD8(lds + PG8_SA(b, h) + aoff + m * 2048); } else { \
        _Pragma("unroll") for (int m = 0; m < 4; ++m) _Pragma("unroll") for (int k = 0; k < 2; ++k) dst[m][k] = *(const PG8_LAS bf16x8*)(lds + PG8_SA(b, h) + aoff + m * 2048 + k * 1024); } } while (0)
#define PG8_LDB(dst, b, h) do { if constexpr (FP8) { _Pragma("unroll") for (int n = 0; n < 2; ++n) dst##8[n] = PG8_LD8(lds + PG8_SB(b, h) + boff + n * 2048); } else { \
        _Pragma("unroll") for (int n = 0; n < 2; ++n) _Pragma("unroll") for (int k = 0; k < 2; ++k) dst[n][k] = *(const PG8_LAS bf16x8*)(lds + PG8_SB(b, h) + boff + n * 2048 + k * 1024); } } while (0)
#define PG8_MMA(ai, bj, At, Bt) do { __builtin_amdgcn_s_setprio(1); if constexpr (FP8) { _Pragma("unroll") for (int m = 0; m < 4; ++m) _Pragma("unroll") for (int n = 0; n < 2; ++n) \
        asm volatile("v_mfma_scale_f32_16x16x128_f8f6f4 %0, %1, %2, %0, %3, %3 op_sel_hi:[0,0,0]" : "+v"(acc[ai][bj][m][n]) : "v"(Bt##8[n]), "v"(At##8[m]), "v"(one8)); } else { \
        _Pragma("unroll") for (int m = 0; m < 4; ++m) _Pragma("unroll") for (int n = 0; n < 2; ++n) _Pragma("unroll") for (int k = 0; k < 2; ++k) \
        acc[ai][bj][m][n] = __builtin_amdgcn_mfma_f32_16x16x32_bf16(Bt[n][k], At[m][k], acc[ai][bj][m][n], 0, 0, 0); } __builtin_amdgcn_s_setprio(0); } while (0)
#define PG8_WAIT_V(n) asm volatile("s_waitcnt vmcnt(" #n ")" ::: "memory")
#define PG8_WAIT_L(n) asm volatile("s_waitcnt lgkmcnt(" #n ")" ::: "memory")
#define PG8_BAR __builtin_amdgcn_s_barrier()
#define PG8_SCHED __builtin_amdgcn_sched_barrier(0)
#define PG8_GLOAD(dst, u) do { if constexpr (GATHER) { const int t2_ = make_tid(wave0); _Pragma("unroll") for (int _i = 0; _i < 2; ++_i) { int R_, C_; stage_rc(t2_ * 16 + _i * 8192, R_, C_); \
        _Pragma("unroll") for (int _h = 0; _h < 2; ++_h) dst[_h][_i] = (unsigned)((u).gidx[_h * HALF + R_] * g.lda + C_) * 2u; } } } while (0)
    Unit cur, nxt; int ui = 0;
    if (!S.next(0, cur)) return;
    f32x4 acc[2][2][4][2];
#pragma unroll
    for (int a = 0; a < 2; ++a)
#pragma unroll
        for (int b = 0; b < 2; ++b)
#pragma unroll
            for (int m = 0; m < 4; ++m)
#pragma unroll
                for (int n = 0; n < 2; ++n) acc[a][b][m][n] = (f32x4){0.f, 0.f, 0.f, 0.f};
    bf16x8 At[4][2], B0[2][2], B1[2][2]; v8i_t At8[4], B08[2], B18[2];
    int one8 = 0x7f7f7f7f; asm volatile("" : "+v"(one8));
    const char* cA = (const char*)g.A + cur.a_off; const char* cB = (const char*)g.Bt + cur.b_off;
    PG8_GLOAD(gvc, cur);
#pragma unroll
    for (int _h = 0; _h < 2; ++_h)
#pragma unroll
        for (int _i = 0; _i < 2; ++_i) gvn[_h][_i] = 0u;
    PG8_STAGE(PG8_SB(0, 0), cB, voffB); PG8_STAGE(PG8_SB(0, 1), cB + hstepB, voffB); PG8_STAGE_A(PG8_SA(0, 0), cA, 0, false); PG8_STAGE_A(PG8_SA(0, 1), cA, 1, false);
    if (wr == 1) PG8_BAR;
    PG8_WAIT_V(2); PG8_BAR;
    PG8_STAGE(PG8_SB(1, 0), cB + kstep, voffB); PG8_STAGE_A(PG8_SA(1, 0), cA + kstep, 0, false); PG8_STAGE(PG8_SB(1, 1), cB + hstepB + kstep, voffB);
    PG8_WAIT_V(6); PG8_BAR;
    for (;;) {
        const bool has_next = S.next(ui + 1, nxt);
        const char* nA = has_next ? (const char*)g.A + nxt.a_off : cA; const char* nB = has_next ? (const char*)g.Bt + nxt.b_off : cB;
        if constexpr (GATHER) { if (has_next) { PG8_GLOAD(gvn, nxt); } else {
#pragma unroll
            for (int _h = 0; _h < 2; ++_h)
#pragma unroll
                for (int _i = 0; _i < 2; ++_i) gvn[_h][_i] = gvc[_h][_i]; } }
        for (int t = 0; t < nt; t += 2) {
            const bool last = (t == nt - 2);
            const char* a1 = cA + (size_t)(t + 1) * kstep;
            const char* a2 = last ? nA : cA + (size_t)(t + 2) * kstep; const char* b2 = last ? nB : cB + (size_t)(t + 2) * kstep;
            const char* a3 = a2 + kstep; const char* b3 = b2 + kstep;
            if constexpr (Epi::MID) { if (t == Epi::MID_T0 || t == Epi::MID_T1) {
                if (wr == 0) PG8_BAR;
#define PG8_MIDROW(ai, m) do { f32x4 v_[2][2] = {{acc[ai][0][m][0], acc[ai][0][m][1]}, {acc[ai][1][m][0], acc[ai][1][m][1]}}; \
                int r_ = cur.pm * BM + (ai) * HALF + wr * 64 + (m) * 16 + fr; asm volatile("" : "+v"(r_)); E.mid_row(cur, r_, t, wc, fq, v_); \
                acc[ai][0][m][0] = v_[0][0]; acc[ai][0][m][1] = v_[0][1]; acc[ai][1][m][0] = v_[1][0]; acc[ai][1][m][1] = v_[1][1]; asm volatile("" ::: "memory"); } while (0)
                PG8_MIDROW(0, 0); PG8_MIDROW(0, 1); PG8_MIDROW(0, 2); PG8_MIDROW(0, 3); PG8_MIDROW(1, 0); PG8_MIDROW(1, 1); PG8_MIDROW(1, 2); PG8_MIDROW(1, 3);
#undef PG8_MIDROW
                if (wr == 1) PG8_BAR;
            } }
            PG8_LDB(B0, 0, 0); PG8_LDB(B1, 0, 1); PG8_SCHED; PG8_LDA(At, 0, 0); PG8_STAGE_A(PG8_SA(1, 1), a1, 1, false);
            PG8_WAIT_V(8); PG8_WAIT_L(0); PG8_BAR; PG8_MMA(0, 0, At, B0); PG8_MMA(0, 1, At, B1); PG8_BAR; PG8_SCHED;
            PG8_LDA(At, 0, 1); PG8_STAGE(PG8_SB(0, 0), b2, voffB); PG8_STAGE(PG8_SB(0, 1), b2 + hstepB, voffB); PG8_STAGE_A(PG8_SA(0, 0), a2, 0, last);
            PG8_WAIT_V(8); PG8_WAIT_L(0); PG8_BAR; PG8_MMA(1, 0, At, B0); PG8_MMA(1, 1, At, B1); PG8_BAR; PG8_SCHED;
            PG8_LDB(B0, 1, 0); PG8_LDB(B1, 1, 1); PG8_SCHED; PG8_LDA(At, 1, 0); PG8_STAGE_A(PG8_SA(0, 1), a2, 1, last);
            PG8_WAIT_V(8); PG8_WAIT_L(0); PG8_BAR; PG8_MMA(0, 0, At, B0); PG8_MMA(0, 1, At, B1); PG8_BAR; PG8_SCHED;
            PG8_LDA(At, 1, 1); PG8_STAGE(PG8_SB(1, 0), b3, voffB); PG8_STAGE(PG8_SB(1, 1), b3 + hstepB, voffB); PG8_STAGE_A(PG8_SA(1, 0), a3, 0, last);
            PG8_WAIT_V(8); PG8_WAIT_L(0); PG8_BAR; PG8_MMA(1, 0, At, B0); PG8_MMA(1, 1, At, B1); PG8_BAR; PG8_SCHED;
        }
        if constexpr (FP8) asm volatile("s_nop 15\n\ts_nop 15" ::: "memory");
        if (wr == 0) PG8_BAR;
        {
#define PG8_ROW(ai, m) do { const f32x4 v_[2][2] = {{acc[ai][0][m][0], acc[ai][0][m][1]}, {acc[ai][1][m][0], acc[ai][1][m][1]}}; \
            int r_ = cur.pm * BM + (ai) * HALF + wr * 64 + (m) * 16 + fr; asm volatile("" : "+v"(r_)); E.row(cur, r_, (ai) * 4 + (m), wc, fq, v_); asm volatile("" ::: "memory"); } while (0)
            PG8_ROW(0, 0); PG8_ROW(0, 1); PG8_ROW(0, 2); PG8_ROW(0, 3); PG8_ROW(1, 0); PG8_ROW(1, 1); PG8_ROW(1, 2); PG8_ROW(1, 3);
#undef PG8_ROW
        }
        if (!has_next) break;
#pragma unroll
        for (int a = 0; a < 2; ++a)
#pragma unroll
            for (int b = 0; b < 2; ++b)
#pragma unroll
                for (int m = 0; m < 4; ++m)
#pragma unroll
                    for (int n = 0; n < 2; ++n) acc[a][b][m][n] = (f32x4){0.f, 0.f, 0.f, 0.f};
        cur = nxt; cA = nA; cB = nB; ++ui;
        if constexpr (GATHER) {
#pragma unroll
            for (int _h = 0; _h < 2; ++_h)
#pragma unroll
                for (int _i = 0; _i < 2; ++_i) gvc[_h][_i] = gvn[_h][_i]; }
        if (wr == 1) PG8_BAR;
    }
    PG8_WAIT_V(0);
    PG8_BAR;
#undef PG8_SA
#undef PG8_SB
#undef PG8_STAGE
#undef PG8_STAGE_A
#undef PG8_LDA
#undef PG8_LD8
#undef PG8_LDB
#undef PG8_MMA
#undef PG8_WAIT_V
#undef PG8_WAIT_L
#undef PG8_BAR
#undef PG8_SCHED
#undef PG8_GLOAD
}

template <bool PERM>
__device__ __forceinline__ void small_tile(PG8_LAS unsigned char* lds, const bf16_t* A16, int lda, const bf16_t* Bt, int ldb, int K, int pn, int wc, f32x4 (&v)[2][2], int wave0) {
    const int tid = make_tid(wave0), wid = __builtin_amdgcn_readfirstlane(tid >> 6), lane = tid & 63, fr = lane & 15, fq = lane >> 4;
    const int kper = K >> 3, k0 = wid * kper;
    f32x4 acc[2][2];
#pragma unroll
    for (int bj = 0; bj < 2; ++bj)
#pragma unroll
        for (int n = 0; n < 2; ++n) acc[bj][n] = (f32x4){0.f, 0.f, 0.f, 0.f};
    const bf16_t* ap = A16 + (size_t)fr * lda + k0 + 8 * fq;
    const bf16_t* bp[2][2];
#pragma unroll
    for (int bj = 0; bj < 2; ++bj)
#pragma unroll
        for (int n = 0; n < 2; ++n) { const int rr = PERM ? perm32(16 * n + fr) : 16 * n + fr; bp[bj][n] = Bt + (size_t)(pn * 256 + bj * 128 + wc * 32 + rr) * ldb + k0 + 8 * fq; }
    for (int k = 0; k < kper; k += 32) {
        const bf16x8 a = *(const bf16x8*)(ap + k);
#pragma unroll
        for (int bj = 0; bj < 2; ++bj)
#pragma unroll
            for (int n = 0; n < 2; ++n) { const bf16x8 b = *(const bf16x8*)(bp[bj][n] + k); acc[bj][n] = __builtin_amdgcn_mfma_f32_16x16x32_bf16(b, a, acc[bj][n], 0, 0, 0); }
    }
    PG8_LAS f32x4* red = (PG8_LAS f32x4*)lds;
#pragma unroll
    for (int bj = 0; bj < 2; ++bj)
#pragma unroll
        for (int n = 0; n < 2; ++n) red[(wid * 4 + bj * 2 + n) * 64 + lane] = acc[bj][n];
    __syncthreads();
    if (wid == 0) {
#pragma unroll
        for (int bj = 0; bj < 2; ++bj)
#pragma unroll
            for (int n = 0; n < 2; ++n) { f32x4 s = red[(bj * 2 + n) * 64 + lane];
#pragma unroll
                for (int w = 1; w < 8; ++w) s += red[(w * 4 + bj * 2 + n) * 64 + lane];
                v[bj][n] = s; }
    }
    __syncthreads();
}
}
namespace attn_body {
using bf16=__hip_bfloat16;
using bf16x8=__attribute__((ext_vector_type(8)))short;
using s16x4=__attribute__((ext_vector_type(4)))short;
using f32x16=__attribute__((ext_vector_type(16)))float;
using u32x4=__attribute__((ext_vector_type(4)))unsigned;
constexpr int BATCH=4,SEQ=4352,D=64,QKP=1024,VP=512,OP=1024;
constexpr int NW=8,QBLK=32,QB=QBLK*NW,KVBLK=64,NQB=SEQ/QB;
constexpr int ATTN_UNIT_ROWS=QB;
__device__ __forceinline__ int crow(int r,int hi){return (r&3)+8*(r>>2)+4*hi;}
#define SBAR() __builtin_amdgcn_sched_barrier(0)
__device__ __forceinline__ void cmask(f32x16&p0,f32x16&p1,int jb,int qrel,int hi){
  const float NEG=-INFINITY; int kb=64*jb+4*hi;
  #pragma unroll
  for(int r=0;r<16;++r){int kv=kb+(r&3)+8*(r>>2); if(kv>qrel)p0[r]=NEG; if(kv+32>qrel)p1[r]=NEG;}
}

__device__ __forceinline__ void biasmask(f32x16&p0,f32x16&p1,int jb,int qrel,int hi,const __attribute__((address_space(3))) float*tab){
  const float NEG=-INFINITY; const int kb=64*jb+4*hi;
  #pragma unroll
  for(int r=0;r<16;++r){const int n0=qrel-(kb+(r&3)+8*(r>>2)),n1=n0-32;
    const float b0=tab[n0<0?0:(n0>127?127:n0)],b1=tab[n1<0?0:(n1>127?127:n1)];
    p0[r]=n0<0?NEG:p0[r]+b0; p1[r]=n1<0?NEG:p1[r]+b1;}
}
constexpr int NSLOT=3, SLOTB=8192;
constexpr int VSLOTB=2*SLOTB;
constexpr int LDS_K=0, LDS_V=NSLOT*SLOTB, LDS_WS=LDS_V+NSLOT*VSLOTB, LDS_TAB=LDS_WS+NW*64*4, LDS_OST=0  , LDS_BYTES=LDS_TAB+2048;
constexpr float C2=0.125f*1.4426950408889634f;
__device__ __forceinline__ void glds16(const void*gsrc,unsigned lds_dst){unsigned keep;
  asm volatile("s_mov_b32 %0, m0\n\ts_mov_b32 m0, %2\n\ts_nop 0\n\tglobal_load_lds_dwordx4 %1, off\n\ts_mov_b32 m0, %0":"=&s"(keep):"v"(gsrc),"s"(lds_dst):"memory");}
__device__ __forceinline__ float max3f(float a,float b,float c){float r;asm("v_max3_f32 %0, %1, %2, %3":"=v"(r):"v"(a),"v"(b),"v"(c));return r;}
__device__ __forceinline__ float max2f(float a,float b){float r;asm("v_max_f32_e32 %0, %1, %2":"=v"(r):"v"(a),"v"(b));return r;}
__device__ __forceinline__ float fadd_s(float a,float b){float r;asm("v_add_f32_e32 %0, %1, %2":"=v"(r):"v"(a),"v"(b));return r;}
__device__ __forceinline__ float fsub_s(float a,float b){float r;asm("v_sub_f32_e32 %0, %1, %2":"=v"(r):"v"(a),"v"(b));return r;}
typedef float f32x2_t __attribute__((ext_vector_type(2))); typedef __bf16 bf16x2_t __attribute__((ext_vector_type(2)));
__device__ __forceinline__ unsigned cvtpk_s(float lo,float hi){f32x2_t v={lo,hi};bf16x2_t b=__builtin_convertvector(v,bf16x2_t);return __builtin_bit_cast(unsigned,b);}
#define WAIT_BAR(N) asm volatile("s_waitcnt vmcnt(" #N ") lgkmcnt(0)\n\ts_barrier":::"memory")

__device__ __forceinline__ void qkt(f32x16&p0,f32x16&p1,const char*Kslot,const bf16x8*qr,const f32x16&negm,int r32,int hi){
  const char*kb=Kslot+hi*1024+r32*16;
  #pragma unroll
  for(int d0=0;d0<4;++d0){
    const bf16x8 b0=*reinterpret_cast<const bf16x8*>(kb+d0*2048);
    const bf16x8 b1=*reinterpret_cast<const bf16x8*>(kb+d0*2048+512);
    if(d0==0){p0=__builtin_amdgcn_mfma_f32_32x32x16_bf16(b0,qr[0],negm,0,0,0);p1=__builtin_amdgcn_mfma_f32_32x32x16_bf16(b1,qr[0],negm,0,0,0);}
    else{p0=__builtin_amdgcn_mfma_f32_32x32x16_bf16(b0,qr[d0],p0,0,0,0);p1=__builtin_amdgcn_mfma_f32_32x32x16_bf16(b1,qr[d0],p1,0,0,0);}}
}
typedef __attribute__((address_space(3))) const char* lds_cptr;
typedef short v4i16_t __attribute__((ext_vector_type(4)));
__device__ __forceinline__ void kload8(bf16x8*kf,lds_cptr kp){
  kf[0]=*(const __attribute__((address_space(3))) bf16x8*)(kp);      kf[1]=*(const __attribute__((address_space(3))) bf16x8*)(kp+512);
  kf[2]=*(const __attribute__((address_space(3))) bf16x8*)(kp+2048); kf[3]=*(const __attribute__((address_space(3))) bf16x8*)(kp+2560);
  kf[4]=*(const __attribute__((address_space(3))) bf16x8*)(kp+4096); kf[5]=*(const __attribute__((address_space(3))) bf16x8*)(kp+4608);
  kf[6]=*(const __attribute__((address_space(3))) bf16x8*)(kp+6144); kf[7]=*(const __attribute__((address_space(3))) bf16x8*)(kp+6656);
}
__device__ __forceinline__ void kload2(bf16x8*kf,lds_cptr kp,int j){ kf[2*j]=*(const __attribute__((address_space(3))) bf16x8*)(kp+j*2048); kf[2*j+1]=*(const __attribute__((address_space(3))) bf16x8*)(kp+j*2048+512); }
__device__ __forceinline__ s16x4 vtr(lds_cptr p){ return __builtin_bit_cast(s16x4,__builtin_amdgcn_ds_read_tr16_b64_v4i16((__attribute__((address_space(3))) v4i16_t*)p)); }
__device__ __forceinline__ float rowmax(const f32x16&p0,const f32x16&p1){
  float a=max3f(p0[0],p0[1],p1[0]),b=max3f(p0[2],p0[3],p1[1]);a=max3f(a,p1[2],p1[3]);
  #pragma unroll
  for(int r=4;r<16;r+=4){a=max3f(a,p0[r],p0[r+1]);b=max3f(b,p0[r+2],p0[r+3]);a=max3f(a,p1[r],p1[r+1]);b=max3f(b,p1[r+2],p1[r+3]);}
  const float m=max2f(a,b);
  auto rr=__builtin_amdgcn_permlane32_swap(__float_as_uint(m),__float_as_uint(m),false,false);
  return max2f(__uint_as_float(rr[0]),__uint_as_float(rr[1]));
}
__device__ __forceinline__ void pv(f32x16*o,int vb,bf16x8 pa0,bf16x8 pa1,bf16x8 pa2,bf16x8 pa3){
  #pragma unroll
  for(int d0=0;d0<4;++d0){s16x4 lo[4],hi[4];
    #pragma unroll
    for(int ks=0;ks<4;++ks){
      asm volatile("ds_read_b64_tr_b16 %0,%1 offset:%c2":"=&v"(lo[ks]):"v"(vb),"i"(d0*4096+ks*1024):"memory");
      asm volatile("ds_read_b64_tr_b16 %0,%1 offset:%c2":"=&v"(hi[ks]):"v"(vb),"i"(d0*4096+ks*1024+512):"memory");}
    asm volatile("s_waitcnt lgkmcnt(0)":::"memory");SBAR();
    #define PK(k) (bf16x8){lo[k][0],lo[k][1],lo[k][2],lo[k][3],hi[k][0],hi[k][1],hi[k][2],hi[k][3]}
    o[d0]=__builtin_amdgcn_mfma_f32_32x32x16_bf16(pa0,PK(0),o[d0],0,0,0);
    o[d0]=__builtin_amdgcn_mfma_f32_32x32x16_bf16(pa1,PK(1),o[d0],0,0,0);
    o[d0]=__builtin_amdgcn_mfma_f32_32x32x16_bf16(pa2,PK(2),o[d0],0,0,0);
    o[d0]=__builtin_amdgcn_mfma_f32_32x32x16_bf16(pa3,PK(3),o[d0],0,0,0);
    #undef PK
  }
}

#ifndef ATTN_STORE16
#define ATTN_STORE16(p,v) (*(u32x4*)(p)=(v))
#endif
template<int THRL> __device__ __forceinline__ void attn_unit(int b,int vh,int qb,const bf16*__restrict__ QK,const bf16*__restrict__ V,bf16*O,char*shm,int wave0){
  const int mp=vh>>2,hh=vh&3; const int qcol=(mp*4+hh)*64,kcol=512+(mp*4+hh)*64,vcol=hh*128,ocol=mp*512+hh*128;
  const int tid=pg8::make_tid(wave0),lane=tid&63,r32=lane&31,hi=lane>>5; const int wid=__builtin_amdgcn_readfirstlane(tid>>6);
  const long rowbase=(long)b*SEQ; const int q0=qb*QB;
  const bf16*Qw=QK+(rowbase+q0+wid*QBLK)*QKP+qcol;
  const bf16*Kh=QK+rowbase*QKP+kcol,*Vh=V+rowbase*VP+vcol;
  const __attribute__((address_space(3))) float*tab=(const __attribute__((address_space(3))) float*)((__attribute__((address_space(3))) char*)shm+LDS_TAB)+hh*128;
  const unsigned lds0=(unsigned)(uintptr_t)shm;
  float*wsf=(float*)(shm+LDS_WS)+wid*64;
  const bf16*ksrc=Kh+(long)lane*QKP+wid*8;
  const bf16*vsrc=Vh+(long)(16*(wid&3)+(lane>>2))*VP+(wid>>2)*32+(lane&3)*8;
  const unsigned kdst=lds0+LDS_K+wid*1024, vdst=lds0+LDS_V+wid*1024;
  #define DMA_K(t,slot) glds16(ksrc+(long)(t)*KVBLK*QKP,(unsigned)__builtin_amdgcn_readfirstlane(kdst+(slot)))
  #define DMA_V(t,slot) do{ glds16(vsrc+(long)(t)*KVBLK*VP,(unsigned)__builtin_amdgcn_readfirstlane(vdst+2*(slot))); glds16(vsrc+64+(long)(t)*KVBLK*VP,(unsigned)__builtin_amdgcn_readfirstlane(vdst+2*(slot)+8192)); }while(0)
  const int vb0=(int)(lds0+LDS_V)+((lane>>4)&1)*32+(lane&3)*8+(4*hi+((lane&15)>>2))*64;
  const char*Kbase=shm+LDS_K; bf16x8 kf[8];
  const lds_cptr shm3=(lds_cptr)shm; const lds_cptr kp0=shm3+LDS_K+hi*1024+r32*16; const lds_cptr vp0=shm3+LDS_V+((lane>>4)&1)*32+(lane&3)*8+(4*hi+((lane&15)>>2))*64;
  const int NT=(q0+QB)/KVBLK;
  DMA_K(0,0);DMA_V(0,0);DMA_K(1,SLOTB);
  bf16x8 qr[4];
  #pragma unroll
  for(int d0=0;d0<4;++d0)qr[d0]=*reinterpret_cast<const bf16x8*>(&Qw[(long)r32*QKP+d0*16+hi*8]);
  float mhat=0.f,l_reg=0.f;f32x16 o[4];o[0]=f32x16{};o[1]=f32x16{};o[2]=f32x16{};o[3]=f32x16{};f32x16 negm=f32x16{};asm volatile("":"+v"(negm));
  const int qrel=wid*QBLK+r32;
  #define CMASK(P0,P1,t) do{int jb_=(t)-(NT-4); if(jb_>=-2)biasmask(P0,P1,jb_,qrel,hi,tab);}while(0)
  bool resc=false;
  #define START(P0,P1) do{ const float rm=rowmax(P0,P1); resc=false; \
    { const float dl=rm; mhat=fadd_s(mhat,dl); \
      _Pragma("unroll") for(int r=0;r<16;++r){P0[r]=fsub_s(P0[r],dl);P1[r]=fsub_s(P1[r],dl);} \
      _Pragma("unroll") for(int r=0;r<16;++r)negm[r]=-mhat; asm volatile("":"+v"(negm)); } \
    _Pragma("unroll") for(int r=0;r<16;++r)P0[r]=__builtin_amdgcn_exp2f(P0[r]); }while(0)
  #define RESC() do{ if(resc){ asm volatile("s_waitcnt lgkmcnt(0)":::"memory"); \
      _Pragma("unroll") for(int d_=0;d_<4;++d_) _Pragma("unroll") for(int r=0;r<16;++r)o[d_][r]*=wsf[crow(r,hi)]; } }while(0)
  f32x16 pA0,pA1,pB0,pB1;
  int sl_prev=0,sl_cur=0,sl_next=SLOTB;
  #define ROT() do{sl_prev=sl_cur;sl_cur=sl_next;sl_next=(sl_next==(NSLOT-1)*SLOTB)?0:sl_next+SLOTB;}while(0)
  DMA_K(2,2*SLOTB);
  WAIT_BAR(4);
  qkt(pA0,pA1,Kbase,qr,negm,r32,hi);asm volatile("s_nop 15\n\ts_nop 7":"+v"(pA0),"+v"(pA1));CMASK(pA0,pA1,0);
  START(pA0,pA1);
  _Pragma("unroll") for(int r=0;r<16;++r)pA1[r]=__builtin_amdgcn_exp2f(pA1[r]);
  WAIT_BAR(0);
  DMA_K(3,0);DMA_V(1,SLOTB);
  ROT();
  kload8(kf,kp0+sl_cur);
  WAIT_BAR(3);
  s16x4 vlo[4],vhi[4]; u32x4 pw0,pw1,pw2,pw3;
  #define PKW(P,B) cvtpk_s(P[B],P[B+1])
  #define PAF(k) __builtin_bit_cast(bf16x8,pw##k)
  #define VFR(i) (bf16x8){vlo[i][0],vlo[i][1],vlo[i][2],vlo[i][3],vhi[i][0],vhi[i][1],vhi[i][2],vhi[i][3]}
  #define PIN(x) asm volatile("":"+v"(x))
  #define MX3(a,b,c) __builtin_fmaxf(__builtin_fmaxf((a),(b)),(c))
  #define GAPA(MF,A0,A1,A2,A3,W0,W1,PW) do{ MF; sacc+=A0; sacc+=A1; sacc+=A2; sacc+=A3; PIN(sacc); W0; W1; PIN(PW); SBAR(); }while(0)
  #define EX(v) __builtin_amdgcn_exp2f(v)
  #define GAPB(MF,VR,X,B) do{ MF; VR; X[B]=EX(X[B]); X[B+1]=EX(X[B+1]); PIN(X); SBAR(); }while(0)
  #define VRJ(kg,d0) do{ vlo[d0]=vtr(vp_+((d0)*4096+(kg)*1024)); vhi[d0]=vtr(vp_+((d0)*4096+(kg)*1024+512)); }while(0)
  #define KRD(G,j) do{ if(G){ kload2(kf,kp0+sl_next,j); SBAR(); } }while(0)
  #define STEP(C0,C1,P0,P1,t,GK,GV,GL) do{ SBAR(); \
    const lds_cptr vp_=vp0+2*sl_prev; \
    float sacc=(P0[0]+P0[1]); \
    GAPA(C0=__builtin_amdgcn_mfma_f32_32x32x16_bf16(kf[0],qr[0],negm,0,0,0), P0[2],P0[3],P0[4],P0[5],     pw0[0]=PKW(P0,0), pw0[1]=PKW(P0,2), pw0); \
    GAPA(C1=__builtin_amdgcn_mfma_f32_32x32x16_bf16(kf[1],qr[0],negm,0,0,0), P0[6],P0[7],P0[8],P0[9],     pw0[2]=PKW(P0,4), pw0[3]=PKW(P0,6), pw0); \
    GAPA(C0=__builtin_amdgcn_mfma_f32_32x32x16_bf16(kf[2],qr[1],C0,0,0,0),   P0[10],P0[11],P0[12],P0[13], pw1[0]=PKW(P0,8), pw1[1]=PKW(P0,10), pw1); \
    GAPA(C1=__builtin_amdgcn_mfma_f32_32x32x16_bf16(kf[3],qr[1],C1,0,0,0),   P0[14],P0[15],P1[0],P1[1],   pw1[2]=PKW(P0,12),pw1[3]=PKW(P0,14), pw1); \
    GAPA(C0=__builtin_amdgcn_mfma_f32_32x32x16_bf16(kf[4],qr[2],C0,0,0,0),   P1[2],P1[3],P1[4],P1[5],     pw2[0]=PKW(P1,0), pw2[1]=PKW(P1,2), pw2); \
    GAPA(C1=__builtin_amdgcn_mfma_f32_32x32x16_bf16(kf[5],qr[2],C1,0,0,0),   P1[6],P1[7],P1[8],P1[9],     pw2[2]=PKW(P1,4), pw2[3]=PKW(P1,6), pw2); \
    GAPA(C0=__builtin_amdgcn_mfma_f32_32x32x16_bf16(kf[6],qr[3],C0,0,0,0),   P1[10],P1[11],P1[12],P1[13], pw3[0]=PKW(P1,8), pw3[1]=PKW(P1,10), pw3); \
    GAPA(C1=__builtin_amdgcn_mfma_f32_32x32x16_bf16(kf[7],qr[3],C1,0,0,0),   P1[14],P1[15],0.f,0.f,       pw3[2]=PKW(P1,12),pw3[3]=PKW(P1,14), pw3); \
    l_reg+=sacc; \
    if(GK){DMA_K((t)+3,sl_cur);} if(GV){DMA_V((t)+1,sl_next);} \
    VRJ(0,0); VRJ(0,1); VRJ(0,2); VRJ(0,3); SBAR(); \
    CMASK(C0,C1,t); \
    { float a=MX3(C0[0],C0[1],C1[0]),b=MX3(C0[2],C0[3],C1[1]); a=MX3(a,C1[2],C1[3]); \
      _Pragma("unroll") for(int r=4;r<16;r+=4){a=MX3(a,C0[r],C0[r+1]);b=MX3(b,C0[r+2],C0[r+3]);a=MX3(a,C1[r],C1[r+1]);b=MX3(b,C1[r+2],C1[r+3]);} \
      float rm=__builtin_fmaxf(a,b); { auto rr=__builtin_amdgcn_permlane32_swap(__float_as_uint(rm),__float_as_uint(rm),false,false); rm=__builtin_fmaxf(__uint_as_float(rr[0]),__uint_as_float(rr[1])); } \
      resc=false; \
      if(__builtin_expect(__any(rm>(float)THRL),0)){ const float dl=__builtin_fmaxf(rm,0.f); mhat+=dl; \
        _Pragma("unroll") for(int r=0;r<16;++r){C0[r]-=dl;C1[r]-=dl;} \
        _Pragma("unroll") for(int r=0;r<16;++r)negm[r]=-mhat; asm volatile("":"+v"(negm)); \
        const float f=__builtin_amdgcn_exp2f(-dl); l_reg*=f; if(hi==0)wsf[r32]=f; resc=true; } } \
    SBAR(); \
    GAPB(o[0]=__builtin_amdgcn_mfma_f32_32x32x16_bf16(PAF(0),VFR(0),o[0],0,0,0), VRJ(1,0), C0,0); \
    GAPB(o[1]=__builtin_amdgcn_mfma_f32_32x32x16_bf16(PAF(0),VFR(1),o[1],0,0,0), VRJ(1,1), C0,2); \
    GAPB(o[2]=__builtin_amdgcn_mfma_f32_32x32x16_bf16(PAF(0),VFR(2),o[2],0,0,0), VRJ(1,2), C0,4); \
    GAPB(o[3]=__builtin_amdgcn_mfma_f32_32x32x16_bf16(PAF(0),VFR(3),o[3],0,0,0), VRJ(1,3), C0,6); \
    GAPB(o[0]=__builtin_amdgcn_mfma_f32_32x32x16_bf16(PAF(1),VFR(0),o[0],0,0,0), VRJ(2,0), C0,8); \
    KRD(GL,0); GAPB(o[1]=__builtin_amdgcn_mfma_f32_32x32x16_bf16(PAF(1),VFR(1),o[1],0,0,0), VRJ(2,1), C0,10); \
    GAPB(o[2]=__builtin_amdgcn_mfma_f32_32x32x16_bf16(PAF(1),VFR(2),o[2],0,0,0), VRJ(2,2), C0,12); \
    KRD(GL,1); GAPB(o[3]=__builtin_amdgcn_mfma_f32_32x32x16_bf16(PAF(1),VFR(3),o[3],0,0,0), VRJ(2,3), C0,14); \
    GAPB(o[0]=__builtin_amdgcn_mfma_f32_32x32x16_bf16(PAF(2),VFR(0),o[0],0,0,0), VRJ(3,0), C1,0); \
    KRD(GL,2); GAPB(o[1]=__builtin_amdgcn_mfma_f32_32x32x16_bf16(PAF(2),VFR(1),o[1],0,0,0), VRJ(3,1), C1,2); \
    GAPB(o[2]=__builtin_amdgcn_mfma_f32_32x32x16_bf16(PAF(2),VFR(2),o[2],0,0,0), VRJ(3,2), C1,4); \
    KRD(GL,3); GAPB(o[3]=__builtin_amdgcn_mfma_f32_32x32x16_bf16(PAF(2),VFR(3),o[3],0,0,0), VRJ(3,3), C1,6); \
    GAPB(o[0]=__builtin_amdgcn_mfma_f32_32x32x16_bf16(PAF(3),VFR(0),o[0],0,0,0), (void)0, C1,8); \
    GAPB(o[1]=__builtin_amdgcn_mfma_f32_32x32x16_bf16(PAF(3),VFR(1),o[1],0,0,0), (void)0, C1,10); \
    GAPB(o[2]=__builtin_amdgcn_mfma_f32_32x32x16_bf16(PAF(3),VFR(2),o[2],0,0,0), (void)0, C1,12); \
    GAPB(o[3]=__builtin_amdgcn_mfma_f32_32x32x16_bf16(PAF(3),VFR(3),o[3],0,0,0), (void)0, C1,14); \
    }while(0)
  int t=1;
  #undef CMASK
  #define CMASK(P0,P1,t) do{}while(0)
  for(;t+7<NT;t+=2){
    STEP(pB0,pB1,pA0,pA1,t,true,true,true);     WAIT_BAR(3); RESC(); ROT();
    STEP(pA0,pA1,pB0,pB1,t+1,true,true,true);   WAIT_BAR(3); RESC(); ROT();
  }
  #undef CMASK
  #define CMASK(P0,P1,t) do{int jb_=(t)-(NT-4); if(jb_>=-2)biasmask(P0,P1,jb_,qrel,hi,tab);}while(0)
  #define ENDW(tt) do{ if((tt)+3<NT){WAIT_BAR(3);} else if((tt)+2<NT){WAIT_BAR(2);} else {WAIT_BAR(0);} }while(0)
  for(;t+1<NT;t+=2){
    STEP(pB0,pB1,pA0,pA1,t,(t+3<NT),(t+1<NT),(t+1<NT));       ENDW(t);   RESC(); ROT();
    STEP(pA0,pA1,pB0,pB1,t+1,(t+4<NT),(t+2<NT),(t+2<NT));     ENDW(t+1); RESC(); ROT();
  }
  STEP(pB0,pB1,pA0,pA1,NT-1,false,false,false); RESC();
  { float sacc=pB0[0]+pB0[1]; _Pragma("unroll") for(int r=2;r<16;++r)sacc+=pB0[r]; _Pragma("unroll") for(int r=0;r<16;++r)sacc+=pB1[r]; l_reg+=sacc;
    pw0=(u32x4){PKW(pB0,0),PKW(pB0,2),PKW(pB0,4),PKW(pB0,6)};pw1=(u32x4){PKW(pB0,8),PKW(pB0,10),PKW(pB0,12),PKW(pB0,14)};pw2=(u32x4){PKW(pB1,0),PKW(pB1,2),PKW(pB1,4),PKW(pB1,6)};pw3=(u32x4){PKW(pB1,8),PKW(pB1,10),PKW(pB1,12),PKW(pB1,14)};
    SBAR(); pv(o,vb0+2*sl_cur,PAF(0),PAF(1),PAF(2),PAF(3)); }
  #undef PKW
  #undef PAF
  #undef VFR
  #undef PIN
  #undef MX3
  #undef GAPA
  #undef GAPB
  #undef EX
  #undef VRJ
  #undef KRD
  #undef STEP
  #undef ENDW
  {auto rr=__builtin_amdgcn_permlane32_swap(__float_as_uint(l_reg),__float_as_uint(l_reg),false,false);l_reg=__uint_as_float(rr[0])+__uint_as_float(rr[1]);}
  if(hi==0)wsf[32+r32]=l_reg;asm volatile("s_waitcnt lgkmcnt(0)":::"memory");
  float rli[16];
  #pragma unroll
  for(int r=0;r<16;++r)rli[r]=__builtin_amdgcn_rcpf(wsf[32+crow(r,hi)]);
  bf16*Ow=O+(rowbase+q0+wid*QBLK)*OP+ocol;
  asm volatile("s_waitcnt lgkmcnt(0)\n\ts_barrier":::"memory");
  { bf16*stg=(bf16*)(shm+LDS_OST)+wid*4096;
    #pragma unroll
    for(int r=0;r<16;++r){const int orow=crow(r,hi);
      #pragma unroll
      for(int d0=0;d0<4;++d0)stg[orow*128+d0*32+r32]=__float2bfloat16(o[d0][r]*rli[r]);}
    asm volatile("s_waitcnt lgkmcnt(0)":::"memory");
    #pragma unroll
    for(int i=0;i<8;++i){const int row=i*4+(lane>>4),ch=lane&15; const u32x4 v=*(const u32x4*)(stg+row*128+ch*8); ATTN_STORE16(Ow+(long)row*OP+ch*8,v);} }
  asm volatile("s_waitcnt lgkmcnt(0)\n\ts_barrier":::"memory");
  #undef DMA_K
  #undef DMA_V
  #undef CMASK
  #undef START
  #undef RESC
  #undef ROT
}
constexpr int ATTN_LDS_BYTES=LDS_BYTES;
__device__ __forceinline__ bool attn_next(int G,int vcu,int i,int&b,int&vh,int&qb){
  if(G==256){ const int g=vcu&7, bv=vcu>>3; int q=-1;
    if(g<7){ q=(i==0)?16-g:(i==1)?1+g:-1; } else { q=(i==0)?9:(i==1)?8:(i==2)?0:-1; }
    if(q<0)return false; b=bv>>3; vh=bv&7; qb=q; return true; }
  const int u=vcu+i*G; if(u>=BATCH*8*17)return false; b=u/(8*17); vh=(u/17)&7; qb=u%17; return true;
}
#undef SBAR
#undef WAIT_BAR
}
namespace mk {
using pg8::bf16_t; using pg8::bf16x8; using pg8::f32x4; using pg8::u32x4; using pg8::u32x2; using pg8::Unit; using pg8::Gemm; using pg8::cvt_pk_bf16;
constexpr int NWAVES = 8;
constexpr int D = 1024, NB = 4, SEQ = 4096, NM = 16, MR = NB * SEQ  , MROWS = MR + NM  , MPAD = 16640;
constexpr int TP = 4352, MATT = NB * TP;
constexpr int INC = 8192, FFD = 2816, FFE = 3584, NE = 8;
constexpr float EPS = 1e-6f, LOG2E = 1.4426950408889634f, C2 = 0.125f * LOG2E;
constexpr size_t MiB = 1u << 20;
constexpr size_t WS_CTL = 0, CTL_ZERO_BYTES = 1 * MiB;
constexpr size_t WS_SMALL = 1 * MiB;
constexpr size_t WS_HN = 3 * MiB;
constexpr size_t WS_WIN = 36 * MiB, WS_WBR = 52 * MiB, WS_WO = 55 * MiB, WS_WGU0 = 57 * MiB, WS_WD0 = 68 * MiB;
constexpr size_t WS_U = 74 * MiB;
constexpr size_t WS_O = 123 * MiB, WS_ST = 157 * MiB, WS_HQ = 190 * MiB, WS_LOGF = 207 * MiB, WS_HG = 240 * MiB;
constexpr size_t WS_QK = 257 * MiB, WS_V = 291 * MiB, WS_CONV = 308 * MiB, WS_HV = 357 * MiB, WS_DS = 374 * MiB;
constexpr size_t WS_GATES = 257 * MiB, WS_MIXED = 355 * MiB, WS_MSCR = 388 * MiB;
constexpr size_t WS_H0 = 123 * MiB;
constexpr size_t WS_DEC = 440 * MiB;
constexpr size_t WS_HQ2 = 441 * MiB, WS_OI = 458 * MiB;
constexpr size_t WS_MGU = 36 * MiB, WS_MD = 148 * MiB, WS_MH = 204 * MiB, WS_MY = 442 * MiB;
constexpr size_t WS_HN8 = 491 * MiB, WS_WIN8 = 508 * MiB;
constexpr size_t WS_SLAB = 36 * MiB;
constexpr int LISTCAP = 16640;
constexpr size_t SMB_LIST = 128 * 1024, SMB_TOK = 704 * 1024;
constexpr int CW_CNT = 8192;
constexpr int SM_SCAL = 0;
constexpr int SM_LOGLB = 64, SM_LOG1M = 64 + 1024;
constexpr int SM_TAB = 64 + 2048;
constexpr int SM_METAHS = 4096;
constexpr int RING_OFF = 0, RING_BYTES = 131072, LDSCTL_OFF = RING_BYTES, MISC_OFF = LDSCTL_OFF + 320, LDS_BYTES = 147456;

#define GAS __attribute__((address_space(1)))
#define LAS __attribute__((address_space(3)))
typedef GAS unsigned gu32;
#define RLX_AGENT __ATOMIC_RELAXED, __HIP_MEMORY_SCOPE_AGENT
#define LDS_WAIT() asm volatile("s_waitcnt lgkmcnt(0)" ::: "memory")
__device__ __forceinline__ unsigned f2bf(float f) { unsigned u = __builtin_bit_cast(unsigned, f); return (u + 0x7fffu + ((u >> 16) & 1u)) >> 16; }
__device__ __forceinline__ unsigned pk2(float lo, float hi) { return cvt_pk_bf16(lo, hi); }
__device__ __forceinline__ unsigned f2bf_hw(float f) { return cvt_pk_bf16(f, 0.f) & 0xffffu; }
__device__ __forceinline__ float bf2f(unsigned short b) { return __builtin_bit_cast(float, (unsigned)b << 16); }
__device__ __forceinline__ float bflo(unsigned w) { return __builtin_bit_cast(float, w << 16); }
__device__ __forceinline__ float bfhi(unsigned w) { return __builtin_bit_cast(float, w & 0xffff0000u); }
#ifdef SLOWMATH
__device__ __forceinline__ float sigm(float x) { return 1.f / (1.f + __expf(-x)); }
__device__ __forceinline__ float silu(float x) { return x / (1.f + __expf(-x)); }
#else
__device__ __forceinline__ float sigm(float x) { return __builtin_amdgcn_rcpf(1.f + __expf(-x)); }
__device__ __forceinline__ float silu(float x) { return x * __builtin_amdgcn_rcpf(1.f + __expf(-x)); }
#endif
#ifdef SLOWMATH
__device__ __forceinline__ float logf_gate(float z, float la, float lm) { const float ls = fminf(z, 0.f) - log1pf(expf(-fabsf(z))), bb = lm + ls; return (la == -INFINITY) ? bb : fmaxf(la, bb) + log1pf(expf(-fabsf(la - bb))); }
#else
__device__ __forceinline__ float logf_gate(float z, float la, float lm) { const float ls = fminf(z, 0.f) - __logf(1.f + __expf(-fabsf(z))), bb = lm + ls; return (la == -INFINITY) ? bb : fmaxf(la, bb) + __logf(1.f + __expf(-fabsf(la - bb))); }
#endif
template <int O> __device__ __forceinline__ float xadd(float v) {
    if constexpr (O < 32) return v + __builtin_bit_cast(float, __builtin_amdgcn_ds_swizzle(__builtin_bit_cast(int, v), (O << 10) | 0x1f));
    else { const int l = pg8::lane_id(); return v + __builtin_bit_cast(float, __builtin_amdgcn_ds_bpermute((l ^ 32) << 2, __builtin_bit_cast(int, v))); }
}
__device__ __forceinline__ float wave_sum(float v) { v = xadd<1>(v); v = xadd<2>(v); v = xadd<4>(v); v = xadd<8>(v); v = xadd<16>(v); return xadd<32>(v); }

#define XB_TMO      128
#define XB_XCNT(j)  (256  + 64 * (j))
#define XB_XSUB(j)  (1280 + 64 * (j))
#define XB_XGEN(j)  (2304 + 64 * (j))
#define XB_TOP      3328
#define XB_TOPGEN   3392
#define XCD_BAR_WORDS 3456
#define XB_SPIN_CAP (1u << 18)
__device__ __forceinline__ unsigned xb_ld(unsigned* p)              { return __hip_atomic_load(p, __ATOMIC_RELAXED, __HIP_MEMORY_SCOPE_AGENT); }
__device__ __forceinline__ unsigned xb_add(unsigned* p, unsigned v) { return __hip_atomic_fetch_add(p, v, __ATOMIC_RELAXED, __HIP_MEMORY_SCOPE_AGENT); }
__device__ __forceinline__ unsigned xb_xcc_id() { return (unsigned)__builtin_amdgcn_s_getreg((3 << 11) | 20) & 0xFu; }
#define XB_SPIN(cond, bar) do { unsigned _sp = 0; while (cond) { __builtin_amdgcn_s_sleep(1); \
    if ((++_sp & 255u) == 0u) { if (xb_ld(&(bar)[XB_TMO])) break; if (_sp > XB_SPIN_CAP) { atomicAdd(&(bar)[XB_TMO], 1u); break; } } } } while (0)
struct XcdBarrier { unsigned* bar; unsigned x; volatile LAS unsigned* st; };
__device__ __forceinline__ XcdBarrier xcd_barrier_post(unsigned* bar, volatile LAS unsigned* st, int tid) {
    XcdBarrier b; b.bar = bar; b.x = xb_xcc_id(); b.st = st;
    if (tid == 0) (void)xb_add(&bar[XB_XCNT(b.x)], 1u);
    return b;
}
__device__ __forceinline__ void xcd_barrier_complete(unsigned* bar, unsigned x, unsigned& nloc, unsigned& nx) {
    const unsigned G = gridDim.x * gridDim.y * gridDim.z;
    unsigned sum, cnt, mine, sp = 0u;
    for (;;) {
        sum = 0u; cnt = 0u; mine = 0u;
#pragma unroll
        for (unsigned j = 0; j < 16; ++j) { const unsigned c = xb_ld(&bar[XB_XCNT(j)]); sum += c; cnt += (c > 0u) ? 1u : 0u; mine = (j == x) ? c : mine; }
        if (sum == G) break;
        __builtin_amdgcn_s_sleep(1);
        if ((++sp & 255u) == 0u) { if (xb_ld(&bar[XB_TMO])) break; if (sp > XB_SPIN_CAP) { atomicAdd(&bar[XB_TMO], 1u); break; } }
    }
    nloc = mine > 0u ? mine : 1u; nx = cnt > 0u ? cnt : 1u;
}
__device__ __forceinline__ void xcd_barrier(const XcdBarrier& b, int tid) {
    asm volatile("s_waitcnt vmcnt(0)" ::: "memory");
    __syncthreads();
    if (tid == 0) {
        unsigned* bar = b.bar;
        __builtin_amdgcn_s_waitcnt(0);
        unsigned nloc = b.st[0], nx = b.st[1];
        if (nloc == 0u) { xcd_barrier_complete(bar, b.x, nloc, nx); b.st[0] = nloc; b.st[1] = nx; }
        const unsigned old = xb_add(&bar[XB_XSUB(b.x)], 1u);
        const unsigned gen = old / nloc, tgt = (gen + 1u) * nx;
        if (old + 1u == (gen + 1u) * nloc) {
            __builtin_amdgcn_fence(__ATOMIC_RELEASE, "agent");
            asm volatile("s_waitcnt vmcnt(0)" ::: "memory");
            (void)xb_add(&bar[XB_TOP], 1u);
        }
        XB_SPIN(xb_ld(&bar[XB_TOP]) < tgt, bar);
        __builtin_amdgcn_fence(__ATOMIC_ACQUIRE, "agent");
        asm volatile("s_waitcnt vmcnt(0)" ::: "memory");
    }
    __syncthreads();
}

struct Frame {
    LAS unsigned char* lds; unsigned char* lds_gen;
    int tid, lane, wave, vcu, G;
    const float* const* in; float* out; unsigned char* ws;
};
#define WSP(T, off) ((T*)(F.ws + (off)))
#define SMALLF (WSP(float, WS_SMALL))

__device__ __forceinline__ void cvt_block(const float* W, int ldw, int k0, int c0, bf16_t* WT, int ldt, int r0, LAS float* scr, int lane) {
    float wv[32];
    const float* wp = W + (size_t)(k0 + (lane >> 5)) * ldw + c0 + (lane & 31);
#pragma unroll
    for (int i = 0; i < 32; ++i) wv[i] = __builtin_nontemporal_load(wp + (size_t)(2 * i) * ldw);
#pragma unroll
    for (int i = 0; i < 32; ++i) scr[(2 * i + (lane >> 5)) * 33 + (lane & 31)] = wv[i];
    LDS_WAIT(); asm volatile("" ::: "memory");
    const int c = lane & 7;
#pragma unroll
    for (int j = 0; j < 4; ++j) { const int n = (lane >> 3) + 8 * j; const LAS float* s = scr + (8 * c) * 33 + n;
        u32x4 o; o.x = pk2(s[0 * 33], s[1 * 33]); o.y = pk2(s[2 * 33], s[3 * 33]); o.z = pk2(s[4 * 33], s[5 * 33]); o.w = pk2(s[6 * 33], s[7 * 33]);
        *(GAS u32x4*)(WT + (size_t)(r0 + n) * ldt + k0 + 8 * c) = o; }
    LDS_WAIT(); asm volatile("" ::: "memory");
}
constexpr float W8_SCALE = 32.f, H8_SCALE = 4.f, WD8_SCALE = 64.f;
__device__ __forceinline__ unsigned pk4_fp8(float a, float b, float c, float d) { int r = __builtin_amdgcn_cvt_pk_fp8_f32(a, b, 0, false); r = __builtin_amdgcn_cvt_pk_fp8_f32(c, d, r, true); return (unsigned)r; }
__device__ __forceinline__ void cvt_block_fp8(const float* W, int ldw, int k0, int c0, unsigned char* WT, int ldt, int r0, LAS float* scr, int lane, float wscale) {
    float wv[32];
    const float* wp = W + (size_t)(k0 + (lane >> 5)) * ldw + c0 + (lane & 31);
#pragma unroll
    for (int i = 0; i < 32; ++i) wv[i] = __builtin_nontemporal_load(wp + (size_t)(2 * i) * ldw);
#pragma unroll
    for (int i = 0; i < 32; ++i) scr[(2 * i + (lane >> 5)) * 33 + (lane & 31)] = wv[i] * wscale;
    LDS_WAIT(); asm volatile("" ::: "memory");
    const int c = lane & 7;
#pragma unroll
    for (int j = 0; j < 4; ++j) { const int n = (lane >> 3) + 8 * j; const LAS float* s = scr + (8 * c) * 33 + n;
        u32x2 o; o.x = pk4_fp8(s[0 * 33], s[1 * 33], s[2 * 33], s[3 * 33]); o.y = pk4_fp8(s[4 * 33], s[5 * 33], s[6 * 33], s[7 * 33]);
        *(GAS u32x2*)(WT + (size_t)(r0 + n) * ldt + k0 + 8 * c) = o; }
    LDS_WAIT(); asm volatile("" ::: "memory");
}
struct CvtItem { const float* W; int ldw, k0, c0; void* WT; int ldt, r0; };
__device__ __forceinline__ void cvt_load(float (&wv)[32], const CvtItem& c, int lane) {
    const float* wp = c.W + (size_t)(c.k0 + (lane >> 5)) * c.ldw + c.c0 + (lane & 31);
#pragma unroll
    for (int i = 0; i < 32; ++i) wv[i] = __builtin_nontemporal_load(wp + (size_t)(2 * i) * c.ldw);
}
template <bool FP8> __device__ __forceinline__ void cvt_store(const float (&wv)[32], const CvtItem& c, LAS float* scr, int lane, float wscale) {
#pragma unroll
    for (int i = 0; i < 32; ++i) scr[(2 * i + (lane >> 5)) * 33 + (lane & 31)] = FP8 ? wv[i] * wscale : wv[i];
    LDS_WAIT(); asm volatile("" ::: "memory");
    const int cc = lane & 7;
#pragma unroll
    for (int j = 0; j < 4; ++j) { const int n = (lane >> 3) + 8 * j; const LAS float* q = scr + (8 * cc) * 33 + n;
        if constexpr (FP8) { u32x2 o; o.x = pk4_fp8(q[0 * 33], q[1 * 33], q[2 * 33], q[3 * 33]); o.y = pk4_fp8(q[4 * 33], q[5 * 33], q[6 * 33], q[7 * 33]);
            *(GAS u32x2*)((unsigned char*)c.WT + (size_t)(c.r0 + n) * c.ldt + c.k0 + 8 * cc) = o; }
        else { u32x4 o; o.x = pk2(q[0 * 33], q[1 * 33]); o.y = pk2(q[2 * 33], q[3 * 33]); o.z = pk2(q[4 * 33], q[5 * 33]); o.w = pk2(q[6 * 33], q[7 * 33]);
            *(GAS u32x4*)((bf16_t*)c.WT + (size_t)(c.r0 + n) * c.ldt + c.k0 + 8 * cc) = o; } }
    LDS_WAIT(); asm volatile("" ::: "memory");
}
template <bool FP8, class Dec> __device__ __forceinline__ void cvt_run(int it0, int stride, int n, const Dec& dec, LAS float* scr, int lane, float wscale) {
    for (int it = it0; it < n; it += 2 * stride) {
        float a[32], b[32]; const CvtItem ca = dec(it); cvt_load(a, ca, lane);
        const int it2 = it + stride; const bool hb = it2 < n; CvtItem cb = ca; if (hb) { cb = dec(it2); cvt_load(b, cb, lane); }
        cvt_store<FP8>(a, ca, scr, lane, wscale); if (hb) cvt_store<FP8>(b, cb, scr, lane, wscale);
    }
}
__device__ __forceinline__ int win_src_col(int db) { const int r0 = db * 32, tile = r0 >> 8, loc = r0 & 255; if (tile >= 4) return r0; const int bj = loc >> 7, wc = (loc & 127) >> 5; return tile * 256 + 64 * wc + 32 * bj; }

__device__ __forceinline__ void convert_layer_weights(Frame& F, int l, int widx = -1, int nw = 0, int part = 0) {
    LAS float* scr = (LAS float*)(F.lds + RING_OFF + F.wave * 16384);
    const int gw = widx >= 0 ? widx : F.vcu * NWAVES + F.wave, NGW = widx >= 0 ? nw : F.G * NWAVES;
    const float* w_in = F.in[4] + (size_t)l * D * INC; const float* w_br = F.in[13] + (size_t)l * 3 * 512 * D; const float* w_o = F.in[14] + (size_t)l * D * D;
    constexpr int I_IN = 16 * 256, I_BR = 3 * 8 * 32, I_O = 16 * 32, I_GU = 16 * 176, I_DN = 44 * 32;
    const int nitems = I_IN + I_BR + I_O + (l == 0 ? I_GU + I_DN : 0);
    const auto dec = [&](int it) -> CvtItem { int r = it;
        if (r < I_IN) { const int kb = r >> 8, db = r & 255; return CvtItem{w_in, INC, kb * 64, win_src_col(db), WSP(bf16_t, WS_WIN), D, db * 32}; } r -= I_IN;
        if (r < I_BR) { const int br = r / 256, q = r % 256, kb = q >> 5, db = q & 31; return CvtItem{w_br + (size_t)br * 512 * D, D, kb * 64, db * 32, WSP(bf16_t, WS_WBR) + 512 * br, 1536, db * 32}; }   r -= I_BR;
        if (r < I_O) { const int kb = r >> 5, db = r & 31; return CvtItem{w_o, D, kb * 64, db * 32, WSP(bf16_t, WS_WO), D, db * 32}; } r -= I_O;
        if (r < I_GU) { const int kb = r / 176, db = r % 176, tile = db >> 3, l32 = db & 7; const float* src = (l32 < 4) ? F.in[15] : F.in[16];
            return CvtItem{src, FFD, kb * 64, tile * 128 + (l32 & 3) * 32, WSP(bf16_t, WS_WGU0), D, db * 32}; } r -= I_GU;
        const int kb = r >> 5, db = r & 31; return CvtItem{F.in[17], D, kb * 64, db * 32, WSP(bf16_t, WS_WD0), FFD, db * 32}; };
    const int it_lo = part == 2 ? I_IN + I_BR + I_O : 0, it_hi = part == 1 ? I_IN + I_BR + I_O : nitems;
    cvt_run<false>(it_lo + gw, NGW, it_hi, dec, scr, F.lane, 1.f);
    if (part == 2) return;
    const auto dec8 = [&](int it) -> CvtItem { const int kb = it / 96, db = it % 96; return CvtItem{w_in, INC, kb * 64, (160 + db) * 32, F.ws + WS_WIN8, D, db * 32}; };
    cvt_run<true>(gw, NGW, 16 * 96, dec8, scr, F.lane, W8_SCALE);
}
__device__ __forceinline__ void setup_small(Frame& F) {
    float* sm = SMALLF;
    if (blockIdx.x == 0) {
        if (F.tid < 2) { const int l = F.tid; const float* lp = F.in[7] + l * 256; float s1 = 0.f, s2 = 0.f;
            for (int i = 0; i < 64; ++i) { s1 += lp[i] * lp[64 + i]; s2 += lp[128 + i] * lp[192 + i]; }
            const float li = 0.8f - 0.6f * expf(-0.3f * (float)l); sm[SM_SCAL + l * 4] = expf(s1) - expf(s2) + li; sm[SM_SCAL + l * 4 + 1] = 1.f - li; }
        { const int c = F.tid; const float a = F.in[11][c], b = F.in[11][512 + c], mx = fmaxf(a, b), e0 = expf(a - mx), e1 = expf(b - mx), lb1 = e1 / (e0 + e1);
            sm[SM_LOGLB + c] = -INFINITY; sm[SM_LOG1M + c] = 0.f; sm[SM_LOGLB + 512 + c] = logf(lb1); sm[SM_LOG1M + 512 + c] = log1pf(-lb1); }
        { const int h = F.tid >> 7, n = F.tid & 127; int bk = n; if (n >= 16) { bk = 16 + (int)(logf((float)n / 16.f) / 2.0794415416798357f * 16.f); bk = bk < 31 ? bk : 31; }
            sm[SM_TAB + h * 128 + n] = (F.in[9][bk * 4 + h] - F.in[9][31 * 4 + h]) * LOG2E; }
    }
    const int gt = F.vcu * 512 + F.tid, NT = F.G * 512;
    for (int i = gt; i < NE * LISTCAP; i += NT) ((int*)(F.ws + WS_SMALL + SMB_LIST))[i] = 0;
    for (int i = gt; i < NB * 240 * (1024 / 8); i += NT) { const int row = i / 128, c = i % 128, b = row / 240, p = 4112 + row % 240; *(GAS u32x4*)(WSP(bf16_t, WS_QK) + ((size_t)(b * TP + p)) * 1024 + c * 8) = (u32x4){0u, 0u, 0u, 0u}; }
    for (int i = gt; i < NB * 240 * (512 / 8); i += NT) { const int row = i / 64, c = i % 64, b = row / 240, p = 4112 + row % 240; *(GAS u32x4*)(WSP(bf16_t, WS_V) + ((size_t)(b * TP + p)) * 512 + c * 8) = (u32x4){0u, 0u, 0u, 0u}; }
}
__device__ __forceinline__ const float* res_row(Frame& F, int r, bool first) {
    if (r < MR) return (first ? F.in[0] : (const float*)F.out) + (size_t)r * D;
    return (first ? F.in[1] : (const float*)(SMALLF + SM_METAHS)) + (size_t)(r - MR) * D;
}
__device__ __forceinline__ float* res_row_w(Frame& F, int r) { return (r < MR) ? F.out + (size_t)r * D : SMALLF + SM_METAHS + (size_t)(r - MR) * D; }
__device__ __forceinline__ void norm_pass(Frame& F, const float* gain, bool first, bool copy8) {
    const int gw = F.vcu * NWAVES + F.wave, NGW = F.G * NWAVES;
    f32x4 gv[4];
#pragma unroll
    for (int j = 0; j < 4; ++j) gv[j] = ((const f32x4*)gain)[F.lane + 64 * j];
    for (int r = gw; r < MROWS; r += NGW) {
        const GAS f32x4* xr = (const GAS f32x4*)res_row(F, r, first) + F.lane;
        f32x4 v[4]; float s = 0.f;
#pragma unroll
        for (int j = 0; j < 4; ++j) { v[j] = xr[64 * j]; s += (v[j].x * v[j].x + v[j].y * v[j].y) + (v[j].z * v[j].z + v[j].w * v[j].w); }
        const float sc = rsqrtf(wave_sum(s) * (1.f / D) + EPS);
        GAS u32x2* o = (GAS u32x2*)(WSP(bf16_t, WS_HN) + (size_t)r * D) + F.lane;
#pragma unroll
        for (int j = 0; j < 4; ++j) { u32x2 w; w.x = pk2(v[j].x * sc * gv[j].x, v[j].y * sc * gv[j].y); w.y = pk2(v[j].z * sc * gv[j].z, v[j].w * sc * gv[j].w); o[64 * j] = w; }
        if (copy8 && r < MR) { GAS unsigned* o8 = (GAS unsigned*)(F.ws + WS_HN8 + (size_t)r * D) + F.lane;
#pragma unroll
            for (int j = 0; j < 4; ++j) o8[64 * j] = pk4_fp8(v[j].x * sc * gv[j].x, v[j].y * sc * gv[j].y, v[j].z * sc * gv[j].z, v[j].w * sc * gv[j].w); }
    }
}

struct TileOrder {
    int nM, nN, nwg, G, c, pn0; long lda2, ldb2;
    __device__ void init(int nM_, int nN_, int pn0_, int G_, int c_, int lda, int ldb) { nM = nM_; nN = nN_; nwg = nM * nN; G = G_; c = c_; pn0 = pn0_; lda2 = 2L * lda; ldb2 = 2L * ldb; }
    __device__ __forceinline__ bool next(int i, Unit& u) const {
        const long L = (long)i * G + c; if (L >= nwg) return false;
        int wgid = (int)L; { const int q = nwg / 8, r = nwg % 8, xcd = wgid % 8, off = wgid / 8; wgid = (xcd < r ? xcd * (q + 1) : r * (q + 1) + (xcd - r) * q) + off; }
        const int nig = 8 * nN, gid = wgid / nig, fm = gid * 8, gsz = (nM - fm) < 8 ? (nM - fm) : 8;
        u.pm = fm + ((wgid % nig) % gsz); u.pn = pn0 + (wgid % nig) / gsz; u.z = 0; u.a_off = (unsigned)((long)u.pm * 256 * lda2); u.b_off = (unsigned)((long)u.pn * 256 * ldb2); u.gidx = nullptr; return true;
    }
};
__device__ __forceinline__ u32x4 pack8(const f32x4 a, const f32x4 b) { u32x4 w; w.x = cvt_pk_bf16(a[0], a[1]); w.y = cvt_pk_bf16(a[2], a[3]); w.z = cvt_pk_bf16(b[0], b[1]); w.w = cvt_pk_bf16(b[2], b[3]); return w; }
__device__ __forceinline__ void store_att(bf16_t* buf, int pitch, int r, int col, u32x4 w) {
    if (r < MR) { const int ar = (r >> 12) * TP + NM + (r & 4095); *(u32x4*)(buf + (size_t)ar * pitch + col) = w; }
    else { const int j = r - MR;
#pragma unroll
        for (int b = 0; b < NB; ++b) *(u32x4*)(buf + (size_t)(b * TP + j) * pitch + col) = w; }
}
struct EpiProj {
    static constexpr bool PERM = true, MID = false;
    unsigned char* ws; const float *qg, *kg; int l; float gsc;
    __device__ __forceinline__ void row(const Unit& u, int r, int slot, int wc, int fq, const f32x4 (&v)[2][2]) const {
        const int pn = u.pn;
        bf16_t* QK = (bf16_t*)(ws + WS_QK); bf16_t* V = (bf16_t*)(ws + WS_V); bf16_t* CONV = (bf16_t*)(ws + WS_CONV); bf16_t* HQ = (bf16_t*)(ws + WS_HQ); bf16_t* HV = (bf16_t*)(ws + WS_HV); bf16_t* HG = (bf16_t*)(ws + WS_HG);
        bf16_t* GATES = (bf16_t*)(ws + WS_GATES); float* LOGF = (float*)(ws + WS_LOGF); const float* loglb = (const float*)(ws + WS_SMALL) + SM_LOGLB + l * 512; const float* log1m = (const float*)(ws + WS_SMALL) + SM_LOG1M + l * 512;
        if (pn < 4) {
            float ss = 0.f;
#pragma unroll
            for (int bj = 0; bj < 2; ++bj)
#pragma unroll
                for (int n = 0; n < 2; ++n) ss += (v[bj][n][0] * v[bj][n][0] + v[bj][n][1] * v[bj][n][1]) + (v[bj][n][2] * v[bj][n][2] + v[bj][n][3] * v[bj][n][3]);
            ss = xadd<16>(ss); ss = xadd<32>(ss);
            const float sc = rsqrtf(ss * (1.f / 64.f) + EPS) * (pn < 2 ? C2 : 1.f); const float* gv = pn < 2 ? qg : kg;
#pragma unroll
            for (int bj = 0; bj < 2; ++bj) { const int d0 = 32 * bj + 8 * fq; const f32x4 g0 = *(const f32x4*)(gv + d0), g1 = *(const f32x4*)(gv + d0 + 4);
                store_att(QK, 1024, r, pn * 256 + 64 * wc + d0, pack8(v[bj][0] * g0 * sc, v[bj][1] * g1 * sc)); }
            return;
        }
#pragma unroll
        for (int bj = 0; bj < 2; ++bj) {
            const int cl = 128 * bj + 32 * wc + 8 * fq; f32x4 a = v[bj][0], b = v[bj][1];
            if (pn < 6) { store_att(V, 512, r, (pn - 4) * 256 + cl, pack8(a, b)); }
            else if (pn < 12) { *(u32x4*)(CONV + (size_t)r * 1536 + (pn - 6) * 256 + cl) = pack8(a, b); }
            else if (pn < 14 || (pn >= 18 && pn < 20)) {
#pragma unroll
                for (int e = 0; e < 4; ++e) { a[e] = silu(a[e]); b[e] = silu(b[e]); }
                bf16_t* dst = (pn < 14) ? HQ + (size_t)r * 512 + (pn - 12) * 256 + cl : HG + (size_t)r * 512 + (pn - 18) * 256 + cl; *(u32x4*)dst = pack8(a, b); }
            else if (pn < 16) {
                const int c = (pn - 14) * 256 + cl; const f32x4 la0 = *(const f32x4*)(loglb + c), la1 = *(const f32x4*)(loglb + c + 4), lm0 = *(const f32x4*)(log1m + c), lm1 = *(const f32x4*)(log1m + c + 4);
                f32x4 o0, o1;
#pragma unroll
                for (int e = 0; e < 4; ++e) {
                    o0[e] = logf_gate(a[e], la0[e], lm0[e]); o1[e] = logf_gate(b[e], la1[e], lm1[e]);
                }
                float* dst = LOGF + (size_t)r * 512 + c; *(f32x4*)dst = o0; *(f32x4*)(dst + 4) = o1; }
            else if (pn < 18) { *(u32x4*)(HV + (size_t)r * 512 + (pn - 16) * 256 + cl) = pack8(a, b); }
            else {
#pragma unroll
                for (int e = 0; e < 4; ++e) { a[e] = sigm(a[e] * gsc); b[e] = sigm(b[e] * gsc); }
                *(u32x4*)(GATES + (size_t)r * 3072 + (pn - 20) * 256 + cl) = pack8(a, b); }
        }
    }
};
struct EpiMerge {
    static constexpr bool PERM = true, MID = true; static constexpr int MID_T0 = 8, MID_T1 = 16;
    const bf16_t* GATES; bf16_t* MIXED;
    __device__ __forceinline__ void mid_row(const Unit& u, int r, int t, int wc, int fq, f32x4 (&v)[2][2]) const {
        const int b = (t >> 3) - 1;
#pragma unroll
        for (int bj = 0; bj < 2; ++bj) {
            const bf16_t* gp = GATES + (size_t)r * 3072 + b * 1024 + u.pn * 256 + 128 * bj + 32 * wc + 8 * fq; const u32x4 ga = *(const u32x4*)gp, gb = *(const u32x4*)(gp + 1024);
#define MK_RT(x, y) ((x) * __builtin_amdgcn_rcpf(fmaxf((y), 1e-20f)))
            v[bj][0][0] *= MK_RT(bflo(ga.x), bflo(gb.x)); v[bj][0][1] *= MK_RT(bfhi(ga.x), bfhi(gb.x)); v[bj][0][2] *= MK_RT(bflo(ga.y), bflo(gb.y)); v[bj][0][3] *= MK_RT(bfhi(ga.y), bfhi(gb.y));
            v[bj][1][0] *= MK_RT(bflo(ga.z), bflo(gb.z)); v[bj][1][1] *= MK_RT(bfhi(ga.z), bfhi(gb.z)); v[bj][1][2] *= MK_RT(bflo(ga.w), bflo(gb.w)); v[bj][1][3] *= MK_RT(bfhi(ga.w), bfhi(gb.w));
#undef MK_RT
        }
    }
    __device__ __forceinline__ void row(const Unit& u, int r, int slot, int wc, int fq, const f32x4 (&v)[2][2]) const {
        u32x4 gws[2];
#pragma unroll
        for (int bj = 0; bj < 2; ++bj) gws[bj] = *(const GAS u32x4*)(GATES + (size_t)r * 3072 + 2048 + u.pn * 256 + 128 * bj + 32 * wc + 8 * fq);
#pragma unroll
        for (int bj = 0; bj < 2; ++bj) {
            const int cl = 128 * bj + 32 * wc + 8 * fq; const u32x4 gw = gws[bj];
            f32x4 a = v[bj][0], b = v[bj][1];
            a[0] *= bflo(gw.x); a[1] *= bfhi(gw.x); a[2] *= bflo(gw.y); a[3] *= bfhi(gw.y); b[0] *= bflo(gw.z); b[1] *= bfhi(gw.z); b[2] *= bflo(gw.w); b[3] *= bfhi(gw.w);
            *(u32x4*)(MIXED + (size_t)r * D + u.pn * 256 + cl) = pack8(a, b);
        }
    }
};
struct EpiRes {
    static constexpr bool PERM = false, MID = false;
    const float* base; float* out; const float* mbase; float* mout;
    __device__ __forceinline__ void row(const Unit& u, int r, int slot, int wc, int fq, const f32x4 (&v)[2][2]) const {
        const float* bp = (r < MR) ? base + (size_t)r * D : mbase + (size_t)(r - MR) * D; float* op = (r < MR) ? out + (size_t)r * D : mout + (size_t)(r - MR) * D;
        f32x4 bs[2][2];
#pragma unroll
        for (int bj = 0; bj < 2; ++bj)
#pragma unroll
            for (int n = 0; n < 2; ++n) { const int col = u.pn * 256 + 128 * bj + 32 * wc + 16 * n + 4 * fq; bs[bj][n] = *(const GAS f32x4*)(bp + col); }
#pragma unroll
        for (int bj = 0; bj < 2; ++bj)
#pragma unroll
            for (int n = 0; n < 2; ++n) { const int col = u.pn * 256 + 128 * bj + 32 * wc + 16 * n + 4 * fq; *(GAS f32x4*)(op + col) = bs[bj][n] + v[bj][n]; }
    }
};
struct EpiGU {
    static constexpr bool PERM = true, MID = false;
    bf16_t* H; int ldh; float sc;
    __device__ __forceinline__ void row(const Unit& u, int r, int slot, int wc, int fq, const f32x4 (&v)[2][2]) const {
        f32x4 a, b;
#pragma unroll
        for (int e = 0; e < 4; ++e) { a[e] = silu(v[0][0][e] * sc) * (v[1][0][e] * sc); b[e] = silu(v[0][1][e] * sc) * (v[1][1][e] * sc); }
        *(u32x4*)(H + (size_t)r * ldh + u.pn * 128 + 32 * wc + 8 * fq) = pack8(a, b);
    }
};

struct EpiGU8 {
    static constexpr bool PERM = true, MID = false;
    unsigned char* H; int ldh; float sc;
    __device__ __forceinline__ void row(const Unit& u, int r, int slot, int wc, int fq, const f32x4 (&v)[2][2]) const {
        f32x4 a, b;
#pragma unroll
        for (int e = 0; e < 4; ++e) { a[e] = silu(v[0][0][e] * sc) * (v[1][0][e] * (sc * H8_SCALE)); b[e] = silu(v[0][1][e] * sc) * (v[1][1][e] * (sc * H8_SCALE)); }
#pragma unroll
        for (int e = 0; e < 4; ++e) { a[e] = __builtin_amdgcn_fmed3f(a[e], -448.f, 448.f); b[e] = __builtin_amdgcn_fmed3f(b[e], -448.f, 448.f); }
        u32x2 o; o.x = pk4_fp8(a[0], a[1], a[2], a[3]); o.y = pk4_fp8(b[0], b[1], b[2], b[3]);
        *(u32x2*)(H + (size_t)r * ldh + u.pn * 128 + 32 * wc + 8 * fq) = o;
    }
};
template <class Epi>
__device__ __forceinline__ void meta_gemm(Frame& F, const bf16_t* A16, int lda, const bf16_t* Bt, int ldb, int K, int pn_lo, int pn_hi, const Epi& E) {
    const int fr = F.lane & 15, fq = F.lane >> 4;
    for (int task = pn_lo * 4 + F.vcu; task < pn_hi * 4; task += F.G) {
        const int pn = task >> 2, wc = task & 3; f32x4 v[2][2];
        pg8::small_tile<Epi::PERM>(F.lds + RING_OFF, A16, lda, Bt, ldb, K, pn, wc, v, F.wave);
        if (F.wave == 0) { Unit u; u.pm = 64; u.pn = pn; u.z = 0; u.a_off = 0; u.b_off = 0; u.gidx = nullptr; E.row(u, MR + fr, 0, wc, fq, v); }
    }
}
__device__ __forceinline__ void meta_merge(Frame& F, const bf16_t* U16, const bf16_t* Wbr, const bf16_t* GATES, bf16_t* MIXED) {
    const int fr = F.lane & 15, fq = F.lane >> 4;
    for (int task = F.vcu; task < 16; task += F.G) {
        const int pn = task >> 2, wc = task & 3; f32x4 tot[2][2];
#pragma unroll
        for (int bj = 0; bj < 2; ++bj)
#pragma unroll
            for (int n = 0; n < 2; ++n) tot[bj][n] = (f32x4){0.f, 0.f, 0.f, 0.f};
        for (int z = 0; z < 3; ++z) {
            f32x4 v[2][2];
            pg8::small_tile<true>(F.lds + RING_OFF, U16 + 512 * z, 1536, Wbr + 512 * z, 1536, 512, pn, wc, v, F.wave);
            if (F.wave == 0) {
#pragma unroll
                for (int bj = 0; bj < 2; ++bj) { const int cl = 128 * bj + 32 * wc + 8 * fq; const u32x4 gw = *(const u32x4*)(GATES + (size_t)(MR + fr) * 3072 + z * 1024 + pn * 256 + cl);
                    f32x4 a = v[bj][0], b = v[bj][1];
                    a[0] *= bflo(gw.x); a[1] *= bfhi(gw.x); a[2] *= bflo(gw.y); a[3] *= bfhi(gw.y); b[0] *= bflo(gw.z); b[1] *= bfhi(gw.z); b[2] *= bflo(gw.w); b[3] *= bfhi(gw.w);
                    tot[bj][0] += a; tot[bj][1] += b; }
            }
        }
        if (F.wave == 0) {
#pragma unroll
            for (int bj = 0; bj < 2; ++bj) { const int cl = 128 * bj + 32 * wc + 8 * fq; *(u32x4*)(MIXED + (size_t)(MR + fr) * D + pn * 256 + cl) = pack8(tot[bj][0], tot[bj][1]); }
        }
    }
}

__device__ __forceinline__ int prev_row(int r, int d) {
    if (r >= MR) { const int j = r - MR - d; return j >= 0 ? MR + j : -1; }
    const int s = r & 4095; if (s >= d) return r - d; return MR + NM + s - d;
}
__device__ __forceinline__ void conv_pass(Frame& F, const float* cw) {
    const bf16_t* CONV = WSP(bf16_t, WS_CONV); bf16_t* U = WSP(bf16_t, WS_U);
    const int gt = F.vcu * 512 + F.tid, NT = F.G * 512, c8 = (gt & 63) * 8;
    f32x4 w0[3], w1[3];
#pragma unroll
    for (int k = 0; k < 3; ++k) { w0[k] = *(const GAS f32x4*)(cw + k * 512 + c8); w1[k] = *(const GAS f32x4*)(cw + k * 512 + c8 + 4); }
    for (int i = gt; i < MROWS * 64; i += 2 * NT) {
        u32x4 cv[2][3], hv[2][3], bv[2]; float mk[2][3];
#pragma unroll
        for (int q = 0; q < 2; ++q) { const int iq = i + q * NT; const int r = (iq < MROWS * 64 ? iq : i) >> 6;
#pragma unroll
            for (int k = 0; k < 3; ++k) { const int rr = (k == 2) ? r : prev_row(r, 2 - k); mk[q][k] = rr < 0 ? 0.f : 1.f; const int rc = rr < 0 ? r : rr;
                cv[q][k] = *(const GAS u32x4*)(CONV + (size_t)rc * 1536 + 512 + c8); hv[q][k] = *(const GAS u32x4*)(CONV + (size_t)rc * 1536 + 1024 + c8); }
            bv[q] = *(const GAS u32x4*)(CONV + (size_t)r * 1536 + c8); }
#pragma unroll
        for (int q = 0; q < 2; ++q) { const int iq = i + q * NT; if (iq >= MROWS * 64) continue; const int r = iq >> 6; float y[8];
#pragma unroll
            for (int e = 0; e < 8; ++e) y[e] = 0.f;
#pragma unroll
            for (int k = 0; k < 3; ++k) { const u32x4 c = cv[q][k], hh = hv[q][k]; const f32x4 a0 = w0[k] * mk[q][k], a1 = w1[k] * mk[q][k];
                y[0] += a0[0] * bflo(c.x) * bflo(hh.x); y[1] += a0[1] * bfhi(c.x) * bfhi(hh.x); y[2] += a0[2] * bflo(c.y) * bflo(hh.y); y[3] += a0[3] * bfhi(c.y) * bfhi(hh.y);
                y[4] += a1[0] * bflo(c.z) * bflo(hh.z); y[5] += a1[1] * bfhi(c.z) * bfhi(hh.z); y[6] += a1[2] * bflo(c.w) * bflo(hh.w); y[7] += a1[3] * bfhi(c.w) * bfhi(hh.w); }
            const u32x4 bq = bv[q];
            u32x4 o; o.x = pk2(bflo(bq.x) * y[0], bfhi(bq.x) * y[1]); o.y = pk2(bflo(bq.y) * y[2], bfhi(bq.y) * y[3]); o.z = pk2(bflo(bq.z) * y[4], bfhi(bq.z) * y[5]); o.w = pk2(bflo(bq.w) * y[6], bfhi(bq.w) * y[7]);
            *(GAS u32x4*)(U + (size_t)r * 1536 + 512 + c8) = o; }
    }
}
__device__ __forceinline__ void attcomb_pass(Frame& F, const float* sg, int l) {
    const bf16_t* O = WSP(bf16_t, WS_O); bf16_t* U = WSP(bf16_t, WS_U);
    const int gw = F.vcu * NWAVES + F.wave, NGW = F.G * NWAVES;
    const float lam = SMALLF[SM_SCAL + l * 4], oml = SMALLF[SM_SCAL + l * 4 + 1];
    const int c8 = F.lane * 8; const f32x4 g0 = *(const f32x4*)(sg + (c8 & 127)), g1 = *(const f32x4*)(sg + (c8 & 127) + 4);
    for (int r = gw; r < MROWS; r += NGW) {
        const int ar = (r < MR) ? (r >> 12) * TP + NM + (r & 4095) : (r - MR);
        const u32x4 a = *(const u32x4*)(O + (size_t)ar * 1024 + c8), b = *(const u32x4*)(O + (size_t)ar * 1024 + 512 + c8);
        float d[8]; d[0] = bflo(a.x) - lam * bflo(b.x); d[1] = bfhi(a.x) - lam * bfhi(b.x); d[2] = bflo(a.y) - lam * bflo(b.y); d[3] = bfhi(a.y) - lam * bfhi(b.y);
        d[4] = bflo(a.z) - lam * bflo(b.z); d[5] = bfhi(a.z) - lam * bfhi(b.z); d[6] = bflo(a.w) - lam * bflo(b.w); d[7] = bfhi(a.w) - lam * bfhi(b.w);
        float ss = 0.f;
#pragma unroll
        for (int e = 0; e < 8; ++e) ss += d[e] * d[e];
        ss = xadd<1>(ss); ss = xadd<2>(ss); ss = xadd<4>(ss); ss = xadd<8>(ss);
        const float sc = rsqrtf(ss * (1.f / 128.f) + EPS) * oml;
        u32x4 o; o.x = pk2(d[0] * sc * g0[0], d[1] * sc * g0[1]); o.y = pk2(d[2] * sc * g0[2], d[3] * sc * g0[3]); o.z = pk2(d[4] * sc * g1[0], d[5] * sc * g1[1]); o.w = pk2(d[6] * sc * g1[2], d[7] * sc * g1[3]);
        *(u32x4*)(U + (size_t)r * 1536 + c8) = o;
    }
}

constexpr int HA_QP = 0, HA_KP = 43520, HA_KT = HA_KP + 17408, HA_VT = HA_KT + 18432, HA_PB = HA_VT + 18432, HA_TOT = HA_PB + 9216;
__device__ __forceinline__ int qp_base(int j) { return j == 0 ? 0 : (j == 1 ? 64 : (j == 2 ? 112 : 144)); }
struct HgIn { float lf[16], qv[16], vv[16]; };
__device__ __forceinline__ void hgrnA_load(Frame& F, int id, HgIn& in) {
    const bool meta = id >= 1024; const int bh = meta ? 0 : id >> 6, c = id & 63, h = meta ? id - 1024 : bh & 3, b = bh >> 2;
    const int row0 = meta ? MR : b * SEQ + c * 64, nvalid = meta ? NM : 64;
    const int d = F.tid & 127, i = F.tid >> 7;
    const bf16_t* HQ = WSP(bf16_t, WS_HQ); const bf16_t* HV = WSP(bf16_t, WS_HV); const float* LOGF = WSP(float, WS_LOGF);
#pragma unroll
    for (int j = 0; j < 16; ++j) { const int t = 16 * i + j; const bool ok = t < nvalid; const size_t off = (size_t)(row0 + (ok ? t : 0)) * 512 + h * 128 + d;
        const float a = LOGF[off]; const unsigned short q = HQ[off], v = HV[off]; in.lf[j] = ok ? a : 0.f; in.qv[j] = ok ? bf2f(q) : 0.f; in.vv[j] = ok ? bf2f(v) : 0.f; }
}
#ifndef HG_NORAW
#define HG_BAR() do { asm volatile("s_waitcnt lgkmcnt(0)" ::: "memory"); __builtin_amdgcn_s_barrier(); asm volatile("" ::: "memory"); } while (0)
#else
#define HG_BAR() __syncthreads()
#endif
#define HG_BAR_UNUSED()
__device__ __forceinline__ void hgrnA_compute(Frame& F, int id, const HgIn& in) {
    const bool meta = id >= 1024; const int bh = meta ? 0 : id >> 6, c = id & 63, h = meta ? id - 1024 : bh & 3, b = bh >> 2;
    const int row0 = meta ? MR : b * SEQ + c * 64, nvalid = meta ? NM : 64;
    const int d = F.tid & 127, i = F.tid >> 7;
    LAS unsigned char* L = F.lds + RING_OFF;
    const float (&lf)[16] = in.lf; const float (&qv)[16] = in.qv; const float (&vv)[16] = in.vv;
    float Lc[16]; { float s = 0.f;
#pragma unroll
        for (int j = 0; j < 16; ++j) { s += lf[j]; Lc[j] = s; } }
    LAS float* TOT = (LAS float*)(L + HA_TOT);
    TOT[i * 128 + d] = Lc[15];
    HG_BAR();
    float rho[4]; { float s = 0.f;
#pragma unroll
        for (int j = 0; j < 4; ++j) { s += TOT[j * 128 + d]; rho[j] = s; } }
    const float rhoi = (i == 0) ? rho[0] : (i == 1) ? rho[1] : (i == 2) ? rho[2] : rho[3], ri = (i == 0) ? 0.f : (i == 1) ? rho[0] : (i == 2) ? rho[1] : rho[2], glast = rho[3];
    const float fK2 = __expf(glast - rhoi), fQ2 = __expf(rhoi);
    float fQ[4];
#pragma unroll
    for (int jj = 0; jj < 4; ++jj) fQ[jj] = (jj <= i) ? __expf(rhoi - rho[jj]) : 0.f;
    LAS bf16_t* KP = (LAS bf16_t*)(L + HA_KP); LAS bf16_t* QP = (LAS bf16_t*)(L + HA_QP);
    unsigned kt[8], vt[8];
#pragma unroll
    for (int j = 0; j < 16; j += 2) {
        float kp[2], qe[2];
#pragma unroll
        for (int q = 0; q < 2; ++q) { const float G = ri + Lc[j + q], E = __expf(G - rhoi), k = 1.f - __expf(lf[j + q]); kp[q] = k * __builtin_amdgcn_rcpf(E); qe[q] = qv[j + q] * E; }
        const int t = 16 * i + j;
        { const unsigned w = cvt_pk_bf16(kp[0], kp[1]); KP[t * 136 + d] = (bf16_t)(w & 0xffffu); KP[(t + 1) * 136 + d] = (bf16_t)(w >> 16); }
        kt[j >> 1] = cvt_pk_bf16(kp[0] * fK2, kp[1] * fK2); vt[j >> 1] = cvt_pk_bf16(vv[j], vv[j + 1]);
#pragma unroll
        for (int jj = 0; jj < 4; ++jj) if (jj <= i) { const unsigned w = cvt_pk_bf16(qe[0] * fQ[jj], qe[1] * fQ[jj]); const int rb = qp_base(jj) + t - 16 * jj; QP[rb * 136 + d] = (bf16_t)(w & 0xffffu); QP[(rb + 1) * 136 + d] = (bf16_t)(w >> 16); }
        { const unsigned w = cvt_pk_bf16(qe[0] * fQ2, qe[1] * fQ2); bf16_t* hq2 = WSP(bf16_t, WS_HQ2) + (size_t)(row0 + t) * 512 + h * 128 + d;
          if (t < nvalid) hq2[0] = (bf16_t)(w & 0xffffu); if (t + 1 < nvalid) hq2[512] = (bf16_t)(w >> 16); }
    }
    { LAS u32x4* ktp = (LAS u32x4*)(L + HA_KT + d * 144 + i * 32); ktp[0] = (u32x4){kt[0], kt[1], kt[2], kt[3]}; ktp[1] = (u32x4){kt[4], kt[5], kt[6], kt[7]};
      LAS u32x4* vtp = (LAS u32x4*)(L + HA_VT + d * 144 + i * 32); vtp[0] = (u32x4){vt[0], vt[1], vt[2], vt[3]}; vtp[1] = (u32x4){vt[4], vt[5], vt[6], vt[7]}; }
    if (i == 0) WSP(float, WS_DEC)[(size_t)id * 128 + d] = __expf(glast);
    HG_BAR();
    const int w = F.wave, fr = F.lane & 15, fq = F.lane >> 4;
    {
        LAS unsigned char* PB = L + HA_PB;
        for (int blk = w; blk < 16; blk += 8) {
            int it, js;
            if (blk < 10) { it = (blk >= 6) ? 3 : (blk >= 3) ? 2 : (blk >= 1) ? 1 : 0; js = blk - ((it * (it + 1)) >> 1); }
            else { const int q = blk - 10; it = (q < 3) ? 0 : (q < 5) ? 1 : 2; js = (q < 3) ? q + 1 : (q < 5) ? q - 1 : 3; }
            f32x4 acc = (f32x4){0.f, 0.f, 0.f, 0.f};
            if (blk < 10) {
#pragma unroll
                for (int ks = 0; ks < 4; ++ks) {
                    const bf16x8 qa = *(const LAS bf16x8*)(L + HA_QP + ((qp_base(js) + 16 * it - 16 * js + fr) * 136 + 32 * ks + 8 * fq) * 2);
                    const bf16x8 kb = *(const LAS bf16x8*)(L + HA_KP + ((16 * js + fr) * 136 + 32 * ks + 8 * fq) * 2);
                    acc = __builtin_amdgcn_mfma_f32_16x16x32_bf16(kb, qa, acc, 0, 0, 0);
                }
                if (it == js) {
#pragma unroll
                    for (int e = 0; e < 4; ++e) if (4 * fq + e > fr) acc[e] = 0.f;
                }
            }
            u32x2 pw; pw.x = pk2(acc[0], acc[1]); pw.y = pk2(acc[2], acc[3]);
            *(LAS u32x2*)(PB + (16 * it + fr) * 144 + (16 * js + 4 * fq) * 2) = pw;
        }
    }
    HG_BAR();
    {
        const int tb = w >> 1, dv0 = (w & 1) * 4;
        f32x4 acc[4];
#pragma unroll
        for (int q = 0; q < 4; ++q) acc[q] = (f32x4){0.f, 0.f, 0.f, 0.f};
#pragma unroll
        for (int ks = 0; ks < 2; ++ks) {
            const bf16x8 pa = *(const LAS bf16x8*)(L + HA_PB + (16 * tb + fr) * 144 + (32 * ks + 8 * fq) * 2);
#pragma unroll
            for (int q = 0; q < 4; ++q) { const bf16x8 vb = *(const LAS bf16x8*)(L + HA_VT + (16 * (dv0 + q) + fr) * 144 + (32 * ks + 8 * fq) * 2);
                acc[q] = __builtin_amdgcn_mfma_f32_16x16x32_bf16(vb, pa, acc[q], 0, 0, 0); }
        }
        const int t = 16 * tb + fr;
        if (t < nvalid) {
#pragma unroll
            for (int q = 0; q < 4; ++q) *(f32x4*)(WSP(float, WS_OI) + (size_t)(row0 + t) * 512 + h * 128 + 16 * (dv0 + q) + 4 * fq) = acc[q];
        }
    }
    {
        f32x4 acc[8];
#pragma unroll
        for (int q = 0; q < 8; ++q) acc[q] = (f32x4){0.f, 0.f, 0.f, 0.f};
#pragma unroll
        for (int ks = 0; ks < 2; ++ks) {
            const bf16x8 va = *(const LAS bf16x8*)(L + HA_VT + (16 * w + fr) * 144 + (32 * ks + 8 * fq) * 2);
#pragma unroll
            for (int q = 0; q < 8; ++q) { const bf16x8 kb = *(const LAS bf16x8*)(L + HA_KT + (16 * q + fr) * 144 + (32 * ks + 8 * fq) * 2);
                acc[q] = __builtin_amdgcn_mfma_f32_16x16x32_bf16(kb, va, acc[q], 0, 0, 0); }
        }
        float* DS = WSP(float, WS_DS) + (size_t)id * 16384 + (size_t)(16 * w + fr) * 128;
#pragma unroll
        for (int q = 0; q < 8; ++q) *(f32x4*)(DS + 16 * q + 4 * fq) = acc[q];
    }
    HG_BAR();
}
__device__ __forceinline__ void hgrn_scan(Frame& F) {
    const float* DS = WSP(float, WS_DS); const float* DEC = WSP(float, WS_DEC); bf16_t* ST = WSP(bf16_t, WS_ST);
    const int gt = F.vcu * 512 + F.tid, NT = F.G * 512;
    typedef float f32x2 __attribute__((ext_vector_type(2)));
    for (int idx = gt; idx < 16 * 8192; idx += NT) {
        const int bh = idx >> 13, e2 = (idx & 8191) * 2, dk = e2 & 127, h = bh & 3;
        f32x2 s = *(const GAS f32x2*)(DS + (size_t)(1024 + h) * 16384 + e2);
        for (int c0 = 0; c0 < 64; c0 += 16) {
            f32x2 dd[16], ds[16];
#pragma unroll
            for (int j = 0; j < 16; ++j) { const size_t id = (size_t)bh * 64 + c0 + j; dd[j] = *(const GAS f32x2*)(DEC + id * 128 + dk); ds[j] = *(const GAS f32x2*)(DS + id * 16384 + e2); }
#pragma unroll
            for (int j = 0; j < 16; ++j) { const size_t id = (size_t)bh * 64 + c0 + j; *(GAS unsigned*)(ST + id * 16384 + e2) = pk2(s.x, s.y); s = dd[j] * s + ds[j]; }
        }
    }
}
__device__ __forceinline__ void hgrnC_pass(Frame& F, const float* og) {
    const bf16_t* HQ = WSP(bf16_t, WS_HQ2); const bf16_t* HG = WSP(bf16_t, WS_HG); const float* OI = WSP(float, WS_OI); const bf16_t* ST = WSP(bf16_t, WS_ST); bf16_t* U = WSP(bf16_t, WS_U);
    const int gw = F.vcu * NWAVES + F.wave, NGW = F.G * NWAVES, fr = F.lane & 15, fq = F.lane >> 4;
    for (int task = gw; task < 1024 * 4 + 4; task += NGW) {
        const bool meta = task >= 4096; const int id = meta ? 0 : task >> 2, tb = meta ? 0 : task & 3, bh = id >> 6, c = id & 63, h = meta ? task - 4096 : bh & 3, b = bh >> 2;
        const int row = (meta ? MR : b * SEQ + c * 64 + 16 * tb) + fr;
        f32x4 acc[8], og4[8]; u32x2 hg2[8];
#pragma unroll
        for (int q = 0; q < 8; ++q) { acc[q] = *(const GAS f32x4*)(OI + (size_t)row * 512 + h * 128 + 16 * q + 4 * fq);
            og4[q] = *(const GAS f32x4*)(og + 16 * q + 4 * fq); hg2[q] = *(const GAS u32x2*)(HG + (size_t)row * 512 + h * 128 + 16 * q + 4 * fq); }
        if (!meta) {
            const bf16_t* Sb = ST + (size_t)id * 16384;
#pragma unroll
            for (int ks = 0; ks < 4; ++ks) {
                const bf16x8 qa = *(const bf16x8*)(HQ + (size_t)row * 512 + h * 128 + 32 * ks + 8 * fq);
#pragma unroll
                for (int q = 0; q < 8; ++q) { const bf16x8 sb = *(const bf16x8*)(Sb + (size_t)(16 * q + fr) * 128 + 32 * ks + 8 * fq);
                    acc[q] = __builtin_amdgcn_mfma_f32_16x16x32_bf16(sb, qa, acc[q], 0, 0, 0); }
            }
        }
        float ss = 0.f;
#pragma unroll
        for (int q = 0; q < 8; ++q) ss += (acc[q][0] * acc[q][0] + acc[q][1] * acc[q][1]) + (acc[q][2] * acc[q][2] + acc[q][3] * acc[q][3]);
        ss = xadd<16>(ss); ss = xadd<32>(ss);
        const float sc = rsqrtf(ss * (1.f / 128.f) + EPS);
#pragma unroll
        for (int q = 0; q < 8; ++q) { const int dv = 16 * q + 4 * fq; const f32x4 g = og4[q]; const u32x2 gg = hg2[q];
            u32x2 o; o.x = pk2(acc[q][0] * sc * g[0] * bflo(gg.x), acc[q][1] * sc * g[1] * bfhi(gg.x)); o.y = pk2(acc[q][2] * sc * g[2] * bflo(gg.y), acc[q][3] * sc * g[3] * bfhi(gg.y));
            *(GAS u32x2*)(U + (size_t)row * 1536 + 1024 + h * 128 + dv) = o; }
    }
}
struct TokInfo { int e1, s1, e2, s2; float w1, w2; int pad0, pad1; };
__device__ __forceinline__ void convert_moe_gu(Frame& F, int early = -1, int widx = 0, int nw = 1, int skip = -1) {
    LAS float* scr = early >= 0 ? (LAS float*)(F.lds + RING_OFF + F.wave * 16384) : (LAS float*)(F.lds + RING_OFF + 32768 + F.wave * 8704);
    const int gw = early >= 0 ? widx : F.vcu * NWAVES + F.wave, NGW = early >= 0 ? nw : F.G * NWAVES;
    constexpr int I_GU = 16 * 224;
    const int ne = early >= 0 ? 1 : (skip >= 0 ? NE - 1 : NE);
    const auto dec = [&](int it) -> CvtItem { int e = it / I_GU; const int r = it - e * I_GU, kb = r / 224, db = r % 224, tile = db >> 3, l32 = db & 7;
        e = early >= 0 ? early : (skip >= 0 && e >= skip ? e + 1 : e);
        const float* src = ((l32 < 4) ? F.in[19] : F.in[20]) + (size_t)e * D * FFE;
        return CvtItem{src, FFE, kb * 64, tile * 128 + (l32 & 3) * 32, F.ws + WS_MGU + (size_t)e * 7168 * D, D, db * 32}; };
    cvt_run<true>(gw, NGW, ne * I_GU, dec, scr, F.lane, W8_SCALE);
}
__device__ __forceinline__ void convert_moe_down(Frame& F, int widx, int nw) {
    LAS float* scr = (LAS float*)(F.lds + RING_OFF + F.wave * 16384);
    constexpr int I_DN = 56 * 32;
    const auto dec = [&](int it) -> CvtItem { const int e = it / I_DN, r = it - e * I_DN, kb = r >> 5, db = r & 31;
        return CvtItem{F.in[21] + (size_t)e * FFE * D, D, kb * 64, db * 32, F.ws + WS_MD + (size_t)e * D * FFE, FFE, db * 32}; };
    cvt_run<true>(widx, nw, NE * I_DN, dec, scr, F.lane, WD8_SCALE);
}
__device__ __forceinline__ void norm_route_pass(Frame& F, const float* gain) {
    LAS float* rwl = (LAS float*)(F.lds + RING_OFF);
    for (int i = F.tid; i < D * NE / 4; i += 512) ((LAS f32x4*)rwl)[i] = ((const f32x4*)F.in[18])[i];
    __syncthreads();
    const int gw = F.vcu * NWAVES + F.wave, NGW = F.G * NWAVES;
    f32x4 gv[4];
#pragma unroll
    for (int j = 0; j < 4; ++j) gv[j] = ((const f32x4*)gain)[F.lane + 64 * j];
    unsigned* cnt = (unsigned*)(F.ws + WS_CTL) + CW_CNT; int* lists = (int*)(F.ws + WS_SMALL + SMB_LIST); TokInfo* ti = (TokInfo*)(F.ws + WS_SMALL + SMB_TOK);
    f32x4 vn[4];
    { const GAS f32x4* x0 = (const GAS f32x4*)(F.out + (size_t)(gw < MR ? gw : 0) * D) + F.lane;
#pragma unroll
      for (int j = 0; j < 4; ++j) vn[j] = x0[64 * j]; }
    for (int r = gw; r < MR; r += NGW) {
        f32x4 v[4]; float s = 0.f;
#pragma unroll
        for (int j = 0; j < 4; ++j) v[j] = vn[j];
        { const int rn = r + NGW; const GAS f32x4* xn = (const GAS f32x4*)(F.out + (size_t)(rn < MR ? rn : r) * D) + F.lane;
#pragma unroll
          for (int j = 0; j < 4; ++j) vn[j] = xn[64 * j]; }
#pragma unroll
        for (int j = 0; j < 4; ++j) s += (v[j].x * v[j].x + v[j].y * v[j].y) + (v[j].z * v[j].z + v[j].w * v[j].w);
        const float sc = rsqrtf(wave_sum(s) * (1.f / D) + EPS);
        GAS unsigned* o = (GAS unsigned*)(F.ws + WS_HN + (size_t)r * D) + F.lane;
        float lg[8];
#pragma unroll
        for (int e = 0; e < 8; ++e) lg[e] = 0.f;
#pragma unroll
        for (int j = 0; j < 4; ++j) {
            v[j] = v[j] * sc * gv[j];
            o[64 * j] = pk4_fp8(v[j].x, v[j].y, v[j].z, v[j].w);
#pragma unroll
            for (int q = 0; q < 4; ++q) { const int d = (F.lane + 64 * j) * 4 + q; const f32x4 r0 = *(const LAS f32x4*)(rwl + d * 8), r1 = *(const LAS f32x4*)(rwl + d * 8 + 4); const float x = v[j][q];
                lg[0] += x * r0[0]; lg[1] += x * r0[1]; lg[2] += x * r0[2]; lg[3] += x * r0[3]; lg[4] += x * r1[0]; lg[5] += x * r1[1]; lg[6] += x * r1[2]; lg[7] += x * r1[3]; }
        }
#pragma unroll
        for (int e = 0; e < 8; ++e) lg[e] = wave_sum(lg[e]);
        int i1 = 0; float m1 = lg[0];
#pragma unroll
        for (int e = 1; e < 8; ++e) if (lg[e] > m1) { m1 = lg[e]; i1 = e; }
        int i2 = -1; float m2 = -INFINITY;
#pragma unroll
        for (int e = 0; e < 8; ++e) if (e != i1 && lg[e] > m2) { m2 = lg[e]; i2 = e; }
        if (F.lane == 0) {
            const float w1 = 1.f / (1.f + expf(m2 - m1));
            const unsigned s1 = __hip_atomic_fetch_add(cnt + 64 * i1, 1u, RLX_AGENT), s2 = __hip_atomic_fetch_add(cnt + 64 * i2, 1u, RLX_AGENT);
            lists[i1 * LISTCAP + s1] = r; lists[i2 * LISTCAP + s2] = r;
            TokInfo t; t.e1 = i1; t.s1 = (int)s1; t.e2 = i2; t.s2 = (int)s2; t.w1 = w1; t.w2 = 1.f - w1; t.pad0 = 0; t.pad1 = 0; ti[r] = t;
        }
    }
}
struct MoeTiles { int ts[9]; };
__device__ __forceinline__ MoeTiles moe_tiles(Frame& F) {
    MoeTiles m; const unsigned* cnt = (const unsigned*)(F.ws + WS_CTL) + CW_CNT; int a = 0;
#pragma unroll
    for (int e = 0; e < 8; ++e) { m.ts[e] = a; const unsigned c = (unsigned)__builtin_amdgcn_readfirstlane((int)__hip_atomic_load(cnt + 64 * e, RLX_AGENT)); a += (int)((c + 255u) >> 8); }
    m.ts[8] = a; return m;
}
__device__ __forceinline__ int moe_expert_of(const MoeTiles& m, int rt) { int e = 0;
#pragma unroll
    for (int k = 1; k < 8; ++k) e += (rt >= m.ts[k]) ? 1 : 0;
    return e; }
struct MoeGuOrder {
    MoeTiles m; int G, c; const int* lists;
    __device__ __forceinline__ bool next(int i, Unit& u) const {
        const int L = i * G + c; if (L >= m.ts[8] * 28) return false;
        const int rt = L / 28, pn = L - rt * 28, e = moe_expert_of(m, rt);
        int tsb = 0;
#pragma unroll
        for (int k = 0; k < 8; ++k) tsb = (k == e) ? m.ts[k] : tsb;
        u.pm = rt; u.pn = pn; u.z = e; u.a_off = 0u; u.b_off = (unsigned)(((long)e * 7168 + pn * 256) * D); u.gidx = lists + e * LISTCAP + (rt - tsb) * 256; return true;
    }
};
struct MoeDownOrder {
    MoeTiles m; int G, c;
    __device__ __forceinline__ bool next(int i, Unit& u) const {
        const int nt = m.ts[8] < 128 ? m.ts[8] : 128; const int L = i * G + c; if (L >= nt * 4) return false;
        const int rt = L >> 2, pn = L & 3, e = moe_expert_of(m, rt);
        u.pm = rt; u.pn = pn; u.z = e; u.a_off = (unsigned)((long)rt * 256 * FFE); u.b_off = (unsigned)(((long)e * D + pn * 256) * FFE); u.gidx = nullptr; return true;
    }
};
struct MoeSlabOrder {
    MoeTiles m; int G, c, S, Kp;
    __device__ __forceinline__ bool next(int i, Unit& u) const {
        const int nleft = (m.ts[8] - 128) * 4; const int q = i * G + c; if (q >= nleft * S) return false;
        const int up = q / S, sl = q - up * S, rt = 128 + (up >> 2), pn = up & 3, e = moe_expert_of(m, rt);
        u.pm = rt; u.pn = pn; u.z = q; u.a_off = (unsigned)((long)rt * 256 * FFE + (long)sl * Kp * 2); u.b_off = (unsigned)(((long)e * D + pn * 256) * FFE + (long)sl * Kp * 2); u.gidx = nullptr; return true;
    }
};
struct EpiSlab {
    static constexpr bool PERM = false, MID = false;
    float* SL; float sc;
    __device__ __forceinline__ void row(const Unit& u, int r, int slot, int wc, int fq, const f32x4 (&v)[2][2]) const {
        float* p = SL + (size_t)u.z * 65536 + (size_t)(r & 255) * 256 + 32 * wc + 4 * fq;
#pragma unroll
        for (int bj = 0; bj < 2; ++bj)
#pragma unroll
            for (int n = 0; n < 2; ++n) *(f32x4*)(p + 128 * bj + 16 * n) = v[bj][n] * sc;
    }
};
__device__ __forceinline__ void moe_slab_split(int tiles, int G, int& S, int& Kp) { S = 7; Kp = 256; }
struct EpiY {
    static constexpr bool PERM = true, MID = false;
    bf16_t* Y; float sc;
    __device__ __forceinline__ void row(const Unit& u, int r, int slot, int wc, int fq, const f32x4 (&v)[2][2]) const {
#pragma unroll
        for (int bj = 0; bj < 2; ++bj) *(u32x4*)(Y + (size_t)r * D + u.pn * 256 + 128 * bj + 32 * wc + 8 * fq) = pack8(v[bj][0] * sc, v[bj][1] * sc);
    }
};
__device__ __forceinline__ f32x4 moe_y4(const bf16_t* Y, const float* SL, int S, size_t R, int j, int lane) {
    if (R < 32768) { const u32x2 y = *((const GAS u32x2*)(Y + R * D) + lane + 64 * j); return (f32x4){bflo(y.x), bfhi(y.x), bflo(y.y), bfhi(y.y)}; }
    const float* p = SL + ((size_t)(((R >> 8) - 128) * 4 + j) * S) * 65536 + (R & 255) * 256 + 4 * lane; f32x4 a = (f32x4){0.f, 0.f, 0.f, 0.f};
    for (int s0 = 0; s0 < S; s0 += 7) {
        f32x4 q[7];
#pragma unroll
        for (int sl = 0; sl < 7; ++sl) q[sl] = *(const f32x4*)(p + (size_t)(s0 + sl) * 65536);
#pragma unroll
        for (int sl = 0; sl < 7; ++sl) a += q[sl];
    }
    return a;
}
__device__ __forceinline__ void moe_combine_pass(Frame& F) {
    const MoeTiles m = moe_tiles(F); const TokInfo* ti = (const TokInfo*)(F.ws + WS_SMALL + SMB_TOK); const bf16_t* Y = WSP(bf16_t, WS_MY); const float* SL = WSP(float, WS_SLAB);
    int S, Kp; moe_slab_split(m.ts[8], F.G, S, Kp);
    const int gw = F.vcu * NWAVES + F.wave, NGW = F.G * NWAVES;
    TokInfo tn = ti[gw < MR ? gw : 0];
    for (int r = gw; r < MR; r += NGW) {
        const TokInfo t = tn; { const int rn = r + NGW; tn = ti[rn < MR ? rn : r]; }
        int b1 = 0, b2 = 0;
#pragma unroll
        for (int k = 0; k < 8; ++k) { b1 = (k == t.e1) ? m.ts[k] : b1; b2 = (k == t.e2) ? m.ts[k] : b2; }
        const size_t r1 = (size_t)b1 * 256 + t.s1, r2 = (size_t)b2 * 256 + t.s2;
        GAS f32x4* o = (GAS f32x4*)(F.out + (size_t)r * D) + F.lane;
        if (r1 < 32768 && r2 < 32768) {
            u32x2 y1[4], y2[4]; f32x4 x[4];
#pragma unroll
            for (int j = 0; j < 4; ++j) { y1[j] = *((const GAS u32x2*)(Y + r1 * D) + F.lane + 64 * j); y2[j] = *((const GAS u32x2*)(Y + r2 * D) + F.lane + 64 * j); x[j] = o[64 * j]; }
#pragma unroll
            for (int j = 0; j < 4; ++j) { x[j][0] += t.w1 * bflo(y1[j].x) + t.w2 * bflo(y2[j].x); x[j][1] += t.w1 * bfhi(y1[j].x) + t.w2 * bfhi(y2[j].x); x[j][2] += t.w1 * bflo(y1[j].y) + t.w2 * bflo(y2[j].y); x[j][3] += t.w1 * bfhi(y1[j].y) + t.w2 * bfhi(y2[j].y); o[64 * j] = x[j]; }
        } else {
#pragma unroll
            for (int j = 0; j < 4; ++j) { const f32x4 y1 = moe_y4(Y, SL, S, r1, j, F.lane), y2 = moe_y4(Y, SL, S, r2, j, F.lane); o[64 * j] = o[64 * j] + y1 * t.w1 + y2 * t.w2; }
        }
    }
}
}
namespace mk {
enum { P_CVT = 0, P_NORM1, P_PROJ, P_MIX, P_SCAN, P_FIN, P_GATES, P_MERGE, P_WOUT, P_NORM2, P_GU, P_DOWN, P_COMB, P_NPH };
struct Args { const float* in[22]; float* out; unsigned char* ws; unsigned pmask; int l0, l1; unsigned dup; };

#define PH(k) ((a.pmask >> (k)) & 1u)
#define PHASE_FRAME() Frame F = F0; { const int t_ = pg8::make_tid(F0.wave); F.tid = t_; F.lane = t_ & 63; F.wave = F0.wave; unsigned char* w_ = F0.ws; asm volatile("" : "+s"(w_)); F.ws = w_; int g_ = F0.G, v_ = F0.vcu; asm volatile("" : "+s"(g_), "+s"(v_)); F.G = g_; F.vcu = v_; } float* sm = SMALLF; (void)sm
#define GRID_BAR() xcd_barrier(bar, F.tid)
template <int l> __device__ __forceinline__ void layer_body(const Args& a, const Frame& F0, const XcdBarrier& bar, unsigned char* lds) {
    constexpr bool first = (l == 0);
#ifndef NO_P_CVT
        if (PH(P_CVT) && l == 0) for (int rep_ = 0; rep_ <= (int)((a.dup >> (16 + l)) & (a.dup >> P_CVT) & 1u); ++rep_) { PHASE_FRAME(); setup_small(F); convert_layer_weights(F, 0, -1, 0, F.G == 256 ? 1 : 0); }
#endif
#ifndef NO_P_NORM1
        if (PH(P_NORM1)) for (int rep_ = 0; rep_ <= (int)((a.dup >> (16 + l)) & (a.dup >> P_NORM1) & 1u); ++rep_) { PHASE_FRAME(); norm_pass(F, F.in[2] + l * D, first, true); GRID_BAR(); }
#endif
#ifndef NO_P_PROJ
        if (PH(P_PROJ)) for (int rep_ = 0; rep_ <= (int)((a.dup >> (16 + l)) & (a.dup >> P_PROJ) & 1u); ++rep_) { PHASE_FRAME();
            Gemm g{WSP(bf16_t, WS_HN), WSP(bf16_t, WS_WIN), D, D, D}; TileOrder S; S.init(64, 20, 0, F.G, (int)blockIdx.x, D, D);
            EpiProj E{F.ws, F.in[5] + l * 64, F.in[6] + l * 64, l, 1.f};
            pg8::gemm_phase<EpiProj, TileOrder>(F.lds + RING_OFF, g, S, E, F.wave);
            meta_gemm(F, WSP(bf16_t, WS_HN) + (size_t)MR * D, D, WSP(bf16_t, WS_WIN), D, D, 0, 20, E);
            GRID_BAR();
        }
#endif
#ifndef NO_P_MIX
        if (PH(P_MIX)) for (int rep_ = 0; rep_ <= (int)((a.dup >> (16 + l)) & (a.dup >> P_MIX) & 1u); ++rep_) { PHASE_FRAME();
            if (!(a.dup & 0x8000u) || rep_ == 0) {
                if (F.G == 256) {
                    const bool hm = (F.vcu & 7) == 0 && F.vcu < 32; const int idm = 1024 + (F.vcu >> 3);
                    HgIn A, B; hgrnA_load(F, F.vcu, A); hgrnA_load(F, F.vcu + 256, B); hgrnA_compute(F, F.vcu, A);
                    hgrnA_load(F, F.vcu + 512, A); hgrnA_compute(F, F.vcu + 256, B); hgrnA_load(F, F.vcu + 768, B); hgrnA_compute(F, F.vcu + 512, A);
                    if (hm) hgrnA_load(F, idm, A);
                    hgrnA_compute(F, F.vcu + 768, B); if (hm) hgrnA_compute(F, idm, A); }
                else for (int id = F.vcu; id < 1028; id += F.G) { HgIn A; hgrnA_load(F, id, A); hgrnA_compute(F, id, A); }
            }
            if (rep_ == 1 && !(a.dup & 0x8000u)) { GRID_BAR(); continue; }
            conv_pass(F, F.in[10] + l * 1536);
            { LAS float* tabl = (LAS float*)(F.lds + RING_OFF + attn_body::LDS_TAB); tabl[F.tid] = sm[SM_TAB + F.tid]; }
            __syncthreads();
            { int b, vh, qb;
              for (int i = 0; attn_body::attn_next(F.G, F.vcu, i, b, vh, qb); ++i)
                  attn_body::attn_unit<8>(b, vh, qb, (const attn_body::bf16*)WSP(bf16_t, WS_QK), (const attn_body::bf16*)WSP(bf16_t, WS_V), (attn_body::bf16*)WSP(bf16_t, WS_O), (char*)lds + RING_OFF, F.wave); }
            if (l == 0 && F.G == 256) {
                const int g = F.vcu & 7, bv = F.vcu >> 3;
                if (g != 7 && !(g == 0 && bv < 4)) { const int idx = bv < 4 ? bv * 6 + (g - 1) : 24 + (bv - 4) * 7 + g; convert_layer_weights(F, 0, idx * NWAVES + F.wave, 220 * NWAVES, 2); } }
            if (l == 1 && F.G == 256) {
                const int g = F.vcu & 7, bv = F.vcu >> 3;
                if (g != 7 && !(g == 0 && bv < 4)) { const int idx = bv < 4 ? bv * 6 + (g - 1) : 24 + (bv - 4) * 7 + g; convert_moe_gu(F, 3, idx * NWAVES + F.wave, 220 * NWAVES); } }
            GRID_BAR();
        }
#endif
#ifndef NO_P_SCAN
        if (PH(P_SCAN)) for (int rep_ = 0; rep_ <= (int)((a.dup >> (16 + l)) & (a.dup >> P_SCAN) & 1u); ++rep_) { PHASE_FRAME(); hgrn_scan(F); GRID_BAR(); }
#endif
#ifndef NO_P_FIN
        if (PH(P_FIN)) for (int rep_ = 0; rep_ <= (int)((a.dup >> (16 + l)) & (a.dup >> P_FIN) & 1u); ++rep_) { PHASE_FRAME(); hgrnC_pass(F, F.in[12] + l * 128); attcomb_pass(F, F.in[8] + l * 128, l); }
#endif
#ifndef NO_P_GATES
        if (PH(P_GATES)) for (int rep_ = 0; rep_ <= (int)((a.dup >> (16 + l)) & (a.dup >> P_GATES) & 1u); ++rep_) { PHASE_FRAME();
            Gemm g{(const bf16_t*)(F.ws + WS_HN8), (const bf16_t*)(F.ws + WS_WIN8 - (size_t)20 * 256 * D), D / 2, D / 2, D / 2}; TileOrder S; S.init(64, 12, 20, F.G, (int)blockIdx.x, D / 2, D / 2);
            EpiProj E{F.ws, F.in[5] + l * 64, F.in[6] + l * 64, l, 1.f / W8_SCALE};
            pg8::gemm_phase<EpiProj, TileOrder, false, true>(F.lds + RING_OFF, g, S, E, F.wave);
            if (l == 0) { EpiProj Em{F.ws, F.in[5] + l * 64, F.in[6] + l * 64, l, 1.f}; meta_gemm(F, WSP(bf16_t, WS_HN) + (size_t)MR * D, D, WSP(bf16_t, WS_WIN), D, D, 20, 32, Em); }
            GRID_BAR();
        }
#endif
#ifndef NO_P_MERGE
        if (PH(P_MERGE)) for (int rep_ = 0; rep_ <= (int)((a.dup >> (16 + l)) & (a.dup >> P_MERGE) & 1u); ++rep_) { PHASE_FRAME();
            Gemm g{WSP(bf16_t, WS_U), WSP(bf16_t, WS_WBR), 1536, 1536, 1536}; TileOrder S; S.init(64, 4, 0, F.G, (int)blockIdx.x, 1536, 1536);
            EpiMerge E{WSP(bf16_t, WS_GATES), WSP(bf16_t, WS_MIXED)};
            pg8::gemm_phase<EpiMerge, TileOrder>(F.lds + RING_OFF, g, S, E, F.wave);
            if (l == 0) meta_merge(F, WSP(bf16_t, WS_U) + (size_t)MR * 1536, WSP(bf16_t, WS_WBR), WSP(bf16_t, WS_GATES), WSP(bf16_t, WS_MIXED));
            GRID_BAR();
        }
#endif
#ifndef NO_P_WOUT
        if (PH(P_WOUT)) for (int rep_ = 0; rep_ <= (int)((a.dup >> (16 + l)) & (a.dup >> P_WOUT) & 1u); ++rep_) { PHASE_FRAME();
            Gemm g{WSP(bf16_t, WS_MIXED), WSP(bf16_t, WS_WO), D, D, D}; TileOrder S; S.init(64, 4, 0, F.G, (int)blockIdx.x, D, D);
            EpiRes E{first ? F.in[0] : (const float*)F.out, F.out, first ? F.in[1] : (const float*)(sm + SM_METAHS), sm + SM_METAHS};
            pg8::gemm_phase<EpiRes, TileOrder>(F.lds + RING_OFF, g, S, E, F.wave);
            if (l == 0) meta_gemm(F, WSP(bf16_t, WS_MIXED) + (size_t)MR * D, D, WSP(bf16_t, WS_WO), D, D, 0, 4, E);
            GRID_BAR();
        }
#endif
#ifndef NO_P_NORM2
        if (PH(P_NORM2) && l == 0) for (int rep_ = 0; rep_ <= (int)((a.dup >> (16 + l)) & (a.dup >> P_NORM2) & 1u); ++rep_) { PHASE_FRAME(); norm_pass(F, F.in[3] + l * D, false, false); if (PH(P_CVT)) setup_small(F); GRID_BAR(); }
        if (PH(P_NORM2) && l == 1) for (int rep_ = 0; rep_ <= (int)((a.dup >> (16 + l)) & (a.dup >> P_NORM2) & 1u); ++rep_) { PHASE_FRAME(); norm_route_pass(F, F.in[3] + l * D); convert_moe_gu(F, -1, 0, 1, F.G == 256 ? 3 : -1); GRID_BAR(); }
#endif
#ifndef NO_P_GU
        if (PH(P_GU) && l == 0) for (int rep_ = 0; rep_ <= (int)((a.dup >> (16 + l)) & (a.dup >> P_GU) & 1u); ++rep_) { PHASE_FRAME();
            Gemm g{WSP(bf16_t, WS_HN), WSP(bf16_t, WS_WGU0), D, D, D}; TileOrder S; S.init(64, 22, 0, F.G, (int)blockIdx.x, D, D);
            EpiGU E{WSP(bf16_t, WS_H0), FFD, 1.f};
            pg8::gemm_phase<EpiGU, TileOrder>(F.lds + RING_OFF, g, S, E, F.wave);
            meta_gemm(F, WSP(bf16_t, WS_HN) + (size_t)MR * D, D, WSP(bf16_t, WS_WGU0), D, D, 0, 22, E);
            if (PH(P_CVT) && rep_ == 0) { const int total = 64 * 22, rem = total % F.G, bx = (int)blockIdx.x;
              if (rem == 0) convert_layer_weights(F, 1, bx * NWAVES + F.wave, F.G * NWAVES); else if (bx >= rem) convert_layer_weights(F, 1, (bx - rem) * NWAVES + F.wave, (F.G - rem) * NWAVES); }
            GRID_BAR();
        }
#endif
#ifndef NO_P_DOWN
        if (PH(P_DOWN) && l == 0) for (int rep_ = 0; rep_ <= (int)((a.dup >> (16 + l)) & (a.dup >> P_DOWN) & 1u); ++rep_) { PHASE_FRAME();
            Gemm g{WSP(bf16_t, WS_H0), WSP(bf16_t, WS_WD0), FFD, FFD, FFD}; TileOrder S; S.init(64, 4, 0, F.G, (int)blockIdx.x, FFD, FFD);
            EpiRes E{(const float*)F.out, F.out, (const float*)(sm + SM_METAHS), sm + SM_METAHS};
            pg8::gemm_phase<EpiRes, TileOrder>(F.lds + RING_OFF, g, S, E, F.wave);
            meta_gemm(F, WSP(bf16_t, WS_H0) + (size_t)MR * FFD, FFD, WSP(bf16_t, WS_WD0), FFD, FFD, 0, 4, E);
            GRID_BAR();
        }
#endif
#ifndef NO_P_MOE
        if (PH(P_GU) && l == 1) for (int rep_ = 0; rep_ <= (int)((a.dup >> (16 + l)) & (a.dup >> P_GU) & 1u); ++rep_) { PHASE_FRAME();
            Gemm g{WSP(bf16_t, WS_HN), WSP(bf16_t, WS_MGU), D / 2, D / 2, D / 2};   MoeGuOrder S{moe_tiles(F), F.G, (int)blockIdx.x, (const int*)(F.ws + WS_SMALL + SMB_LIST)};
            EpiGU8 E{F.ws + WS_MH, FFE, 1.f / W8_SCALE};
            pg8::gemm_phase<EpiGU8, MoeGuOrder, true, true>(F.lds + RING_OFF, g, S, E, F.wave);
            { const int total = S.m.ts[8] * 28, rem = total % F.G, bx = (int)blockIdx.x;
              if (rem == 0) convert_moe_down(F, bx * NWAVES + F.wave, F.G * NWAVES); else if (bx >= rem) convert_moe_down(F, (bx - rem) * NWAVES + F.wave, (F.G - rem) * NWAVES); }
            GRID_BAR();
        }
        if (PH(P_DOWN) && l == 1) for (int rep_ = 0; rep_ <= (int)((a.dup >> (16 + l)) & (a.dup >> P_DOWN) & 1u); ++rep_) { PHASE_FRAME();
            Gemm g{WSP(bf16_t, WS_MH), WSP(bf16_t, WS_MD), FFE / 2, FFE / 2, FFE / 2};   MoeDownOrder S{moe_tiles(F), F.G, (int)blockIdx.x};
            EpiY E{WSP(bf16_t, WS_MY), 1.f / (H8_SCALE * WD8_SCALE)};
            pg8::gemm_phase<EpiY, MoeDownOrder, false, true>(F.lds + RING_OFF, g, S, E, F.wave);
            { int SS, Kp; moe_slab_split(S.m.ts[8], F.G, SS, Kp);
              Gemm g2{WSP(bf16_t, WS_MH), WSP(bf16_t, WS_MD), FFE / 2, FFE / 2, Kp}; MoeSlabOrder S2{S.m, F.G, (int)blockIdx.x, SS, Kp}; EpiSlab E2{WSP(float, WS_SLAB), 1.f / (H8_SCALE * WD8_SCALE)};
              pg8::gemm_phase<EpiSlab, MoeSlabOrder, false, true>(F.lds + RING_OFF, g2, S2, E2, F.wave); }
            GRID_BAR();
        }
        if (PH(P_COMB) && l == 1) for (int rep_ = 0; rep_ <= (int)((a.dup >> (16 + l)) & (a.dup >> P_COMB) & 1u); ++rep_) { PHASE_FRAME(); moe_combine_pass(F); if (rep_ < (int)((a.dup >> (16 + l)) & (a.dup >> P_COMB) & 1u)) GRID_BAR(); }
#endif
}
__global__ void __launch_bounds__(NWAVES * 64, 2) mega(Args a) {
    extern __shared__ __attribute__((aligned(16))) unsigned char lds[];
    Frame F0; Frame& F = F0;
    F.lds = (LAS unsigned char*)lds; F.lds_gen = lds;
    F.wave = __builtin_amdgcn_readfirstlane((int)threadIdx.x >> 6); F.tid = pg8::make_tid(F.wave); F.lane = F.tid & 63;
    F.G = gridDim.x; { const int bx = blockIdx.x; F.vcu = (F.G % 8 == 0) ? (bx % 8) * (F.G / 8) + bx / 8 : bx; }
    F.in = a.in; F.out = a.out; F.ws = a.ws;
    for (int u = F.tid; u < (LDS_BYTES - LDSCTL_OFF) / 4; u += NWAVES * 64) ((LAS unsigned*)(F.lds + LDSCTL_OFF))[u] = 0u;
    __syncthreads();
    volatile LAS unsigned* MISC = (volatile LAS unsigned*)(F.lds + MISC_OFF);
    XcdBarrier bar = xcd_barrier_post((unsigned*)(F.ws + WS_CTL) + 4096, MISC + 8, F.tid);
    if (a.l0 <= 0 && 0 < a.l1) layer_body<0>(a, F0, bar, lds);
    if (a.l0 <= 1 && 1 < a.l1) layer_body<1>(a, F0, bar, lds);
}
#undef PH
#undef GRID_BAR


#ifndef MK_DUP
#define MK_DUP 0u
#endif
static int g_grid = 0;
static bool mega_init() {
    if (g_grid) return g_grid > 0;
    int dev = 0, cus = 0, per_cu = 0;
    if (hipGetDevice(&dev) != hipSuccess || hipDeviceGetAttribute(&cus, hipDeviceAttributeMultiprocessorCount, dev) != hipSuccess) { g_grid = -1; return false; }
    if (hipFuncSetAttribute((const void*)mega, hipFuncAttributeMaxDynamicSharedMemorySize, LDS_BYTES) != hipSuccess) { g_grid = -1; return false; }
    if (hipOccupancyMaxActiveBlocksPerMultiprocessor(&per_cu, (const void*)mega, NWAVES * 64, LDS_BYTES) != hipSuccess || per_cu < 1) { fprintf(stderr, "mega: occupancy query says %d\n", per_cu); }
    (void)hipGetLastError();
    g_grid = cus;
    return true;
}
static void mega_launch(void* const* d_in, float* out, unsigned char* ws, unsigned pmask, int l0, int l1, hipStream_t st) {
    if (!mega_init()) return;
    (void)hipMemsetAsync(ws + WS_CTL, 0, CTL_ZERO_BYTES, st);
    Args a{};
    for (int i = 0; i < 22; ++i) a.in[i] = (const float*)d_in[i];
    a.out = out; a.ws = ws; a.pmask = pmask; a.l0 = l0; a.l1 = l1; a.dup = MK_DUP;
    hipLaunchKernelGGL(mega, dim3(g_grid), dim3(NWAVES * 64), LDS_BYTES, st, a);
}
}
extern "C" void kernel_launch(void* const* d_in, const int* in_sizes, int n_in, void* d_out, int out_size, void* d_ws, size_t ws_size, hipStream_t stream) {
    (void)in_sizes; (void)n_in; (void)out_size;
    if (ws_size < (size_t)512 * (1u << 20)) { fprintf(stderr, "kernel_launch: workspace too small (%zu)\n", ws_size); return; }
    mk::mega_launch(d_in, (float*)d_out, (unsigned char*)d_ws, (1u << mk::P_NPH) - 1u, 0, 2, stream);
}
```

```cpp
#include <hip/hip_runtime.h>
#include <cstdio>
#include <cstdint>
#include <cmath>
#include <hip/hip_bf16.h>
namespace pg8 {
#define PG8_LAS __attribute__((address_space(3)))
typedef unsigned short bf16_t;
typedef short bf16x8 __attribute__((ext_vector_type(8)));
typedef float f32x4 __attribute__((ext_vector_type(4)));
typedef unsigned u32x4 __attribute__((ext_vector_type(4)));
typedef unsigned u32x2 __attribute__((ext_vector_type(2)));
typedef int v4i_t __attribute__((ext_vector_type(4)));
typedef int v8i_t __attribute__((ext_vector_type(8)));
constexpr int BM = 256, BK = 64, HALF = 128, HTB = HALF * BK * 2, STAGE_BYTES = 8 * HTB;

__host__ __device__ __forceinline__ int lds_byte(int r, int c) { const int st = (r >> 4) * 2 + (c >> 5), rr = r & 15, cc = c & 31, ob = rr * 64 + cc * 2; return st * 1024 + (ob ^ (((ob >> 9) & 1) << 5)); }
__host__ __device__ __forceinline__ void stage_rc(int b, int& R, int& C) { const int st = b / 1024, sb = b % 1024, swz = sb ^ (((sb >> 9) & 1) << 5); R = (st >> 1) * 16 + swz / 64; C = (st & 1) * 32 + (swz % 64) / 2; }
__host__ __device__ __forceinline__ int perm32(int rho) { const int n = rho >> 4, i = rho & 15; return 8 * (i >> 2) + 4 * n + (i & 3); }

struct Unit { int pm, pn, z; unsigned a_off, b_off; const int* gidx; };
struct Gemm { const bf16_t* A; const bf16_t* Bt; int lda, ldb, K; };

__device__ __forceinline__ int lane_id() { unsigned m = ~0u; asm volatile("" : "+s"(m)); return (int)__builtin_amdgcn_mbcnt_hi(m, __builtin_amdgcn_mbcnt_lo(m, 0u)); }
__device__ __forceinline__ int make_tid(int wave) { int t = (wave << 6) | lane_id(); asm volatile("" : "+v"(t)); return t; }
typedef float f32x2_cv __attribute__((ext_vector_type(2))); typedef __bf16 bf16x2_cv __attribute__((ext_vector_type(2)));
__device__ __forceinline__ unsigned cvt_pk_bf16(float lo, float hi) { const f32x2_cv v = {lo, hi}; const bf16x2_cv b = __builtin_convertvector(v, bf16x2_cv); return __builtin_bit_cast(unsigned, b); }

template <class Epi, class Sched, bool GATHER = false, bool FP8 = false>
__device__ __forceinline__ void gemm_phase(PG8_LAS unsigned char* lds, const Gemm g, const Sched& S, const Epi& E, int wave0) {
    const int tid = make_tid(wave0),
              wid = __builtin_amdgcn_readfirstlane(tid >> 6), lane = tid & 63, wr = wid >> 2, wc = wid & 3, fr = lane & 15, fq = lane >> 4;
    const int K = g.K, nt = K / BK;
    unsigned voffA[2], voffB[2];
#pragma unroll
    for (int i = 0; i < 2; ++i) { int R, C; stage_rc(tid * 16 + i * 8192, R, C); const int Rb = Epi::PERM ? ((R & ~31) + perm32(R & 31)) : R;
        voffA[i] = (unsigned)(R * g.lda + C) * 2u; voffB[i] = (unsigned)(Rb * g.ldb + C) * 2u; }
    const size_t kstep = (size_t)(BK * 2);
    const size_t hstepA = GATHER ? 0 : (size_t)HALF * g.lda * 2, hstepB = (size_t)HALF * g.ldb * 2;
    const unsigned ldsw = (unsigned)wid * 1024u;
    const int aoff = lds_byte(wr * 64 + fr, fq * 8), boff = lds_byte(wc * 32 + fr, fq * 8);
    unsigned gvc[2][2], gvn[2][2];
#define PG8_SA(b, h) (((b) * 2 + (h)) * HTB)
#define PG8_SB(b, h) ((4 + (b) * 2 + (h)) * HTB)
#define PG8_STAGE(bufoff, gbase, voff) do { _Pragma("unroll") for (int _i = 0; _i < 2; ++_i) \
        __builtin_amdgcn_global_load_lds((const unsigned*)((const char*)(gbase) + (voff)[_i]), (PG8_LAS unsigned*)(lds + (bufoff) + ldsw + _i * 8192), 16, 0, 0); } while (0)
#define PG8_STAGE_A(bufoff, base, h, nx) do { if constexpr (GATHER) { if (nx) PG8_STAGE(bufoff, base, gvn[h]); else PG8_STAGE(bufoff, base, gvc[h]); } else { PG8_STAGE(bufoff, (base) + (h) * hstepA, voffA); } } while (0)
#define PG8_LD8(a_) __builtin_shufflevector(*(const PG8_LAS v4i_t*)(a_), *(const PG8_LAS v4i_t*)((a_) + 1024), 0, 1, 2, 3, 4, 5, 6, 7)
#define PG8_LDA(dst, b, h) do { if constexpr (FP8) { _Pragma("unroll") for (int m = 0; m < 4; ++m) dst##8[m] = PG8_LD8(lds + PG8_SA(b, h) + aoff + m * 2048); } else { \
        _Pragma("unroll") for (int m = 0; m < 4; ++m) _Pragma("unroll") for (int k = 0; k < 2; ++k) dst[m][k] = *(const PG8_LAS bf16x8*)(lds + PG8_SA(b, h) + aoff + m * 2048 + k * 1024); } } while (0)
#define PG8_LDB(dst, b, h) do { if constexpr (FP8) { _Pragma("unroll") for (int n = 0; n < 2; ++n) dst##8[n] = PG8_LD8(lds + PG8_SB(b, h) + boff + n * 2048); } else { \
        _Pragma("unroll") for (int n = 0; n < 2; ++n) _Pragma("unroll") for (int k = 0; k < 2; ++k) dst[n][k] = *(const PG8_LAS bf16x8*)(lds + PG8_SB(b, h) + boff + n * 2048 + k * 1024); } } while (0)
#define PG8_MMA(ai, bj, At, Bt) do { __builtin_amdgcn_s_setprio(1); if constexpr (FP8) { _Pragma("unroll") for (int m = 0; m < 4; ++m) _Pragma("unroll") for (int n = 0; n < 2; ++n) \
        asm volatile("v_mfma_scale_f32_16x16x128_f8f6f4 %0, %1, %2, %0, %3, %3 op_sel_hi:[0,0,0]" : "+v"(acc[ai][bj][m][n]) : "v"(Bt##8[n]), "v"(At##8[m]), "v"(one8)); } else { \
        _Pragma("unroll") for (int m = 0; m < 4; ++m) _Pragma("unroll") for (int n = 0; n < 2; ++n) _Pragma("unroll") for (int k = 0; k < 2; ++k) \
        acc[ai][bj][m][n] = __builtin_amdgcn_mfma_f32_16x16x32_bf16(Bt[n][k], At[m][k], acc[ai][bj][m][n], 0, 0, 0); } __builtin_amdgcn_s_setprio(0); } while (0)
#define PG8_WAIT_V(n) asm volatile("s_waitcnt vmcnt(" #n ")" ::: "memory")
#define PG8_WAIT_L(n) asm volatile("s_waitcnt lgkmcnt(" #n ")" ::: "memory")
#define PG8_BAR __builtin_amdgcn_s_barrier()
#define PG8_SCHED __builtin_amdgcn_sched_barrier(0)
#define PG8_GLOAD(dst, u) do { if constexpr (GATHER) { const int t2_ = make_tid(wave0); _Pragma("unroll") for (int _i = 0; _i < 2; ++_i) { int R_, C_; stage_rc(t2_ * 16 + _i * 8192, R_, C_); \
        _Pragma("unroll") for (int _h = 0; _h < 2; ++_h) dst[_h][_i] = (unsigned)((u).gidx[_h * HALF + R_] * g.lda + C_) * 2u; } } } while (0)
    Unit cur, nxt; int ui = 0;
    if (!S.next(0, cur)) return;
    f32x4 acc[2][2][4][2];
#pragma unroll
    for (int a = 0; a < 2; ++a)
#pragma unroll
        for (int b = 0; b < 2; ++b)
#pragma unroll
            for (int m = 0; m < 4; ++m)
#pragma unroll
                for (int n = 0; n < 2; ++n) acc[a][b][m][n] = (f32x4){0.f, 0.f, 0.f, 0.f};
    bf16x8 At[4][2], B0[2][2], B1[2][2]; v8i_t At8[4], B08[2], B18[2];
    int one8 = 0x7f7f7f7f; asm volatile("" : "+v"(one8));
    const char* cA = (const char*)g.A + cur.a_off; const char* cB = (const char*)g.Bt + cur.b_off;
    PG8_GLOAD(gvc, cur);
#pragma unroll
    for (int _h = 0; _h < 2; ++_h)
#pragma unroll
        for (int _i = 0; _i < 2; ++_i) gvn[_h][_i] = 0u;
    PG8_STAGE(PG8_SB(0, 0), cB, voffB); PG8_STAGE(PG8_SB(0, 1), cB + hstepB, voffB); PG8_STAGE_A(PG8_SA(0, 0), cA, 0, false); PG8_STAGE_A(PG8_SA(0, 1), cA, 1, false);
    if (wr == 1) PG8_BAR;
    PG8_WAIT_V(2); PG8_BAR;
    PG8_STAGE(PG8_SB(1, 0), cB + kstep, voffB); PG8_STAGE_A(PG8_SA(1, 0), cA + kstep, 0, false); PG8_STAGE(PG8_SB(1, 1), cB + hstepB + kstep, voffB);
    PG8_WAIT_V(6); PG8_BAR;
    for (;;) {
        const bool has_next = S.next(ui + 1, nxt);
        const char* nA = has_next ? (const char*)g.A + nxt.a_off : cA; const char* nB = has_next ? (const char*)g.Bt + nxt.b_off : cB;
        if constexpr (GATHER) { if (has_next) { PG8_GLOAD(gvn, nxt); } else {
#pragma unroll
            for (int _h = 0; _h < 2; ++_h)
#pragma unroll
                for (int _i = 0; _i < 2; ++_i) gvn[_h][_i] = gvc[_h][_i]; } }
        for (int t = 0; t < nt; t += 2) {
            const bool last = (t == nt - 2);
            const char* a1 = cA + (size_t)(t + 1) * kstep;
            const char* a2 = last ? nA : cA + (size_t)(t + 2) * kstep; const char* b2 = last ? nB : cB + (size_t)(t + 2) * kstep;
            const char* a3 = a2 + kstep; const char* b3 = b2 + kstep;
            if constexpr (Epi::MID) { if (t == Epi::MID_T0 || t == Epi::MID_T1) {
                if (wr == 0) PG8_BAR;
#define PG8_MIDROW(ai, m) do { f32x4 v_[2][2] = {{acc[ai][0][m][0], acc[ai][0][m][1]}, {acc[ai][1][m][0], acc[ai][1][m][1]}}; \
                int r_ = cur.pm * BM + (ai) * HALF + wr * 64 + (m) * 16 + fr; asm volatile("" : "+v"(r_)); E.mid_row(cur, r_, t, wc, fq, v_); \
                acc[ai][0][m][0] = v_[0][0]; acc[ai][0][m][1] = v_[0][1]; acc[ai][1][m][0] = v_[1][0]; acc[ai][1][m][1] = v_[1][1]; asm volatile("" ::: "memory"); } while (0)
                PG8_MIDROW(0, 0); PG8_MIDROW(0, 1); PG8_MIDROW(0, 2); PG8_MIDROW(0, 3); PG8_MIDROW(1, 0); PG8_MIDROW(1, 1); PG8_MIDROW(1, 2); PG8_MIDROW(1, 3);
#undef PG8_MIDROW
                if (wr == 1) PG8_BAR;
            } }
            PG8_LDB(B0, 0, 0); PG8_LDB(B1, 0, 1); PG8_SCHED; PG8_LDA(At, 0, 0); PG8_STAGE_A(PG8_SA(1, 1), a1, 1, false);
            PG8_WAIT_V(8); PG8_WAIT_L(0); PG8_BAR; PG8_MMA(0, 0, At, B0); PG8_MMA(0, 1, At, B1); PG8_BAR; PG8_SCHED;
            PG8_LDA(At, 0, 1); PG8_STAGE(PG8_SB(0, 0), b2, voffB); PG8_STAGE(PG8_SB(0, 1), b2 + hstepB, voffB); PG8_STAGE_A(PG8_SA(0, 0), a2, 0, last);
            PG8_WAIT_V(8); PG8_WAIT_L(0); PG8_BAR; PG8_MMA(1, 0, At, B0); PG8_MMA(1, 1, At, B1); PG8_BAR; PG8_SCHED;
            PG8_LDB(B0, 1, 0); PG8_LDB(B1, 1, 1); PG8_SCHED; PG8_LDA(At, 1, 0); PG8_STAGE_A(PG8_SA(0, 1), a2, 1, last);
            PG8_WAIT_V(8); PG8_WAIT_L(0); PG8_BAR; PG8_MMA(0, 0, At, B0); PG8_MMA(0, 1, At, B1); PG8_BAR; PG8_SCHED;
            PG8_LDA(At, 1, 1); PG8_STAGE(PG8_SB(1, 0), b3, voffB); PG8_STAGE(PG8_SB(1, 1), b3 + hstepB, voffB); PG8_STAGE_A(PG8_SA(1, 0), a3, 0, last);
            PG8_WAIT_V(8); PG8_WAIT_L(0); PG8_BAR; PG8_MMA(1, 0, At, B0); PG8_MMA(1, 1, At, B1); PG8_BAR; PG8_SCHED;
        }
        if constexpr (FP8) asm volatile("s_nop 15\n\ts_nop 15" ::: "memory");
        if (wr == 0) PG8_BAR;
        {
#define PG8_ROW(ai, m) do { const f32x4 v_[2][2] = {{acc[ai][0][m][0], acc[ai][0][m][1]}, {acc[ai][1][m][0], acc[ai][1][m][1]}}; \
            int r_ = cur.pm * BM + (ai) * HALF + wr * 64 + (m) * 16 + fr; asm volatile("" : "+v"(r_)); E.row(cur, r_, (ai) * 4 + (m), wc, fq, v_); asm volatile("" ::: "memory"); } while (0)
            PG8_ROW(0, 0); PG8_ROW(0, 1); PG8_ROW(0, 2); PG8_ROW(0, 3); PG8_ROW(1, 0); PG8_ROW(1, 1); PG8_ROW(1, 2); PG8_ROW(1, 3);
#undef PG8_ROW
        }
        if (!has_next) break;
#pragma unroll
        for (int a = 0; a < 2; ++a)
#pragma unroll
            for (int b = 0; b < 2; ++b)
#pragma unroll
                for (int m = 0; m < 4; ++m)
#pragma unroll
                    for (int n = 0; n < 2; ++n) acc[a][b][m][n] = (f32x4){0.f, 0.f, 0.f, 0.f};
        cur = nxt; cA = nA; cB = nB; ++ui;
        if constexpr (GATHER) {
#pragma unroll
            for (int _h = 0; _h < 2; ++_h)
#pragma unroll
                for (int _i = 0; _i < 2; ++_i) gvc[_h][_i] = gvn[_h][_i]; }
        if (wr == 1) PG8_BAR;
    }
    PG8_WAIT_V(0);
    PG8_BAR;
#undef PG8_SA
#undef PG8_SB
#undef PG8_STAGE
#undef PG8_STAGE_A
#undef PG8_LDA
#undef PG8_LD8
#undef PG8_LDB
#undef PG8_MMA
#undef PG8_WAIT_V
#undef PG8_WAIT_L
#undef PG8_BAR
#undef PG8_SCHED
#undef PG8_GLOAD
}

template <bool PERM>
__device__ __forceinline__ void small_tile(PG8_LAS unsigned char* lds, const bf16_t* A16, int lda, const bf16_t* Bt, int ldb, int K, int pn, int wc, f32x4 (&v)[2][2], int wave0) {
    const int tid = make_tid(wave0), wid = __builtin_amdgcn_readfirstlane(tid >> 6), lane = tid & 63, fr = lane & 15, fq = lane >> 4;
    const int kper = K >> 3, k0 = wid * kper;
    f32x4 acc[2][2];
#pragma unroll
    for (int bj = 0; bj < 2; ++bj)
#pragma unroll
        for (int n = 0; n < 2; ++n) acc[bj][n] = (f32x4){0.f, 0.f, 0.f, 0.f};
    const bf16_t* ap = A16 + (size_t)fr * lda + k0 + 8 * fq;
    const bf16_t* bp[2][2];
#pragma unroll
    for (int bj = 0; bj < 2; ++bj)
#pragma unroll
        for (int n = 0; n < 2; ++n) { const int rr = PERM ? perm32(16 * n + fr) : 16 * n + fr; bp[bj][n] = Bt + (size_t)(pn * 256 + bj * 128 + wc * 32 + rr) * ldb + k0 + 8 * fq; }
    for (int k = 0; k < kper; k += 32) {
        const bf16x8 a = *(const bf16x8*)(ap + k);
#pragma unroll
        for (int bj = 0; bj < 2; ++bj)
#pragma unroll
            for (int n = 0; n < 2; ++n) { const bf16x8 b = *(const bf16x8*)(bp[bj][n] + k); acc[bj][n] = __builtin_amdgcn_mfma_f32_16x16x32_bf16(b, a, acc[bj][n], 0, 0, 0); }
    }
    PG8_LAS f32x4* red = (PG8_LAS f32x4*)lds;
#pragma unroll
    for (int bj = 0; bj < 2; ++bj)
#pragma unroll
        for (int n = 0; n < 2; ++n) red[(wid * 4 + bj * 2 + n) * 64 + lane] = acc[bj][n];
    __syncthreads();
    if (wid == 0) {
#pragma unroll
        for (int bj = 0; bj < 2; ++bj)
#pragma unroll
            for (int n = 0; n < 2; ++n) { f32x4 s = red[(bj * 2 + n) * 64 + lane];
#pragma unroll
                for (int w = 1; w < 8; ++w) s += red[(w * 4 + bj * 2 + n) * 64 + lane];
                v[bj][n] = s; }
    }
    __syncthreads();
}
}
namespace attn_body {
using bf16=__hip_bfloat16;
using bf16x8=__attribute__((ext_vector_type(8)))short;
using s16x4=__attribute__((ext_vector_type(4)))short;
using f32x16=__attribute__((ext_vector_type(16)))float;
using u32x4=__attribute__((ext_vector_type(4)))unsigned;
constexpr int BATCH=4,SEQ=4352,D=64,QKP=1024,VP=512,OP=1024;
constexpr int NW=8,QBLK=32,QB=QBLK*NW,KVBLK=64,NQB=SEQ/QB;
constexpr int ATTN_UNIT_ROWS=QB;
__device__ __forceinline__ int crow(int r,int hi){return (r&3)+8*(r>>2)+4*hi;}
#define SBAR() __builtin_amdgcn_sched_barrier(0)
__device__ __forceinline__ void cmask(f32x16&p0,f32x16&p1,int jb,int qrel,int hi){
  const float NEG=-INFINITY; int kb=64*jb+4*hi;
  #pragma unroll
  for(int r=0;r<16;++r){int kv=kb+(r&3)+8*(r>>2); if(kv>qrel)p0[r]=NEG; if(kv+32>qrel)p1[r]=NEG;}
}

__device__ __forceinline__ void biasmask(f32x16&p0,f32x16&p1,int jb,int qrel,int hi,const __attribute__((address_space(3))) float*tab){
  const float NEG=-INFINITY; const int kb=64*jb+4*hi;
  #pragma unroll
  for(int r=0;r<16;++r){const int n0=qrel-(kb+(r&3)+8*(r>>2)),n1=n0-32;
    const float b0=tab[n0<0?0:(n0>127?127:n0)],b1=tab[n1<0?0:(n1>127?127:n1)];
    p0[r]=n0<0?NEG:p0[r]+b0; p1[r]=n1<0?NEG:p1[r]+b1;}
}
constexpr int NSLOT=3, SLOTB=8192;
constexpr int VSLOTB=2*SLOTB;
constexpr int LDS_K=0, LDS_V=NSLOT*SLOTB, LDS_WS=LDS_V+NSLOT*VSLOTB, LDS_TAB=LDS_WS+NW*64*4, LDS_OST=0  , LDS_BYTES=LDS_TAB+2048;
constexpr float C2=0.125f*1.4426950408889634f;
__device__ __forceinline__ void glds16(const void*gsrc,unsigned lds_dst){unsigned keep;
  asm volatile("s_mov_b32 %0, m0\n\ts_mov_b32 m0, %2\n\ts_nop 0\n\tglobal_load_lds_dwordx4 %1, off\n\ts_mov_b32 m0, %0":"=&s"(keep):"v"(gsrc),"s"(lds_dst):"memory");}
__device__ __forceinline__ float max3f(float a,float b,float c){float r;asm("v_max3_f32 %0, %1, %2, %3":"=v"(r):"v"(a),"v"(b),"v"(c));return r;}
__device__ __forceinline__ float max2f(float a,float b){float r;asm("v_max_f32_e32 %0, %1, %2":"=v"(r):"v"(a),"v"(b));return r;}
__device__ __forceinline__ float fadd_s(float a,float b){float r;asm("v_add_f32_e32 %0, %1, %2":"=v"(r):"v"(a),"v"(b));return r;}
__device__ __forceinline__ float fsub_s(float a,float b){float r;asm("v_sub_f32_e32 %0, %1, %2":"=v"(r):"v"(a),"v"(b));return r;}
typedef float f32x2_t __attribute__((ext_vector_type(2))); typedef __bf16 bf16x2_t __attribute__((ext_vector_type(2)));
__device__ __forceinline__ unsigned cvtpk_s(float lo,float hi){f32x2_t v={lo,hi};bf16x2_t b=__builtin_convertvector(v,bf16x2_t);return __builtin_bit_cast(unsigned,b);}
#define WAIT_BAR(N) asm volatile("s_waitcnt vmcnt(" #N ") lgkmcnt(0)\n\ts_barrier":::"memory")

__device__ __forceinline__ void qkt(f32x16&p0,f32x16&p1,const char*Kslot,const bf16x8*qr,const f32x16&negm,int r32,int hi){
  const char*kb=Kslot+hi*1024+r32*16;
  #pragma unroll
  for(int d0=0;d0<4;++d0){
    const bf16x8 b0=*reinterpret_cast<const bf16x8*>(kb+d0*2048);
    const bf16x8 b1=*reinterpret_cast<const bf16x8*>(kb+d0*2048+512);
    if(d0==0){p0=__builtin_amdgcn_mfma_f32_32x32x16_bf16(b0,qr[0],negm,0,0,0);p1=__builtin_amdgcn_mfma_f32_32x32x16_bf16(b1,qr[0],negm,0,0,0);}
    else{p0=__builtin_amdgcn_mfma_f32_32x32x16_bf16(b0,qr[d0],p0,0,0,0);p1=__builtin_amdgcn_mfma_f32_32x32x16_bf16(b1,qr[d0],p1,0,0,0);}}
}
typedef __attribute__((address_space(3))) const char* lds_cptr;
typedef short v4i16_t __attribute__((ext_vector_type(4)));
__device__ __forceinline__ void kload8(bf16x8*kf,lds_cptr kp){
  kf[0]=*(const __attribute__((address_space(3))) bf16x8*)(kp);      kf[1]=*(const __attribute__((address_space(3))) bf16x8*)(kp+512);
  kf[2]=*(const __attribute__((address_space(3))) bf16x8*)(kp+2048); kf[3]=*(const __attribute__((address_space(3))) bf16x8*)(kp+2560);
  kf[4]=*(const __attribute__((address_space(3))) bf16x8*)(kp+4096); kf[5]=*(const __attribute__((address_space(3))) bf16x8*)(kp+4608);
  kf[6]=*(const __attribute__((address_space(3))) bf16x8*)(kp+6144); kf[7]=*(const __attribute__((address_space(3))) bf16x8*)(kp+6656);
}
__device__ __forceinline__ void kload2(bf16x8*kf,lds_cptr kp,int j){ kf[2*j]=*(const __attribute__((address_space(3))) bf16x8*)(kp+j*2048); kf[2*j+1]=*(const __attribute__((address_space(3))) bf16x8*)(kp+j*2048+512); }
__device__ __forceinline__ s16x4 vtr(lds_cptr p){ return __builtin_bit_cast(s16x4,__builtin_amdgcn_ds_read_tr16_b64_v4i16((__attribute__((address_space(3))) v4i16_t*)p)); }
__device__ __forceinline__ float rowmax(const f32x16&p0,const f32x16&p1){
  float a=max3f(p0[0],p0[1],p1[0]),b=max3f(p0[2],p0[3],p1[1]);a=max3f(a,p1[2],p1[3]);
  #pragma unroll
  for(int r=4;r<16;r+=4){a=max3f(a,p0[r],p0[r+1]);b=max3f(b,p0[r+2],p0[r+3]);a=max3f(a,p1[r],p1[r+1]);b=max3f(b,p1[r+2],p1[r+3]);}
  const float m=max2f(a,b);
  auto rr=__builtin_amdgcn_permlane32_swap(__float_as_uint(m),__float_as_uint(m),false,false);
  return max2f(__uint_as_float(rr[0]),__uint_as_float(rr[1]));
}
__device__ __forceinline__ void pv(f32x16*o,int vb,bf16x8 pa0,bf16x8 pa1,bf16x8 pa2,bf16x8 pa3){
  #pragma unroll
  for(int d0=0;d0<4;++d0){s16x4 lo[4],hi[4];
    #pragma unroll
    for(int ks=0;ks<4;++ks){
      asm volatile("ds_read_b64_tr_b16 %0,%1 offset:%c2":"=&v"(lo[ks]):"v"(vb),"i"(d0*4096+ks*1024):"memory");
      asm volatile("ds_read_b64_tr_b16 %0,%1 offset:%c2":"=&v"(hi[ks]):"v"(vb),"i"(d0*4096+ks*1024+512):"memory");}
    asm volatile("s_waitcnt lgkmcnt(0)":::"memory");SBAR();
    #define PK(k) (bf16x8){lo[k][0],lo[k][1],lo[k][2],lo[k][3],hi[k][0],hi[k][1],hi[k][2],hi[k][3]}
    o[d0]=__builtin_amdgcn_mfma_f32_32x32x16_bf16(pa0,PK(0),o[d0],0,0,0);
    o[d0]=__builtin_amdgcn_mfma_f32_32x32x16_bf16(pa1,PK(1),o[d0],0,0,0);
    o[d0]=__builtin_amdgcn_mfma_f32_32x32x16_bf16(pa2,PK(2),o[d0],0,0,0);
    o[d0]=__builtin_amdgcn_mfma_f32_32x32x16_bf16(pa3,PK(3),o[d0],0,0,0);
    #undef PK
  }
}

#ifndef ATTN_STORE16
#define ATTN_STORE16(p,v) (*(u32x4*)(p)=(v))
#endif
template<int THRL> __device__ __forceinline__ void attn_unit(int b,int vh,int qb,const bf16*__restrict__ QK,const bf16*__restrict__ V,bf16*O,char*shm,int wave0){
  const int mp=vh>>2,hh=vh&3; const int qcol=(mp*4+hh)*64,kcol=512+(mp*4+hh)*64,vcol=hh*128,ocol=mp*512+hh*128;
  const int tid=pg8::make_tid(wave0),lane=tid&63,r32=lane&31,hi=lane>>5; const int wid=__builtin_amdgcn_readfirstlane(tid>>6);
  const long rowbase=(long)b*SEQ; const int q0=qb*QB;
  const bf16*Qw=QK+(rowbase+q0+wid*QBLK)*QKP+qcol;
  const bf16*Kh=QK+rowbase*QKP+kcol,*Vh=V+rowbase*VP+vcol;
  const __attribute__((address_space(3))) float*tab=(const __attribute__((address_space(3))) float*)((__attribute__((address_space(3))) char*)shm+LDS_TAB)+hh*128;
  const unsigned lds0=(unsigned)(uintptr_t)shm;
  float*wsf=(float*)(shm+LDS_WS)+wid*64;
  const bf16*ksrc=Kh+(long)lane*QKP+wid*8;
  const bf16*vsrc=Vh+(long)(16*(wid&3)+(lane>>2))*VP+(wid>>2)*32+(lane&3)*8;
  const unsigned kdst=lds0+LDS_K+wid*1024, vdst=lds0+LDS_V+wid*1024;
  #define DMA_K(t,slot) glds16(ksrc+(long)(t)*KVBLK*QKP,(unsigned)__builtin_amdgcn_readfirstlane(kdst+(slot)))
  #define DMA_V(t,slot) do{ glds16(vsrc+(long)(t)*KVBLK*VP,(unsigned)__builtin_amdgcn_readfirstlane(vdst+2*(slot))); glds16(vsrc+64+(long)(t)*KVBLK*VP,(unsigned)__builtin_amdgcn_readfirstlane(vdst+2*(slot)+8192)); }while(0)
  const int vb0=(int)(lds0+LDS_V)+((lane>>4)&1)*32+(lane&3)*8+(4*hi+((lane&15)>>2))*64;
  const char*Kbase=shm+LDS_K; bf16x8 kf[8];
  const lds_cptr shm3=(lds_cptr)shm; const lds_cptr kp0=shm3+LDS_K+hi*1024+r32*16; const lds_cptr vp0=shm3+LDS_V+((lane>>4)&1)*32+(lane&3)*8+(4*hi+((lane&15)>>2))*64;
  const int NT=(q0+QB)/KVBLK;
  DMA_K(0,0);DMA_V(0,0);DMA_K(1,SLOTB);
  bf16x8 qr[4];
  #pragma unroll
  for(int d0=0;d0<4;++d0)qr[d0]=*reinterpret_cast<const bf16x8*>(&Qw[(long)r32*QKP+d0*16+hi*8]);
  float mhat=0.f,l_reg=0.f;f32x16 o[4];o[0]=f32x16{};o[1]=f32x16{};o[2]=f32x16{};o[3]=f32x16{};f32x16 negm=f32x16{};asm volatile("":"+v"(negm));
  const int qrel=wid*QBLK+r32;
  #define CMASK(P0,P1,t) do{int jb_=(t)-(NT-4); if(jb_>=-2)biasmask(P0,P1,jb_,qrel,hi,tab);}while(0)
  bool resc=false;
  #define START(P0,P1) do{ const float rm=rowmax(P0,P1); resc=false; \
    { const float dl=rm; mhat=fadd_s(mhat,dl); \
      _Pragma("unroll") for(int r=0;r<16;++r){P0[r]=fsub_s(P0[r],dl);P1[r]=fsub_s(P1[r],dl);} \
      _Pragma("unroll") for(int r=0;r<16;++r)negm[r]=-mhat; asm volatile("":"+v"(negm)); } \
    _Pragma("unroll") for(int r=0;r<16;++r)P0[r]=__builtin_amdgcn_exp2f(P0[r]); }while(0)
  #define RESC() do{ if(resc){ asm volatile("s_waitcnt lgkmcnt(0)":::"memory"); \
      _Pragma("unroll") for(int d_=0;d_<4;++d_) _Pragma("unroll") for(int r=0;r<16;++r)o[d_][r]*=wsf[crow(r,hi)]; } }while(0)
  f32x16 pA0,pA1,pB0,pB1;
  int sl_prev=0,sl_cur=0,sl_next=SLOTB;
  #define ROT() do{sl_prev=sl_cur;sl_cur=sl_next;sl_next=(sl_next==(NSLOT-1)*SLOTB)?0:sl_next+SLOTB;}while(0)
  DMA_K(2,2*SLOTB);
  WAIT_BAR(4);
  qkt(pA0,pA1,Kbase,qr,negm,r32,hi);asm volatile("s_nop 15\n\ts_nop 7":"+v"(pA0),"+v"(pA1));CMASK(pA0,pA1,0);
  START(pA0,pA1);
  _Pragma("unroll") for(int r=0;r<16;++r)pA1[r]=__builtin_amdgcn_exp2f(pA1[r]);
  WAIT_BAR(0);
  DMA_K(3,0);DMA_V(1,SLOTB);
  ROT();
  kload8(kf,kp0+sl_cur);
  WAIT_BAR(3);
  s16x4 vlo[4],vhi[4]; u32x4 pw0,pw1,pw2,pw3;
  #define PKW(P,B) cvtpk_s(P[B],P[B+1])
  #define PAF(k) __builtin_bit_cast(bf16x8,pw##k)
  #define VFR(i) (bf16x8){vlo[i][0],vlo[i][1],vlo[i][2],vlo[i][3],vhi[i][0],vhi[i][1],vhi[i][2],vhi[i][3]}
  #define PIN(x) asm volatile("":"+v"(x))
  #define MX3(a,b,c) __builtin_fmaxf(__builtin_fmaxf((a),(b)),(c))
  #define GAPA(MF,A0,A1,A2,A3,W0,W1,PW) do{ MF; sacc+=A0; sacc+=A1; sacc+=A2; sacc+=A3; PIN(sacc); W0; W1; PIN(PW); SBAR(); }while(0)
  #define EX(v) __builtin_amdgcn_exp2f(v)
  #define GAPB(MF,VR,X,B) do{ MF; VR; X[B]=EX(X[B]); X[B+1]=EX(X[B+1]); PIN(X); SBAR(); }while(0)
  #define VRJ(kg,d0) do{ vlo[d0]=vtr(vp_+((d0)*4096+(kg)*1024)); vhi[d0]=vtr(vp_+((d0)*4096+(kg)*1024+512)); }while(0)
  #define KRD(G,j) do{ if(G){ kload2(kf,kp0+sl_next,j); SBAR(); } }while(0)
  #define STEP(C0,C1,P0,P1,t,GK,GV,GL) do{ SBAR(); \
    const lds_cptr vp_=vp0+2*sl_prev; \
    float sacc=(P0[0]+P0[1]); \
    GAPA(C0=__builtin_amdgcn_mfma_f32_32x32x16_bf16(kf[0],qr[0],negm,0,0,0), P0[2],P0[3],P0[4],P0[5],     pw0[0]=PKW(P0,0), pw0[1]=PKW(P0,2), pw0); \
    GAPA(C1=__builtin_amdgcn_mfma_f32_32x32x16_bf16(kf[1],qr[0],negm,0,0,0), P0[6],P0[7],P0[8],P0[9],     pw0[2]=PKW(P0,4), pw0[3]=PKW(P0,6), pw0); \
    GAPA(C0=__builtin_amdgcn_mfma_f32_32x32x16_bf16(kf[2],qr[1],C0,0,0,0),   P0[10],P0[11],P0[12],P0[13], pw1[0]=PKW(P0,8), pw1[1]=PKW(P0,10), pw1); \
    GAPA(C1=__builtin_amdgcn_mfma_f32_32x32x16_bf16(kf[3],qr[1],C1,0,0,0),   P0[14],P0[15],P1[0],P1[1],   pw1[2]=PKW(P0,12),pw1[3]=PKW(P0,14), pw1); \
    GAPA(C0=__builtin_amdgcn_mfma_f32_32x32x16_bf16(kf[4],qr[2],C0,0,0,0),   P1[2],P1[3],P1[4],P1[5],     pw2[0]=PKW(P1,0), pw2[1]=PKW(P1,2), pw2); \
    GAPA(C1=__builtin_amdgcn_mfma_f32_32x32x16_bf16(kf[5],qr[2],C1,0,0,0),   P1[6],P1[7],P1[8],P1[9],     pw2[2]=PKW(P1,4), pw2[3]=PKW(P1,6), pw2); \
    GAPA(C0=__builtin_amdgcn_mfma_f32_32x32x16_bf16(kf[6],qr[3],C0,0,0,0),   P1[10],P1[11],P1[12],P1[13], pw3[0]=PKW(P1,8), pw3[1]=PKW(P1,10), pw3); \
    GAPA(C1=__builtin_amdgcn_mfma_f32_32x32x16_bf16(kf[7],qr[3],C1,0,0,0),   P1[14],P1[15],0.f,0.f,       pw3[2]=PKW(P1,12),pw3[3]=PKW(P1,14), pw3); \
    l_reg+=sacc; \
    if(GK){DMA_K((t)+3,sl_cur);} if(GV){DMA_V((t)+1,sl_next);} \
    VRJ(0,0); VRJ(0,1); VRJ(0,2); VRJ(0,3); SBAR(); \
    CMASK(C0,C1,t); \
    { float a=MX3(C0[0],C0[1],C1[0]),b=MX3(C0[2],C0[3],C1[1]); a=MX3(a,C1[2],C1[3]); \
      _Pragma("unroll") for(int r=4;r<16;r+=4){a=MX3(a,C0[r],C0[r+1]);b=MX3(b,C0[r+2],C0[r+3]);a=MX3(a,C1[r],C1[r+1]);b=MX3(b,C1[r+2],C1[r+3]);} \
      float rm=__builtin_fmaxf(a,b); { auto rr=__builtin_amdgcn_permlane32_swap(__float_as_uint(rm),__float_as_uint(rm),false,false); rm=__builtin_fmaxf(__uint_as_float(rr[0]),__uint_as_float(rr[1])); } \
      resc=false; \
      if(__builtin_expect(__any(rm>(float)THRL),0)){ const float dl=__builtin_fmaxf(rm,0.f); mhat+=dl; \
        _Pragma("unroll") for(int r=0;r<16;++r){C0[r]-=dl;C1[r]-=dl;} \
        _Pragma("unroll") for(int r=0;r<16;++r)negm[r]=-mhat; asm volatile("":"+v"(negm)); \
        const float f=__builtin_amdgcn_exp2f(-dl); l_reg*=f; if(hi==0)wsf[r32]=f; resc=true; } } \
    SBAR(); \
    GAPB(o[0]=__builtin_amdgcn_mfma_f32_32x32x16_bf16(PAF(0),VFR(0),o[0],0,0,0), VRJ(1,0), C0,0); \
    GAPB(o[1]=__builtin_amdgcn_mfma_f32_32x32x16_bf16(PAF(0),VFR(1),o[1],0,0,0), VRJ(1,1), C0,2); \
    GAPB(o[2]=__builtin_amdgcn_mfma_f32_32x32x16_bf16(PAF(0),VFR(2),o[2],0,0,0), VRJ(1,2), C0,4); \
    GAPB(o[3]=__builtin_amdgcn_mfma_f32_32x32x16_bf16(PAF(0),VFR(3),o[3],0,0,0), VRJ(1,3), C0,6); \
    GAPB(o[0]=__builtin_amdgcn_mfma_f32_32x32x16_bf16(PAF(1),VFR(0),o[0],0,0,0), VRJ(2,0), C0,8); \
    KRD(GL,0); GAPB(o[1]=__builtin_amdgcn_mfma_f32_32x32x16_bf16(PAF(1),VFR(1),o[1],0,0,0), VRJ(2,1), C0,10); \
    GAPB(o[2]=__builtin_amdgcn_mfma_f32_32x32x16_bf16(PAF(1),VFR(2),o[2],0,0,0), VRJ(2,2), C0,12); \
    KRD(GL,1); GAPB(o[3]=__builtin_amdgcn_mfma_f32_32x32x16_bf16(PAF(1),VFR(3),o[3],0,0,0), VRJ(2,3), C0,14); \
    GAPB(o[0]=__builtin_amdgcn_mfma_f32_32x32x16_bf16(PAF(2),VFR(0),o[0],0,0,0), VRJ(3,0), C1,0); \
    KRD(GL,2); GAPB(o[1]=__builtin_amdgcn_mfma_f32_32x32x16_bf16(PAF(2),VFR(1),o[1],0,0,0), VRJ(3,1), C1,2); \
    GAPB(o[2]=__builtin_amdgcn_mfma_f32_32x32x16_bf16(PAF(2),VFR(2),o[2],0,0,0), VRJ(3,2), C1,4); \
    KRD(GL,3); GAPB(o[3]=__builtin_amdgcn_mfma_f32_32x32x16_bf16(PAF(2),VFR(3),o[3],0,0,0), VRJ(3,3), C1,6); \
    GAPB(o[0]=__builtin_amdgcn_mfma_f32_32x32x16_bf16(PAF(3),VFR(0),o[0],0,0,0), (void)0, C1,8); \
    GAPB(o[1]=__builtin_amdgcn_mfma_f32_32x32x16_bf16(PAF(3),VFR(1),o[1],0,0,0), (void)0, C1,10); \
    GAPB(o[2]=__builtin_amdgcn_mfma_f32_32x32x16_bf16(PAF(3),VFR(2),o[2],0,0,0), (void)0, C1,12); \
    GAPB(o[3]=__builtin_amdgcn_mfma_f32_32x32x16_bf16(PAF(3),VFR(3),o[3],0,0,0), (void)0, C1,14); \
    }while(0)
  int t=1;
  #undef CMASK
  #define CMASK(P0,P1,t) do{}while(0)
  for(;t+7<NT;t+=2){
    STEP(pB0,pB1,pA0,pA1,t,true,true,true);     WAIT_BAR(3); RESC(); ROT();
    STEP(pA0,pA1,pB0,pB1,t+1,true,true,true);   WAIT_BAR(3); RESC(); ROT();
  }
  #undef CMASK
  #define CMASK(P0,P1,t) do{int jb_=(t)-(NT-4); if(jb_>=-2)biasmask(P0,P1,jb_,qrel,hi,tab);}while(0)
  #define ENDW(tt) do{ if((tt)+3<NT){WAIT_BAR(3);} else if((tt)+2<NT){WAIT_BAR(2);} else {WAIT_BAR(0);} }while(0)
  for(;t+1<NT;t+=2){
    STEP(pB0,pB1,pA0,pA1,t,(t+3<NT),(t+1<NT),(t+1<NT));       ENDW(t);   RESC(); ROT();
    STEP(pA0,pA1,pB0,pB1,t+1,(t+4<NT),(t+2<NT),(t+2<NT));     ENDW(t+1); RESC(); ROT();
  }
  STEP(pB0,pB1,pA0,pA1,NT-1,false,false,false); RESC();
  { float sacc=pB0[0]+pB0[1]; _Pragma("unroll") for(int r=2;r<16;++r)sacc+=pB0[r]; _Pragma("unroll") for(int r=0;r<16;++r)sacc+=pB1[r]; l_reg+=sacc;
    pw0=(u32x4){PKW(pB0,0),PKW(pB0,2),PKW(pB0,4),PKW(pB0,6)};pw1=(u32x4){PKW(pB0,8),PKW(pB0,10),PKW(pB0,12),PKW(pB0,14)};pw2=(u32x4){PKW(pB1,0),PKW(pB1,2),PKW(pB1,4),PKW(pB1,6)};pw3=(u32x4){PKW(pB1,8),PKW(pB1,10),PKW(pB1,12),PKW(pB1,14)};
    SBAR(); pv(o,vb0+2*sl_cur,PAF(0),PAF(1),PAF(2),PAF(3)); }
  #undef PKW
  #undef PAF
  #undef VFR
  #undef PIN
  #undef MX3
  #undef GAPA
  #undef GAPB
  #undef EX
  #undef VRJ
  #undef KRD
  #undef STEP
  #undef ENDW
  {auto rr=__builtin_amdgcn_permlane32_swap(__float_as_uint(l_reg),__float_as_uint(l_reg),false,false);l_reg=__uint_as_float(rr[0])+__uint_as_float(rr[1]);}
  if(hi==0)wsf[32+r32]=l_reg;asm volatile("s_waitcnt lgkmcnt(0)":::"memory");
  float rli[16];
  #pragma unroll
  for(int r=0;r<16;++r)rli[r]=__builtin_amdgcn_rcpf(wsf[32+crow(r,hi)]);
  bf16*Ow=O+(rowbase+q0+wid*QBLK)*OP+ocol;
  asm volatile("s_waitcnt lgkmcnt(0)\n\ts_barrier":::"memory");
  { bf16*stg=(bf16*)(shm+LDS_OST)+wid*4096;
    #pragma unroll
    for(int r=0;r<16;++r){const int orow=crow(r,hi);
      #pragma unroll
      for(int d0=0;d0<4;++d0)stg[orow*128+d0*32+r32]=__float2bfloat16(o[d0][r]*rli[r]);}
    asm volatile("s_waitcnt lgkmcnt(0)":::"memory");
    #pragma unroll
    for(int i=0;i<8;++i){const int row=i*4+(lane>>4),ch=lane&15; const u32x4 v=*(const u32x4*)(stg+row*128+ch*8); ATTN_STORE16(Ow+(long)row*OP+ch*8,v);} }
  asm volatile("s_waitcnt lgkmcnt(0)\n\ts_barrier":::"memory");
  #undef DMA_K
  #undef DMA_V
  #undef CMASK
  #undef START
  #undef RESC
  #undef ROT
}
constexpr int ATTN_LDS_BYTES=LDS_BYTES;
__device__ __forceinline__ bool attn_next(int G,int vcu,int i,int&b,int&vh,int&qb){
  if(G==256){ const int g=vcu&7, bv=vcu>>3; int q=-1;
    if(g<7){ q=(i==0)?16-g:(i==1)?1+g:-1; } else { q=(i==0)?9:(i==1)?8:(i==2)?0:-1; }
    if(q<0)return false; b=bv>>3; vh=bv&7; qb=q; return true; }
  const int u=vcu+i*G; if(u>=BATCH*8*17)return false; b=u/(8*17); vh=(u/17)&7; qb=u%17; return true;
}
#undef SBAR
#undef WAIT_BAR
}
namespace mk {
using pg8::bf16_t; using pg8::bf16x8; using pg8::f32x4; using pg8::u32x4; using pg8::u32x2; using pg8::Unit; using pg8::Gemm; using pg8::cvt_pk_bf16;
constexpr int NWAVES = 8;
constexpr int D = 1024, NB = 4, SEQ = 4096, NM = 16, MR = NB * SEQ  , MROWS = MR + NM  , MPAD = 16640;
constexpr int TP = 4352, MATT = NB * TP;
constexpr int INC = 8192, FFD = 2816, FFE = 3584, NE = 8;
constexpr float EPS = 1e-6f, LOG2E = 1.4426950408889634f, C2 = 0.125f * LOG2E;
constexpr size_t MiB = 1u << 20;
constexpr size_t WS_CTL = 0, CTL_ZERO_BYTES = 1 * MiB;
constexpr size_t WS_SMALL = 1 * MiB;
constexpr size_t WS_HN = 3 * MiB;
constexpr size_t WS_WIN = 36 * MiB, WS_WBR = 52 * MiB, WS_WO = 55 * MiB, WS_WGU0 = 57 * MiB, WS_WD0 = 68 * MiB;
constexpr size_t WS_U = 74 * MiB;
constexpr size_t WS_O = 123 * MiB, WS_ST = 157 * MiB, WS_HQ = 190 * MiB, WS_LOGF = 207 * MiB, WS_HG = 240 * MiB;
constexpr size_t WS_QK = 257 * MiB, WS_V = 291 * MiB, WS_CONV = 308 * MiB, WS_HV = 357 * MiB, WS_DS = 374 * MiB;
constexpr size_t WS_GATES = 257 * MiB, WS_MIXED = 355 * MiB, WS_MSCR = 388 * MiB;
constexpr size_t WS_H0 = 123 * MiB;
constexpr size_t WS_DEC = 440 * MiB;
constexpr size_t WS_HQ2 = 441 * MiB, WS_OI = 458 * MiB;
constexpr size_t WS_MGU = 36 * MiB, WS_MD = 148 * MiB, WS_MH = 204 * MiB, WS_MY = 442 * MiB;
constexpr size_t WS_HN8 = 491 * MiB, WS_WIN8 = 508 * MiB;
constexpr size_t WS_SLAB = 36 * MiB;
constexpr int LISTCAP = 16640;
constexpr size_t SMB_LIST = 128 * 1024, SMB_TOK = 704 * 1024;
constexpr int CW_CNT = 8192;
constexpr int SM_SCAL = 0;
constexpr int SM_LOGLB = 64, SM_LOG1M = 64 + 1024;
constexpr int SM_TAB = 64 + 2048;
constexpr int SM_METAHS = 4096;
constexpr int RING_OFF = 0, RING_BYTES = 131072, LDSCTL_OFF = RING_BYTES, MISC_OFF = LDSCTL_OFF + 320, LDS_BYTES = 147456;

#define GAS __attribute__((address_space(1)))
#define LAS __attribute__((address_space(3)))
typedef GAS unsigned gu32;
#define RLX_AGENT __ATOMIC_RELAXED, __HIP_MEMORY_SCOPE_AGENT
#define LDS_WAIT() asm volatile("s_waitcnt lgkmcnt(0)" ::: "memory")
__device__ __forceinline__ unsigned f2bf(float f) { unsigned u = __builtin_bit_cast(unsigned, f); return (u + 0x7fffu + ((u >> 16) & 1u)) >> 16; }
__device__ __forceinline__ unsigned pk2(float lo, float hi) { return cvt_pk_bf16(lo, hi); }
__device__ __forceinline__ unsigned f2bf_hw(float f) { return cvt_pk_bf16(f, 0.f) & 0xffffu; }
__device__ __forceinline__ float bf2f(unsigned short b) { return __builtin_bit_cast(float, (unsigned)b << 16); }
__device__ __forceinline__ float bflo(unsigned w) { return __builtin_bit_cast(float, w << 16); }
__device__ __forceinline__ float bfhi(unsigned w) { return __builtin_bit_cast(float, w & 0xffff0000u); }
#ifdef SLOWMATH
__device__ __forceinline__ float sigm(float x) { return 1.f / (1.f + __expf(-x)); }
__device__ __forceinline__ float silu(float x) { return x / (1.f + __expf(-x)); }
#else
__device__ __forceinline__ float sigm(float x) { return __builtin_amdgcn_rcpf(1.f + __expf(-x)); }
__device__ __forceinline__ float silu(float x) { return x * __builtin_amdgcn_rcpf(1.f + __expf(-x)); }
#endif
#ifdef SLOWMATH
__device__ __forceinline__ float logf_gate(float z, float la, float lm) { const float ls = fminf(z, 0.f) - log1pf(expf(-fabsf(z))), bb = lm + ls; return (la == -INFINITY) ? bb : fmaxf(la, bb) + log1pf(expf(-fabsf(la - bb))); }
#else
__device__ __forceinline__ float logf_gate(float z, float la, float lm) { const float ls = fminf(z, 0.f) - __logf(1.f + __expf(-fabsf(z))), bb = lm + ls; return (la == -INFINITY) ? bb : fmaxf(la, bb) + __logf(1.f + __expf(-fabsf(la - bb))); }
#endif
template <int O> __device__ __forceinline__ float xadd(float v) {
    if constexpr (O < 32) return v + __builtin_bit_cast(float, __builtin_amdgcn_ds_swizzle(__builtin_bit_cast(int, v), (O << 10) | 0x1f));
    else { const int l = pg8::lane_id(); return v + __builtin_bit_cast(float, __builtin_amdgcn_ds_bpermute((l ^ 32) << 2, __builtin_bit_cast(int, v))); }
}
__device__ __forceinline__ float wave_sum(float v) { v = xadd<1>(v); v = xadd<2>(v); v = xadd<4>(v); v = xadd<8>(v); v = xadd<16>(v); return xadd<32>(v); }

#define XB_TMO      128
#define XB_XCNT(j)  (256  + 64 * (j))
#define XB_XSUB(j)  (1280 + 64 * (j))
#define XB_XGEN(j)  (2304 + 64 * (j))
#define XB_TOP      3328
#define XB_TOPGEN   3392
#define XCD_BAR_WORDS 3456
#define XB_SPIN_CAP (1u << 18)
__device__ __forceinline__ unsigned xb_ld(unsigned* p)              { return __hip_atomic_load(p, __ATOMIC_RELAXED, __HIP_MEMORY_SCOPE_AGENT); }
__device__ __forceinline__ unsigned xb_add(unsigned* p, unsigned v) { return __hip_atomic_fetch_add(p, v, __ATOMIC_RELAXED, __HIP_MEMORY_SCOPE_AGENT); }
__device__ __forceinline__ unsigned xb_xcc_id() { return (unsigned)__builtin_amdgcn_s_getreg((3 << 11) | 20) & 0xFu; }
#define XB_SPIN(cond, bar) do { unsigned _sp = 0; while (cond) { __builtin_amdgcn_s_sleep(1); \
    if ((++_sp & 255u) == 0u) { if (xb_ld(&(bar)[XB_TMO])) break; if (_sp > XB_SPIN_CAP) { atomicAdd(&(bar)[XB_TMO], 1u); break; } } } } while (0)
struct XcdBarrier { unsigned* bar; unsigned x; volatile LAS unsigned* st; };
__device__ __forceinline__ XcdBarrier xcd_barrier_post(unsigned* bar, volatile LAS unsigned* st, int tid) {
    XcdBarrier b; b.bar = bar; b.x = xb_xcc_id(); b.st = st;
    if (tid == 0) (void)xb_add(&bar[XB_XCNT(b.x)], 1u);
    return b;
}
__device__ __forceinline__ void xcd_barrier_complete(unsigned* bar, unsigned x, unsigned& nloc, unsigned& nx) {
    const unsigned G = gridDim.x * gridDim.y * gridDim.z;
    unsigned sum, cnt, mine, sp = 0u;
    for (;;) {
        sum = 0u; cnt = 0u; mine = 0u;
#pragma unroll
        for (unsigned j = 0; j < 16; ++j) { const unsigned c = xb_ld(&bar[XB_XCNT(j)]); sum += c; cnt += (c > 0u) ? 1u : 0u; mine = (j == x) ? c : mine; }
        if (sum == G) break;
        __builtin_amdgcn_s_sleep(1);
        if ((++sp & 255u) == 0u) { if (xb_ld(&bar[XB_TMO])) break; if (sp > XB_SPIN_CAP) { atomicAdd(&bar[XB_TMO], 1u); break; } }
    }
    nloc = mine > 0u ? mine : 1u; nx = cnt > 0u ? cnt : 1u;
}
__device__ __forceinline__ void xcd_barrier(const XcdBarrier& b, int tid) {
    asm volatile("s_waitcnt vmcnt(0)" ::: "memory");
    __syncthreads();
    if (tid == 0) {
        unsigned* bar = b.bar;
        __builtin_amdgcn_s_waitcnt(0);
        unsigned nloc = b.st[0], nx = b.st[1];
        if (nloc == 0u) { xcd_barrier_complete(bar, b.x, nloc, nx); b.st[0] = nloc; b.st[1] = nx; }
        const unsigned old = xb_add(&bar[XB_XSUB(b.x)], 1u);
        const unsigned gen = old / nloc, tgt = (gen + 1u) * nx;
        if (old + 1u == (gen + 1u) * nloc) {
            __builtin_amdgcn_fence(__ATOMIC_RELEASE, "agent");
            asm volatile("s_waitcnt vmcnt(0)" ::: "memory");
            (void)xb_add(&bar[XB_TOP], 1u);
        }
        XB_SPIN(xb_ld(&bar[XB_TOP]) < tgt, bar);
        __builtin_amdgcn_fence(__ATOMIC_ACQUIRE, "agent");
        asm volatile("s_waitcnt vmcnt(0)" ::: "memory");
    }
    __syncthreads();
}

struct Frame {
    LAS unsigned char* lds; unsigned char* lds_gen;
    int tid, lane, wave, vcu, G;
    const float* const* in; float* out; unsigned char* ws;
};
#define WSP(T, off) ((T*)(F.ws + (off)))
#define SMALLF (WSP(float, WS_SMALL))

__device__ __forceinline__ void cvt_block(const float* W, int ldw, int k0, int c0, bf16_t* WT, int ldt, int r0, LAS float* scr, int lane) {
    float wv[32];
    const float* wp = W + (size_t)(k0 + (lane >> 5)) * ldw + c0 + (lane & 31);
#pragma unroll
    for (int i = 0; i < 32; ++i) wv[i] = __builtin_nontemporal_load(wp + (size_t)(2 * i) * ldw);
#pragma unroll
    for (int i = 0; i < 32; ++i) scr[(2 * i + (lane >> 5)) * 33 + (lane & 31)] = wv[i];
    LDS_WAIT(); asm volatile("" ::: "memory");
    const int c = lane & 7;
#pragma unroll
    for (int j = 0; j < 4; ++j) { const int n = (lane >> 3) + 8 * j; const LAS float* s = scr + (8 * c) * 33 + n;
        u32x4 o; o.x = pk2(s[0 * 33], s[1 * 33]); o.y = pk2(s[2 * 33], s[3 * 33]); o.z = pk2(s[4 * 33], s[5 * 33]); o.w = pk2(s[6 * 33], s[7 * 33]);
        *(GAS u32x4*)(WT + (size_t)(r0 + n) * ldt + k0 + 8 * c) = o; }
    LDS_WAIT(); asm volatile("" ::: "memory");
}
constexpr float W8_SCALE = 32.f, H8_SCALE = 4.f, WD8_SCALE = 64.f;
__device__ __forceinline__ unsigned pk4_fp8(float a, float b, float c, float d) { int r = __builtin_amdgcn_cvt_pk_fp8_f32(a, b, 0, false); r = __builtin_amdgcn_cvt_pk_fp8_f32(c, d, r, true); return (unsigned)r; }
__device__ __forceinline__ void cvt_block_fp8(const float* W, int ldw, int k0, int c0, unsigned char* WT, int ldt, int r0, LAS float* scr, int lane, float wscale) {
    float wv[32];
    const float* wp = W + (size_t)(k0 + (lane >> 5)) * ldw + c0 + (lane & 31);
#pragma unroll
    for (int i = 0; i < 32; ++i) wv[i] = __builtin_nontemporal_load(wp + (size_t)(2 * i) * ldw);
#pragma unroll
    for (int i = 0; i < 32; ++i) scr[(2 * i + (lane >> 5)) * 33 + (lane & 31)] = wv[i] * wscale;
    LDS_WAIT(); asm volatile("" ::: "memory");
    const int c = lane & 7;
#pragma unroll
    for (int j = 0; j < 4; ++j) { const int n = (lane >> 3) + 8 * j; const LAS float* s = scr + (8 * c) * 33 + n;
        u32x2 o; o.x = pk4_fp8(s[0 * 33], s[1 * 33], s[2 * 33], s[3 * 33]); o.y = pk4_fp8(s[4 * 33], s[5 * 33], s[6 * 33], s[7 * 33]);
        *(GAS u32x2*)(WT + (size_t)(r0 + n) * ldt + k0 + 8 * c) = o; }
    LDS_WAIT(); asm volatile("" ::: "memory");
}
struct CvtItem { const float* W; int ldw, k0, c0; void* WT; int ldt, r0; };
__device__ __forceinline__ void cvt_load(float (&wv)[32], const CvtItem& c, int lane) {
    const float* wp = c.W + (size_t)(c.k0 + (lane >> 5)) * c.ldw + c.c0 + (lane & 31);
#pragma unroll
    for (int i = 0; i < 32; ++i) wv[i] = __builtin_nontemporal_load(wp + (size_t)(2 * i) * c.ldw);
}
template <bool FP8> __device__ __forceinline__ void cvt_store(const float (&wv)[32], const CvtItem& c, LAS float* scr, int lane, float wscale) {
#pragma unroll
    for (int i = 0; i < 32; ++i) scr[(2 * i + (lane >> 5)) * 33 + (lane & 31)] = FP8 ? wv[i] * wscale : wv[i];
    LDS_WAIT(); asm volatile("" ::: "memory");
    const int cc = lane & 7;
#pragma unroll
    for (int j = 0; j < 4; ++j) { const int n = (lane >> 3) + 8 * j; const LAS float* q = scr + (8 * cc) * 33 + n;
        if constexpr (FP8) { u32x2 o; o.x = pk4_fp8(q[0 * 33], q[1 * 33], q[2 * 33], q[3 * 33]); o.y = pk4_fp8(q[4 * 33], q[5 * 33], q[6 * 33], q[7 * 33]);
            *(GAS u32x2*)((unsigned char*)c.WT + (size_t)(c.r0 + n) * c.ldt + c.k0 + 8 * cc) = o; }
        else { u32x4 o; o.x = pk2(q[0 * 33], q[1 * 33]); o.y = pk2(q[2 * 33], q[3 * 33]); o.z = pk2(q[4 * 33], q[5 * 33]); o.w = pk2(q[6 * 33], q[7 * 33]);
            *(GAS u32x4*)((bf16_t*)c.WT + (size_t)(c.r0 + n) * c.ldt + c.k0 + 8 * cc) = o; } }
    LDS_WAIT(); asm volatile("" ::: "memory");
}
template <bool FP8, class Dec> __device__ __forceinline__ void cvt_run(int it0, int stride, int n, const Dec& dec, LAS float* scr, int lane, float wscale) {
    for (int it = it0; it < n; it += 2 * stride) {
        float a[32], b[32]; const CvtItem ca = dec(it); cvt_load(a, ca, lane);
        const int it2 = it + stride; const bool hb = it2 < n; CvtItem cb = ca; if (hb) { cb = dec(it2); cvt_load(b, cb, lane); }
        cvt_store<FP8>(a, ca, scr, lane, wscale); if (hb) cvt_store<FP8>(b, cb, scr, lane, wscale);
    }
}
__device__ __forceinline__ int win_src_col(int db) { const int r0 = db * 32, tile = r0 >> 8, loc = r0 & 255; if (tile >= 4) return r0; const int bj = loc >> 7, wc = (loc & 127) >> 5; return tile * 256 + 64 * wc + 32 * bj; }

__device__ __forceinline__ void convert_layer_weights(Frame& F, int l, int widx = -1, int nw = 0, int part = 0) {
    LAS float* scr = (LAS float*)(F.lds + RING_OFF + F.wave * 16384);
    const int gw = widx >= 0 ? widx : F.vcu * NWAVES + F.wave, NGW = widx >= 0 ? nw : F.G * NWAVES;
    const float* w_in = F.in[4] + (size_t)l * D * INC; const float* w_br = F.in[13] + (size_t)l * 3 * 512 * D; const float* w_o = F.in[14] + (size_t)l * D * D;
    constexpr int I_IN = 16 * 256, I_BR = 3 * 8 * 32, I_O = 16 * 32, I_GU = 16 * 176, I_DN = 44 * 32;
    const int nitems = I_IN + I_BR + I_O + (l == 0 ? I_GU + I_DN : 0);
    const auto dec = [&](int it) -> CvtItem { int r = it;
        if (r < I_IN) { const int kb = r >> 8, db = r & 255; return CvtItem{w_in, INC, kb * 64, win_src_col(db), WSP(bf16_t, WS_WIN), D, db * 32}; } r -= I_IN;
        if (r < I_BR) { const int br = r / 256, q = r % 256, kb = q >> 5, db = q & 31; return CvtItem{w_br + (size_t)br * 512 * D, D, kb * 64, db * 32, WSP(bf16_t, WS_WBR) + 512 * br, 1536, db * 32}; }   r -= I_BR;
        if (r < I_O) { const int kb = r >> 5, db = r & 31; return CvtItem{w_o, D, kb * 64, db * 32, WSP(bf16_t, WS_WO), D, db * 32}; } r -= I_O;
        if (r < I_GU) { const int kb = r / 176, db = r % 176, tile = db >> 3, l32 = db & 7; const float* src = (l32 < 4) ? F.in[15] : F.in[16];
            return CvtItem{src, FFD, kb * 64, tile * 128 + (l32 & 3) * 32, WSP(bf16_t, WS_WGU0), D, db * 32}; } r -= I_GU;
        const int kb = r >> 5, db = r & 31; return CvtItem{F.in[17], D, kb * 64, db * 32, WSP(bf16_t, WS_WD0), FFD, db * 32}; };
    const int it_lo = part == 2 ? I_IN + I_BR + I_O : 0, it_hi = part == 1 ? I_IN + I_BR + I_O : nitems;
    cvt_run<false>(it_lo + gw, NGW, it_hi, dec, scr, F.lane, 1.f);
    if (part == 2) return;
    const auto dec8 = [&](int it) -> CvtItem { const int kb = it / 96, db = it % 96; return CvtItem{w_in, INC, kb * 64, (160 + db) * 32, F.ws + WS_WIN8, D, db * 32}; };
    cvt_run<true>(gw, NGW, 16 * 96, dec8, scr, F.lane, W8_SCALE);
}
__device__ __forceinline__ void setup_small(Frame& F, bool tables = true) {
    float* sm = SMALLF;
    if (blockIdx.x == 0 && tables) {
        if (F.tid < 2) { const int l = F.tid; const float* lp = F.in[7] + l * 256; float s1 = 0.f, s2 = 0.f;
            for (int i = 0; i < 64; ++i) { s1 += lp[i] * lp[64 + i]; s2 += lp[128 + i] * lp[192 + i]; }
            const float li = 0.8f - 0.6f * expf(-0.3f * (float)l); sm[SM_SCAL + l * 4] = expf(s1) - expf(s2) + li; sm[SM_SCAL + l * 4 + 1] = 1.f - li; }
        { const int c = F.tid; const float a = F.in[11][c], b = F.in[11][512 + c], mx = fmaxf(a, b), e0 = expf(a - mx), e1 = expf(b - mx), lb1 = e1 / (e0 + e1);
            sm[SM_LOGLB + c] = -INFINITY; sm[SM_LOG1M + c] = 0.f; sm[SM_LOGLB + 512 + c] = logf(lb1); sm[SM_LOG1M + 512 + c] = log1pf(-lb1); }
        { const int h = F.tid >> 7, n = F.tid & 127; int bk = n; if (n >= 16) { bk = 16 + (int)(logf((float)n / 16.f) / 2.0794415416798357f * 16.f); bk = bk < 31 ? bk : 31; }
            sm[SM_TAB + h * 128 + n] = (F.in[9][bk * 4 + h] - F.in[9][31 * 4 + h]) * LOG2E; }
    }
    const int gt = F.vcu * 512 + F.tid, NT = F.G * 512;
    for (int i = gt; i < NE * LISTCAP; i += NT) ((int*)(F.ws + WS_SMALL + SMB_LIST))[i] = 0;
    for (int i = gt; i < NB * 240 * (1024 / 8); i += NT) { const int row = i / 128, c = i % 128, b = row / 240, p = 4112 + row % 240; *(GAS u32x4*)(WSP(bf16_t, WS_QK) + ((size_t)(b * TP + p)) * 1024 + c * 8) = (u32x4){0u, 0u, 0u, 0u}; }
    for (int i = gt; i < NB * 240 * (512 / 8); i += NT) { const int row = i / 64, c = i % 64, b = row / 240, p = 4112 + row % 240; *(GAS u32x4*)(WSP(bf16_t, WS_V) + ((size_t)(b * TP + p)) * 512 + c * 8) = (u32x4){0u, 0u, 0u, 0u}; }
}
__device__ __forceinline__ const float* res_row(Frame& F, int r, bool first) {
    if (r < MR) return (first ? F.in[0] : (const float*)F.out) + (size_t)r * D;
    return (first ? F.in[1] : (const float*)(SMALLF + SM_METAHS)) + (size_t)(r - MR) * D;
}
__device__ __forceinline__ float* res_row_w(Frame& F, int r) { return (r < MR) ? F.out + (size_t)r * D : SMALLF + SM_METAHS + (size_t)(r - MR) * D; }
__device__ __forceinline__ void norm_pass(Frame& F, const float* gain, bool first, bool copy8) {
    const int gw = F.vcu * NWAVES + F.wave, NGW = F.G * NWAVES;
    f32x4 gv[4];
#pragma unroll
    for (int j = 0; j < 4; ++j) gv[j] = ((const f32x4*)gain)[F.lane + 64 * j];
    for (int r = gw; r < MROWS; r += NGW) {
        const GAS f32x4* xr = (const GAS f32x4*)res_row(F, r, first) + F.lane;
        f32x4 v[4]; float s = 0.f;
#pragma unroll
        for (int j = 0; j < 4; ++j) { v[j] = xr[64 * j]; s += (v[j].x * v[j].x + v[j].y * v[j].y) + (v[j].z * v[j].z + v[j].w * v[j].w); }
        const float sc = rsqrtf(wave_sum(s) * (1.f / D) + EPS);
        GAS u32x2* o = (GAS u32x2*)(WSP(bf16_t, WS_HN) + (size_t)r * D) + F.lane;
#pragma unroll
        for (int j = 0; j < 4; ++j) { u32x2 w; w.x = pk2(v[j].x * sc * gv[j].x, v[j].y * sc * gv[j].y); w.y = pk2(v[j].z * sc * gv[j].z, v[j].w * sc * gv[j].w); o[64 * j] = w; }
        if (copy8 && r < MR) { GAS unsigned* o8 = (GAS unsigned*)(F.ws + WS_HN8 + (size_t)r * D) + F.lane;
#pragma unroll
            for (int j = 0; j < 4; ++j) o8[64 * j] = pk4_fp8(v[j].x * sc * gv[j].x, v[j].y * sc * gv[j].y, v[j].z * sc * gv[j].z, v[j].w * sc * gv[j].w); }
    }
}

struct TileOrder {
    int nM, nN, nwg, G, c, pn0; long lda2, ldb2;
    __device__ void init(int nM_, int nN_, int pn0_, int G_, int c_, int lda, int ldb) { nM = nM_; nN = nN_; nwg = nM * nN; G = G_; c = c_; pn0 = pn0_; lda2 = 2L * lda; ldb2 = 2L * ldb; }
    __device__ __forceinline__ bool next(int i, Unit& u) const {
        const long L = (long)i * G + c; if (L >= nwg) return false;
        int wgid = (int)L; { const int q = nwg / 8, r = nwg % 8, xcd = wgid % 8, off = wgid / 8; wgid = (xcd < r ? xcd * (q + 1) : r * (q + 1) + (xcd - r) * q) + off; }
        const int nig = 8 * nN, gid = wgid / nig, fm = gid * 8, gsz = (nM - fm) < 8 ? (nM - fm) : 8;
        u.pm = fm + ((wgid % nig) % gsz); u.pn = pn0 + (wgid % nig) / gsz; u.z = 0; u.a_off = (unsigned)((long)u.pm * 256 * lda2); u.b_off = (unsigned)((long)u.pn * 256 * ldb2); u.gidx = nullptr; return true;
    }
};
__device__ __forceinline__ u32x4 pack8(const f32x4 a, const f32x4 b) { u32x4 w; w.x = cvt_pk_bf16(a[0], a[1]); w.y = cvt_pk_bf16(a[2], a[3]); w.z = cvt_pk_bf16(b[0], b[1]); w.w = cvt_pk_bf16(b[2], b[3]); return w; }
__device__ __forceinline__ void store_att(bf16_t* buf, int pitch, int r, int col, u32x4 w) {
    if (r < MR) { const int ar = (r >> 12) * TP + NM + (r & 4095); *(u32x4*)(buf + (size_t)ar * pitch + col) = w; }
    else { const int j = r - MR;
#pragma unroll
        for (int b = 0; b < NB; ++b) *(u32x4*)(buf + (size_t)(b * TP + j) * pitch + col) = w; }
}
struct EpiProj {
    static constexpr bool PERM = true, MID = false;
    unsigned char* ws; const float *qg, *kg; int l; float gsc;
    __device__ __forceinline__ void row(const Unit& u, int r, int slot, int wc, int fq, const f32x4 (&v)[2][2]) const {
        const int pn = u.pn;
        bf16_t* QK = (bf16_t*)(ws + WS_QK); bf16_t* V = (bf16_t*)(ws + WS_V); bf16_t* CONV = (bf16_t*)(ws + WS_CONV); bf16_t* HQ = (bf16_t*)(ws + WS_HQ); bf16_t* HV = (bf16_t*)(ws + WS_HV); bf16_t* HG = (bf16_t*)(ws + WS_HG);
        bf16_t* GATES = (bf16_t*)(ws + WS_GATES); float* LOGF = (float*)(ws + WS_LOGF); const float* loglb = (const float*)(ws + WS_SMALL) + SM_LOGLB + l * 512; const float* log1m = (const float*)(ws + WS_SMALL) + SM_LOG1M + l * 512;
        if (pn < 4) {
            float ss = 0.f;
#pragma unroll
            for (int bj = 0; bj < 2; ++bj)
#pragma unroll
                for (int n = 0; n < 2; ++n) ss += (v[bj][n][0] * v[bj][n][0] + v[bj][n][1] * v[bj][n][1]) + (v[bj][n][2] * v[bj][n][2] + v[bj][n][3] * v[bj][n][3]);
            ss = xadd<16>(ss); ss = xadd<32>(ss);
            const float sc = rsqrtf(ss * (1.f / 64.f) + EPS) * (pn < 2 ? C2 : 1.f); const float* gv = pn < 2 ? qg : kg;
#pragma unroll
            for (int bj = 0; bj < 2; ++bj) { const int d0 = 32 * bj + 8 * fq; const f32x4 g0 = *(const f32x4*)(gv + d0), g1 = *(const f32x4*)(gv + d0 + 4);
                store_att(QK, 1024, r, pn * 256 + 64 * wc + d0, pack8(v[bj][0] * g0 * sc, v[bj][1] * g1 * sc)); }
            return;
        }
#pragma unroll
        for (int bj = 0; bj < 2; ++bj) {
            const int cl = 128 * bj + 32 * wc + 8 * fq; f32x4 a = v[bj][0], b = v[bj][1];
            if (pn < 6) { store_att(V, 512, r, (pn - 4) * 256 + cl, pack8(a, b)); }
            else if (pn < 12) { *(u32x4*)(CONV + (size_t)r * 1536 + (pn - 6) * 256 + cl) = pack8(a, b); }
            else if (pn < 14 || (pn >= 18 && pn < 20)) {
#pragma unroll
                for (int e = 0; e < 4; ++e) { a[e] = silu(a[e]); b[e] = silu(b[e]); }
                bf16_t* dst = (pn < 14) ? HQ + (size_t)r * 512 + (pn - 12) * 256 + cl : HG + (size_t)r * 512 + (pn - 18) * 256 + cl; *(u32x4*)dst = pack8(a, b); }
            else if (pn < 16) {
                const int c = (pn - 14) * 256 + cl; const f32x4 la0 = *(const f32x4*)(loglb + c), la1 = *(const f32x4*)(loglb + c + 4), lm0 = *(const f32x4*)(log1m + c), lm1 = *(const f32x4*)(log1m + c + 4);
                f32x4 o0, o1;
#pragma unroll
                for (int e = 0; e < 4; ++e) {
                    o0[e] = logf_gate(a[e], la0[e], lm0[e]); o1[e] = logf_gate(b[e], la1[e], lm1[e]);
                }
                float* dst = LOGF + (size_t)r * 512 + c; *(f32x4*)dst = o0; *(f32x4*)(dst + 4) = o1; }
            else if (pn < 18) { *(u32x4*)(HV + (size_t)r * 512 + (pn - 16) * 256 + cl) = pack8(a, b); }
            else {
#pragma unroll
                for (int e = 0; e < 4; ++e) { a[e] = sigm(a[e] * gsc); b[e] = sigm(b[e] * gsc); }
                *(u32x4*)(GATES + (size_t)r * 3072 + (pn - 20) * 256 + cl) = pack8(a, b); }
        }
    }
};
struct EpiMerge {
    static constexpr bool PERM = true, MID = true; static constexpr int MID_T0 = 8, MID_T1 = 16;
    const bf16_t* GATES; bf16_t* MIXED;
    __device__ __forceinline__ void mid_row(const Unit& u, int r, int t, int wc, int fq, f32x4 (&v)[2][2]) const {
        const int b = (t >> 3) - 1;
#pragma unroll
        for (int bj = 0; bj < 2; ++bj) {
            const bf16_t* gp = GATES + (size_t)r * 3072 + b * 1024 + u.pn * 256 + 128 * bj + 32 * wc + 8 * fq; const u32x4 ga = *(const u32x4*)gp, gb = *(const u32x4*)(gp + 1024);
#define MK_RT(x, y) ((x) * __builtin_amdgcn_rcpf(fmaxf((y), 1e-20f)))
            v[bj][0][0] *= MK_RT(bflo(ga.x), bflo(gb.x)); v[bj][0][1] *= MK_RT(bfhi(ga.x), bfhi(gb.x)); v[bj][0][2] *= MK_RT(bflo(ga.y), bflo(gb.y)); v[bj][0][3] *= MK_RT(bfhi(ga.y), bfhi(gb.y));
            v[bj][1][0] *= MK_RT(bflo(ga.z), bflo(gb.z)); v[bj][1][1] *= MK_RT(bfhi(ga.z), bfhi(gb.z)); v[bj][1][2] *= MK_RT(bflo(ga.w), bflo(gb.w)); v[bj][1][3] *= MK_RT(bfhi(ga.w), bfhi(gb.w));
#undef MK_RT
        }
    }
    __device__ __forceinline__ void row(const Unit& u, int r, int slot, int wc, int fq, const f32x4 (&v)[2][2]) const {
        u32x4 gws[2];
#pragma unroll
        for (int bj = 0; bj < 2; ++bj) gws[bj] = *(const GAS u32x4*)(GATES + (size_t)r * 3072 + 2048 + u.pn * 256 + 128 * bj + 32 * wc + 8 * fq);
#pragma unroll
        for (int bj = 0; bj < 2; ++bj) {
            const int cl = 128 * bj + 32 * wc + 8 * fq; const u32x4 gw = gws[bj];
            f32x4 a = v[bj][0], b = v[bj][1];
            a[0] *= bflo(gw.x); a[1] *= bfhi(gw.x); a[2] *= bflo(gw.y); a[3] *= bfhi(gw.y); b[0] *= bflo(gw.z); b[1] *= bfhi(gw.z); b[2] *= bflo(gw.w); b[3] *= bfhi(gw.w);
            *(u32x4*)(MIXED + (size_t)r * D + u.pn * 256 + cl) = pack8(a, b);
        }
    }
};
struct EpiRes {
    static constexpr bool PERM = false, MID = false;
    const float* base; float* out; const float* mbase; float* mout;
    __device__ __forceinline__ void row(const Unit& u, int r, int slot, int wc, int fq, const f32x4 (&v)[2][2]) const {
        const float* bp = (r < MR) ? base + (size_t)r * D : mbase + (size_t)(r - MR) * D; float* op = (r < MR) ? out + (size_t)r * D : mout + (size_t)(r - MR) * D;
        f32x4 bs[2][2];
#pragma unroll
        for (int bj = 0; bj < 2; ++bj)
#pragma unroll
            for (int n = 0; n < 2; ++n) { const int col = u.pn * 256 + 128 * bj + 32 * wc + 16 * n + 4 * fq; bs[bj][n] = *(const GAS f32x4*)(bp + col); }
#pragma unroll
        for (int bj = 0; bj < 2; ++bj)
#pragma unroll
            for (int n = 0; n < 2; ++n) { const int col = u.pn * 256 + 128 * bj + 32 * wc + 16 * n + 4 * fq; *(GAS f32x4*)(op + col) = bs[bj][n] + v[bj][n]; }
    }
};
struct EpiGU {
    static constexpr bool PERM = true, MID = false;
    bf16_t* H; int ldh; float sc;
    __device__ __forceinline__ void row(const Unit& u, int r, int slot, int wc, int fq, const f32x4 (&v)[2][2]) const {
        f32x4 a, b;
#pragma unroll
        for (int e = 0; e < 4; ++e) { a[e] = silu(v[0][0][e] * sc) * (v[1][0][e] * sc); b[e] = silu(v[0][1][e] * sc) * (v[1][1][e] * sc); }
        *(u32x4*)(H + (size_t)r * ldh + u.pn * 128 + 32 * wc + 8 * fq) = pack8(a, b);
    }
};

struct EpiGU8 {
    static constexpr bool PERM = true, MID = false;
    unsigned char* H; int ldh; float sc;
    __device__ __forceinline__ void row(const Unit& u, int r, int slot, int wc, int fq, const f32x4 (&v)[2][2]) const {
        f32x4 a, b;
#pragma unroll
        for (int e = 0; e < 4; ++e) { a[e] = silu(v[0][0][e] * sc) * (v[1][0][e] * (sc * H8_SCALE)); b[e] = silu(v[0][1][e] * sc) * (v[1][1][e] * (sc * H8_SCALE)); }
#pragma unroll
        for (int e = 0; e < 4; ++e) { a[e] = __builtin_amdgcn_fmed3f(a[e], -448.f, 448.f); b[e] = __builtin_amdgcn_fmed3f(b[e], -448.f, 448.f); }
        u32x2 o; o.x = pk4_fp8(a[0], a[1], a[2], a[3]); o.y = pk4_fp8(b[0], b[1], b[2], b[3]);
        *(u32x2*)(H + (size_t)r * ldh + u.pn * 128 + 32 * wc + 8 * fq) = o;
    }
};
template <class Epi>
__device__ __forceinline__ void meta_gemm(Frame& F, const bf16_t* A16, int lda, const bf16_t* Bt, int ldb, int K, int pn_lo, int pn_hi, const Epi& E, int widx = -1, int nw = 0) {
    const int fr = F.lane & 15, fq = F.lane >> 4;
    for (int task = pn_lo * 4 + (widx >= 0 ? widx : F.vcu); task < pn_hi * 4; task += (widx >= 0 ? nw : F.G)) {
        const int pn = task >> 2, wc = task & 3; f32x4 v[2][2];
        pg8::small_tile<Epi::PERM>(F.lds + RING_OFF, A16, lda, Bt, ldb, K, pn, wc, v, F.wave);
        if (F.wave == 0) { Unit u; u.pm = 64; u.pn = pn; u.z = 0; u.a_off = 0; u.b_off = 0; u.gidx = nullptr; E.row(u, MR + fr, 0, wc, fq, v); }
    }
}
__device__ __forceinline__ void meta_merge(Frame& F, const bf16_t* U16, const bf16_t* Wbr, const bf16_t* GATES, bf16_t* MIXED) {
    const int fr = F.lane & 15, fq = F.lane >> 4;
    for (int task = F.vcu; task < 16; task += F.G) {
        const int pn = task >> 2, wc = task & 3; f32x4 tot[2][2];
#pragma unroll
        for (int bj = 0; bj < 2; ++bj)
#pragma unroll
            for (int n = 0; n < 2; ++n) tot[bj][n] = (f32x4){0.f, 0.f, 0.f, 0.f};
        for (int z = 0; z < 3; ++z) {
            f32x4 v[2][2];
            pg8::small_tile<true>(F.lds + RING_OFF, U16 + 512 * z, 1536, Wbr + 512 * z, 1536, 512, pn, wc, v, F.wave);
            if (F.wave == 0) {
#pragma unroll
                for (int bj = 0; bj < 2; ++bj) { const int cl = 128 * bj + 32 * wc + 8 * fq; const u32x4 gw = *(const u32x4*)(GATES + (size_t)(MR + fr) * 3072 + z * 1024 + pn * 256 + cl);
                    f32x4 a = v[bj][0], b = v[bj][1];
                    a[0] *= bflo(gw.x); a[1] *= bfhi(gw.x); a[2] *= bflo(gw.y); a[3] *= bfhi(gw.y); b[0] *= bflo(gw.z); b[1] *= bfhi(gw.z); b[2] *= bflo(gw.w); b[3] *= bfhi(gw.w);
                    tot[bj][0] += a; tot[bj][1] += b; }
            }
        }
        if (F.wave == 0) {
#pragma unroll
            for (int bj = 0; bj < 2; ++bj) { const int cl = 128 * bj + 32 * wc + 8 * fq; *(u32x4*)(MIXED + (size_t)(MR + fr) * D + pn * 256 + cl) = pack8(tot[bj][0], tot[bj][1]); }
        }
    }
}

__device__ __forceinline__ int prev_row(int r, int d) {
    if (r >= MR) { const int j = r - MR - d; return j >= 0 ? MR + j : -1; }
    const int s = r & 4095; if (s >= d) return r - d; return MR + NM + s - d;
}
__device__ __forceinline__ void conv_pass(Frame& F, const float* cw) {
    const bf16_t* CONV = WSP(bf16_t, WS_CONV); bf16_t* U = WSP(bf16_t, WS_U);
    const int gt = F.vcu * 512 + F.tid, NT = F.G * 512, c8 = (gt & 63) * 8;
    f32x4 w0[3], w1[3];
#pragma unroll
    for (int k = 0; k < 3; ++k) { w0[k] = *(const GAS f32x4*)(cw + k * 512 + c8); w1[k] = *(const GAS f32x4*)(cw + k * 512 + c8 + 4); }
    for (int i = gt; i < MROWS * 64; i += 2 * NT) {
        u32x4 cv[2][3], hv[2][3], bv[2]; float mk[2][3];
#pragma unroll
        for (int q = 0; q < 2; ++q) { const int iq = i + q * NT; const int r = (iq < MROWS * 64 ? iq : i) >> 6;
#pragma unroll
            for (int k = 0; k < 3; ++k) { const int rr = (k == 2) ? r : prev_row(r, 2 - k); mk[q][k] = rr < 0 ? 0.f : 1.f; const int rc = rr < 0 ? r : rr;
                cv[q][k] = *(const GAS u32x4*)(CONV + (size_t)rc * 1536 + 512 + c8); hv[q][k] = *(const GAS u32x4*)(CONV + (size_t)rc * 1536 + 1024 + c8); }
            bv[q] = *(const GAS u32x4*)(CONV + (size_t)r * 1536 + c8); }
#pragma unroll
        for (int q = 0; q < 2; ++q) { const int iq = i + q * NT; if (iq >= MROWS * 64) continue; const int r = iq >> 6; float y[8];
#pragma unroll
            for (int e = 0; e < 8; ++e) y[e] = 0.f;
#pragma unroll
            for (int k = 0; k < 3; ++k) { const u32x4 c = cv[q][k], hh = hv[q][k]; const f32x4 a0 = w0[k] * mk[q][k], a1 = w1[k] * mk[q][k];
                y[0] += a0[0] * bflo(c.x) * bflo(hh.x); y[1] += a0[1] * bfhi(c.x) * bfhi(hh.x); y[2] += a0[2] * bflo(c.y) * bflo(hh.y); y[3] += a0[3] * bfhi(c.y) * bfhi(hh.y);
                y[4] += a1[0] * bflo(c.z) * bflo(hh.z); y[5] += a1[1] * bfhi(c.z) * bfhi(hh.z); y[6] += a1[2] * bflo(c.w) * bflo(hh.w); y[7] += a1[3] * bfhi(c.w) * bfhi(hh.w); }
            const u32x4 bq = bv[q];
            u32x4 o; o.x = pk2(bflo(bq.x) * y[0], bfhi(bq.x) * y[1]); o.y = pk2(bflo(bq.y) * y[2], bfhi(bq.y) * y[3]); o.z = pk2(bflo(bq.z) * y[4], bfhi(bq.z) * y[5]); o.w = pk2(bflo(bq.w) * y[6], bfhi(bq.w) * y[7]);
            *(GAS u32x4*)(U + (size_t)r * 1536 + 512 + c8) = o; }
    }
}
__device__ __forceinline__ void attcomb_pass(Frame& F, const float* sg, int l) {
    const bf16_t* O = WSP(bf16_t, WS_O); bf16_t* U = WSP(bf16_t, WS_U);
    const int gw = F.vcu * NWAVES + F.wave, NGW = F.G * NWAVES;
    const float lam = SMALLF[SM_SCAL + l * 4], oml = SMALLF[SM_SCAL + l * 4 + 1];
    const int c8 = F.lane * 8; const f32x4 g0 = *(const f32x4*)(sg + (c8 & 127)), g1 = *(const f32x4*)(sg + (c8 & 127) + 4);
    for (int r = gw; r < MROWS; r += NGW) {
        const int ar = (r < MR) ? (r >> 12) * TP + NM + (r & 4095) : (r - MR);
        const u32x4 a = *(const u32x4*)(O + (size_t)ar * 1024 + c8), b = *(const u32x4*)(O + (size_t)ar * 1024 + 512 + c8);
        float d[8]; d[0] = bflo(a.x) - lam * bflo(b.x); d[1] = bfhi(a.x) - lam * bfhi(b.x); d[2] = bflo(a.y) - lam * bflo(b.y); d[3] = bfhi(a.y) - lam * bfhi(b.y);
        d[4] = bflo(a.z) - lam * bflo(b.z); d[5] = bfhi(a.z) - lam * bfhi(b.z); d[6] = bflo(a.w) - lam * bflo(b.w); d[7] = bfhi(a.w) - lam * bfhi(b.w);
        float ss = 0.f;
#pragma unroll
        for (int e = 0; e < 8; ++e) ss += d[e] * d[e];
        ss = xadd<1>(ss); ss = xadd<2>(ss); ss = xadd<4>(ss); ss = xadd<8>(ss);
        const float sc = rsqrtf(ss * (1.f / 128.f) + EPS) * oml;
        u32x4 o; o.x = pk2(d[0] * sc * g0[0], d[1] * sc * g0[1]); o.y = pk2(d[2] * sc * g0[2], d[3] * sc * g0[3]); o.z = pk2(d[4] * sc * g1[0], d[5] * sc * g1[1]); o.w = pk2(d[6] * sc * g1[2], d[7] * sc * g1[3]);
        *(u32x4*)(U + (size_t)r * 1536 + c8) = o;
    }
}

constexpr int HA_QP = 0, HA_KP = 43520, HA_KT = HA_KP + 17408, HA_VT = HA_KT + 18432, HA_PB = HA_VT + 18432, HA_TOT = HA_PB + 9216;
__device__ __forceinline__ int qp_base(int j) { return j == 0 ? 0 : (j == 1 ? 64 : (j == 2 ? 112 : 144)); }
struct HgIn { float lf[16], qv[16], vv[16]; };
__device__ __forceinline__ void hgrnA_load(Frame& F, int id, HgIn& in) {
    const bool meta = id >= 1024; const int bh = meta ? 0 : id >> 6, c = id & 63, h = meta ? id - 1024 : bh & 3, b = bh >> 2;
    const int row0 = meta ? MR : b * SEQ + c * 64, nvalid = meta ? NM : 64;
    const int d = F.tid & 127, i = F.tid >> 7;
    const bf16_t* HQ = WSP(bf16_t, WS_HQ); const bf16_t* HV = WSP(bf16_t, WS_HV); const float* LOGF = WSP(float, WS_LOGF);
#pragma unroll
    for (int j = 0; j < 16; ++j) { const int t = 16 * i + j; const bool ok = t < nvalid; const size_t off = (size_t)(row0 + (ok ? t : 0)) * 512 + h * 128 + d;
        const float a = LOGF[off]; const unsigned short q = HQ[off], v = HV[off]; in.lf[j] = ok ? a : 0.f; in.qv[j] = ok ? bf2f(q) : 0.f; in.vv[j] = ok ? bf2f(v) : 0.f; }
}
#ifndef HG_NORAW
#define HG_BAR() do { asm volatile("s_waitcnt lgkmcnt(0)" ::: "memory"); __builtin_amdgcn_s_barrier(); asm volatile("" ::: "memory"); } while (0)
#else
#define HG_BAR() __syncthreads()
#endif
#define HG_BAR_UNUSED()
__device__ __forceinline__ void hgrnA_compute(Frame& F, int id, const HgIn& in) {
    const bool meta = id >= 1024; const int bh = meta ? 0 : id >> 6, c = id & 63, h = meta ? id - 1024 : bh & 3, b = bh >> 2;
    const int row0 = meta ? MR : b * SEQ + c * 64, nvalid = meta ? NM : 64;
    const int d = F.tid & 127, i = F.tid >> 7;
    LAS unsigned char* L = F.lds + RING_OFF;
    const float (&lf)[16] = in.lf; const float (&qv)[16] = in.qv; const float (&vv)[16] = in.vv;
    float Lc[16]; { float s = 0.f;
#pragma unroll
        for (int j = 0; j < 16; ++j) { s += lf[j]; Lc[j] = s; } }
    LAS float* TOT = (LAS float*)(L + HA_TOT);
    TOT[i * 128 + d] = Lc[15];
    HG_BAR();
    float rho[4]; { float s = 0.f;
#pragma unroll
        for (int j = 0; j < 4; ++j) { s += TOT[j * 128 + d]; rho[j] = s; } }
    const float rhoi = (i == 0) ? rho[0] : (i == 1) ? rho[1] : (i == 2) ? rho[2] : rho[3], ri = (i == 0) ? 0.f : (i == 1) ? rho[0] : (i == 2) ? rho[1] : rho[2], glast = rho[3];
    const float fK2 = __expf(glast - rhoi), fQ2 = __expf(rhoi);
    float fQ[4];
#pragma unroll
    for (int jj = 0; jj < 4; ++jj) fQ[jj] = (jj <= i) ? __expf(rhoi - rho[jj]) : 0.f;
    LAS bf16_t* KP = (LAS bf16_t*)(L + HA_KP); LAS bf16_t* QP = (LAS bf16_t*)(L + HA_QP);
    unsigned kt[8], vt[8];
#pragma unroll
    for (int j = 0; j < 16; j += 2) {
        float kp[2], qe[2];
#pragma unroll
        for (int q = 0; q < 2; ++q) { const float G = ri + Lc[j + q], E = __expf(G - rhoi), k = 1.f - __expf(lf[j + q]); kp[q] = k * __builtin_amdgcn_rcpf(E); qe[q] = qv[j + q] * E; }
        const int t = 16 * i + j;
        { const unsigned w = cvt_pk_bf16(kp[0], kp[1]); KP[t * 136 + d] = (bf16_t)(w & 0xffffu); KP[(t + 1) * 136 + d] = (bf16_t)(w >> 16); }
        kt[j >> 1] = cvt_pk_bf16(kp[0] * fK2, kp[1] * fK2); vt[j >> 1] = cvt_pk_bf16(vv[j], vv[j + 1]);
#pragma unroll
        for (int jj = 0; jj < 4; ++jj) if (jj <= i) { const unsigned w = cvt_pk_bf16(qe[0] * fQ[jj], qe[1] * fQ[jj]); const int rb = qp_base(jj) + t - 16 * jj; QP[rb * 136 + d] = (bf16_t)(w & 0xffffu); QP[(rb + 1) * 136 + d] = (bf16_t)(w >> 16); }
        { const unsigned w = cvt_pk_bf16(qe[0] * fQ2, qe[1] * fQ2); bf16_t* hq2 = WSP(bf16_t, WS_HQ2) + (size_t)(row0 + t) * 512 + h * 128 + d;
          if (t < nvalid) hq2[0] = (bf16_t)(w & 0xffffu); if (t + 1 < nvalid) hq2[512] = (bf16_t)(w >> 16); }
    }
    { LAS u32x4* ktp = (LAS u32x4*)(L + HA_KT + d * 144 + i * 32); ktp[0] = (u32x4){kt[0], kt[1], kt[2], kt[3]}; ktp[1] = (u32x4){kt[4], kt[5], kt[6], kt[7]};
      LAS u32x4* vtp = (LAS u32x4*)(L + HA_VT + d * 144 + i * 32); vtp[0] = (u32x4){vt[0], vt[1], vt[2], vt[3]}; vtp[1] = (u32x4){vt[4], vt[5], vt[6], vt[7]}; }
    if (i == 0) WSP(float, WS_DEC)[(size_t)id * 128 + d] = __expf(glast);
    HG_BAR();
    const int w = F.wave, fr = F.lane & 15, fq = F.lane >> 4;
    {
        LAS unsigned char* PB = L + HA_PB;
        for (int blk = w; blk < 16; blk += 8) {
            int it, js;
            if (blk < 10) { it = (blk >= 6) ? 3 : (blk >= 3) ? 2 : (blk >= 1) ? 1 : 0; js = blk - ((it * (it + 1)) >> 1); }
            else { const int q = blk - 10; it = (q < 3) ? 0 : (q < 5) ? 1 : 2; js = (q < 3) ? q + 1 : (q < 5) ? q - 1 : 3; }
            f32x4 acc = (f32x4){0.f, 0.f, 0.f, 0.f};
            if (blk < 10) {
#pragma unroll
                for (int ks = 0; ks < 4; ++ks) {
                    const bf16x8 qa = *(const LAS bf16x8*)(L + HA_QP + ((qp_base(js) + 16 * it - 16 * js + fr) * 136 + 32 * ks + 8 * fq) * 2);
                    const bf16x8 kb = *(const LAS bf16x8*)(L + HA_KP + ((16 * js + fr) * 136 + 32 * ks + 8 * fq) * 2);
                    acc = __builtin_amdgcn_mfma_f32_16x16x32_bf16(kb, qa, acc, 0, 0, 0);
                }
                if (it == js) {
#pragma unroll
                    for (int e = 0; e < 4; ++e) if (4 * fq + e > fr) acc[e] = 0.f;
                }
            }
            u32x2 pw; pw.x = pk2(acc[0], acc[1]); pw.y = pk2(acc[2], acc[3]);
            *(LAS u32x2*)(PB + (16 * it + fr) * 144 + (16 * js + 4 * fq) * 2) = pw;
        }
    }
    HG_BAR();
    {
        const int tb = w >> 1, dv0 = (w & 1) * 4;
        f32x4 acc[4];
#pragma unroll
        for (int q = 0; q < 4; ++q) acc[q] = (f32x4){0.f, 0.f, 0.f, 0.f};
#pragma unroll
        for (int ks = 0; ks < 2; ++ks) {
            const bf16x8 pa = *(const LAS bf16x8*)(L + HA_PB + (16 * tb + fr) * 144 + (32 * ks + 8 * fq) * 2);
#pragma unroll
            for (int q = 0; q < 4; ++q) { const bf16x8 vb = *(const LAS bf16x8*)(L + HA_VT + (16 * (dv0 + q) + fr) * 144 + (32 * ks + 8 * fq) * 2);
                acc[q] = __builtin_amdgcn_mfma_f32_16x16x32_bf16(vb, pa, acc[q], 0, 0, 0); }
        }
        const int t = 16 * tb + fr;
        if (t < nvalid) {
#pragma unroll
            for (int q = 0; q < 4; ++q) *(f32x4*)(WSP(float, WS_OI) + (size_t)(row0 + t) * 512 + h * 128 + 16 * (dv0 + q) + 4 * fq) = acc[q];
        }
    }
    {
        f32x4 acc[8];
#pragma unroll
        for (int q = 0; q < 8; ++q) acc[q] = (f32x4){0.f, 0.f, 0.f, 0.f};
#pragma unroll
        for (int ks = 0; ks < 2; ++ks) {
            const bf16x8 va = *(const LAS bf16x8*)(L + HA_VT + (16 * w + fr) * 144 + (32 * ks + 8 * fq) * 2);
#pragma unroll
            for (int q = 0; q < 8; ++q) { const bf16x8 kb = *(const LAS bf16x8*)(L + HA_KT + (16 * q + fr) * 144 + (32 * ks + 8 * fq) * 2);
                acc[q] = __builtin_amdgcn_mfma_f32_16x16x32_bf16(kb, va, acc[q], 0, 0, 0); }
        }
        float* DS = WSP(float, WS_DS) + (size_t)id * 16384 + (size_t)(16 * w + fr) * 128;
#pragma unroll
        for (int q = 0; q < 8; ++q) *(f32x4*)(DS + 16 * q + 4 * fq) = acc[q];
    }
    HG_BAR();
}
__device__ __forceinline__ void hgrn_scan(Frame& F) {
    const float* DS = WSP(float, WS_DS); const float* DEC = WSP(float, WS_DEC); bf16_t* ST = WSP(bf16_t, WS_ST);
    const int gt = F.vcu * 512 + F.tid, NT = F.G * 512;
    typedef float f32x2 __attribute__((ext_vector_type(2)));
    for (int idx = gt; idx < 16 * 8192; idx += NT) {
        const int bh = idx >> 13, e2 = (idx & 8191) * 2, dk = e2 & 127, h = bh & 3;
        f32x2 s = *(const GAS f32x2*)(DS + (size_t)(1024 + h) * 16384 + e2);
        for (int c0 = 0; c0 < 64; c0 += 16) {
            f32x2 dd[16], ds[16];
#pragma unroll
            for (int j = 0; j < 16; ++j) { const size_t id = (size_t)bh * 64 + c0 + j; dd[j] = *(const GAS f32x2*)(DEC + id * 128 + dk); ds[j] = *(const GAS f32x2*)(DS + id * 16384 + e2); }
#pragma unroll
            for (int j = 0; j < 16; ++j) { const size_t id = (size_t)bh * 64 + c0 + j; *(GAS unsigned*)(ST + id * 16384 + e2) = pk2(s.x, s.y); s = dd[j] * s + ds[j]; }
        }
    }
}
__device__ __forceinline__ void hgrnC_pass(Frame& F, const float* og) {
    const bf16_t* HQ = WSP(bf16_t, WS_HQ2); const bf16_t* HG = WSP(bf16_t, WS_HG); const float* OI = WSP(float, WS_OI); const bf16_t* ST = WSP(bf16_t, WS_ST); bf16_t* U = WSP(bf16_t, WS_U);
    const int gw = F.vcu * NWAVES + F.wave, NGW = F.G * NWAVES, fr = F.lane & 15, fq = F.lane >> 4;
    for (int task = gw; task < 1024 * 4 + 4; task += NGW) {
        const bool meta = task >= 4096; const int id = meta ? 0 : task >> 2, tb = meta ? 0 : task & 3, bh = id >> 6, c = id & 63, h = meta ? task - 4096 : bh & 3, b = bh >> 2;
        const int row = (meta ? MR : b * SEQ + c * 64 + 16 * tb) + fr;
        f32x4 acc[8], og4[8]; u32x2 hg2[8];
#pragma unroll
        for (int q = 0; q < 8; ++q) { acc[q] = *(const GAS f32x4*)(OI + (size_t)row * 512 + h * 128 + 16 * q + 4 * fq);
            og4[q] = *(const GAS f32x4*)(og + 16 * q + 4 * fq); hg2[q] = *(const GAS u32x2*)(HG + (size_t)row * 512 + h * 128 + 16 * q + 4 * fq); }
        if (!meta) {
            const bf16_t* Sb = ST + (size_t)id * 16384;
#pragma unroll
            for (int ks = 0; ks < 4; ++ks) {
                const bf16x8 qa = *(const bf16x8*)(HQ + (size_t)row * 512 + h * 128 + 32 * ks + 8 * fq);
#pragma unroll
                for (int q = 0; q < 8; ++q) { const bf16x8 sb = *(const bf16x8*)(Sb + (size_t)(16 * q + fr) * 128 + 32 * ks + 8 * fq);
                    acc[q] = __builtin_amdgcn_mfma_f32_16x16x32_bf16(sb, qa, acc[q], 0, 0, 0); }
            }
        }
        float ss = 0.f;
#pragma unroll
        for (int q = 0; q < 8; ++q) ss += (acc[q][0] * acc[q][0] + acc[q][1] * acc[q][1]) + (acc[q][2] * acc[q][2] + acc[q][3] * acc[q][3]);
        ss = xadd<16>(ss); ss = xadd<32>(ss);
        const float sc = rsqrtf(ss * (1.f / 128.f) + EPS);
#pragma unroll
        for (int q = 0; q < 8; ++q) { const int dv = 16 * q + 4 * fq; const f32x4 g = og4[q]; const u32x2 gg = hg2[q];
            u32x2 o; o.x = pk2(acc[q][0] * sc * g[0] * bflo(gg.x), acc[q][1] * sc * g[1] * bfhi(gg.x)); o.y = pk2(acc[q][2] * sc * g[2] * bflo(gg.y), acc[q][3] * sc * g[3] * bfhi(gg.y));
            *(GAS u32x2*)(U + (size_t)row * 1536 + 1024 + h * 128 + dv) = o; }
    }
}
struct TokInfo { int e1, s1, e2, s2; float w1, w2; int pad0, pad1; };
__device__ __forceinline__ void convert_moe_gu(Frame& F, int early = -1, int widx = 0, int nw = 1, int skip = -1) {
    LAS float* scr = early >= 0 ? (LAS float*)(F.lds + RING_OFF + F.wave * 16384) : (LAS float*)(F.lds + RING_OFF + 32768 + F.wave * 8704);
    const int gw = early >= 0 ? widx : F.vcu * NWAVES + F.wave, NGW = early >= 0 ? nw : F.G * NWAVES;
    constexpr int I_GU = 16 * 224;
    const int ne = early >= 0 ? 1 : (skip >= 0 ? NE - 1 : NE);
    const auto dec = [&](int it) -> CvtItem { int e = it / I_GU; const int r = it - e * I_GU, kb = r / 224, db = r % 224, tile = db >> 3, l32 = db & 7;
        e = early >= 0 ? early : (skip >= 0 && e >= skip ? e + 1 : e);
        const float* src = ((l32 < 4) ? F.in[19] : F.in[20]) + (size_t)e * D * FFE;
        return CvtItem{src, FFE, kb * 64, tile * 128 + (l32 & 3) * 32, F.ws + WS_MGU + (size_t)e * 7168 * D, D, db * 32}; };
    cvt_run<true>(gw, NGW, ne * I_GU, dec, scr, F.lane, W8_SCALE);
}
__device__ __forceinline__ void convert_moe_down(Frame& F, int widx, int nw) {
    LAS float* scr = (LAS float*)(F.lds + RING_OFF + F.wave * 16384);
    constexpr int I_DN = 56 * 32;
    const auto dec = [&](int it) -> CvtItem { const int e = it / I_DN, r = it - e * I_DN, kb = r >> 5, db = r & 31;
        return CvtItem{F.in[21] + (size_t)e * FFE * D, D, kb * 64, db * 32, F.ws + WS_MD + (size_t)e * D * FFE, FFE, db * 32}; };
    cvt_run<true>(widx, nw, NE * I_DN, dec, scr, F.lane, WD8_SCALE);
}
__device__ __forceinline__ void norm_route_pass(Frame& F, const float* gain) {
    LAS float* rwl = (LAS float*)(F.lds + RING_OFF);
    for (int i = F.tid; i < D * NE / 4; i += 512) ((LAS f32x4*)rwl)[i] = ((const f32x4*)F.in[18])[i];
    __syncthreads();
    const int gw = F.vcu * NWAVES + F.wave, NGW = F.G * NWAVES;
    f32x4 gv[4];
#pragma unroll
    for (int j = 0; j < 4; ++j) gv[j] = ((const f32x4*)gain)[F.lane + 64 * j];
    unsigned* cnt = (unsigned*)(F.ws + WS_CTL) + CW_CNT; int* lists = (int*)(F.ws + WS_SMALL + SMB_LIST); TokInfo* ti = (TokInfo*)(F.ws + WS_SMALL + SMB_TOK);
    f32x4 vn[4];
    { const GAS f32x4* x0 = (const GAS f32x4*)(F.out + (size_t)(gw < MR ? gw : 0) * D) + F.lane;
#pragma unroll
      for (int j = 0; j < 4; ++j) vn[j] = x0[64 * j]; }
    for (int r = gw; r < MR; r += NGW) {
        f32x4 v[4]; float s = 0.f;
#pragma unroll
        for (int j = 0; j < 4; ++j) v[j] = vn[j];
        { const int rn = r + NGW; const GAS f32x4* xn = (const GAS f32x4*)(F.out + (size_t)(rn < MR ? rn : r) * D) + F.lane;
#pragma unroll
          for (int j = 0; j < 4; ++j) vn[j] = xn[64 * j]; }
#pragma unroll
        for (int j = 0; j < 4; ++j) s += (v[j].x * v[j].x + v[j].y * v[j].y) + (v[j].z * v[j].z + v[j].w * v[j].w);
        const float sc = rsqrtf(wave_sum(s) * (1.f / D) + EPS);
        GAS unsigned* o = (GAS unsigned*)(F.ws + WS_HN + (size_t)r * D) + F.lane;
        float lg[8];
#pragma unroll
        for (int e = 0; e < 8; ++e) lg[e] = 0.f;
#pragma unroll
        for (int j = 0; j < 4; ++j) {
            v[j] = v[j] * sc * gv[j];
            o[64 * j] = pk4_fp8(v[j].x, v[j].y, v[j].z, v[j].w);
#pragma unroll
            for (int q = 0; q < 4; ++q) { const int d = (F.lane + 64 * j) * 4 + q; const f32x4 r0 = *(const LAS f32x4*)(rwl + d * 8), r1 = *(const LAS f32x4*)(rwl + d * 8 + 4); const float x = v[j][q];
                lg[0] += x * r0[0]; lg[1] += x * r0[1]; lg[2] += x * r0[2]; lg[3] += x * r0[3]; lg[4] += x * r1[0]; lg[5] += x * r1[1]; lg[6] += x * r1[2]; lg[7] += x * r1[3]; }
        }
#pragma unroll
        for (int e = 0; e < 8; ++e) lg[e] = wave_sum(lg[e]);
        int i1 = 0; float m1 = lg[0];
#pragma unroll
        for (int e = 1; e < 8; ++e) if (lg[e] > m1) { m1 = lg[e]; i1 = e; }
        int i2 = -1; float m2 = -INFINITY;
#pragma unroll
        for (int e = 0; e < 8; ++e) if (e != i1 && lg[e] > m2) { m2 = lg[e]; i2 = e; }
        if (F.lane == 0) {
            const float w1 = 1.f / (1.f + expf(m2 - m1));
            const unsigned s1 = __hip_atomic_fetch_add(cnt + 64 * i1, 1u, RLX_AGENT), s2 = __hip_atomic_fetch_add(cnt + 64 * i2, 1u, RLX_AGENT);
            lists[i1 * LISTCAP + s1] = r; lists[i2 * LISTCAP + s2] = r;
            TokInfo t; t.e1 = i1; t.s1 = (int)s1; t.e2 = i2; t.s2 = (int)s2; t.w1 = w1; t.w2 = 1.f - w1; t.pad0 = 0; t.pad1 = 0; ti[r] = t;
        }
    }
}
struct MoeTiles { int ts[9]; };
__device__ __forceinline__ MoeTiles moe_tiles(Frame& F) {
    MoeTiles m; const unsigned* cnt = (const unsigned*)(F.ws + WS_CTL) + CW_CNT; int a = 0;
#pragma unroll
    for (int e = 0; e < 8; ++e) { m.ts[e] = a; const unsigned c = (unsigned)__builtin_amdgcn_readfirstlane((int)__hip_atomic_load(cnt + 64 * e, RLX_AGENT)); a += (int)((c + 255u) >> 8); }
    m.ts[8] = a; return m;
}
__device__ __forceinline__ int moe_expert_of(const MoeTiles& m, int rt) { int e = 0;
#pragma unroll
    for (int k = 1; k < 8; ++k) e += (rt >= m.ts[k]) ? 1 : 0;
    return e; }
struct MoeGuOrder {
    MoeTiles m; int G, c; const int* lists;
    __device__ __forceinline__ bool next(int i, Unit& u) const {
        const int L = i * G + c; if (L >= m.ts[8] * 28) return false;
        const int rt = L / 28, pn = L - rt * 28, e = moe_expert_of(m, rt);
        int tsb = 0;
#pragma unroll
        for (int k = 0; k < 8; ++k) tsb = (k == e) ? m.ts[k] : tsb;
        u.pm = rt; u.pn = pn; u.z = e; u.a_off = 0u; u.b_off = (unsigned)(((long)e * 7168 + pn * 256) * D); u.gidx = lists + e * LISTCAP + (rt - tsb) * 256; return true;
    }
};
struct MoeDownOrder {
    MoeTiles m; int G, c;
    __device__ __forceinline__ bool next(int i, Unit& u) const {
        const int nt = m.ts[8] < 128 ? m.ts[8] : 128; const int L = i * G + c; if (L >= nt * 4) return false;
        const int rt = L >> 2, pn = L & 3, e = moe_expert_of(m, rt);
        u.pm = rt; u.pn = pn; u.z = e; u.a_off = (unsigned)((long)rt * 256 * FFE); u.b_off = (unsigned)(((long)e * D + pn * 256) * FFE); u.gidx = nullptr; return true;
    }
};
struct MoeSlabOrder {
    MoeTiles m; int G, c, S, Kp;
    __device__ __forceinline__ bool next(int i, Unit& u) const {
        const int nleft = (m.ts[8] - 128) * 4; const int q = i * G + c; if (q >= nleft * S) return false;
        const int up = q / S, sl = q - up * S, rt = 128 + (up >> 2), pn = up & 3, e = moe_expert_of(m, rt);
        u.pm = rt; u.pn = pn; u.z = q; u.a_off = (unsigned)((long)rt * 256 * FFE + (long)sl * Kp * 2); u.b_off = (unsigned)(((long)e * D + pn * 256) * FFE + (long)sl * Kp * 2); u.gidx = nullptr; return true;
    }
};
struct EpiSlab {
    static constexpr bool PERM = false, MID = false;
    float* SL; float sc;
    __device__ __forceinline__ void row(const Unit& u, int r, int slot, int wc, int fq, const f32x4 (&v)[2][2]) const {
        float* p = SL + (size_t)u.z * 65536 + (size_t)(r & 255) * 256 + 32 * wc + 4 * fq;
#pragma unroll
        for (int bj = 0; bj < 2; ++bj)
#pragma unroll
            for (int n = 0; n < 2; ++n) *(f32x4*)(p + 128 * bj + 16 * n) = v[bj][n] * sc;
    }
};
__device__ __forceinline__ void moe_slab_split(int tiles, int G, int& S, int& Kp) { S = 7; Kp = 256; }
struct EpiY {
    static constexpr bool PERM = true, MID = false;
    bf16_t* Y; float sc;
    __device__ __forceinline__ void row(const Unit& u, int r, int slot, int wc, int fq, const f32x4 (&v)[2][2]) const {
#pragma unroll
        for (int bj = 0; bj < 2; ++bj) *(u32x4*)(Y + (size_t)r * D + u.pn * 256 + 128 * bj + 32 * wc + 8 * fq) = pack8(v[bj][0] * sc, v[bj][1] * sc);
    }
};
__device__ __forceinline__ f32x4 moe_y4(const bf16_t* Y, const float* SL, int S, size_t R, int j, int lane) {
    if (R < 32768) { const u32x2 y = *((const GAS u32x2*)(Y + R * D) + lane + 64 * j); return (f32x4){bflo(y.x), bfhi(y.x), bflo(y.y), bfhi(y.y)}; }
    const float* p = SL + ((size_t)(((R >> 8) - 128) * 4 + j) * S) * 65536 + (R & 255) * 256 + 4 * lane; f32x4 a = (f32x4){0.f, 0.f, 0.f, 0.f};
    for (int s0 = 0; s0 < S; s0 += 7) {
        f32x4 q[7];
#pragma unroll
        for (int sl = 0; sl < 7; ++sl) q[sl] = *(const f32x4*)(p + (size_t)(s0 + sl) * 65536);
#pragma unroll
        for (int sl = 0; sl < 7; ++sl) a += q[sl];
    }
    return a;
}
__device__ __forceinline__ void moe_combine_pass(Frame& F) {
    const MoeTiles m = moe_tiles(F); const TokInfo* ti = (const TokInfo*)(F.ws + WS_SMALL + SMB_TOK); const bf16_t* Y = WSP(bf16_t, WS_MY); const float* SL = WSP(float, WS_SLAB);
    int S, Kp; moe_slab_split(m.ts[8], F.G, S, Kp);
    const int gw = F.vcu * NWAVES + F.wave, NGW = F.G * NWAVES;
    TokInfo tn = ti[gw < MR ? gw : 0];
    for (int r = gw; r < MR; r += NGW) {
        const TokInfo t = tn; { const int rn = r + NGW; tn = ti[rn < MR ? rn : r]; }
        int b1 = 0, b2 = 0;
#pragma unroll
        for (int k = 0; k < 8; ++k) { b1 = (k == t.e1) ? m.ts[k] : b1; b2 = (k == t.e2) ? m.ts[k] : b2; }
        const size_t r1 = (size_t)b1 * 256 + t.s1, r2 = (size_t)b2 * 256 + t.s2;
        GAS f32x4* o = (GAS f32x4*)(F.out + (size_t)r * D) + F.lane;
        if (r1 < 32768 && r2 < 32768) {
            u32x2 y1[4], y2[4]; f32x4 x[4];
#pragma unroll
            for (int j = 0; j < 4; ++j) { y1[j] = *((const GAS u32x2*)(Y + r1 * D) + F.lane + 64 * j); y2[j] = *((const GAS u32x2*)(Y + r2 * D) + F.lane + 64 * j); x[j] = o[64 * j]; }
#pragma unroll
            for (int j = 0; j < 4; ++j) { x[j][0] += t.w1 * bflo(y1[j].x) + t.w2 * bflo(y2[j].x); x[j][1] += t.w1 * bfhi(y1[j].x) + t.w2 * bfhi(y2[j].x); x[j][2] += t.w1 * bflo(y1[j].y) + t.w2 * bflo(y2[j].y); x[j][3] += t.w1 * bfhi(y1[j].y) + t.w2 * bfhi(y2[j].y); o[64 * j] = x[j]; }
        } else {
#pragma unroll
            for (int j = 0; j < 4; ++j) { const f32x4 y1 = moe_y4(Y, SL, S, r1, j, F.lane), y2 = moe_y4(Y, SL, S, r2, j, F.lane); o[64 * j] = o[64 * j] + y1 * t.w1 + y2 * t.w2; }
        }
    }
}
}
namespace mk {
enum { P_CVT = 0, P_NORM1, P_PROJ, P_MIX, P_SCAN, P_FIN, P_GATES, P_MERGE, P_WOUT, P_NORM2, P_GU, P_DOWN, P_COMB, P_NPH };
struct Args { const float* in[22]; float* out; unsigned char* ws; unsigned pmask; int l0, l1; unsigned dup; };

#define PH(k) ((a.pmask >> (k)) & 1u)
#define PHASE_FRAME() Frame F = F0; { const int t_ = pg8::make_tid(F0.wave); F.tid = t_; F.lane = t_ & 63; F.wave = F0.wave; unsigned char* w_ = F0.ws; asm volatile("" : "+s"(w_)); F.ws = w_; int g_ = F0.G, v_ = F0.vcu; asm volatile("" : "+s"(g_), "+s"(v_)); F.G = g_; F.vcu = v_; } float* sm = SMALLF; (void)sm
#define GRID_BAR() xcd_barrier(bar, F.tid)
template <int l> __device__ __forceinline__ void layer_body(const Args& a, const Frame& F0, const XcdBarrier& bar, unsigned char* lds) {
    constexpr bool first = (l == 0);
#ifndef NO_P_CVT
        if (PH(P_CVT) && l == 0) for (int rep_ = 0; rep_ <= (int)((a.dup >> (16 + l)) & (a.dup >> P_CVT) & 1u); ++rep_) { PHASE_FRAME(); setup_small(F); if (F.G == 256) { if (F.vcu != 0) convert_layer_weights(F, 0, (F.vcu - 1) * NWAVES + F.wave, (F.G - 1) * NWAVES, 1); }   else convert_layer_weights(F, 0, -1, 0, 0); }
#endif
#ifndef NO_P_NORM1
        if (PH(P_NORM1)) for (int rep_ = 0; rep_ <= (int)((a.dup >> (16 + l)) & (a.dup >> P_NORM1) & 1u); ++rep_) { PHASE_FRAME(); norm_pass(F, F.in[2] + l * D, first, true); GRID_BAR(); }
#endif
#ifndef NO_P_PROJ
        if (PH(P_PROJ)) for (int rep_ = 0; rep_ <= (int)((a.dup >> (16 + l)) & (a.dup >> P_PROJ) & 1u); ++rep_) { PHASE_FRAME();
            Gemm g{WSP(bf16_t, WS_HN), WSP(bf16_t, WS_WIN), D, D, D}; TileOrder S; S.init(64, 20, 0, F.G, (int)blockIdx.x, D, D);
            EpiProj E{F.ws, F.in[5] + l * 64, F.in[6] + l * 64, l, 1.f};
            pg8::gemm_phase<EpiProj, TileOrder>(F.lds + RING_OFF, g, S, E, F.wave);
            meta_gemm(F, WSP(bf16_t, WS_HN) + (size_t)MR * D, D, WSP(bf16_t, WS_WIN), D, D, 0, 20, E);
            GRID_BAR();
        }
#endif
#ifndef NO_P_MIX
        if (PH(P_MIX)) for (int rep_ = 0; rep_ <= (int)((a.dup >> (16 + l)) & (a.dup >> P_MIX) & 1u); ++rep_) { PHASE_FRAME();
            if (!(a.dup & 0x8000u) || rep_ == 0) {
                if (F.G == 256) {
                    const bool hm = (F.vcu & 7) == 0 && F.vcu < 32; const int idm = 1024 + (F.vcu >> 3);
                    HgIn A, B; hgrnA_load(F, F.vcu, A); hgrnA_load(F, F.vcu + 256, B); hgrnA_compute(F, F.vcu, A);
                    hgrnA_load(F, F.vcu + 512, A); hgrnA_compute(F, F.vcu + 256, B); hgrnA_load(F, F.vcu + 768, B); hgrnA_compute(F, F.vcu + 512, A);
                    if (hm) hgrnA_load(F, idm, A);
                    hgrnA_compute(F, F.vcu + 768, B); if (hm) hgrnA_compute(F, idm, A); }
                else for (int id = F.vcu; id < 1028; id += F.G) { HgIn A; hgrnA_load(F, id, A); hgrnA_compute(F, id, A); }
            }
            if (rep_ == 1 && !(a.dup & 0x8000u)) { GRID_BAR(); continue; }
            conv_pass(F, F.in[10] + l * 1536);
            { LAS float* tabl = (LAS float*)(F.lds + RING_OFF + attn_body::LDS_TAB); tabl[F.tid] = sm[SM_TAB + F.tid]; }
            __syncthreads();
            { int b, vh, qb;
              for (int i = 0; attn_body::attn_next(F.G, F.vcu, i, b, vh, qb); ++i)
                  attn_body::attn_unit<8>(b, vh, qb, (const attn_body::bf16*)WSP(bf16_t, WS_QK), (const attn_body::bf16*)WSP(bf16_t, WS_V), (attn_body::bf16*)WSP(bf16_t, WS_O), (char*)lds + RING_OFF, F.wave); }
            if (l == 0 && F.G == 256) {
                const int g = F.vcu & 7, bv = F.vcu >> 3;
                if (g != 7 && !(g == 0 && bv < 4)) { const int idx = bv < 4 ? bv * 6 + (g - 1) : 24 + (bv - 4) * 7 + g; convert_layer_weights(F, 0, idx * NWAVES + F.wave, 220 * NWAVES, 2); } }
            if (l == 1 && F.G == 256) {
                const int g = F.vcu & 7, bv = F.vcu >> 3;
                if (g != 7 && !(g == 0 && bv < 4)) { const int idx = bv < 4 ? bv * 6 + (g - 1) : 24 + (bv - 4) * 7 + g; convert_moe_gu(F, 3, idx * NWAVES + F.wave, 220 * NWAVES); } }
            GRID_BAR();
        }
#endif
#ifndef NO_P_SCAN
        if (PH(P_SCAN)) for (int rep_ = 0; rep_ <= (int)((a.dup >> (16 + l)) & (a.dup >> P_SCAN) & 1u); ++rep_) { PHASE_FRAME(); hgrn_scan(F); GRID_BAR(); }
#endif
#ifndef NO_P_FIN
        if (PH(P_FIN)) for (int rep_ = 0; rep_ <= (int)((a.dup >> (16 + l)) & (a.dup >> P_FIN) & 1u); ++rep_) { PHASE_FRAME(); hgrnC_pass(F, F.in[12] + l * 128); attcomb_pass(F, F.in[8] + l * 128, l); }
#endif
#ifndef NO_P_GATES
        if (PH(P_GATES)) for (int rep_ = 0; rep_ <= (int)((a.dup >> (16 + l)) & (a.dup >> P_GATES) & 1u); ++rep_) { PHASE_FRAME();
            Gemm g{(const bf16_t*)(F.ws + WS_HN8), (const bf16_t*)(F.ws + WS_WIN8 - (size_t)20 * 256 * D), D / 2, D / 2, D / 2}; TileOrder S; S.init(64, 12, 20, F.G, (int)blockIdx.x, D / 2, D / 2);
            EpiProj E{F.ws, F.in[5] + l * 64, F.in[6] + l * 64, l, 1.f / W8_SCALE};
            pg8::gemm_phase<EpiProj, TileOrder, false, true>(F.lds + RING_OFF, g, S, E, F.wave);
            if (l == 0) { EpiProj Em{F.ws, F.in[5] + l * 64, F.in[6] + l * 64, l, 1.f}; meta_gemm(F, WSP(bf16_t, WS_HN) + (size_t)MR * D, D, WSP(bf16_t, WS_WIN), D, D, 20, 32, Em); }
            GRID_BAR();
        }
#endif
#ifndef NO_P_MERGE
        if (PH(P_MERGE)) for (int rep_ = 0; rep_ <= (int)((a.dup >> (16 + l)) & (a.dup >> P_MERGE) & 1u); ++rep_) { PHASE_FRAME();
            Gemm g{WSP(bf16_t, WS_U), WSP(bf16_t, WS_WBR), 1536, 1536, 1536}; TileOrder S; S.init(64, 4, 0, F.G, (int)blockIdx.x, 1536, 1536);
            EpiMerge E{WSP(bf16_t, WS_GATES), WSP(bf16_t, WS_MIXED)};
            pg8::gemm_phase<EpiMerge, TileOrder>(F.lds + RING_OFF, g, S, E, F.wave);
            if (l == 0) meta_merge(F, WSP(bf16_t, WS_U) + (size_t)MR * 1536, WSP(bf16_t, WS_WBR), WSP(bf16_t, WS_GATES), WSP(bf16_t, WS_MIXED));
            GRID_BAR();
        }
#endif
#ifndef NO_P_WOUT
        if (PH(P_WOUT)) for (int rep_ = 0; rep_ <= (int)((a.dup >> (16 + l)) & (a.dup >> P_WOUT) & 1u); ++rep_) { PHASE_FRAME();
            Gemm g{WSP(bf16_t, WS_MIXED), WSP(bf16_t, WS_WO), D, D, D}; TileOrder S; S.init(64, 4, 0, F.G, (int)blockIdx.x, D, D);
            EpiRes E{first ? F.in[0] : (const float*)F.out, F.out, first ? F.in[1] : (const float*)(sm + SM_METAHS), sm + SM_METAHS};
            pg8::gemm_phase<EpiRes, TileOrder>(F.lds + RING_OFF, g, S, E, F.wave);
            if (l == 0) meta_gemm(F, WSP(bf16_t, WS_MIXED) + (size_t)MR * D, D, WSP(bf16_t, WS_WO), D, D, 0, 4, E);
            GRID_BAR();
        }
#endif
#ifndef NO_P_NORM2
        if (PH(P_NORM2) && l == 0) for (int rep_ = 0; rep_ <= (int)((a.dup >> (16 + l)) & (a.dup >> P_NORM2) & 1u); ++rep_) { PHASE_FRAME(); norm_pass(F, F.in[3] + l * D, false, false); if (PH(P_CVT)) setup_small(F, false); GRID_BAR(); }
        if (PH(P_NORM2) && l == 1) for (int rep_ = 0; rep_ <= (int)((a.dup >> (16 + l)) & (a.dup >> P_NORM2) & 1u); ++rep_) { PHASE_FRAME(); norm_route_pass(F, F.in[3] + l * D); convert_moe_gu(F, -1, 0, 1, F.G == 256 ? 3 : -1); GRID_BAR(); }
#endif
#ifndef NO_P_GU
        if (PH(P_GU) && l == 0) for (int rep_ = 0; rep_ <= (int)((a.dup >> (16 + l)) & (a.dup >> P_GU) & 1u); ++rep_) { PHASE_FRAME();
            Gemm g{WSP(bf16_t, WS_HN), WSP(bf16_t, WS_WGU0), D, D, D}; TileOrder S; S.init(64, 22, 0, F.G, (int)blockIdx.x, D, D);
            EpiGU E{WSP(bf16_t, WS_H0), FFD, 1.f};
            pg8::gemm_phase<EpiGU, TileOrder>(F.lds + RING_OFF, g, S, E, F.wave);
            { const int rem_ = (64 * 22) % F.G, bx_ = (int)blockIdx.x;
              if (rem_ == 0) meta_gemm(F, WSP(bf16_t, WS_HN) + (size_t)MR * D, D, WSP(bf16_t, WS_WGU0), D, D, 0, 22, E);
              else if (bx_ >= rem_) meta_gemm(F, WSP(bf16_t, WS_HN) + (size_t)MR * D, D, WSP(bf16_t, WS_WGU0), D, D, 0, 22, E, bx_ - rem_, F.G - rem_); }
            if (PH(P_CVT) && rep_ == 0) { const int total = 64 * 22, rem = total % F.G, bx = (int)blockIdx.x;
              if (rem == 0) convert_layer_weights(F, 1, bx * NWAVES + F.wave, F.G * NWAVES); else if (bx >= rem) convert_layer_weights(F, 1, (bx - rem) * NWAVES + F.wave, (F.G - rem) * NWAVES); }
            GRID_BAR();
        }
#endif
#ifndef NO_P_DOWN
        if (PH(P_DOWN) && l == 0) for (int rep_ = 0; rep_ <= (int)((a.dup >> (16 + l)) & (a.dup >> P_DOWN) & 1u); ++rep_) { PHASE_FRAME();
            Gemm g{WSP(bf16_t, WS_H0), WSP(bf16_t, WS_WD0), FFD, FFD, FFD}; TileOrder S; S.init(64, 4, 0, F.G, (int)blockIdx.x, FFD, FFD);
            EpiRes E{(const float*)F.out, F.out, (const float*)(sm + SM_METAHS), sm + SM_METAHS};
            pg8::gemm_phase<EpiRes, TileOrder>(F.lds + RING_OFF, g, S, E, F.wave);
            meta_gemm(F, WSP(bf16_t, WS_H0) + (size_t)MR * FFD, FFD, WSP(bf16_t, WS_WD0), FFD, FFD, 0, 4, E);
            GRID_BAR();
        }
#endif
#ifndef NO_P_MOE
        if (PH(P_GU) && l == 1) for (int rep_ = 0; rep_ <= (int)((a.dup >> (16 + l)) & (a.dup >> P_GU) & 1u); ++rep_) { PHASE_FRAME();
            Gemm g{WSP(bf16_t, WS_HN), WSP(bf16_t, WS_MGU), D / 2, D / 2, D / 2};   MoeGuOrder S{moe_tiles(F), F.G, (int)blockIdx.x, (const int*)(F.ws + WS_SMALL + SMB_LIST)};
            EpiGU8 E{F.ws + WS_MH, FFE, 1.f / W8_SCALE};
            pg8::gemm_phase<EpiGU8, MoeGuOrder, true, true>(F.lds + RING_OFF, g, S, E, F.wave);
            { const int total = S.m.ts[8] * 28, rem = total % F.G, bx = (int)blockIdx.x;
              if (rem == 0) convert_moe_down(F, bx * NWAVES + F.wave, F.G * NWAVES); else if (bx >= rem) convert_moe_down(F, (bx - rem) * NWAVES + F.wave, (F.G - rem) * NWAVES); }
            GRID_BAR();
        }
        if (PH(P_DOWN) && l == 1) for (int rep_ = 0; rep_ <= (int)((a.dup >> (16 + l)) & (a.dup >> P_DOWN) & 1u); ++rep_) { PHASE_FRAME();
            Gemm g{WSP(bf16_t, WS_MH), WSP(bf16_t, WS_MD), FFE / 2, FFE / 2, FFE / 2};   MoeDownOrder S{moe_tiles(F), F.G, (int)blockIdx.x};
            EpiY E{WSP(bf16_t, WS_MY), 1.f / (H8_SCALE * WD8_SCALE)};
            pg8::gemm_phase<EpiY, MoeDownOrder, false, true>(F.lds + RING_OFF, g, S, E, F.wave);
            { int SS, Kp; moe_slab_split(S.m.ts[8], F.G, SS, Kp);
              Gemm g2{WSP(bf16_t, WS_MH), WSP(bf16_t, WS_MD), FFE / 2, FFE / 2, Kp}; MoeSlabOrder S2{S.m, F.G, (int)blockIdx.x, SS, Kp}; EpiSlab E2{WSP(float, WS_SLAB), 1.f / (H8_SCALE * WD8_SCALE)};
              pg8::gemm_phase<EpiSlab, MoeSlabOrder, false, true>(F.lds + RING_OFF, g2, S2, E2, F.wave); }
            GRID_BAR();
        }
        if (PH(P_COMB) && l == 1) for (int rep_ = 0; rep_ <= (int)((a.dup >> (16 + l)) & (a.dup >> P_COMB) & 1u); ++rep_) { PHASE_FRAME(); moe_combine_pass(F); if (rep_ < (int)((a.dup >> (16 + l)) & (a.dup >> P_COMB) & 1u)) GRID_BAR(); }
#endif
}
__global__ void __launch_bounds__(NWAVES * 64, 2) mega(Args a) {
    extern __shared__ __attribute__((aligned(16))) unsigned char lds[];
    Frame F0; Frame& F = F0;
    F.lds = (LAS unsigned char*)lds; F.lds_gen = lds;
    F.wave = __builtin_amdgcn_readfirstlane((int)threadIdx.x >> 6); F.tid = pg8::make_tid(F.wave); F.lane = F.tid & 63;
    F.G = gridDim.x; { const int bx = blockIdx.x; F.vcu = (F.G % 8 == 0) ? (bx % 8) * (F.G / 8) + bx / 8 : bx; }
    F.in = a.in; F.out = a.out; F.ws = a.ws;
    for (int u = F.tid; u < (LDS_BYTES - LDSCTL_OFF) / 4; u += NWAVES * 64) ((LAS unsigned*)(F.lds + LDSCTL_OFF))[u] = 0u;
    __syncthreads();
    volatile LAS unsigned* MISC = (volatile LAS unsigned*)(F.lds + MISC_OFF);
    XcdBarrier bar = xcd_barrier_post((unsigned*)(F.ws + WS_CTL) + 4096, MISC + 8, F.tid);
    if (a.l0 <= 0 && 0 < a.l1) layer_body<0>(a, F0, bar, lds);
    if (a.l0 <= 1 && 1 < a.l1) layer_body<1>(a, F0, bar, lds);
}
#undef PH
#undef GRID_BAR


#ifndef MK_DUP
#define MK_DUP 0u
#endif
static int g_grid = 0;
static bool mega_init() {
    if (g_grid) return g_grid > 0;
    int dev = 0, cus = 0, per_cu = 0;
    if (hipGetDevice(&dev) != hipSuccess || hipDeviceGetAttribute(&cus, hipDeviceAttributeMultiprocessorCount, dev) != hipSuccess) { g_grid = -1; return false; }
    if (hipFuncSetAttribute((const void*)mega, hipFuncAttributeMaxDynamicSharedMemorySize, LDS_BYTES) != hipSuccess) { g_grid = -1; return false; }
    if (hipOccupancyMaxActiveBlocksPerMultiprocessor(&per_cu, (const void*)mega, NWAVES * 64, LDS_BYTES) != hipSuccess || per_cu < 1) { fprintf(stderr, "mega: occupancy query says %d\n", per_cu); }
    (void)hipGetLastError();
    g_grid = cus;
    return true;
}
static void mega_launch(void* const* d_in, float* out, unsigned char* ws, unsigned pmask, int l0, int l1, hipStream_t st) {
    if (!mega_init()) return;
    (void)hipMemsetAsync(ws + WS_CTL, 0, CTL_ZERO_BYTES, st);
    Args a{};
    for (int i = 0; i < 22; ++i) a.in[i] = (const float*)d_in[i];
    a.out = out; a.ws = ws; a.pmask = pmask; a.l0 = l0; a.l1 = l1; a.dup = MK_DUP;
    hipLaunchKernelGGL(mega, dim3(g_grid), dim3(NWAVES * 64), LDS_BYTES, st, a);
}
}
extern "C" void kernel_launch(void* const* d_in, const int* in_sizes, int n_in, void* d_out, int out_size, void* d_ws, size_t ws_size, hipStream_t stream) {
    (void)in_sizes; (void)n_in; (void)out_size;
    if (ws_size < (size_t)512 * (1u << 20)) { fprintf(stderr, "kernel_launch: workspace too small (%zu)\n", ws_size); return; }
    mk::mega_launch(d_in, (float*)d_out, (unsigned char*)d_ws, (1u << mk::P_NPH) - 1u, 0, 2, stream);
}
```
